# Optimizing an MI355X kernel written in HIP

```python
import jax, jax.numpy as jnp
from jax import lax
import numpy as np

D_MODEL = 1024
BATCH = 8
SEQ = 4096
DEPTH = 2

PLE_DIM = 256
MIX_WIDTH = D_MODEL
POOL_WIDTH = MIX_WIDTH // 2
POOL_WINDOWS = (2, 4, 8, 16)
N_POOL_GROUPS = len(POOL_WINDOWS)
POOL_GROUP_DIM = POOL_WIDTH // N_POOL_GROUPS
SB_WIDTH = MIX_WIDTH - POOL_WIDTH
SB_HEAD_DIM = 64
SB_HEADS = SB_WIDTH // SB_HEAD_DIM
SB_BLOCK = 128
GDN_HEAD_DIM = 128
GDN_HEADS = MIX_WIDTH // GDN_HEAD_DIM
GDN_CONV = 4
GDN_CHUNK = 64
FFN_DIM = 2816
FFN_CONV = 3
EPS = 1e-6
N_EVEN = (DEPTH + 1) // 2
N_ODD = DEPTH // 2
EVEN_IN = POOL_WIDTH + 3 * SB_WIDTH
ODD_IN = 4 * MIX_WIDTH + 2 * GDN_HEADS

kernel_name = 'hybrid_pool_stickbreak_gdn_convffn_ple'


def rmsnorm(x, gain):
    xf = x.astype(jnp.float32)
    y = xf * lax.rsqrt(jnp.mean(xf * xf, axis=-1, keepdims=True) + EPS)
    return (y * gain.astype(jnp.float32)).astype(x.dtype)


def l2norm(x):
    return x * lax.rsqrt(jnp.sum(x * x, axis=-1, keepdims=True) + EPS)


def causal_dwconv(x, w):
    K = w.shape[0]
    T = x.shape[1]
    xp = jnp.pad(x, ((0, 0), (K - 1, 0), (0, 0)))
    return sum(xp[:, i:i + T] * w[i] for i in range(K))


def pool_mixer(u, pool_w, pool_scale):
    B, T, _ = u.shape
    ug = u.reshape(B, T, N_POOL_GROUPS, POOL_GROUP_DIM).astype(jnp.float32)
    cs = jnp.pad(jnp.cumsum(ug, axis=1), ((0, 0), (1, 0), (0, 0), (0, 0)))
    t = jnp.arange(T)
    win = jnp.array(POOL_WINDOWS, dtype=jnp.int32)
    start = jnp.maximum(t[:, None] + 1 - win[None, :], 0)
    g_idx = jnp.arange(N_POOL_GROUPS)[None, :]
    window_sum = cs[:, 1:] - cs[:, start, g_idx]
    count = (t[:, None] + 1 - start).astype(jnp.float32)
    y = window_sum / count[None, :, :, None] - ug
    y = jnp.einsum('btgc,gcd->btgd', y, pool_w.astype(jnp.float32))
    return (y.reshape(B, T, POOL_WIDTH) * pool_scale.astype(jnp.float32)).astype(u.dtype)


def stick_breaking_attention(q, k, v):
    T = q.shape[2]
    scale = SB_HEAD_DIM ** -0.5
    vf = v.astype(jnp.float32)
    outs = []
    for blk in range(T // SB_BLOCK):
        q0 = blk * SB_BLOCK
        end = q0 + SB_BLOCK
        z = jnp.einsum('bhqd,bhkd->bhqk', q[:, :, q0:end], k[:, :, :end]).astype(jnp.float32) * scale
        q_pos = q0 + jnp.arange(SB_BLOCK)
        k_pos = jnp.arange(end)
        valid = k_pos[None, :] < q_pos[:, None]
        log_1m = jnp.where(valid, jax.nn.log_sigmoid(-z), 0.0)
        log_keep = lax.cumsum(log_1m, axis=3, reverse=True) - log_1m
        a = jnp.where(valid, jnp.exp(jax.nn.log_sigmoid(z) + log_keep), 0.0)
        outs.append(jnp.einsum('bhqk,bhkd->bhqd', a, vf[:, :, :end]))
    return jnp.concatenate(outs, axis=2).astype(v.dtype)


def gated_delta_rule_chunked(q, k, v, g, beta):
    B, H, T, dk = q.shape
    dv = v.shape[-1]
    n = T // GDN_CHUNK
    q = q * dk ** -0.5

    def chunks(a):
        return a.reshape(B, H, n, GDN_CHUNK, *a.shape[3:])

    q, k, v, g, beta = chunks(q), chunks(k), chunks(v), chunks(g), chunks(beta)
    gc = jnp.cumsum(g, axis=-1)
    idx = jnp.arange(GDN_CHUNK)
    incl = idx[:, None] >= idx[None, :]
    strict = idx[:, None] > idx[None, :]
    decay = jnp.where(incl, jnp.exp(jnp.where(incl, gc[..., :, None] - gc[..., None, :], 0.0)), 0.0)
    k_beta = k * beta[..., None]
    a_mat = jnp.where(strict, jnp.einsum('bhncd,bhnsd->bhncs', k_beta, k) * decay, 0.0)
    rhs = jnp.concatenate([v * beta[..., None], k_beta * jnp.exp(gc)[..., None]], axis=-1)
    sol = lax.linalg.triangular_solve(jnp.eye(GDN_CHUNK, dtype=a_mat.dtype) + a_mat, rhs,
                                      left_side=True, lower=True, unit_diagonal=True)
    u, w = sol[..., :dv], sol[..., dv:]
    qk = jnp.einsum('bhncd,bhnsd->bhncs', q, k) * decay
    q_dec = q * jnp.exp(gc)[..., None]
    k_dec = k * jnp.exp(gc[..., -1:] - gc)[..., None]
    g_last = jnp.exp(gc[..., -1])
    xs = (jnp.moveaxis(qk, 2, 0), jnp.moveaxis(u, 2, 0), jnp.moveaxis(w, 2, 0),
          jnp.moveaxis(q_dec, 2, 0), jnp.moveaxis(k_dec, 2, 0), jnp.moveaxis(g_last, 2, 0))

    def step(state, inp):
        qk_c, u_c, w_c, q_c, k_c, gl = inp
        v_new = u_c - jnp.einsum('bhcd,bhde->bhce', w_c, state)
        o = jnp.einsum('bhcd,bhde->bhce', q_c, state) + jnp.einsum('bhcs,bhse->bhce', qk_c, v_new)
        state = state * gl[..., None, None] + jnp.einsum('bhcd,bhce->bhde', k_c, v_new)
        return state, o

    s0 = jnp.zeros((B, H, dk, dv), jnp.float32)
    _, o = lax.scan(step, s0, xs)
    return jnp.moveaxis(o, 0, 2).reshape(B, H, T, dv)


def even_mixer(h, w_in, pool_w, pool_scale, w_out):
    B, T, _ = h.shape
    proj = h @ w_in
    u, q, k, v = jnp.split(proj, [POOL_WIDTH, POOL_WIDTH + SB_WIDTH, POOL_WIDTH + 2 * SB_WIDTH], axis=-1)
    pool_out = pool_mixer(u, pool_w, pool_scale)

    def heads(a):
        return a.reshape(B, T, SB_HEADS, SB_HEAD_DIM).transpose(0, 2, 1, 3)

    attn = stick_breaking_attention(heads(q), heads(k), heads(v))
    attn = attn.transpose(0, 2, 1, 3).reshape(B, T, SB_WIDTH)
    return jnp.concatenate([pool_out, attn], axis=-1) @ w_out


def odd_mixer(h, w_in, conv_w, a_log, dt_bias, norm_w, w_out):
    B, T, _ = h.shape
    proj = h @ w_in
    qkv, z, b, a = jnp.split(proj, [3 * MIX_WIDTH, 4 * MIX_WIDTH, 4 * MIX_WIDTH + GDN_HEADS], axis=-1)
    qkv = jax.nn.silu(causal_dwconv(qkv, conv_w))
    q, k, v = jnp.split(qkv, 3, axis=-1)

    def heads(x_):
        return x_.reshape(B, T, GDN_HEADS, GDN_HEAD_DIM).transpose(0, 2, 1, 3).astype(jnp.float32)

    q, k, v = l2norm(heads(q)), l2norm(heads(k)), heads(v)
    beta = jax.nn.sigmoid(b.astype(jnp.float32)).transpose(0, 2, 1)
    g = (-jnp.exp(a_log.astype(jnp.float32))
         * jax.nn.softplus(a.astype(jnp.float32) + dt_bias.astype(jnp.float32))).transpose(0, 2, 1)
    o = gated_delta_rule_chunked(q, k, v, g, beta).transpose(0, 2, 1, 3)
    o = o * lax.rsqrt(jnp.mean(o * o, axis=-1, keepdims=True) + EPS) * norm_w.astype(jnp.float32)
    o = o * jax.nn.silu(z.reshape(B, T, GDN_HEADS, GDN_HEAD_DIM).astype(jnp.float32))
    return o.reshape(B, T, MIX_WIDTH).astype(h.dtype) @ w_out


def conv_ffn(h, w_up, conv_w, w_down):
    up = causal_dwconv(h @ w_up, conv_w)
    gate, val = jnp.split(up, 2, axis=-1)
    return (jax.nn.silu(gate) * val) @ w_down


def setup_inputs(seed: int = 0) -> dict:
    key = jax.random.key(seed)
    ks = jax.random.split(key, 24)
    f32 = jnp.float32

    def dense(k_, shape, fan_in):
        return jax.random.normal(k_, shape, f32) * fan_in ** -0.5

    def gain(k_, shape):
        return 1.0 + 0.02 * jax.random.normal(k_, shape, f32)

    dt = jnp.exp(jax.random.uniform(ks[11], (N_ODD, GDN_HEADS), f32, np.log(1e-3), np.log(1e-1)))
    return {
        'x': jax.random.normal(ks[0], (BATCH, SEQ, D_MODEL), f32),
        'p': jax.random.normal(ks[1], (DEPTH, BATCH, SEQ, PLE_DIM), f32),
        'mix_norm_e': gain(ks[2], (N_EVEN, D_MODEL)),
        'w_in_e': dense(ks[3], (N_EVEN, D_MODEL, EVEN_IN), D_MODEL),
        'pool_w': dense(ks[4], (N_EVEN, N_POOL_GROUPS, POOL_GROUP_DIM, POOL_GROUP_DIM), POOL_GROUP_DIM),
        'pool_scale': 1.0 + 0.1 * jax.random.normal(ks[5], (N_EVEN, POOL_WIDTH), f32),
        'w_out_e': dense(ks[6], (N_EVEN, MIX_WIDTH, D_MODEL), MIX_WIDTH),
        'mix_norm_o': gain(ks[7], (N_ODD, D_MODEL)),
        'w_in_o': dense(ks[8], (N_ODD, D_MODEL, ODD_IN), D_MODEL),
        'conv_qkv_o': dense(ks[9], (N_ODD, GDN_CONV, 3 * MIX_WIDTH), GDN_CONV),
        'a_log_o': jnp.log(jax.random.uniform(ks[10], (N_ODD, GDN_HEADS), f32, 1.0, 16.0)),
        'dt_bias_o': dt + jnp.log(-jnp.expm1(-dt)),
        'gdn_norm_o': gain(ks[12], (N_ODD, GDN_HEAD_DIM)),
        'w_out_o': dense(ks[13], (N_ODD, MIX_WIDTH, D_MODEL), MIX_WIDTH),
        'ffn_norm': gain(ks[14], (DEPTH, D_MODEL)),
        'w_up': dense(ks[15], (DEPTH, D_MODEL, 2 * FFN_DIM), D_MODEL),
        'ffn_conv': dense(ks[16], (DEPTH, FFN_CONV, 2 * FFN_DIM), FFN_CONV),
        'w_down': dense(ks[17], (DEPTH, FFN_DIM, D_MODEL), FFN_DIM),
        'ple_norm': gain(ks[18], (DEPTH, D_MODEL)),
        'w_ple_gate': dense(ks[19], (DEPTH, D_MODEL, D_MODEL), D_MODEL),
        'w_ple': dense(ks[20], (DEPTH, PLE_DIM, D_MODEL), PLE_DIM),
        'final_norm': gain(ks[21], (D_MODEL,)),
    }


def reference(x, p, mix_norm_e, w_in_e, pool_w, pool_scale, w_out_e,
              mix_norm_o, w_in_o, conv_qkv_o, a_log_o, dt_bias_o, gdn_norm_o, w_out_o,
              ffn_norm, w_up, ffn_conv, w_down, ple_norm, w_ple_gate, w_ple, final_norm):
    for i in range(DEPTH):
        j = i // 2
        if i % 2 == 0:
            x = x + even_mixer(rmsnorm(x, mix_norm_e[j]), w_in_e[j], pool_w[j], pool_scale[j], w_out_e[j])
        else:
            x = x + odd_mixer(rmsnorm(x, mix_norm_o[j]), w_in_o[j], conv_qkv_o[j], a_log_o[j],
                              dt_bias_o[j], gdn_norm_o[j], w_out_o[j])
        x = x + conv_ffn(rmsnorm(x, ffn_norm[i]), w_up[i], ffn_conv[i], w_down[i])
        gate = jax.nn.sigmoid(rmsnorm(x, ple_norm[i]) @ w_ple_gate[i])
        x = x + (p[i] @ w_ple[i]) * gate
    return rmsnorm(x, final_norm)
```

```cpp
#include <hip/hip_runtime.h>
#include <hip/hip_cooperative_groups.h>
#include <stdint.h>
#include <cstdio>
namespace cg = cooperative_groups;

#ifndef MULTI_LAUNCH
#define MULTI_LAUNCH 0
#endif

#define DI __device__ __forceinline__
typedef unsigned short bf16_t;
typedef short bf16x8 __attribute__((ext_vector_type(8)));
typedef float f32x4 __attribute__((ext_vector_type(4)));
typedef float f32x2 __attribute__((ext_vector_type(2)));
typedef float f32x16 __attribute__((ext_vector_type(16)));
typedef unsigned u32x4 __attribute__((ext_vector_type(4)));
typedef unsigned u32x2 __attribute__((ext_vector_type(2)));
typedef __bf16 hbf2 __attribute__((ext_vector_type(2)));

DI unsigned pk2(float lo, float hi) { f32x2 v = {lo, hi}; hbf2 r = __builtin_convertvector(v, hbf2); return __builtin_bit_cast(unsigned, r); }
DI bf16_t f2bf(float x) { return (bf16_t)(pk2(x, 0.f) & 0xffffu); }
DI float bf2f(bf16_t v) { return __uint_as_float(((unsigned)v) << 16); }
DI float bflo(unsigned u) { return __uint_as_float(u << 16); }
DI float bfhi(unsigned u) { return __uint_as_float(u & 0xffff0000u); }
DI f32x4 mfma16(bf16x8 a, bf16x8 b, f32x4 c) { return __builtin_amdgcn_mfma_f32_16x16x32_bf16(a, b, c, 0, 0, 0); }
DI f32x16 mfma32(bf16x8 a, bf16x8 b, f32x16 c) { return __builtin_amdgcn_mfma_f32_32x32x16_bf16(a, b, c, 0, 0, 0); }
DI int crow(int reg, int hh) { return (reg & 3) + 8 * (reg >> 2) + 4 * hh; }
DI float fexp2(float x) { return __builtin_amdgcn_exp2f(x); }
DI float flog2(float x) { return __builtin_amdgcn_logf(x); }
DI float frcp(float x) { return __builtin_amdgcn_rcpf(x); }
DI float fexp(float x) { return __builtin_amdgcn_exp2f(x * 1.4426950408889634f); }
DI float sigmoidf_(float x) { return frcp(1.f + fexp(-x)); }
DI float siluf_(float x) { return x * frcp(1.f + fexp(-x)); }
DI bf16x8 mk8(u32x2 lo, u32x2 hi) { u32x4 v = {lo.x, lo.y, hi.x, hi.y}; return __builtin_bit_cast(bf16x8, v); }
DI bf16x8 pack_step(const f32x16& x, int s) {
  u32x4 v;
  v.x = pk2(x[8 * s + 0], x[8 * s + 1]); v.y = pk2(x[8 * s + 2], x[8 * s + 3]);
  v.z = pk2(x[8 * s + 4], x[8 * s + 5]); v.w = pk2(x[8 * s + 6], x[8 * s + 7]);
  return __builtin_bit_cast(bf16x8, v);
}

constexpr int SEQ = 4096, DM = 1024, NTOK = 32768;
constexpr int SMEM_BYTES = 71680;
constexpr float EPSF = 1e-6f;

constexpr size_t OFF_WT_INE = 0;
constexpr size_t OFF_WT_OUTE = OFF_WT_INE + 2048ull * 1024 * 2;
constexpr size_t OFF_WT_INO = OFF_WT_OUTE + 1024ull * 1024 * 2;
constexpr size_t OFF_WT_Z = OFF_WT_INO + 3200ull * 1024 * 2;
constexpr size_t OFF_WT_OUTO = OFF_WT_Z + 1024ull * 1024 * 2;
constexpr size_t OFF_WT_UP = OFF_WT_OUTO + 1024ull * 1024 * 2;
constexpr size_t OFF_WT_DOWN = OFF_WT_UP + 2ull * 5632 * 1024 * 2;
constexpr size_t OFF_WT_PLEG = OFF_WT_DOWN + 2ull * 1024 * 2816 * 2;
constexpr size_t OFF_WT_PLE = OFF_WT_PLEG + 2ull * 1024 * 1024 * 2;
constexpr size_t OFF_WT_POOL = OFF_WT_PLE + 2ull * 1024 * 256 * 2;
constexpr size_t OFF_XB = OFF_WT_POOL + 4ull * 128 * 128 * 2;
constexpr size_t OFF_PB = OFF_XB + 32768ull * 1024 * 2;
constexpr size_t OFF_SS = OFF_PB + 2ull * 32768 * 256 * 2;
constexpr size_t OFF_GB = OFF_SS + 7ull * 32768 * 4;
constexpr size_t OFF_GL = OFF_GB + 32768ull * 16 * 4;
constexpr size_t OFF_R1 = OFF_GL + 4096 * 4;
constexpr size_t OFF_PROJ0 = OFF_R1;
constexpr size_t OFF_VT = OFF_PROJ0 + 32768ull * 1536 * 2;
constexpr size_t OFF_CAT = OFF_VT + 32768ull * 512 * 2;
constexpr size_t OFF_ACT = OFF_R1;
constexpr size_t OFF_UT = OFF_R1;
constexpr size_t OFF_WN = OFF_UT + 67108864ull;
constexpr size_t OFF_QD = OFF_WN + 67108864ull;
constexpr size_t OFF_KD = OFF_QD + 67108864ull;
constexpr size_t OFF_QK = OFF_KD + 67108864ull;
constexpr size_t OFF_QKV = OFF_QK + 33554432ull;
constexpr size_t OFF_GATE = OFF_R1;
constexpr size_t OFF_OB = OFF_WN;

struct P {
  const float* in[22];
  float* out;
  unsigned char* ws;
};

DI void mma_stage(f32x4 (&acc)[4][4], const unsigned char* cA, const unsigned char* cB, int a_rd, int b_rd, int sw0, int sw1) {
#pragma unroll
  for (int ks = 0; ks < 2; ++ks) {
    const int sw = ks ? sw1 : sw0;
    bf16x8 af[4], bfr[4];
#pragma unroll
    for (int m = 0; m < 4; ++m) af[m] = *(const bf16x8*)(cA + a_rd + m * 2048 + sw);
#pragma unroll
    for (int n = 0; n < 4; ++n) bfr[n] = *(const bf16x8*)(cB + b_rd + n * 2048 + sw);
#pragma unroll
    for (int m = 0; m < 4; ++m)
#pragma unroll
      for (int n = 0; n < 4; ++n) acc[m][n] = mfma16(bfr[n], af[m], acc[m][n]);
  }
}

DI void gemm_core(f32x4 (&acc)[4][4], const bf16_t* pa0, const bf16_t* pa1, const bf16_t* pa2, const bf16_t* pa3,
                  const bf16_t* pb0, long ldb32, int nk, unsigned char* smem, int tid) {
  const int lane = tid & 63, wid = tid >> 6, wr = wid >> 1, wc = wid & 1, fr = lane & 15, fq = lane >> 4;
  const int lrow = tid >> 3, lc = tid & 7;
  const int st_off = lrow * 128 + ((lc ^ (lrow & 7)) << 4);
  unsigned char* sA = smem;
  unsigned char* sB = smem + 32768;
  u32x4 ra[4], rb[4];
  ra[0] = *(const u32x4*)pa0; ra[1] = *(const u32x4*)pa1; ra[2] = *(const u32x4*)pa2; ra[3] = *(const u32x4*)pa3;
#pragma unroll
  for (int i = 0; i < 4; ++i) rb[i] = *(const u32x4*)(pb0 + i * ldb32);
  __syncthreads();
#pragma unroll
  for (int i = 0; i < 4; ++i) { *(u32x4*)(sA + st_off + i * 4096) = ra[i]; *(u32x4*)(sB + st_off + i * 4096) = rb[i]; }
  __syncthreads();
  const int a_rd = (64 * wr + fr) * 128, b_rd = (64 * wc + fr) * 128;
  const int sw0 = (fq ^ (fr & 7)) << 4, sw1 = ((4 + fq) ^ (fr & 7)) << 4;
  for (int kt = 0; kt < nk; ++kt) {
    const int cur = kt & 1;
    if (kt + 1 < nk) {
      const int ko = (kt + 1) * 64;
      ra[0] = *(const u32x4*)(pa0 + ko); ra[1] = *(const u32x4*)(pa1 + ko); ra[2] = *(const u32x4*)(pa2 + ko); ra[3] = *(const u32x4*)(pa3 + ko);
#pragma unroll
      for (int i = 0; i < 4; ++i) rb[i] = *(const u32x4*)(pb0 + i * ldb32 + ko);
    }
    mma_stage(acc, sA + cur * 16384, sB + cur * 16384, a_rd, b_rd, sw0, sw1);
    if (kt + 1 < nk) {
      unsigned char* nA = sA + (cur ^ 1) * 16384; unsigned char* nB = sB + (cur ^ 1) * 16384;
#pragma unroll
      for (int i = 0; i < 4; ++i) { *(u32x4*)(nA + st_off + i * 4096) = ra[i]; *(u32x4*)(nB + st_off + i * 4096) = rb[i]; }
    }
    __syncthreads();
  }
}

DI void zero_acc(f32x4 (&acc)[4][4]) {
#pragma unroll
  for (int m = 0; m < 4; ++m)
#pragma unroll
    for (int n = 0; n < 4; ++n) acc[m][n] = (f32x4){0.f, 0.f, 0.f, 0.f};
}

DI void tile_decode(int i, int MT, int NT, int& mt, int& nt) {
  const int g = i / (64 * NT); const int il = i - g * 64 * NT; int gm = MT - 64 * g; gm = gm < 64 ? gm : 64;
  nt = il / gm; mt = 64 * g + (il - nt * gm);
}

DI void transpose_convert(const float* __restrict__ W, int ldw, int K, int mode, int coloff, const float* __restrict__ gain,
                          bf16_t* __restrict__ dst, int kt, int ntile, float* tile, int tid) {
  const int n0 = ntile * 64;
  const int tx = tid & 63, ty = tid >> 6;
  const int n = n0 + tx;
  int src; bool valid = true;
  if (mode == 0) { src = coloff + n; }
  else if (mode == 1) { const int j = n >> 7, nl = n & 127, wc = nl >> 6, nt4 = (nl & 63) >> 4, fr = nl & 15; const int ch = 64 * j + 32 * wc + 16 * (nt4 & 1) + fr; src = (nt4 < 2) ? ch : 2816 + ch; }
  else { if (n < 3072) src = n; else if (n < 3088) src = 4096 + (n - 3072); else { src = 0; valid = false; } }
  __syncthreads();
#pragma unroll 4
  for (int i = 0; i < 16; ++i) {
    const int kl = ty + 4 * i, k = 64 * kt + kl;
    float v = 0.f;
    if (valid) { v = W[(size_t)k * ldw + src]; if (gain) v *= gain[k]; }
    tile[kl * 65 + tx] = v;
  }
  __syncthreads();
  const int nl = tid >> 2, kc = tid & 3;
#pragma unroll
  for (int cc = 0; cc < 2; ++cc) {
    const int kch = kc * 2 + cc;
    float v[8];
#pragma unroll
    for (int i = 0; i < 8; ++i) v[i] = tile[(8 * kch + i) * 65 + nl];
    u32x4 o = {pk2(v[0], v[1]), pk2(v[2], v[3]), pk2(v[4], v[5]), pk2(v[6], v[7])};
    *(u32x4*)(dst + (size_t)(n0 + nl) * K + 64 * kt + 8 * kch) = o;
  }
}

DI void phase_prologue(const P& p, unsigned char* smem, int tid) {
  float* tile = (float*)smem;
  bf16_t* wsb = (bf16_t*)p.ws;
  for (int task = 0; task < 17; ++task) {
    const float* W; int ldw, K, Nd, mode = 0, coloff = 0; const float* gain = nullptr; size_t doff;
    switch (task) {
      case 0: W = p.in[3]; ldw = 2048; K = 1024; Nd = 2048; gain = p.in[2]; doff = OFF_WT_INE; break;
      case 1: W = p.in[6]; ldw = 1024; K = 1024; Nd = 1024; doff = OFF_WT_OUTE; break;
      case 2: W = p.in[8]; ldw = 4112; K = 1024; Nd = 3200; mode = 2; gain = p.in[7]; doff = OFF_WT_INO; break;
      case 3: W = p.in[8]; ldw = 4112; K = 1024; Nd = 1024; coloff = 3072; gain = p.in[7]; doff = OFF_WT_Z; break;
      case 4: W = p.in[13]; ldw = 1024; K = 1024; Nd = 1024; doff = OFF_WT_OUTO; break;
      case 5: W = p.in[15]; ldw = 5632; K = 1024; Nd = 5632; mode = 1; gain = p.in[14]; doff = OFF_WT_UP; break;
      case 6: W = p.in[15] + 1024ull * 5632; ldw = 5632; K = 1024; Nd = 5632; mode = 1; gain = p.in[14] + 1024; doff = OFF_WT_UP + 5632ull * 1024 * 2; break;
      case 7: W = p.in[17]; ldw = 1024; K = 2816; Nd = 1024; doff = OFF_WT_DOWN; break;
      case 8: W = p.in[17] + 2816ull * 1024; ldw = 1024; K = 2816; Nd = 1024; doff = OFF_WT_DOWN + 1024ull * 2816 * 2; break;
      case 9: W = p.in[19]; ldw = 1024; K = 1024; Nd = 1024; gain = p.in[18]; doff = OFF_WT_PLEG; break;
      case 10: W = p.in[19] + 1024ull * 1024; ldw = 1024; K = 1024; Nd = 1024; gain = p.in[18] + 1024; doff = OFF_WT_PLEG + 1024ull * 1024 * 2; break;
      case 11: W = p.in[20]; ldw = 1024; K = 256; Nd = 1024; doff = OFF_WT_PLE; break;
      case 12: W = p.in[20] + 256ull * 1024; ldw = 1024; K = 256; Nd = 1024; doff = OFF_WT_PLE + 1024ull * 256 * 2; break;
      default: W = p.in[4] + (size_t)(task - 13) * 128 * 128; ldw = 128; K = 128; Nd = 128; doff = OFF_WT_POOL + (size_t)(task - 13) * 128 * 128 * 2; break;
    }
    const int nkt = K / 64, ntl = nkt * (Nd / 64);
    for (int t = blockIdx.x; t < ntl; t += gridDim.x)
      transpose_convert(W, ldw, K, mode, coloff, gain, (bf16_t*)(p.ws + doff), t % nkt, t / nkt, tile, tid);
  }
  {
    const float* x = p.in[0]; bf16_t* xb = (bf16_t*)(p.ws + OFF_XB); float* ss = (float*)(p.ws + OFF_SS);
    const int lane = tid & 63, wid = tid >> 6;
    for (int row = blockIdx.x * 4 + wid; row < NTOK; row += gridDim.x * 4) {
      float s = 0.f;
#pragma unroll
      for (int i = 0; i < 4; ++i) {
        const f32x4 v = *(const f32x4*)(x + (size_t)row * 1024 + 256 * i + 4 * lane);
        s += v.x * v.x + v.y * v.y + v.z * v.z + v.w * v.w;
        u32x2 o = {pk2(v.x, v.y), pk2(v.z, v.w)};
        *(u32x2*)(xb + (size_t)row * 1024 + 256 * i + 4 * lane) = o;
      }
#pragma unroll
      for (int off = 32; off > 0; off >>= 1) s += __shfl_xor(s, off);
      if (lane == 0) ss[row] = s;
    }
    for (int i = blockIdx.x * 256 + tid; i < 6 * NTOK; i += gridDim.x * 256) ss[NTOK + i] = 0.f;
    const float* pp = p.in[1]; bf16_t* pb = (bf16_t*)(p.ws + OFF_PB);
    const size_t n4 = 2ull * 32768 * 256 / 4;
    for (size_t i = (size_t)blockIdx.x * 256 + tid; i < n4; i += (size_t)gridDim.x * 256) {
      const f32x4 v = *(const f32x4*)(pp + 4 * i);
      u32x2 o = {pk2(v.x, v.y), pk2(v.z, v.w)};
      *(u32x2*)(pb + 4 * i) = o;
    }
  }
}

#define GEMM_IDS const int lane = tid & 63, wid = tid >> 6, wr = wid >> 1, wc = wid & 1, fr = lane & 15, fq = lane >> 4; const int lrow = tid >> 3, lc = tid & 7; (void)lane;

DI void phase_in_e(const P& p, unsigned char* smem, int tid) {
  GEMM_IDS
  const bf16_t* xb = (const bf16_t*)(p.ws + OFF_XB); const bf16_t* wt = (const bf16_t*)(p.ws + OFF_WT_INE);
  const float* ss = (const float*)(p.ws + OFF_SS);
  bf16_t* proj = (bf16_t*)(p.ws + OFF_PROJ0); bf16_t* vT = (bf16_t*)(p.ws + OFF_VT);
  for (int i = blockIdx.x; i < 256 * 16; i += gridDim.x) {
    int mt, nt; tile_decode(i, 256, 16, mt, nt);
    const int m0 = mt * 128, n0 = nt * 128;
    const bf16_t* pa = xb + (size_t)(m0 + lrow) * 1024 + 8 * lc;
    f32x4 acc[4][4]; zero_acc(acc);
    gemm_core(acc, pa, pa + 32 * 1024, pa + 64 * 1024, pa + 96 * 1024, wt + (size_t)(n0 + lrow) * 1024 + 8 * lc, 32 * 1024, 16, smem, tid);
    const float qs = (n0 >= 512 && n0 < 1024) ? 0.18033688011112042f : 1.f;
#pragma unroll
    for (int m = 0; m < 4; ++m) {
      const int row = m0 + 64 * wr + 16 * m + fr;
      const float rs = rsqrtf(ss[row] * (1.f / 1024.f) + EPSF) * qs;
#pragma unroll
      for (int n = 0; n < 4; ++n) {
        const int col = n0 + 64 * wc + 16 * n + 4 * fq;
        const f32x4 v = acc[m][n] * rs;
        if (n0 < 1536) {
          u32x2 o = {pk2(v.x, v.y), pk2(v.z, v.w)};
          *(u32x2*)(proj + (size_t)row * 1536 + col) = o;
        } else {
          const int cc = col - 1536; const int bh = (row >> 12) * 8 + (cc >> 6), d = cc & 63, t = row & 4095;
          bf16_t* vp = vT + ((size_t)bh * 64 + d) * 4096 + t;
          vp[0] = f2bf(v.x); vp[4096] = f2bf(v.y); vp[8192] = f2bf(v.z); vp[12288] = f2bf(v.w);
        }
      }
    }
  }
}

DI void phase_resid(const P& p, const bf16_t* A, int K, const bf16_t* wt, const float* xold, float* ssn, unsigned char* smem, int tid) {
  GEMM_IDS
  bf16_t* xb = (bf16_t*)(p.ws + OFF_XB); float* xnew = p.out;
  for (int i = blockIdx.x; i < 256 * 8; i += gridDim.x) {
    int mt, nt; tile_decode(i, 256, 8, mt, nt);
    const int m0 = mt * 128, n0 = nt * 128;
    const bf16_t* pa = A + (size_t)(m0 + lrow) * K + 8 * lc;
    f32x4 acc[4][4]; zero_acc(acc);
    gemm_core(acc, pa, pa + 32 * (size_t)K, pa + 64 * (size_t)K, pa + 96 * (size_t)K, wt + (size_t)(n0 + lrow) * K + 8 * lc, 32 * (long)K, K / 64, smem, tid);
#pragma unroll
    for (int m = 0; m < 4; ++m) {
      const int row = m0 + 64 * wr + 16 * m + fr;
      float s = 0.f;
#pragma unroll
      for (int n = 0; n < 4; ++n) {
        const int col = n0 + 64 * wc + 16 * n + 4 * fq;
        const f32x4 xo = *(const f32x4*)(xold + (size_t)row * 1024 + col);
        const f32x4 v = xo + acc[m][n];
        *(f32x4*)(xnew + (size_t)row * 1024 + col) = v;
        u32x2 o = {pk2(v.x, v.y), pk2(v.z, v.w)};
        *(u32x2*)(xb + (size_t)row * 1024 + col) = o;
        s += v.x * v.x + v.y * v.y + v.z * v.z + v.w * v.w;
      }
      s += __shfl_xor(s, 16); s += __shfl_xor(s, 32);
      if (fq == 0) atomicAdd(ssn + row, s);
    }
  }
}

DI void phase_ffn_up(const P& p, int layer, const float* ssc, unsigned char* smem, int tid) {
  GEMM_IDS
  const bf16_t* xb = (const bf16_t*)(p.ws + OFF_XB); const bf16_t* wt = (const bf16_t*)(p.ws + OFF_WT_UP) + (size_t)layer * 5632 * 1024;
  bf16_t* act = (bf16_t*)(p.ws + OFF_ACT);
  const float* cw = p.in[16] + (size_t)layer * 3 * 5632;
  float* Cs = (float*)smem;
  for (int i = blockIdx.x; i < 264 * 44; i += gridDim.x) {
    int mt, nt; tile_decode(i, 264, 44, mt, nt);
    const int b = mt / 33, mi = mt - b * 33;
    const int t0 = 126 * mi - 2;
    const bf16_t* pa[4];
#pragma unroll
    for (int j = 0; j < 4; ++j) { int t = t0 + lrow + 32 * j; t = t < 0 ? 0 : (t > 4095 ? 4095 : t); pa[j] = xb + (size_t)(b * 4096 + t) * 1024 + 8 * lc; }
    f32x4 acc[4][4]; zero_acc(acc);
    gemm_core(acc, pa[0], pa[1], pa[2], pa[3], wt + (size_t)(nt * 128 + lrow) * 1024 + 8 * lc, 32 * 1024, 16, smem, tid);
#pragma unroll
    for (int m = 0; m < 4; ++m) {
      const int lr = 64 * wr + 16 * m + fr;
      int t = t0 + lr; const bool neg = t < 0; t = t < 0 ? 0 : (t > 4095 ? 4095 : t);
      const float rs = neg ? 0.f : rsqrtf(ssc[b * 4096 + t] * (1.f / 1024.f) + EPSF);
#pragma unroll
      for (int n = 0; n < 4; ++n) *(f32x4*)(Cs + lr * 132 + 64 * wc + 16 * n + 4 * fq) = acc[m][n] * rs;
    }
    __syncthreads();
    {
      const int cl = tid & 63, rg = tid >> 6;
      const int gcol = 64 * (cl >> 5) + 16 * ((cl & 31) >> 4) + (cl & 15), vcol = gcol + 32;
      const int ch = nt * 64 + cl;
      const float wg0 = cw[ch], wg1 = cw[5632 + ch], wg2 = cw[2 * 5632 + ch];
      const float wv0 = cw[2816 + ch], wv1 = cw[5632 + 2816 + ch], wv2 = cw[2 * 5632 + 2816 + ch];
      const int lr0 = 2 + 32 * rg;
      float g2 = Cs[(lr0 - 2) * 132 + gcol], g1 = Cs[(lr0 - 1) * 132 + gcol];
      float v2 = Cs[(lr0 - 2) * 132 + vcol], v1 = Cs[(lr0 - 1) * 132 + vcol];
      for (int r = 0; r < 32; ++r) {
        const int lr = lr0 + r; const int t = t0 + lr;
        if (lr >= 128 || t > 4095) break;
        const float g0 = Cs[lr * 132 + gcol], v0 = Cs[lr * 132 + vcol];
        const float yg = wg0 * g2 + wg1 * g1 + wg2 * g0;
        const float yv = wv0 * v2 + wv1 * v1 + wv2 * v0;
        act[(size_t)(b * 4096 + t) * 2816 + ch] = f2bf(siluf_(yg) * yv);
        g2 = g1; g1 = g0; v2 = v1; v1 = v0;
      }
    }
  }
}

DI void phase_ple_gate(const P& p, int layer, const float* ssc, unsigned char* smem, int tid) {
  GEMM_IDS
  const bf16_t* xb = (const bf16_t*)(p.ws + OFF_XB);
  const bf16_t* wg = (const bf16_t*)(p.ws + OFF_WT_PLEG) + (size_t)layer * 1024 * 1024;
  bf16_t* gate = (bf16_t*)(p.ws + OFF_GATE);
  for (int i = blockIdx.x; i < 256 * 8; i += gridDim.x) {
    int mt, nt; tile_decode(i, 256, 8, mt, nt);
    const int m0 = mt * 128, n0 = nt * 128;
    const bf16_t* pa = xb + (size_t)(m0 + lrow) * 1024 + 8 * lc;
    f32x4 acc[4][4]; zero_acc(acc);
    gemm_core(acc, pa, pa + 32 * 1024, pa + 64 * 1024, pa + 96 * 1024, wg + (size_t)(n0 + lrow) * 1024 + 8 * lc, 32 * 1024, 16, smem, tid);
#pragma unroll
    for (int m = 0; m < 4; ++m) {
      const int row = m0 + 64 * wr + 16 * m + fr;
      const float rs = rsqrtf(ssc[row] * (1.f / 1024.f) + EPSF);
#pragma unroll
      for (int n = 0; n < 4; ++n) {
        const int col = n0 + 64 * wc + 16 * n + 4 * fq;
        const f32x4 v = acc[m][n] * rs;
        u32x2 o = {pk2(sigmoidf_(v.x), sigmoidf_(v.y)), pk2(sigmoidf_(v.z), sigmoidf_(v.w))};
        *(u32x2*)(gate + (size_t)row * 1024 + col) = o;
      }
    }
  }
}

DI void phase_ple_add(const P& p, int layer, float* ssn, unsigned char* smem, int tid) {
  GEMM_IDS
  bf16_t* xb = (bf16_t*)(p.ws + OFF_XB);
  const bf16_t* wp = (const bf16_t*)(p.ws + OFF_WT_PLE) + (size_t)layer * 1024 * 256;
  const bf16_t* pb = (const bf16_t*)(p.ws + OFF_PB) + (size_t)layer * 32768 * 256;
  const bf16_t* gate = (const bf16_t*)(p.ws + OFF_GATE);
  float* x = p.out;
  for (int i = blockIdx.x; i < 256 * 8; i += gridDim.x) {
    int mt, nt; tile_decode(i, 256, 8, mt, nt);
    const int m0 = mt * 128, n0 = nt * 128;
    const bf16_t* pa = pb + (size_t)(m0 + lrow) * 256 + 8 * lc;
    f32x4 acc[4][4]; zero_acc(acc);
    gemm_core(acc, pa, pa + 32 * 256, pa + 64 * 256, pa + 96 * 256, wp + (size_t)(n0 + lrow) * 256 + 8 * lc, 32 * 256, 4, smem, tid);
#pragma unroll
    for (int m = 0; m < 4; ++m) {
      const int row = m0 + 64 * wr + 16 * m + fr;
      float s = 0.f;
#pragma unroll
      for (int n = 0; n < 4; ++n) {
        const int col = n0 + 64 * wc + 16 * n + 4 * fq;
        const f32x4 xo = *(const f32x4*)(x + (size_t)row * 1024 + col);
        const u32x2 gp = *(const u32x2*)(gate + (size_t)row * 1024 + col);
        const f32x4 g = {bflo(gp.x), bfhi(gp.x), bflo(gp.y), bfhi(gp.y)};
        const f32x4 v = xo + acc[m][n] * g;
        *(f32x4*)(x + (size_t)row * 1024 + col) = v;
        u32x2 o = {pk2(v.x, v.y), pk2(v.z, v.w)};
        *(u32x2*)(xb + (size_t)row * 1024 + col) = o;
        s += v.x * v.x + v.y * v.y + v.z * v.z + v.w * v.w;
      }
      s += __shfl_xor(s, 16); s += __shfl_xor(s, 32);
      if (fq == 0) atomicAdd(ssn + row, s);
    }
  }
}

DI void phase_in_o(const P& p, int qi, unsigned char* smem, int tid) {
  GEMM_IDS
  const bf16_t* xb = (const bf16_t*)(p.ws + OFF_XB); const bf16_t* wt = (const bf16_t*)(p.ws + OFF_WT_INO);
  const float* ssc = (const float*)(p.ws + OFF_SS) + 3 * NTOK;
  bf16_t* qkv = (bf16_t*)(p.ws + OFF_QKV); float* gb = (float*)(p.ws + OFF_GB);
  const float* a_log = p.in[10]; const float* dt_bias = p.in[11];
  for (int i = blockIdx.x; i < 64 * 25; i += gridDim.x) {
    int mt, nt; tile_decode(i, 64, 25, mt, nt);
    const int mq0 = mt * 128, m0 = qi * 8192 + mq0, n0 = nt * 128;
    const bf16_t* pa = xb + (size_t)(m0 + lrow) * 1024 + 8 * lc;
    f32x4 acc[4][4]; zero_acc(acc);
    gemm_core(acc, pa, pa + 32 * 1024, pa + 64 * 1024, pa + 96 * 1024, wt + (size_t)(n0 + lrow) * 1024 + 8 * lc, 32 * 1024, 16, smem, tid);
#pragma unroll
    for (int m = 0; m < 4; ++m) {
      const int rl = 64 * wr + 16 * m + fr;
      const float rs = rsqrtf(ssc[m0 + rl] * (1.f / 1024.f) + EPSF);
      if (nt < 24) {
#pragma unroll
        for (int n = 0; n < 4; ++n) {
          const int col = n0 + 64 * wc + 16 * n + 4 * fq;
          const f32x4 v = acc[m][n] * rs;
          u32x2 o = {pk2(v.x, v.y), pk2(v.z, v.w)};
          *(u32x2*)(qkv + (size_t)(mq0 + rl) * 3072 + col) = o;
        }
      } else if (wc == 0) {
        const f32x4 v = acc[m][0] * rs;
        f32x4 o;
#pragma unroll
        for (int j = 0; j < 4; ++j) {
          const int cl = 4 * fq + j;
          if (cl < 8) o[j] = sigmoidf_(v[j]);
          else {
            const int hd = cl - 8; const float xx = v[j] + dt_bias[hd];
            const float sp = fmaxf(xx, 0.f) + log1pf(__expf(-fabsf(xx)));
            o[j] = -__expf(a_log[hd]) * sp;
          }
        }
        *(f32x4*)(gb + (size_t)(m0 + rl) * 16 + 4 * fq) = o;
      }
    }
  }
}

DI void phase_z_gate(const P& p, unsigned char* smem, int tid) {
  GEMM_IDS
  const bf16_t* xb = (const bf16_t*)(p.ws + OFF_XB); const bf16_t* wt = (const bf16_t*)(p.ws + OFF_WT_Z);
  const float* ssc = (const float*)(p.ws + OFF_SS) + 3 * NTOK;
  const bf16_t* ob_in = (const bf16_t*)(p.ws + OFF_UT);
  bf16_t* ob = (bf16_t*)(p.ws + OFF_OB);
  const float* nw = p.in[12];
  float* red = (float*)smem;
  for (int i = blockIdx.x; i < 256 * 8; i += gridDim.x) {
    int mt, nt; tile_decode(i, 256, 8, mt, nt);
    const int m0 = mt * 128, n0 = nt * 128;
    const bf16_t* pa = xb + (size_t)(m0 + lrow) * 1024 + 8 * lc;
    f32x4 acc[4][4]; zero_acc(acc);
    gemm_core(acc, pa, pa + 32 * 1024, pa + 64 * 1024, pa + 96 * 1024, wt + (size_t)(n0 + lrow) * 1024 + 8 * lc, 32 * 1024, 16, smem, tid);
    f32x4 ov[4][4];
#pragma unroll
    for (int m = 0; m < 4; ++m) {
      const int rl = 64 * wr + 16 * m + fr; const int row = m0 + rl;
      const int chunk = ((row >> 12) * 8 + nt) * 64 + ((row & 4095) >> 6);
      const bf16_t* op = ob_in + (size_t)chunk * 8192 + (row & 63);
      float s = 0.f;
#pragma unroll
      for (int n = 0; n < 4; ++n) {
        const bf16_t* oe = op + (size_t)(64 * wc + 16 * n + 4 * fq) * 64;
        const f32x4 o = {bf2f(oe[0]), bf2f(oe[64]), bf2f(oe[128]), bf2f(oe[192])};
        ov[m][n] = o; s += o.x * o.x + o.y * o.y + o.z * o.z + o.w * o.w;
      }
      s += __shfl_xor(s, 16); s += __shfl_xor(s, 32);
      if (fq == 0) red[rl * 2 + wc] = s;
    }
    __syncthreads();
#pragma unroll
    for (int m = 0; m < 4; ++m) {
      const int rl = 64 * wr + 16 * m + fr; const int row = m0 + rl;
      const float rs = rsqrtf(ssc[row] * (1.f / 1024.f) + EPSF);
      const float on = rsqrtf((red[rl * 2] + red[rl * 2 + 1]) * (1.f / 128.f) + EPSF);
#pragma unroll
      for (int n = 0; n < 4; ++n) {
        const int cl = 64 * wc + 16 * n + 4 * fq;
        const f32x4 z = acc[m][n] * rs;
        const f32x4 w4 = *(const f32x4*)(nw + cl);
        f32x4 r;
#pragma unroll
        for (int j = 0; j < 4; ++j) r[j] = ov[m][n][j] * on * w4[j] * siluf_(z[j]);
        u32x2 o = {pk2(r.x, r.y), pk2(r.z, r.w)};
        *(u32x2*)(ob + (size_t)row * 1024 + n0 + cl) = o;
      }
    }
  }
}

DI void attn_item(const P& p, int item, unsigned char* smem, int tid) {
  const int lane = tid & 63, w = tid >> 6, r = lane & 31, hh = lane >> 5;
  const int bh = item & 63, jj = item >> 6;
  int qb; { const int a = jj & 7, grp = jj >> 3; qb = grp == 0 ? 31 - a : grp == 1 ? 16 + a : grp == 2 ? 15 - a : a; }
  const int b = bh >> 3, h = bh & 7;
  const int q0 = qb * 128, qw = q0 + 32 * w;
  const bf16_t* proj = (const bf16_t*)(p.ws + OFF_PROJ0);
  const bf16_t* vT = (const bf16_t*)(p.ws + OFF_VT) + (size_t)bh * 64 * 4096;
  bf16x8 qf[4];
  {
    const bf16_t* qp = proj + (size_t)(b * 4096 + qw + r) * 1536 + 512 + h * 64 + 8 * hh;
#pragma unroll
    for (int s = 0; s < 4; ++s) qf[s] = *(const bf16x8*)(qp + 16 * s);
  }
  f32x16 oacc[2];
#pragma unroll
  for (int i = 0; i < 16; ++i) { oacc[0][i] = 0.f; oacc[1][i] = 0.f; }
  float carry = 0.f;
  const int ntile = q0 / 64 + 2;
  const int lrow = tid >> 3, lc = tid & 7;
  const bf16_t* kbase = proj + (size_t)(b * 4096 + lrow) * 1536 + 1024 + h * 64 + 8 * lc;
  const bf16_t* vbase = vT + (size_t)lrow * 4096 + 8 * lc;
  unsigned char* sK = smem;
  unsigned char* sV = smem + 16384;
  const int kst = lrow * 128 + ((lc ^ (lrow & 7)) << 4);
  const int vst = lrow * 136 + lc * 16;
  u32x4 rk[2], rv[2];
  int kt = ntile - 1;
#pragma unroll
  for (int i = 0; i < 2; ++i) { rk[i] = *(const u32x4*)(kbase + (size_t)(kt * 64 + 32 * i) * 1536); rv[i] = *(const u32x4*)(vbase + (size_t)(32 * i) * 4096 + kt * 64); }
  __syncthreads();
#pragma unroll
  for (int i = 0; i < 2; ++i) {
    *(u32x4*)(sK + kst + i * 4096) = rk[i];
    *(u32x2*)(sV + vst + i * 4352) = (u32x2){rv[i].x, rv[i].y}; *(u32x2*)(sV + vst + i * 4352 + 8) = (u32x2){rv[i].z, rv[i].w};
  }
  __syncthreads();
  int cur = 0;
  for (; kt >= 0; --kt) {
    if (kt > 0) {
#pragma unroll
      for (int i = 0; i < 2; ++i) { rk[i] = *(const u32x4*)(kbase + (size_t)((kt - 1) * 64 + 32 * i) * 1536); rv[i] = *(const u32x4*)(vbase + (size_t)(32 * i) * 4096 + (kt - 1) * 64); }
    }
    const unsigned char* cK = sK + cur * 8192; const unsigned char* cV = sV + cur * 8704;
    const int s0 = kt * 64;
#pragma unroll
    for (int sub = 1; sub >= 0; --sub) {
      const int ks = s0 + 32 * sub;
      if (ks <= qw) {
        f32x16 sc;
#pragma unroll
        for (int i = 0; i < 16; ++i) sc[i] = 0.f;
#pragma unroll
        for (int s = 0; s < 4; ++s) {
          const bf16x8 kf = *(const bf16x8*)(cK + (32 * sub + r) * 128 + (((2 * s + hh) ^ (r & 7)) << 4));
          sc = mfma32(kf, qf[s], sc);
        }
        const bool diag = (ks == qw);
        float lm[16], ls[16];
#pragma unroll
        for (int i = 0; i < 16; ++i) {
          const float z = sc[i];
          const float e = fexp2(-fabsf(z));
          const float sp = fmaxf(z, 0.f) + flog2(1.f + e);
          const bool valid = !diag || (crow(i, hh) < r);
          lm[i] = valid ? -sp : 0.f;
          ls[i] = valid ? (z - sp) : -1e30f;
        }
        float G[4], Pp[4], Tt[4];
#pragma unroll
        for (int g = 0; g < 4; ++g) { G[g] = (lm[4 * g] + lm[4 * g + 1]) + (lm[4 * g + 2] + lm[4 * g + 3]); Pp[g] = __shfl_xor(G[g], 32); Tt[g] = G[g] + Pp[g]; }
        float after = carry;
        f32x16 av;
#pragma unroll
        for (int g = 3; g >= 0; --g) {
          float base = after + (hh == 0 ? Pp[g] : 0.f);
          float k3 = base, k2 = k3 + lm[4 * g + 3], k1 = k2 + lm[4 * g + 2], k0 = k1 + lm[4 * g + 1];
          av[4 * g + 3] = fexp2(ls[4 * g + 3] + k3); av[4 * g + 2] = fexp2(ls[4 * g + 2] + k2);
          av[4 * g + 1] = fexp2(ls[4 * g + 1] + k1); av[4 * g + 0] = fexp2(ls[4 * g + 0] + k0);
          after += Tt[g];
        }
        carry = after;
#pragma unroll
        for (int s = 0; s < 2; ++s) {
          const bf16x8 ap = pack_step(av, s);
#pragma unroll
          for (int dt = 0; dt < 2; ++dt) {
            const unsigned char* vp = cV + (32 * dt + r) * 136 + (32 * sub + 16 * s + 4 * hh) * 2;
            const bf16x8 vf = mk8(*(const u32x2*)vp, *(const u32x2*)(vp + 16));
            oacc[dt] = mfma32(vf, ap, oacc[dt]);
          }
        }
      }
    }
    if (kt > 0) {
      unsigned char* nK = sK + (cur ^ 1) * 8192; unsigned char* nV = sV + (cur ^ 1) * 8704;
#pragma unroll
      for (int i = 0; i < 2; ++i) {
        *(u32x4*)(nK + kst + i * 4096) = rk[i];
        *(u32x2*)(nV + vst + i * 4352) = (u32x2){rv[i].x, rv[i].y}; *(u32x2*)(nV + vst + i * 4352 + 8) = (u32x2){rv[i].z, rv[i].w};
      }
    }
    __syncthreads();
    cur ^= 1;
  }
  bf16_t* cat = (bf16_t*)(p.ws + OFF_CAT) + (size_t)(b * 4096 + qw + r) * 1024 + 512 + h * 64;
#pragma unroll
  for (int dt = 0; dt < 2; ++dt)
#pragma unroll
    for (int g = 0; g < 4; ++g) {
      u32x2 o = {pk2(oacc[dt][4 * g], oacc[dt][4 * g + 1]), pk2(oacc[dt][4 * g + 2], oacc[dt][4 * g + 3])};
      *(u32x2*)(cat + 32 * dt + 8 * g + 4 * hh) = o;
    }
}

DI void pool_item(const P& p, int item, unsigned char* smem, int tid) {
  GEMM_IDS
  const int g = item & 3, mt = item >> 2;
  const int m0 = mt * 128;
  const bf16_t* proj = (const bf16_t*)(p.ws + OFF_PROJ0);
  const bf16_t* wt = (const bf16_t*)(p.ws + OFF_WT_POOL) + (size_t)g * 128 * 128;
  unsigned char* sA = smem; unsigned char* sB = smem + 32768;
  __syncthreads();
  {
    const int st_off = lrow * 128 + ((lc ^ (lrow & 7)) << 4);
#pragma unroll
    for (int kt = 0; kt < 2; ++kt)
#pragma unroll
      for (int i = 0; i < 4; ++i) *(u32x4*)(sB + kt * 16384 + st_off + i * 4096) = *(const u32x4*)(wt + (size_t)(lrow + 32 * i) * 128 + kt * 64 + 8 * lc);
  }
  {
    const int c = tid & 127, half = tid >> 7;
    const int w = 2 << g;
    const int tb = (m0 & 4095) + 64 * half;
    const bf16_t* up = proj + (size_t)(m0 - (m0 & 4095)) * 1536 + g * 128 + c;
    float run = 0.f;
    for (int k = 1; k < w; ++k) { const int t = tb - k; if (t >= 0) run += bf2f(up[(size_t)t * 1536]); }
    const int stg = c >> 6, kk = c & 63, chk = kk >> 3, wi = kk & 7;
    for (int rr = 0; rr < 64; ++rr) {
      const int t = tb + rr; const int lr = 64 * half + rr;
      const float ut = bf2f(up[(size_t)t * 1536]);
      run += ut;
      const int cnt = (t + 1 < w) ? (t + 1) : w;
      const float y = run / (float)cnt - ut;
      *(bf16_t*)(sA + stg * 16384 + lr * 128 + ((chk ^ (lr & 7)) << 4) + wi * 2) = f2bf(y);
      if (t - w + 1 >= 0) run -= bf2f(up[(size_t)(t - w + 1) * 1536]);
    }
  }
  __syncthreads();
  f32x4 acc[4][4]; zero_acc(acc);
  const int a_rd = (64 * wr + fr) * 128, b_rd = (64 * wc + fr) * 128;
  const int sw0 = (fq ^ (fr & 7)) << 4, sw1 = ((4 + fq) ^ (fr & 7)) << 4;
  mma_stage(acc, sA, sB, a_rd, b_rd, sw0, sw1);
  mma_stage(acc, sA + 16384, sB + 16384, a_rd, b_rd, sw0, sw1);
  const float* psc = p.in[5] + g * 128;
  bf16_t* cat = (bf16_t*)(p.ws + OFF_CAT);
#pragma unroll
  for (int m = 0; m < 4; ++m) {
    const int row = m0 + 64 * wr + 16 * m + fr;
#pragma unroll
    for (int n = 0; n < 4; ++n) {
      const int cl = 64 * wc + 16 * n + 4 * fq;
      const f32x4 s4 = *(const f32x4*)(psc + cl);
      const f32x4 v = acc[m][n] * s4;
      u32x2 o = {pk2(v.x, v.y), pk2(v.z, v.w)};
      *(u32x2*)(cat + (size_t)row * 1024 + g * 128 + cl) = o;
    }
  }
}


template <int I> struct SolveRow {
  static DI void run(float (&sol)[64], const float* A_v) {
    float s = sol[I];
#pragma unroll
    for (int g8 = 0; g8 < (I + 31) / 32; ++g8) {
      f32x4 a[8];
#pragma unroll
      for (int q = 0; q < 8; ++q) if (32 * g8 + 4 * q < I) a[q] = *(const f32x4*)(A_v + I * 68 + 32 * g8 + 4 * q);
#pragma unroll
      for (int q = 0; q < 8; ++q) {
        const int j = 32 * g8 + 4 * q;
        if (j + 0 < I) s -= a[q].x * sol[j + 0];
        if (j + 1 < I) s -= a[q].y * sol[j + 1];
        if (j + 2 < I) s -= a[q].z * sol[j + 2];
        if (j + 3 < I) s -= a[q].w * sol[j + 3];
      }
      __builtin_amdgcn_sched_barrier(0);
    }
    sol[I] = s;
    SolveRow<I + 1>::run(sol, A_v);
  }
};
template <> struct SolveRow<64> { static DI void run(float (&)[64], const float*) {} };

constexpr int GD_RAW = 0, GD_Q = 18224, GD_K = GD_Q + 17408, GD_V = GD_K + 17408, GD_GC = GD_V + 17408, GD_BETA = GD_GC + 256;
DI void gdn_chunk_item(const P& p, int qi, int item, unsigned char* smem, int tid) {
  const int lane = tid & 63, w = tid >> 6, r = lane & 31, hh = lane >> 5;
  const int h = item & 7, n = (item >> 3) & 63, bq = item >> 9;
  const int b = 2 * qi + bq;
  const int chunk = (b * 8 + h) * 64 + n;
  const bf16_t* qkv = (const bf16_t*)(p.ws + OFF_QKV) + (size_t)(bq * 4096) * 3072;
  const float* gb = (const float*)(p.ws + OFF_GB);
  const float* cw = p.in[9];
  float* gc_s = (float*)(smem + GD_GC); float* beta_s = (float*)(smem + GD_BETA);
  __syncthreads();
  if (w == 0) {
    const int tok = b * 4096 + 64 * n + lane;
    float g = gb[(size_t)tok * 16 + 8 + h]; const float be = gb[(size_t)tok * 16 + h];
#pragma unroll
    for (int off = 1; off < 64; off <<= 1) { const float t = __shfl_up(g, off); if (lane >= off) g += t; }
    gc_s[lane] = g; beta_s[lane] = be;
  }
#pragma unroll 1
  for (int pp = 0; pp < 3; ++pp) {
    for (int i = 0; i < 5; ++i) {
      const int idx = tid + 256 * i;
      if (idx < 1072) {
        const int rr = idx >> 4, c = idx & 15; const int t = 64 * n - 3 + rr;
        u32x4 v = {0u, 0u, 0u, 0u};
        if (t >= 0) v = *(const u32x4*)(qkv + (size_t)t * 3072 + pp * 1024 + h * 128 + 8 * c);
        *(u32x4*)(smem + GD_RAW + rr * 272 + 16 * c) = v;
      }
    }
    __syncthreads();
    {
      const int row = tid >> 2, qtr = tid & 3; const int ch0 = 32 * qtr;
      float y[32];
#pragma unroll
      for (int sub = 0; sub < 4; ++sub) {
        float a[8];
#pragma unroll
        for (int e = 0; e < 8; ++e) a[e] = 0.f;
#pragma unroll
        for (int tap = 0; tap < 4; ++tap) {
          const u32x4 xv = *(const u32x4*)(smem + GD_RAW + (row + tap) * 272 + (ch0 + 8 * sub) * 2);
          const float* wp = cw + (size_t)tap * 3072 + pp * 1024 + h * 128 + ch0 + 8 * sub;
          const f32x4 w0 = *(const f32x4*)wp, w1 = *(const f32x4*)(wp + 4);
          a[0] += w0.x * bflo(xv.x); a[1] += w0.y * bfhi(xv.x); a[2] += w0.z * bflo(xv.y); a[3] += w0.w * bfhi(xv.y);
          a[4] += w1.x * bflo(xv.z); a[5] += w1.y * bfhi(xv.z); a[6] += w1.z * bflo(xv.w); a[7] += w1.w * bfhi(xv.w);
        }
#pragma unroll
        for (int e = 0; e < 8; ++e) y[8 * sub + e] = siluf_(a[e]);
        __builtin_amdgcn_sched_barrier(0);
      }
      if (pp < 2) {
        float s = 0.f;
#pragma unroll
        for (int e = 0; e < 32; ++e) s += y[e] * y[e];
        s += __shfl_xor(s, 1); s += __shfl_xor(s, 2);
        const float inv = rsqrtf(s + EPSF) * (pp == 0 ? 0.08838834764831845f : 1.f);
#pragma unroll
        for (int e = 0; e < 32; ++e) y[e] *= inv;
      }
      unsigned char* dst = smem + (pp == 0 ? GD_Q : pp == 1 ? GD_K : GD_V) + row * 272 + ch0 * 2;
#pragma unroll
      for (int sub = 0; sub < 4; ++sub) {
        u32x4 o = {pk2(y[8 * sub], y[8 * sub + 1]), pk2(y[8 * sub + 2], y[8 * sub + 3]), pk2(y[8 * sub + 4], y[8 * sub + 5]), pk2(y[8 * sub + 6], y[8 * sub + 7])};
        *(u32x4*)(dst + 16 * sub) = o;
      }
    }
    __syncthreads();
  }
  float* A_s = (float*)(smem + GD_RAW);
  bf16_t* qkb = (bf16_t*)(p.ws + OFF_QK) + (size_t)chunk * 4096;
  {
    const int ti = w >> 1, tj = w & 1;
    const int j = 32 * tj + r;
    if (ti == 0 && tj == 1) {
#pragma unroll
      for (int reg = 0; reg < 16; ++reg) qkb[(32 * ti + crow(reg, hh)) * 64 + j] = 0;
    } else {
      f32x16 kk, qk;
#pragma unroll
      for (int i = 0; i < 16; ++i) { kk[i] = 0.f; qk[i] = 0.f; }
#pragma unroll
      for (int s = 0; s < 8; ++s) {
        const bf16x8 bfrag = *(const bf16x8*)(smem + GD_K + (32 * tj + r) * 272 + (16 * s + 8 * hh) * 2);
        const bf16x8 akf = *(const bf16x8*)(smem + GD_K + (32 * ti + r) * 272 + (16 * s + 8 * hh) * 2);
        const bf16x8 aqf = *(const bf16x8*)(smem + GD_Q + (32 * ti + r) * 272 + (16 * s + 8 * hh) * 2);
        kk = mfma32(akf, bfrag, kk); qk = mfma32(aqf, bfrag, qk);
      }
      const float gcj = gc_s[j];
#pragma unroll
      for (int reg = 0; reg < 16; ++reg) {
        const int i = 32 * ti + crow(reg, hh);
        const float dec = (i >= j) ? __expf(gc_s[i] - gcj) : 0.f;
        A_s[i * 68 + j] = (i > j) ? beta_s[i] * kk[reg] * dec : 0.f;
        qkb[i * 64 + j] = f2bf((i >= j) ? qk[reg] * dec : 0.f);
      }
    }
  }
  __syncthreads();
  {
    const int col = tid; const bool isw = col >= 128; const int d = col & 127;
    int vz; asm volatile("v_mov_b32 %0, 0" : "=v"(vz));
    const float* A_v = A_s + vz; const float* gc_v = gc_s + vz; const float* beta_v = beta_s + vz;
    const unsigned char* src = smem + (isw ? GD_K : GD_V) + d * 2;
    float sol[64];
#pragma unroll
    for (int i = 0; i < 64; ++i) {
      float v = bf2f(*(const bf16_t*)(src + i * 272)) * beta_v[i];
      if (isw) v *= __expf(gc_v[i]);
      sol[i] = v;
    }
    SolveRow<1>::run(sol, A_v);
    __syncthreads();
    if (!isw) {
      bf16_t* ut = (bf16_t*)(p.ws + OFF_UT) + (size_t)chunk * 8192 + d * 64;
#pragma unroll
      for (int c8 = 0; c8 < 8; ++c8) {
        u32x4 o = {pk2(sol[8 * c8], sol[8 * c8 + 1]), pk2(sol[8 * c8 + 2], sol[8 * c8 + 3]), pk2(sol[8 * c8 + 4], sol[8 * c8 + 5]), pk2(sol[8 * c8 + 6], sol[8 * c8 + 7])};
        *(u32x4*)(ut + 8 * c8) = o;
      }
      unsigned char* qp = smem + GD_Q + d * 2;
#pragma unroll
      for (int i = 0; i < 64; ++i) { const float v = bf2f(*(const bf16_t*)(qp + i * 272)) * __expf(gc_v[i]); *(bf16_t*)(qp + i * 272) = f2bf(v); }
    } else {
      unsigned char* wp = smem + GD_V + d * 2;
#pragma unroll
      for (int i = 0; i < 64; ++i) *(bf16_t*)(wp + i * 272) = f2bf(-sol[i]);
      bf16_t* kd = (bf16_t*)(p.ws + OFF_KD) + (size_t)chunk * 8192 + d * 64;
      const float gl = gc_v[63];
#pragma unroll
      for (int c8 = 0; c8 < 8; ++c8) {
        float kv[8];
#pragma unroll
        for (int e = 0; e < 8; ++e) kv[e] = bf2f(*(const bf16_t*)(smem + GD_K + (8 * c8 + e) * 272 + d * 2)) * __expf(gl - gc_v[8 * c8 + e]);
        u32x4 o = {pk2(kv[0], kv[1]), pk2(kv[2], kv[3]), pk2(kv[4], kv[5]), pk2(kv[6], kv[7])};
        *(u32x4*)(kd + 8 * c8) = o;
      }
    }
    if (tid == 0) ((float*)(p.ws + OFF_GL))[chunk] = __expf(gc_s[63]);
    __syncthreads();
    {
      bf16_t* wn = (bf16_t*)(p.ws + OFF_WN) + (size_t)chunk * 8192;
      bf16_t* qd = (bf16_t*)(p.ws + OFF_QD) + (size_t)chunk * 8192;
#pragma unroll 1
      for (int i = 0; i < 4; ++i) {
        const int idx = tid + 256 * i; const int lo = (idx >> 4) * 272 + (idx & 15) * 16;
        *(u32x4*)(wn + (size_t)idx * 8) = *(const u32x4*)(smem + GD_V + lo);
        *(u32x4*)(qd + (size_t)idx * 8) = *(const u32x4*)(smem + GD_Q + lo);
      }
    }
  }
}

constexpr int SC_W = 0, SC_QD = 17408, SC_QK = 34816, SC_KD = 34816 + 9216;
DI bf16x8 pack44(const f32x4& a, const f32x4& b) { u32x4 v = {pk2(a.x, a.y), pk2(a.z, a.w), pk2(b.x, b.y), pk2(b.z, b.w)}; return __builtin_bit_cast(bf16x8, v); }
DI void scan_item(const P& p, int item, unsigned char* smem, int tid) {
  const int lane = tid & 63, w = tid >> 6, fr = lane & 15, fq = lane >> 4;
  const int bh = item >> 1, e0 = 64 * (item & 1) + 16 * w;
  const bf16_t* WN = (const bf16_t*)(p.ws + OFF_WN); const bf16_t* QD = (const bf16_t*)(p.ws + OFF_QD);
  const bf16_t* KD = (const bf16_t*)(p.ws + OFF_KD); const bf16_t* QK = (const bf16_t*)(p.ws + OFF_QK);
  const bf16_t* UT = (const bf16_t*)(p.ws + OFF_UT); const float* GL = (const float*)(p.ws + OFF_GL);
  f32x4 S[8];
#pragma unroll
  for (int dt = 0; dt < 8; ++dt) S[dt] = (f32x4){0.f, 0.f, 0.f, 0.f};
  u32x4 st[14];
  const int chunk0 = bh * 64;
#define SC_LOAD(CH) do { \
    const size_t cb = (size_t)(CH) * 8192; \
    _Pragma("unroll") for (int i = 0; i < 4; ++i) { st[i] = *(const u32x4*)(WN + cb + (size_t)(tid + 256 * i) * 8); st[4 + i] = *(const u32x4*)(QD + cb + (size_t)(tid + 256 * i) * 8); st[10 + i] = *(const u32x4*)(KD + cb + (size_t)(tid + 256 * i) * 8); } \
    _Pragma("unroll") for (int i = 0; i < 2; ++i) st[8 + i] = *(const u32x4*)(QK + (size_t)(CH) * 4096 + (size_t)(tid + 256 * i) * 8); \
  } while (0)
#define SC_STORE() do { \
    _Pragma("unroll") for (int i = 0; i < 4; ++i) { const int idx = tid + 256 * i; const int o16 = (idx >> 4) * 272 + (idx & 15) * 16; *(u32x4*)(smem + SC_W + o16) = st[i]; *(u32x4*)(smem + SC_QD + o16) = st[4 + i]; \
      const int o8 = (idx >> 3) * 144 + (idx & 7) * 16; *(u32x4*)(smem + SC_KD + o8) = st[10 + i]; } \
    _Pragma("unroll") for (int i = 0; i < 2; ++i) { const int idx = tid + 256 * i; const int o8 = (idx >> 3) * 144 + (idx & 7) * 16; *(u32x4*)(smem + SC_QK + o8) = st[8 + i]; } \
  } while (0)
  SC_LOAD(chunk0);
  __syncthreads();
  for (int n = 0; n < 64; ++n) {
    const int chunk = chunk0 + n;
    SC_STORE();
    __syncthreads();
    if (n + 1 < 64) SC_LOAD(chunk + 1);
    f32x4 vn[4];
    {
      const bf16_t* up = UT + (size_t)chunk * 8192 + (size_t)(e0 + fr) * 64 + 4 * fq;
#pragma unroll
      for (int ct = 0; ct < 4; ++ct) { const u32x2 u = *(const u32x2*)(up + 16 * ct); vn[ct] = (f32x4){bflo(u.x), bfhi(u.x), bflo(u.y), bfhi(u.y)}; }
    }
    const float gl = GL[chunk];
    bf16x8 Sp[4];
#pragma unroll
    for (int kk = 0; kk < 4; ++kk) Sp[kk] = pack44(S[2 * kk], S[2 * kk + 1]);
#pragma unroll
    for (int ct = 0; ct < 4; ++ct)
#pragma unroll
      for (int kk = 0; kk < 4; ++kk) {
        const unsigned char* ap = smem + SC_W + (16 * ct + fr) * 272 + (32 * kk + 4 * fq) * 2;
        vn[ct] = mfma16(mk8(*(const u32x2*)ap, *(const u32x2*)(ap + 32)), Sp[kk], vn[ct]);
      }
    bf16x8 vp[2];
    vp[0] = pack44(vn[0], vn[1]); vp[1] = pack44(vn[2], vn[3]);
#pragma unroll
    for (int ct = 0; ct < 4; ++ct) {
      f32x4 o = {0.f, 0.f, 0.f, 0.f};
#pragma unroll
      for (int kk = 0; kk < 4; ++kk) {
        const unsigned char* ap = smem + SC_QD + (16 * ct + fr) * 272 + (32 * kk + 4 * fq) * 2;
        o = mfma16(mk8(*(const u32x2*)ap, *(const u32x2*)(ap + 32)), Sp[kk], o);
      }
#pragma unroll
      for (int kc = 0; kc < 2; ++kc) {
        const unsigned char* ap = smem + SC_QK + (16 * ct + fr) * 144 + (32 * kc + 4 * fq) * 2;
        o = mfma16(mk8(*(const u32x2*)ap, *(const u32x2*)(ap + 32)), vp[kc], o);
      }
      bf16_t* op = (bf16_t*)(p.ws + OFF_UT) + (size_t)chunk * 8192 + (size_t)(e0 + fr) * 64 + 16 * ct + 4 * fq;
      *(u32x2*)op = (u32x2){pk2(o.x, o.y), pk2(o.z, o.w)};
    }
#pragma unroll
    for (int dt = 0; dt < 8; ++dt) {
      S[dt] = S[dt] * gl;
#pragma unroll
      for (int kc = 0; kc < 2; ++kc) {
        const unsigned char* ap = smem + SC_KD + (16 * dt + fr) * 144 + (32 * kc + 4 * fq) * 2;
        S[dt] = mfma16(mk8(*(const u32x2*)ap, *(const u32x2*)(ap + 32)), vp[kc], S[dt]);
      }
    }
    __syncthreads();
  }
}

DI void phase_final(const P& p, int tid) {
  const int lane = tid & 63, wid = tid >> 6;
  float* x = p.out; const float* g = p.in[21];
  for (int row = blockIdx.x * 4 + wid; row < NTOK; row += gridDim.x * 4) {
    f32x4 v[4]; float s = 0.f;
#pragma unroll
    for (int i = 0; i < 4; ++i) { v[i] = *(const f32x4*)(x + (size_t)row * 1024 + 256 * i + 4 * lane); s += v[i].x * v[i].x + v[i].y * v[i].y + v[i].z * v[i].z + v[i].w * v[i].w; }
#pragma unroll
    for (int off = 32; off > 0; off >>= 1) s += __shfl_xor(s, off);
    const float rs = rsqrtf(s * (1.f / 1024.f) + EPSF);
#pragma unroll
    for (int i = 0; i < 4; ++i) { const f32x4 gg = *(const f32x4*)(g + 256 * i + 4 * lane); *(f32x4*)(x + (size_t)row * 1024 + 256 * i + 4 * lane) = v[i] * rs * gg; }
  }
}

constexpr int N_PHASES = 24;
DI void run_phase(const P& p0, int ph, unsigned char* smem, int tid) {
  P p = p0;
  asm volatile("" : "+v"(tid));
  asm volatile("" : "+s"(p.ws));
  asm volatile("" : "+s"(p.out));
  float* ss = (float*)(p.ws + OFF_SS);
  switch (ph) {
    case 0: phase_prologue(p, smem, tid); break;
    case 1: phase_in_e(p, smem, tid); break;
    case 2: {
      for (int i = blockIdx.x; i < 2048 + 1024; i += gridDim.x) { if (i < 2048) attn_item(p, i, smem, tid); else pool_item(p, i - 2048, smem, tid); }
    } break;
    case 3: phase_resid(p, (const bf16_t*)(p.ws + OFF_CAT), 1024, (const bf16_t*)(p.ws + OFF_WT_OUTE), p.in[0], ss + 1 * NTOK, smem, tid); break;
    case 4: phase_ffn_up(p, 0, ss + 1 * NTOK, smem, tid); break;
    case 5: phase_resid(p, (const bf16_t*)(p.ws + OFF_ACT), 2816, (const bf16_t*)(p.ws + OFF_WT_DOWN), p.out, ss + 2 * NTOK, smem, tid); break;
    case 6: phase_ple_gate(p, 0, ss + 2 * NTOK, smem, tid); break;
    case 7: phase_ple_add(p, 0, ss + 3 * NTOK, smem, tid); break;
    case 8: case 10: case 12: case 14: phase_in_o(p, (ph - 8) >> 1, smem, tid); break;
    case 9: case 11: case 13: case 15: { const int qi = (ph - 9) >> 1; for (int i = blockIdx.x; i < 1024; i += gridDim.x) gdn_chunk_item(p, qi, i, smem, tid); } break;
    case 16: { for (int i = blockIdx.x; i < 128; i += gridDim.x) scan_item(p, i, smem, tid); } break;
    case 17: phase_z_gate(p, smem, tid); break;
    case 18: phase_resid(p, (const bf16_t*)(p.ws + OFF_OB), 1024, (const bf16_t*)(p.ws + OFF_WT_OUTO), p.out, ss + 4 * NTOK, smem, tid); break;
    case 19: phase_ffn_up(p, 1, ss + 4 * NTOK, smem, tid); break;
    case 20: phase_resid(p, (const bf16_t*)(p.ws + OFF_ACT), 2816, (const bf16_t*)(p.ws + OFF_WT_DOWN) + 1024ull * 2816, p.out, ss + 5 * NTOK, smem, tid); break;
    case 21: phase_ple_gate(p, 1, ss + 5 * NTOK, smem, tid); break;
    case 22: phase_ple_add(p, 1, ss + 6 * NTOK, smem, tid); break;
    case 23: phase_final(p, tid); break;
    default: break;
  }
}

__global__ void __launch_bounds__(256, 2) mega(P p, int ph_lo, int ph_hi) {
  extern __shared__ __attribute__((aligned(16))) unsigned char smem[];
  cg::grid_group grid = cg::this_grid();
  const int tid = threadIdx.x;
#ifdef ONLY_PHASE
  run_phase(p, ONLY_PHASE, smem, tid);
#else
  for (int ph = ph_lo; ph < ph_hi; ++ph) {
    if (ph > ph_lo) grid.sync();
    run_phase(p, ph, smem, tid);
  }
#endif
}

extern "C" void kernel_launch(void* const* d_in, const int* in_sizes, int n_in, void* d_out, int out_size, void* d_ws, size_t ws_size, hipStream_t stream) {
  static int grid_blocks = 0;
  if (!grid_blocks) {
    int dev = 0, cus = 0, per_cu = 0;
    hipGetDevice(&dev);
    hipDeviceGetAttribute(&cus, hipDeviceAttributeMultiprocessorCount, dev);
    hipFuncSetAttribute((const void*)mega, hipFuncAttributeMaxDynamicSharedMemorySize, SMEM_BYTES);
    hipOccupancyMaxActiveBlocksPerMultiprocessor(&per_cu, mega, 256, SMEM_BYTES);
    if (per_cu > 2) per_cu = 2;
    if (per_cu < 1) per_cu = 1;
    grid_blocks = cus * per_cu;
  }
  P p{};
  for (int i = 0; i < 22; ++i) p.in[i] = (const float*)d_in[i];
  p.out = (float*)d_out;
  p.ws = (unsigned char*)d_ws;
#if MULTI_LAUNCH
  for (int ph = 0; ph < N_PHASES; ++ph) {
    int lo = ph, hi = ph + 1;
    void* args[] = {&p, &lo, &hi};
    hipError_t e = hipLaunchCooperativeKernel((const void*)mega, dim3(grid_blocks), dim3(256), args, SMEM_BYTES, stream);
    if (e != hipSuccess) fprintf(stderr, "launch failed: %s\n", hipGetErrorString(e));
  }
#else
  int lo = 0, hi = N_PHASES;
  void* args[] = {&p, &lo, &hi};
  hipError_t e = hipLaunchCooperativeKernel((const void*)mega, dim3(grid_blocks), dim3(256), args, SMEM_BYTES, stream);
  if (e != hipSuccess) fprintf(stderr, "launch failed: %s (grid %d)\n", hipGetErrorString(e), grid_blocks);
#endif
}
```

```cpp
#include <hip/hip_runtime.h>
#include <hip/hip_cooperative_groups.h>
#include <stdint.h>
#include <cstdio>
namespace cg = cooperative_groups;

#ifndef REP_PHASE
#define REP_PHASE -1
#endif
#ifndef MULTI_LAUNCH
#define MULTI_LAUNCH 0
#endif

#define DI __device__ __forceinline__
typedef unsigned short bf16_t;
typedef short bf16x8 __attribute__((ext_vector_type(8)));
typedef float f32x4 __attribute__((ext_vector_type(4)));
typedef float f32x2 __attribute__((ext_vector_type(2)));
typedef float f32x16 __attribute__((ext_vector_type(16)));
typedef unsigned u32x4 __attribute__((ext_vector_type(4)));
typedef unsigned u32x2 __attribute__((ext_vector_type(2)));
typedef __bf16 hbf2 __attribute__((ext_vector_type(2)));

DI unsigned pk2(float lo, float hi) { f32x2 v = {lo, hi}; hbf2 r = __builtin_convertvector(v, hbf2); return __builtin_bit_cast(unsigned, r); }
DI bf16_t f2bf(float x) { return (bf16_t)(pk2(x, 0.f) & 0xffffu); }
DI float bf2f(bf16_t v) { return __uint_as_float(((unsigned)v) << 16); }
DI float bflo(unsigned u) { return __uint_as_float(u << 16); }
DI float bfhi(unsigned u) { return __uint_as_float(u & 0xffff0000u); }
DI f32x4 mfma16(bf16x8 a, bf16x8 b, f32x4 c) { return __builtin_amdgcn_mfma_f32_16x16x32_bf16(a, b, c, 0, 0, 0); }
DI f32x16 mfma32(bf16x8 a, bf16x8 b, f32x16 c) { return __builtin_amdgcn_mfma_f32_32x32x16_bf16(a, b, c, 0, 0, 0); }
DI int crow(int reg, int hh) { return (reg & 3) + 8 * (reg >> 2) + 4 * hh; }
DI float fexp2(float x) { return __builtin_amdgcn_exp2f(x); }
DI float flog2(float x) { return __builtin_amdgcn_logf(x); }
DI float frcp(float x) { return __builtin_amdgcn_rcpf(x); }
DI float fexp(float x) { return __builtin_amdgcn_exp2f(x * 1.4426950408889634f); }
DI float sigmoidf_(float x) { return frcp(1.f + fexp(-x)); }
DI float siluf_(float x) { return x * frcp(1.f + fexp(-x)); }
DI bf16x8 mk8(u32x2 lo, u32x2 hi) { u32x4 v = {lo.x, lo.y, hi.x, hi.y}; return __builtin_bit_cast(bf16x8, v); }
DI bf16x8 pack_step(const f32x16& x, int s) {
  u32x4 v;
  v.x = pk2(x[8 * s + 0], x[8 * s + 1]); v.y = pk2(x[8 * s + 2], x[8 * s + 3]);
  v.z = pk2(x[8 * s + 4], x[8 * s + 5]); v.w = pk2(x[8 * s + 6], x[8 * s + 7]);
  return __builtin_bit_cast(bf16x8, v);
}

constexpr int SEQ = 4096, DM = 1024, NTOK = 32768;
constexpr int SMEM_BYTES = 73728;
constexpr float EPSF = 1e-6f;

constexpr size_t OFF_WT_INE = 0;
constexpr size_t OFF_WT_OUTE = OFF_WT_INE + 2048ull * 1024 * 2;
constexpr size_t OFF_WT_INO = OFF_WT_OUTE + 1024ull * 1024 * 2;
constexpr size_t OFF_WT_Z = OFF_WT_INO + 3328ull * 1024 * 2;
constexpr size_t OFF_WT_OUTO = OFF_WT_Z + 1024ull * 1024 * 2;
constexpr size_t OFF_WT_UP = OFF_WT_OUTO + 1024ull * 1024 * 2;
constexpr size_t OFF_WT_DOWN = OFF_WT_UP + 2ull * 5632 * 1024 * 2;
constexpr size_t OFF_WT_PLEG = OFF_WT_DOWN + 2ull * 1024 * 2816 * 2;
constexpr size_t OFF_WT_PLE = OFF_WT_PLEG + 2ull * 1024 * 1024 * 2;
constexpr size_t OFF_WT_POOL = OFF_WT_PLE + 2ull * 1024 * 256 * 2;
constexpr size_t OFF_XB = OFF_WT_POOL + 4ull * 128 * 128 * 2;
constexpr size_t OFF_PB = OFF_XB + 32768ull * 1024 * 2;
constexpr size_t OFF_SS = OFF_PB + 2ull * 32768 * 256 * 2;
constexpr size_t OFF_GB = OFF_SS + 7ull * 32768 * 4;
constexpr size_t OFF_GL = OFF_GB + 32768ull * 16 * 4;
constexpr size_t OFF_BAR = OFF_GL + 4096 * 4;
constexpr size_t OFF_R1 = OFF_BAR + 16384;
constexpr size_t OFF_PROJ0 = OFF_R1;
constexpr size_t OFF_VT = OFF_PROJ0 + 32768ull * 1536 * 2;
constexpr size_t OFF_CAT = OFF_VT + 32768ull * 512 * 2;
constexpr size_t OFF_ACT = OFF_R1;
constexpr size_t OFF_UT = OFF_R1;
constexpr size_t OFF_WN = OFF_UT + 67108864ull;
constexpr size_t OFF_QD = OFF_WN + 67108864ull;
constexpr size_t OFF_KD = OFF_QD + 67108864ull;
constexpr size_t OFF_QK = OFF_KD + 67108864ull;
constexpr size_t OFF_QKV = OFF_QK + 33554432ull;
constexpr size_t OFF_GATE = OFF_R1;
constexpr size_t OFF_OB = OFF_WN;

struct P {
  const float* in[22];
  float* out;
  unsigned char* ws;
};

DI void mma_stage(f32x4 (&acc)[4][4], const unsigned char* cA, const unsigned char* cB, int a_rd, int b_rd, int sw0, int sw1) {
#pragma unroll
  for (int ks = 0; ks < 2; ++ks) {
    const int sw = ks ? sw1 : sw0;
    bf16x8 af[4], bfr[4];
#pragma unroll
    for (int m = 0; m < 4; ++m) af[m] = *(const bf16x8*)(cA + a_rd + m * 2048 + sw);
#pragma unroll
    for (int n = 0; n < 4; ++n) bfr[n] = *(const bf16x8*)(cB + b_rd + n * 2048 + sw);
#pragma unroll
    for (int m = 0; m < 4; ++m)
#pragma unroll
      for (int n = 0; n < 4; ++n) acc[m][n] = mfma16(bfr[n], af[m], acc[m][n]);
  }
}
DI void zero_acc(f32x4 (&acc)[4][4]) {
#pragma unroll
  for (int m = 0; m < 4; ++m)
#pragma unroll
    for (int n = 0; n < 4; ++n) acc[m][n] = (f32x4){0.f, 0.f, 0.f, 0.f};
}

constexpr int G_STAGE = 24576, G_AB = 8192;
DI void glds16(const bf16_t* g, unsigned char* l) { __builtin_amdgcn_global_load_lds((const unsigned*)g, (unsigned*)l, 16, 0, 0); }
DI void zero_acc8(f32x4 (&acc)[4][8]) {
#pragma unroll
  for (int m = 0; m < 4; ++m)
#pragma unroll
    for (int n = 0; n < 8; ++n) acc[m][n] = (f32x4){0.f, 0.f, 0.f, 0.f};
}
DI void gemm_core(f32x4 (&acc)[4][8], const bf16_t* pa0, const bf16_t* pa1, const bf16_t* pb0, long ldb64, int nk, unsigned char* smem, int tid) {
  const int lane = tid & 63, wid = tid >> 6, wr = wid >> 1, wc = wid & 1, fr = lane & 15, fq = lane >> 4;
  const int lrow = tid >> 2, lc = tid & 3;
  const int csrc = 8 * (lc ^ ((-(lrow >> 2)) & 3));
  pa0 += csrc; pa1 += csrc; pb0 += csrc;
  unsigned char* dA = smem + tid * 16; unsigned char* dB = smem + G_AB + tid * 16;
  asm volatile("s_waitcnt vmcnt(0)" ::: "memory");
  __builtin_amdgcn_s_barrier();
#define G_ISSUE(KT, ST) do { const int ko_ = (KT) * 32; unsigned char* a_ = dA + (ST) * G_STAGE; unsigned char* b_ = dB + (ST) * G_STAGE; \
    glds16(pa0 + ko_, a_); glds16(pa1 + ko_, a_ + 4096); \
    glds16(pb0 + ko_, b_); glds16(pb0 + ldb64 + ko_, b_ + 4096); glds16(pb0 + 2 * ldb64 + ko_, b_ + 8192); glds16(pb0 + 3 * ldb64 + ko_, b_ + 12288); } while (0)
  G_ISSUE(0, 0);
  G_ISSUE(1, 1);
  const int swz = (fq ^ ((-(fr >> 2)) & 3)) << 4;
  const int a_rd = (64 * wr + fr) * 64 + swz, b_rd = G_AB + (128 * wc + fr) * 64 + swz;
  int st = 0;
#pragma unroll 1
  for (int kt = 0; kt < nk; ++kt) {
    if (kt + 1 < nk) asm volatile("s_waitcnt vmcnt(6)" ::: "memory"); else asm volatile("s_waitcnt vmcnt(0)" ::: "memory");
    __builtin_amdgcn_s_barrier();
    if (kt + 2 < nk) { const int s2 = (st >= 1) ? st - 1 : 2; G_ISSUE(kt + 2, s2); }
    const unsigned char* cs = smem + st * G_STAGE;
    bf16x8 af[4], bfr[8];
#pragma unroll
    for (int m = 0; m < 4; ++m) af[m] = *(const bf16x8*)(cs + a_rd + m * 1024);
#pragma unroll
    for (int n = 0; n < 8; ++n) bfr[n] = *(const bf16x8*)(cs + b_rd + n * 1024);
    __builtin_amdgcn_s_setprio(1);
#pragma unroll
    for (int m = 0; m < 4; ++m)
#pragma unroll
      for (int n = 0; n < 8; ++n) acc[m][n] = mfma16(bfr[n], af[m], acc[m][n]);
    __builtin_amdgcn_s_setprio(0);
    st = (st == 2) ? 0 : st + 1;
  }
  __syncthreads();
}

DI int permrow(int r) { const int s = r & 31; return (r & ~31) | (((s >> 2) & 3) << 3) | ((s >> 4) << 2) | (s & 3); }
DI void tile_decode(int i, int MT, int NT, int& mt, int& nt) {
  const int g = i / (64 * NT); const int il = i - g * 64 * NT; int gm = MT - 64 * g; gm = gm < 64 ? gm : 64;
  nt = il / gm; mt = 64 * g + (il - nt * gm);
}

DI void transpose_convert(const float* __restrict__ W, int ldw, int K, int mode, int coloff, const float* __restrict__ gain,
                          bf16_t* __restrict__ dst, int kt, int ntile, float* tile, int tid) {
  const int n0 = ntile * 64;
  const int tx = tid & 63, ty = tid >> 6;
  const int n = n0 + tx;
  int src; bool valid = true;
  if (mode == 0) { src = coloff + n; }
  else if (mode == 1) { const int j = n >> 8, nl = n & 255, wc = nl >> 7, hp = (nl >> 6) & 1, nt4 = (nl & 63) >> 4, fr = nl & 15; const int ch = 128 * j + 64 * wc + 32 * hp + 16 * (nt4 & 1) + fr; src = (nt4 < 2) ? ch : 2816 + ch; }
  else { if (n < 3072) src = n; else if (n < 3088) src = 4096 + (n - 3072); else { src = 0; valid = false; } }
  __syncthreads();
#pragma unroll 4
  for (int i = 0; i < 16; ++i) {
    const int kl = ty + 4 * i, k = 64 * kt + kl;
    float v = 0.f;
    if (valid) { v = W[(size_t)k * ldw + src]; if (gain) v *= gain[k]; }
    tile[kl * 65 + tx] = v;
  }
  __syncthreads();
  const int nl = tid >> 2, kc = tid & 3;
#pragma unroll
  for (int cc = 0; cc < 2; ++cc) {
    const int kch = kc * 2 + cc;
    float v[8];
#pragma unroll
    for (int i = 0; i < 8; ++i) v[i] = tile[(8 * kch + i) * 65 + nl];
    u32x4 o = {pk2(v[0], v[1]), pk2(v[2], v[3]), pk2(v[4], v[5]), pk2(v[6], v[7])};
    *(u32x4*)(dst + (size_t)(n0 + nl) * K + 64 * kt + 8 * kch) = o;
  }
}

DI void phase_prologue(const P& p, unsigned char* smem, int tid) {
  float* tile = (float*)smem;
  bf16_t* wsb = (bf16_t*)p.ws;
  for (int task = 0; task < 17; ++task) {
    const float* W; int ldw, K, Nd, mode = 0, coloff = 0; const float* gain = nullptr; size_t doff;
    switch (task) {
      case 0: W = p.in[3]; ldw = 2048; K = 1024; Nd = 2048; gain = p.in[2]; doff = OFF_WT_INE; break;
      case 1: W = p.in[6]; ldw = 1024; K = 1024; Nd = 1024; doff = OFF_WT_OUTE; break;
      case 2: W = p.in[8]; ldw = 4112; K = 1024; Nd = 3328; mode = 2; gain = p.in[7]; doff = OFF_WT_INO; break;
      case 3: W = p.in[8]; ldw = 4112; K = 1024; Nd = 1024; coloff = 3072; gain = p.in[7]; doff = OFF_WT_Z; break;
      case 4: W = p.in[13]; ldw = 1024; K = 1024; Nd = 1024; doff = OFF_WT_OUTO; break;
      case 5: W = p.in[15]; ldw = 5632; K = 1024; Nd = 5632; mode = 1; gain = p.in[14]; doff = OFF_WT_UP; break;
      case 6: W = p.in[15] + 1024ull * 5632; ldw = 5632; K = 1024; Nd = 5632; mode = 1; gain = p.in[14] + 1024; doff = OFF_WT_UP + 5632ull * 1024 * 2; break;
      case 7: W = p.in[17]; ldw = 1024; K = 2816; Nd = 1024; doff = OFF_WT_DOWN; break;
      case 8: W = p.in[17] + 2816ull * 1024; ldw = 1024; K = 2816; Nd = 1024; doff = OFF_WT_DOWN + 1024ull * 2816 * 2; break;
      case 9: W = p.in[19]; ldw = 1024; K = 1024; Nd = 1024; gain = p.in[18]; doff = OFF_WT_PLEG; break;
      case 10: W = p.in[19] + 1024ull * 1024; ldw = 1024; K = 1024; Nd = 1024; gain = p.in[18] + 1024; doff = OFF_WT_PLEG + 1024ull * 1024 * 2; break;
      case 11: W = p.in[20]; ldw = 1024; K = 256; Nd = 1024; doff = OFF_WT_PLE; break;
      case 12: W = p.in[20] + 256ull * 1024; ldw = 1024; K = 256; Nd = 1024; doff = OFF_WT_PLE + 1024ull * 256 * 2; break;
      default: W = p.in[4] + (size_t)(task - 13) * 128 * 128; ldw = 128; K = 128; Nd = 128; doff = OFF_WT_POOL + (size_t)(task - 13) * 128 * 128 * 2; break;
    }
    const int nkt = K / 64, ntl = nkt * (Nd / 64);
    for (int t = blockIdx.x; t < ntl; t += gridDim.x)
      transpose_convert(W, ldw, K, mode, coloff, gain, (bf16_t*)(p.ws + doff), t % nkt, t / nkt, tile, tid);
  }
  {
    const float* x = p.in[0]; bf16_t* xb = (bf16_t*)(p.ws + OFF_XB); float* ss = (float*)(p.ws + OFF_SS);
    const int lane = tid & 63, wid = tid >> 6;
    for (int row = blockIdx.x * 4 + wid; row < NTOK; row += gridDim.x * 4) {
      float s = 0.f;
#pragma unroll
      for (int i = 0; i < 4; ++i) {
        const f32x4 v = *(const f32x4*)(x + (size_t)row * 1024 + 256 * i + 4 * lane);
        s += v.x * v.x + v.y * v.y + v.z * v.z + v.w * v.w;
        u32x2 o = {pk2(v.x, v.y), pk2(v.z, v.w)};
        *(u32x2*)(xb + (size_t)row * 1024 + 256 * i + 4 * lane) = o;
      }
#pragma unroll
      for (int off = 32; off > 0; off >>= 1) s += __shfl_xor(s, off);
      if (lane == 0) ss[row] = s;
    }
    for (int i = blockIdx.x * 256 + tid; i < 6 * NTOK; i += gridDim.x * 256) ss[NTOK + i] = 0.f;
    const float* pp = p.in[1]; bf16_t* pb = (bf16_t*)(p.ws + OFF_PB);
    const size_t n4 = 2ull * 32768 * 256 / 4;
    for (size_t i = (size_t)blockIdx.x * 256 + tid; i < n4; i += (size_t)gridDim.x * 256) {
      const f32x4 v = *(const f32x4*)(pp + 4 * i);
      u32x2 o = {pk2(v.x, v.y), pk2(v.z, v.w)};
      *(u32x2*)(pb + 4 * i) = o;
    }
  }
}

#define GEMM_IDS const int lrow = tid >> 2;
#define EPI_IDS int tid_e = tid; asm volatile("" : "+v"(tid_e)); const int lane = tid_e & 63, wid = tid_e >> 6, wr = wid >> 1, wc = wid & 1, fr = lane & 15, fq = lane >> 4; (void)lane; (void)wr; (void)wc; (void)fr; (void)fq;

DI void phase_in_e(const P& p, unsigned char* smem, int tid) {
  GEMM_IDS
  const bf16_t* xb = (const bf16_t*)(p.ws + OFF_XB); const bf16_t* wt = (const bf16_t*)(p.ws + OFF_WT_INE);
  const float* ss = (const float*)(p.ws + OFF_SS);
  bf16_t* proj = (bf16_t*)(p.ws + OFF_PROJ0); bf16_t* vT = (bf16_t*)(p.ws + OFF_VT);
  for (int i = blockIdx.x; i < 256 * 8; i += gridDim.x) {
    int mt, nt; tile_decode(i, 256, 8, mt, nt);
    const int m0 = mt * 128, n0 = nt * 256;
    const bf16_t* pa = xb + (size_t)(m0 + lrow) * 1024;
    f32x4 acc[4][8]; zero_acc8(acc);
    gemm_core(acc, pa, pa + 64 * 1024, wt + (size_t)(n0 + permrow(lrow)) * 1024, 64 * 1024, 32, smem, tid);
    EPI_IDS
    const float qs = (n0 >= 512 && n0 < 1024) ? 0.18033688011112042f : 1.f;
#pragma unroll
    for (int m = 0; m < 4; ++m) {
      const int row = m0 + 64 * wr + 16 * m + fr;
      const float rs = rsqrtf(ss[row] * (1.f / 1024.f) + EPSF) * qs;
#pragma unroll
      for (int q = 0; q < 4; ++q) {
        const int col = n0 + 128 * wc + 32 * q + 8 * fq;
        const f32x4 v0 = acc[m][2 * q] * rs, v1 = acc[m][2 * q + 1] * rs;
        if (n0 < 1536) {
          u32x4 o = {pk2(v0.x, v0.y), pk2(v0.z, v0.w), pk2(v1.x, v1.y), pk2(v1.z, v1.w)};
          *(u32x4*)(proj + (size_t)row * 1536 + col) = o;
        } else {
          const int cc = col - 1536; const int bh = (row >> 12) * 8 + (cc >> 6), d = cc & 63, t = row & 4095;
          bf16_t* vp = vT + ((size_t)bh * 64 + d) * 4096 + t;
          vp[0] = f2bf(v0.x); vp[4096] = f2bf(v0.y); vp[8192] = f2bf(v0.z); vp[12288] = f2bf(v0.w);
          vp[16384] = f2bf(v1.x); vp[20480] = f2bf(v1.y); vp[24576] = f2bf(v1.z); vp[28672] = f2bf(v1.w);
        }
      }
    }
  }
}

DI void phase_resid(const P& p, const bf16_t* A, int K, const bf16_t* wt, const float* xold, float* ssn, unsigned char* smem, int tid) {
  GEMM_IDS
  bf16_t* xb = (bf16_t*)(p.ws + OFF_XB); float* xnew = p.out;
  for (int i = blockIdx.x; i < 256 * 4; i += gridDim.x) {
    int mt, nt; tile_decode(i, 256, 4, mt, nt);
    const int m0 = mt * 128, n0 = nt * 256;
    const bf16_t* pa = A + (size_t)(m0 + lrow) * K;
    f32x4 acc[4][8]; zero_acc8(acc);
    gemm_core(acc, pa, pa + 64 * (size_t)K, wt + (size_t)(n0 + permrow(lrow)) * K, 64 * (long)K, K / 32, smem, tid);
    EPI_IDS
#pragma unroll
    for (int m = 0; m < 4; ++m) {
      const int row = m0 + 64 * wr + 16 * m + fr;
      float s = 0.f;
#pragma unroll
      for (int q = 0; q < 4; ++q) {
        const int col = n0 + 128 * wc + 32 * q + 8 * fq;
        const f32x4 v0 = *(const f32x4*)(xold + (size_t)row * 1024 + col) + acc[m][2 * q];
        const f32x4 v1 = *(const f32x4*)(xold + (size_t)row * 1024 + col + 4) + acc[m][2 * q + 1];
        *(f32x4*)(xnew + (size_t)row * 1024 + col) = v0;
        *(f32x4*)(xnew + (size_t)row * 1024 + col + 4) = v1;
        u32x4 o = {pk2(v0.x, v0.y), pk2(v0.z, v0.w), pk2(v1.x, v1.y), pk2(v1.z, v1.w)};
        *(u32x4*)(xb + (size_t)row * 1024 + col) = o;
        s += v0.x * v0.x + v0.y * v0.y + v0.z * v0.z + v0.w * v0.w + v1.x * v1.x + v1.y * v1.y + v1.z * v1.z + v1.w * v1.w;
      }
      s += __shfl_xor(s, 16); s += __shfl_xor(s, 32);
      if (fq == 0) atomicAdd(ssn + row, s);
      __builtin_amdgcn_sched_barrier(0);
    }
  }
}

DI void phase_ffn_up(const P& p, int layer, const float* ssc, unsigned char* smem, int tid) {
  GEMM_IDS
  const bf16_t* xb = (const bf16_t*)(p.ws + OFF_XB); const bf16_t* wt = (const bf16_t*)(p.ws + OFF_WT_UP) + (size_t)layer * 5632 * 1024;
  bf16_t* act = (bf16_t*)(p.ws + OFF_ACT);
  const float* cw = p.in[16] + (size_t)layer * 3 * 5632;
  float* Cs = (float*)smem;
  for (int i = blockIdx.x; i < 264 * 22; i += gridDim.x) {
    int mt, nt; tile_decode(i, 264, 22, mt, nt);
    const int b = mt / 33, mi = mt - b * 33;
    const int t0 = 126 * mi - 2;
    const bf16_t* pa[2];
#pragma unroll
    for (int j = 0; j < 2; ++j) { int t = t0 + lrow + 64 * j; t = t < 0 ? 0 : (t > 4095 ? 4095 : t); pa[j] = xb + (size_t)(b * 4096 + t) * 1024; }
    f32x4 acc[4][8]; zero_acc8(acc);
    gemm_core(acc, pa[0], pa[1], wt + (size_t)(nt * 256 + lrow) * 1024, 64 * 1024, 32, smem, tid);
    EPI_IDS
    float rsv[4];
#pragma unroll
    for (int m = 0; m < 4; ++m) {
      int t = t0 + 64 * wr + 16 * m + fr; const bool neg = t < 0; t = t < 0 ? 0 : (t > 4095 ? 4095 : t);
      rsv[m] = neg ? 0.f : rsqrtf(ssc[b * 4096 + t] * (1.f / 1024.f) + EPSF);
    }
#pragma unroll
    for (int hp = 0; hp < 2; ++hp) {
      if (hp) __syncthreads();
#pragma unroll
      for (int m = 0; m < 4; ++m) {
        const int lr = 64 * wr + 16 * m + fr;
#pragma unroll
        for (int n = 0; n < 4; ++n) *(f32x4*)(Cs + lr * 132 + 64 * wc + 16 * n + 4 * fq) = acc[m][4 * hp + n] * rsv[m];
      }
      __syncthreads();
      const int cl = tid & 63, rg = tid >> 6;
      const int gcol = 64 * (cl >> 5) + 16 * ((cl & 31) >> 4) + (cl & 15), vcol = gcol + 32;
      const int ch = nt * 128 + 64 * (cl >> 5) + 32 * hp + (cl & 31);
      const float wg0 = cw[ch], wg1 = cw[5632 + ch], wg2 = cw[2 * 5632 + ch];
      const float wv0 = cw[2816 + ch], wv1 = cw[5632 + 2816 + ch], wv2 = cw[2 * 5632 + 2816 + ch];
      const int lr0 = 2 + 32 * rg;
      float g2 = Cs[(lr0 - 2) * 132 + gcol], g1 = Cs[(lr0 - 1) * 132 + gcol];
      float v2 = Cs[(lr0 - 2) * 132 + vcol], v1 = Cs[(lr0 - 1) * 132 + vcol];
      for (int r = 0; r < 32; ++r) {
        const int lr = lr0 + r; const int t = t0 + lr;
        if (lr >= 128 || t > 4095) break;
        const float g0 = Cs[lr * 132 + gcol], v0 = Cs[lr * 132 + vcol];
        const float yg = wg0 * g2 + wg1 * g1 + wg2 * g0;
        const float yv = wv0 * v2 + wv1 * v1 + wv2 * v0;
        act[(size_t)(b * 4096 + t) * 2816 + ch] = f2bf(siluf_(yg) * yv);
        g2 = g1; g1 = g0; v2 = v1; v1 = v0;
      }
    }
  }
}

DI void phase_ple_gate(const P& p, int layer, const float* ssc, unsigned char* smem, int tid) {
  GEMM_IDS
  const bf16_t* xb = (const bf16_t*)(p.ws + OFF_XB);
  const bf16_t* wg = (const bf16_t*)(p.ws + OFF_WT_PLEG) + (size_t)layer * 1024 * 1024;
  bf16_t* gate = (bf16_t*)(p.ws + OFF_GATE);
  for (int i = blockIdx.x; i < 256 * 4; i += gridDim.x) {
    int mt, nt; tile_decode(i, 256, 4, mt, nt);
    const int m0 = mt * 128, n0 = nt * 256;
    const bf16_t* pa = xb + (size_t)(m0 + lrow) * 1024;
    f32x4 acc[4][8]; zero_acc8(acc);
    gemm_core(acc, pa, pa + 64 * 1024, wg + (size_t)(n0 + permrow(lrow)) * 1024, 64 * 1024, 32, smem, tid);
    EPI_IDS
#pragma unroll
    for (int m = 0; m < 4; ++m) {
      const int row = m0 + 64 * wr + 16 * m + fr;
      const float rs = rsqrtf(ssc[row] * (1.f / 1024.f) + EPSF);
#pragma unroll
      for (int q = 0; q < 4; ++q) {
        const int col = n0 + 128 * wc + 32 * q + 8 * fq;
        const f32x4 v0 = acc[m][2 * q] * rs, v1 = acc[m][2 * q + 1] * rs;
        u32x4 o = {pk2(sigmoidf_(v0.x), sigmoidf_(v0.y)), pk2(sigmoidf_(v0.z), sigmoidf_(v0.w)), pk2(sigmoidf_(v1.x), sigmoidf_(v1.y)), pk2(sigmoidf_(v1.z), sigmoidf_(v1.w))};
        *(u32x4*)(gate + (size_t)row * 1024 + col) = o;
      }
    }
  }
}

DI void phase_ple_add(const P& p, int layer, float* ssn, unsigned char* smem, int tid) {
  GEMM_IDS
  bf16_t* xb = (bf16_t*)(p.ws + OFF_XB);
  const bf16_t* wp = (const bf16_t*)(p.ws + OFF_WT_PLE) + (size_t)layer * 1024 * 256;
  const bf16_t* pb = (const bf16_t*)(p.ws + OFF_PB) + (size_t)layer * 32768 * 256;
  const bf16_t* gate = (const bf16_t*)(p.ws + OFF_GATE);
  float* x = p.out;
  for (int i = blockIdx.x; i < 256 * 4; i += gridDim.x) {
    int mt, nt; tile_decode(i, 256, 4, mt, nt);
    const int m0 = mt * 128, n0 = nt * 256;
    const bf16_t* pa = pb + (size_t)(m0 + lrow) * 256;
    f32x4 acc[4][8]; zero_acc8(acc);
    gemm_core(acc, pa, pa + 64 * 256, wp + (size_t)(n0 + permrow(lrow)) * 256, 64 * 256, 8, smem, tid);
    EPI_IDS
#pragma unroll
    for (int m = 0; m < 4; ++m) {
      const int row = m0 + 64 * wr + 16 * m + fr;
      float s = 0.f;
#pragma unroll
      for (int q = 0; q < 4; ++q) {
        const int col = n0 + 128 * wc + 32 * q + 8 * fq;
        const u32x4 gp = *(const u32x4*)(gate + (size_t)row * 1024 + col);
        const f32x4 g0 = {bflo(gp.x), bfhi(gp.x), bflo(gp.y), bfhi(gp.y)}, g1 = {bflo(gp.z), bfhi(gp.z), bflo(gp.w), bfhi(gp.w)};
        const f32x4 v0 = *(const f32x4*)(x + (size_t)row * 1024 + col) + acc[m][2 * q] * g0;
        const f32x4 v1 = *(const f32x4*)(x + (size_t)row * 1024 + col + 4) + acc[m][2 * q + 1] * g1;
        *(f32x4*)(x + (size_t)row * 1024 + col) = v0;
        *(f32x4*)(x + (size_t)row * 1024 + col + 4) = v1;
        u32x4 o = {pk2(v0.x, v0.y), pk2(v0.z, v0.w), pk2(v1.x, v1.y), pk2(v1.z, v1.w)};
        *(u32x4*)(xb + (size_t)row * 1024 + col) = o;
        s += v0.x * v0.x + v0.y * v0.y + v0.z * v0.z + v0.w * v0.w + v1.x * v1.x + v1.y * v1.y + v1.z * v1.z + v1.w * v1.w;
      }
      s += __shfl_xor(s, 16); s += __shfl_xor(s, 32);
      if (fq == 0) atomicAdd(ssn + row, s);
      __builtin_amdgcn_sched_barrier(0);
    }
  }
}

DI void phase_in_o(const P& p, int qi, unsigned char* smem, int tid) {
  GEMM_IDS
  const bf16_t* xb = (const bf16_t*)(p.ws + OFF_XB); const bf16_t* wt = (const bf16_t*)(p.ws + OFF_WT_INO);
  const float* ssc = (const float*)(p.ws + OFF_SS) + 3 * NTOK;
  bf16_t* qkv = (bf16_t*)(p.ws + OFF_QKV); float* gb = (float*)(p.ws + OFF_GB);
  const float* a_log = p.in[10]; const float* dt_bias = p.in[11];
  for (int i = blockIdx.x; i < 64 * 13; i += gridDim.x) {
    int mt, nt; tile_decode(i, 64, 13, mt, nt);
    const int mq0 = mt * 128, m0 = qi * 8192 + mq0, n0 = nt * 256;
    const bf16_t* pa = xb + (size_t)(m0 + lrow) * 1024;
    f32x4 acc[4][8]; zero_acc8(acc);
    gemm_core(acc, pa, pa + 64 * 1024, wt + (size_t)(n0 + permrow(lrow)) * 1024, 64 * 1024, 32, smem, tid);
    EPI_IDS
#pragma unroll
    for (int m = 0; m < 4; ++m) {
      const int rl = 64 * wr + 16 * m + fr;
      const float rs = rsqrtf(ssc[m0 + rl] * (1.f / 1024.f) + EPSF);
      if (nt < 12) {
#pragma unroll
        for (int q = 0; q < 4; ++q) {
          const int col = n0 + 128 * wc + 32 * q + 8 * fq;
          const f32x4 v0 = acc[m][2 * q] * rs, v1 = acc[m][2 * q + 1] * rs;
          u32x4 o = {pk2(v0.x, v0.y), pk2(v0.z, v0.w), pk2(v1.x, v1.y), pk2(v1.z, v1.w)};
          *(u32x4*)(qkv + (size_t)(mq0 + rl) * 3072 + col) = o;
        }
      } else if (wc == 0 && fq < 2) {
        const f32x4 v0 = acc[m][0] * rs, v1 = acc[m][1] * rs;
        float o[8];
#pragma unroll
        for (int j = 0; j < 8; ++j) {
          const float vv = j < 4 ? v0[j] : v1[j - 4];
          if (fq == 0) o[j] = sigmoidf_(vv);
          else {
            const float xx = vv + dt_bias[j];
            const float sp = fmaxf(xx, 0.f) + log1pf(__expf(-fabsf(xx)));
            o[j] = -__expf(a_log[j]) * sp;
          }
        }
        float* gp = gb + (size_t)(m0 + rl) * 16 + 8 * fq;
        *(f32x4*)gp = (f32x4){o[0], o[1], o[2], o[3]}; *(f32x4*)(gp + 4) = (f32x4){o[4], o[5], o[6], o[7]};
      }
    }
  }
}

DI void phase_z_gate(const P& p, unsigned char* smem, int tid) {
  GEMM_IDS
  const bf16_t* xb = (const bf16_t*)(p.ws + OFF_XB); const bf16_t* wt = (const bf16_t*)(p.ws + OFF_WT_Z);
  const float* ssc = (const float*)(p.ws + OFF_SS) + 3 * NTOK;
  const bf16_t* ob_in = (const bf16_t*)(p.ws + OFF_UT);
  bf16_t* ob = (bf16_t*)(p.ws + OFF_OB);
  const float* nw = p.in[12];
  for (int i = blockIdx.x; i < 256 * 4; i += gridDim.x) {
    int mt, nt; tile_decode(i, 256, 4, mt, nt);
    const int m0 = mt * 128, n0 = nt * 256;
    const bf16_t* pa = xb + (size_t)(m0 + lrow) * 1024;
    f32x4 acc[4][8]; zero_acc8(acc);
    gemm_core(acc, pa, pa + 64 * 1024, wt + (size_t)(n0 + permrow(lrow)) * 1024, 64 * 1024, 32, smem, tid);
    EPI_IDS
    const int hd = 2 * nt + wc;
#pragma unroll
    for (int m = 0; m < 4; ++m) {
      const int row = m0 + 64 * wr + 16 * m + fr;
      const int chunk = ((row >> 12) * 8 + hd) * 64 + ((row & 4095) >> 6);
      const bf16_t* op = ob_in + (size_t)chunk * 8192 + (row & 63);
      float s = 0.f;
      {
        const bf16_t* oq = op + (size_t)(8 * fq) * 64;
#pragma unroll 1
        for (int q = 0; q < 4; ++q) {
#pragma unroll
          for (int j = 0; j < 8; ++j) { const float o = bf2f(oq[j * 64]); s += o * o; }
          oq += 32 * 64;
        }
      }
      s += __shfl_xor(s, 16); s += __shfl_xor(s, 32);
      const float on = rsqrtf(s * (1.f / 128.f) + EPSF);
      const float rs = rsqrtf(ssc[row] * (1.f / 1024.f) + EPSF);
      __builtin_amdgcn_sched_barrier(0);
#pragma unroll
      for (int q = 0; q < 4; ++q) {
        const int cl = 32 * q + 8 * fq;
        const f32x4 z0 = acc[m][2 * q] * rs, z1 = acc[m][2 * q + 1] * rs;
        const f32x4 w0 = *(const f32x4*)(nw + cl), w1 = *(const f32x4*)(nw + cl + 4);
        float r[8];
#pragma unroll
        for (int j = 0; j < 4; ++j) {
          r[j] = bf2f(op[(size_t)(cl + j) * 64]) * on * w0[j] * siluf_(z0[j]);
          r[4 + j] = bf2f(op[(size_t)(cl + 4 + j) * 64]) * on * w1[j] * siluf_(z1[j]);
        }
        u32x4 o = {pk2(r[0], r[1]), pk2(r[2], r[3]), pk2(r[4], r[5]), pk2(r[6], r[7])};
        *(u32x4*)(ob + (size_t)row * 1024 + n0 + 128 * wc + cl) = o;
      }
      __builtin_amdgcn_sched_barrier(0);
    }
  }
}

#ifndef DUMMY_MODE
#define DUMMY_MODE -1
#endif
DI void phase_dummy(const P& p, int mode, unsigned char* smem, int tid) {
  GEMM_IDS
  const bf16_t* xb = (const bf16_t*)(p.ws + OFF_XB);
  const bf16_t* wg = (const bf16_t*)(p.ws + OFF_WT_PLEG);
  for (int i = blockIdx.x; i < 256 * 4; i += gridDim.x) {
    int mt, nt; tile_decode(i, 256, 4, mt, nt);
    if (mode == 1) { mt = 0; nt = 0; }
    if (mode == 2) { mt = blockIdx.x & 255; nt = 0; }
    const int m0 = mt * 128, n0 = nt * 256;
    const bf16_t* pa = xb + (size_t)(m0 + lrow) * 1024;
    f32x4 acc[4][8]; zero_acc8(acc);
    gemm_core(acc, pa, pa + 64 * 1024, wg + (size_t)(n0 + lrow) * 1024, 64 * 1024, 32, smem, tid);
    EPI_IDS
    float s = 0.f;
#pragma unroll
    for (int m = 0; m < 4; ++m)
#pragma unroll
      for (int n = 0; n < 8; ++n) s += acc[m][n].x + acc[m][n].y + acc[m][n].z + acc[m][n].w;
    if (s == 123456.789f) ((float*)(p.ws + OFF_GL))[0] = s;
  }
}

DI void attn_item(const P& p, int item, unsigned char* smem, int tid) {
  const int lane = tid & 63, w = tid >> 6, r = lane & 31, hh = lane >> 5;
  const int bh = item & 63, jj = item >> 6;
  int qb; { const int a = jj & 7, grp = jj >> 3; qb = grp == 0 ? 31 - a : grp == 1 ? 16 + a : grp == 2 ? 15 - a : a; }
  const int b = bh >> 3, h = bh & 7;
  const int q0 = qb * 128, qw = q0 + 32 * w;
  const bf16_t* proj = (const bf16_t*)(p.ws + OFF_PROJ0);
  const bf16_t* vT = (const bf16_t*)(p.ws + OFF_VT) + (size_t)bh * 64 * 4096;
  bf16x8 qf[4];
  {
    const bf16_t* qp = proj + (size_t)(b * 4096 + qw + r) * 1536 + 512 + h * 64 + 8 * hh;
#pragma unroll
    for (int s = 0; s < 4; ++s) qf[s] = *(const bf16x8*)(qp + 16 * s);
  }
  f32x16 oacc[2];
#pragma unroll
  for (int i = 0; i < 16; ++i) { oacc[0][i] = 0.f; oacc[1][i] = 0.f; }
  float carry = 0.f;
  const int ntile = q0 / 64 + 2;
  const int lrow = tid >> 3, lc = tid & 7;
  const bf16_t* kbase = proj + (size_t)(b * 4096 + lrow) * 1536 + 1024 + h * 64 + 8 * lc;
  const bf16_t* vbase = vT + (size_t)lrow * 4096 + 8 * lc;
  unsigned char* sK = smem;
  unsigned char* sV = smem + 16384;
  const int kst = lrow * 128 + ((lc ^ (lrow & 7)) << 4);
  const int vst = lrow * 136 + lc * 16;
  u32x4 rk[2], rv[2];
  int kt = ntile - 1;
#pragma unroll
  for (int i = 0; i < 2; ++i) { rk[i] = *(const u32x4*)(kbase + (size_t)(kt * 64 + 32 * i) * 1536); rv[i] = *(const u32x4*)(vbase + (size_t)(32 * i) * 4096 + kt * 64); }
  __syncthreads();
#pragma unroll
  for (int i = 0; i < 2; ++i) {
    *(u32x4*)(sK + kst + i * 4096) = rk[i];
    *(u32x2*)(sV + vst + i * 4352) = (u32x2){rv[i].x, rv[i].y}; *(u32x2*)(sV + vst + i * 4352 + 8) = (u32x2){rv[i].z, rv[i].w};
  }
  __syncthreads();
  int cur = 0;
  for (; kt >= 0; --kt) {
    if (kt > 0) {
#pragma unroll
      for (int i = 0; i < 2; ++i) { rk[i] = *(const u32x4*)(kbase + (size_t)((kt - 1) * 64 + 32 * i) * 1536); rv[i] = *(const u32x4*)(vbase + (size_t)(32 * i) * 4096 + (kt - 1) * 64); }
    }
    const unsigned char* cK = sK + cur * 8192; const unsigned char* cV = sV + cur * 8704;
    const int s0 = kt * 64;
#pragma unroll
    for (int sub = 1; sub >= 0; --sub) {
      const int ks = s0 + 32 * sub;
      if (ks <= qw) {
        f32x16 sc;
#pragma unroll
        for (int i = 0; i < 16; ++i) sc[i] = 0.f;
#pragma unroll
        for (int s = 0; s < 4; ++s) {
          const bf16x8 kf = *(const bf16x8*)(cK + (32 * sub + r) * 128 + (((2 * s + hh) ^ (r & 7)) << 4));
          sc = mfma32(kf, qf[s], sc);
        }
        const bool diag = (ks == qw);
        float lm[16], ls[16];
#pragma unroll
        for (int i = 0; i < 16; ++i) {
          const float z = sc[i];
          const float e = fexp2(-fabsf(z));
          const float sp = fmaxf(z, 0.f) + flog2(1.f + e);
          const bool valid = !diag || (crow(i, hh) < r);
          lm[i] = valid ? -sp : 0.f;
          ls[i] = valid ? (z - sp) : -1e30f;
        }
        float G[4], Pp[4], Tt[4];
#pragma unroll
        for (int g = 0; g < 4; ++g) { G[g] = (lm[4 * g] + lm[4 * g + 1]) + (lm[4 * g + 2] + lm[4 * g + 3]); Pp[g] = __shfl_xor(G[g], 32); Tt[g] = G[g] + Pp[g]; }
        float after = carry;
        f32x16 av;
#pragma unroll
        for (int g = 3; g >= 0; --g) {
          float base = after + (hh == 0 ? Pp[g] : 0.f);
          float k3 = base, k2 = k3 + lm[4 * g + 3], k1 = k2 + lm[4 * g + 2], k0 = k1 + lm[4 * g + 1];
          av[4 * g + 3] = fexp2(ls[4 * g + 3] + k3); av[4 * g + 2] = fexp2(ls[4 * g + 2] + k2);
          av[4 * g + 1] = fexp2(ls[4 * g + 1] + k1); av[4 * g + 0] = fexp2(ls[4 * g + 0] + k0);
          after += Tt[g];
        }
        carry = after;
#pragma unroll
        for (int s = 0; s < 2; ++s) {
          const bf16x8 ap = pack_step(av, s);
#pragma unroll
          for (int dt = 0; dt < 2; ++dt) {
            const unsigned char* vp = cV + (32 * dt + r) * 136 + (32 * sub + 16 * s + 4 * hh) * 2;
            const bf16x8 vf = mk8(*(const u32x2*)vp, *(const u32x2*)(vp + 16));
            oacc[dt] = mfma32(vf, ap, oacc[dt]);
          }
        }
      }
    }
    if (kt > 0) {
      unsigned char* nK = sK + (cur ^ 1) * 8192; unsigned char* nV = sV + (cur ^ 1) * 8704;
#pragma unroll
      for (int i = 0; i < 2; ++i) {
        *(u32x4*)(nK + kst + i * 4096) = rk[i];
        *(u32x2*)(nV + vst + i * 4352) = (u32x2){rv[i].x, rv[i].y}; *(u32x2*)(nV + vst + i * 4352 + 8) = (u32x2){rv[i].z, rv[i].w};
      }
    }
    __syncthreads();
    cur ^= 1;
  }
  bf16_t* cat = (bf16_t*)(p.ws + OFF_CAT) + (size_t)(b * 4096 + qw + r) * 1024 + 512 + h * 64;
#pragma unroll
  for (int dt = 0; dt < 2; ++dt)
#pragma unroll
    for (int g = 0; g < 4; ++g) {
      u32x2 o = {pk2(oacc[dt][4 * g], oacc[dt][4 * g + 1]), pk2(oacc[dt][4 * g + 2], oacc[dt][4 * g + 3])};
      *(u32x2*)(cat + 32 * dt + 8 * g + 4 * hh) = o;
    }
}

DI void pool_item(const P& p, int item, unsigned char* smem, int tid) {
  const int lane = tid & 63, wid = tid >> 6, wr = wid >> 1, wc = wid & 1, fr = lane & 15, fq = lane >> 4; const int lrow = tid >> 3, lc = tid & 7; (void)lane;
  const int g = item & 3, mt = item >> 2;
  const int m0 = mt * 128;
  const bf16_t* proj = (const bf16_t*)(p.ws + OFF_PROJ0);
  const bf16_t* wt = (const bf16_t*)(p.ws + OFF_WT_POOL) + (size_t)g * 128 * 128;
  unsigned char* sA = smem; unsigned char* sB = smem + 32768;
  __syncthreads();
  {
    const int st_off = lrow * 128 + ((lc ^ (lrow & 7)) << 4);
#pragma unroll
    for (int kt = 0; kt < 2; ++kt)
#pragma unroll
      for (int i = 0; i < 4; ++i) *(u32x4*)(sB + kt * 16384 + st_off + i * 4096) = *(const u32x4*)(wt + (size_t)(lrow + 32 * i) * 128 + kt * 64 + 8 * lc);
  }
  {
    const int c = tid & 127, half = tid >> 7;
    const int w = 2 << g;
    const int tb = (m0 & 4095) + 64 * half;
    const bf16_t* up = proj + (size_t)(m0 - (m0 & 4095)) * 1536 + g * 128 + c;
    float run = 0.f;
    for (int k = 1; k < w; ++k) { const int t = tb - k; if (t >= 0) run += bf2f(up[(size_t)t * 1536]); }
    const int stg = c >> 6, kk = c & 63, chk = kk >> 3, wi = kk & 7;
    for (int rr = 0; rr < 64; ++rr) {
      const int t = tb + rr; const int lr = 64 * half + rr;
      const float ut = bf2f(up[(size_t)t * 1536]);
      run += ut;
      const int cnt = (t + 1 < w) ? (t + 1) : w;
      const float y = run / (float)cnt - ut;
      *(bf16_t*)(sA + stg * 16384 + lr * 128 + ((chk ^ (lr & 7)) << 4) + wi * 2) = f2bf(y);
      if (t - w + 1 >= 0) run -= bf2f(up[(size_t)(t - w + 1) * 1536]);
    }
  }
  __syncthreads();
  f32x4 acc[4][4]; zero_acc(acc);
  const int a_rd = (64 * wr + fr) * 128, b_rd = (64 * wc + fr) * 128;
  const int sw0 = (fq ^ (fr & 7)) << 4, sw1 = ((4 + fq) ^ (fr & 7)) << 4;
  mma_stage(acc, sA, sB, a_rd, b_rd, sw0, sw1);
  mma_stage(acc, sA + 16384, sB + 16384, a_rd, b_rd, sw0, sw1);
  const float* psc = p.in[5] + g * 128;
  bf16_t* cat = (bf16_t*)(p.ws + OFF_CAT);
#pragma unroll
  for (int m = 0; m < 4; ++m) {
    const int row = m0 + 64 * wr + 16 * m + fr;
#pragma unroll
    for (int n = 0; n < 4; ++n) {
      const int cl = 64 * wc + 16 * n + 4 * fq;
      const f32x4 s4 = *(const f32x4*)(psc + cl);
      const f32x4 v = acc[m][n] * s4;
      u32x2 o = {pk2(v.x, v.y), pk2(v.z, v.w)};
      *(u32x2*)(cat + (size_t)row * 1024 + g * 128 + cl) = o;
    }
  }
}


template <int I> struct SolveRow {
  static DI void run(float (&sol)[64], const float* A_v) {
    float s = sol[I];
#pragma unroll
    for (int g8 = 0; g8 < (I + 31) / 32; ++g8) {
      f32x4 a[8];
#pragma unroll
      for (int q = 0; q < 8; ++q) if (32 * g8 + 4 * q < I) a[q] = *(const f32x4*)(A_v + I * 68 + 32 * g8 + 4 * q);
#pragma unroll
      for (int q = 0; q < 8; ++q) {
        const int j = 32 * g8 + 4 * q;
        if (j + 0 < I) s -= a[q].x * sol[j + 0];
        if (j + 1 < I) s -= a[q].y * sol[j + 1];
        if (j + 2 < I) s -= a[q].z * sol[j + 2];
        if (j + 3 < I) s -= a[q].w * sol[j + 3];
      }
      __builtin_amdgcn_sched_barrier(0);
    }
    sol[I] = s;
    SolveRow<I + 1>::run(sol, A_v);
  }
};
template <> struct SolveRow<64> { static DI void run(float (&)[64], const float*) {} };

constexpr int GD_RAW = 0, GD_Q = 18224, GD_K = GD_Q + 17408, GD_V = GD_K + 17408, GD_GC = GD_V + 17408, GD_BETA = GD_GC + 256;
DI void gdn_chunk_item(const P& p, int qi, int item, unsigned char* smem, int tid) {
  const int lane = tid & 63, w = tid >> 6, r = lane & 31, hh = lane >> 5;
  const int h = item & 7, n = (item >> 3) & 63, bq = item >> 9;
  const int b = 2 * qi + bq;
  const int chunk = (b * 8 + h) * 64 + n;
  const bf16_t* qkv = (const bf16_t*)(p.ws + OFF_QKV) + (size_t)(bq * 4096) * 3072;
  const float* gb = (const float*)(p.ws + OFF_GB);
  const float* cw = p.in[9];
  float* gc_s = (float*)(smem + GD_GC); float* beta_s = (float*)(smem + GD_BETA);
  __syncthreads();
  if (w == 0) {
    const int tok = b * 4096 + 64 * n + lane;
    float g = gb[(size_t)tok * 16 + 8 + h]; const float be = gb[(size_t)tok * 16 + h];
#pragma unroll
    for (int off = 1; off < 64; off <<= 1) { const float t = __shfl_up(g, off); if (lane >= off) g += t; }
    gc_s[lane] = g; beta_s[lane] = be;
  }
#pragma unroll 1
  for (int pp = 0; pp < 3; ++pp) {
    for (int i = 0; i < 5; ++i) {
      const int idx = tid + 256 * i;
      if (idx < 1072) {
        const int rr = idx >> 4, c = idx & 15; const int t = 64 * n - 3 + rr;
        u32x4 v = {0u, 0u, 0u, 0u};
        if (t >= 0) v = *(const u32x4*)(qkv + (size_t)t * 3072 + pp * 1024 + h * 128 + 8 * c);
        *(u32x4*)(smem + GD_RAW + rr * 272 + 16 * c) = v;
      }
    }
    __syncthreads();
    {
      const int row = tid >> 2, qtr = tid & 3; const int ch0 = 32 * qtr;
      float y[32];
#pragma unroll
      for (int sub = 0; sub < 4; ++sub) {
        float a[8];
#pragma unroll
        for (int e = 0; e < 8; ++e) a[e] = 0.f;
#pragma unroll
        for (int tap = 0; tap < 4; ++tap) {
          const u32x4 xv = *(const u32x4*)(smem + GD_RAW + (row + tap) * 272 + (ch0 + 8 * sub) * 2);
          const float* wp = cw + (size_t)tap * 3072 + pp * 1024 + h * 128 + ch0 + 8 * sub;
          const f32x4 w0 = *(const f32x4*)wp, w1 = *(const f32x4*)(wp + 4);
          a[0] += w0.x * bflo(xv.x); a[1] += w0.y * bfhi(xv.x); a[2] += w0.z * bflo(xv.y); a[3] += w0.w * bfhi(xv.y);
          a[4] += w1.x * bflo(xv.z); a[5] += w1.y * bfhi(xv.z); a[6] += w1.z * bflo(xv.w); a[7] += w1.w * bfhi(xv.w);
        }
#pragma unroll
        for (int e = 0; e < 8; ++e) y[8 * sub + e] = siluf_(a[e]);
        __builtin_amdgcn_sched_barrier(0);
      }
      if (pp < 2) {
        float s = 0.f;
#pragma unroll
        for (int e = 0; e < 32; ++e) s += y[e] * y[e];
        s += __shfl_xor(s, 1); s += __shfl_xor(s, 2);
        const float inv = rsqrtf(s + EPSF) * (pp == 0 ? 0.08838834764831845f : 1.f);
#pragma unroll
        for (int e = 0; e < 32; ++e) y[e] *= inv;
      }
      unsigned char* dst = smem + (pp == 0 ? GD_Q : pp == 1 ? GD_K : GD_V) + row * 272 + ch0 * 2;
#pragma unroll
      for (int sub = 0; sub < 4; ++sub) {
        u32x4 o = {pk2(y[8 * sub], y[8 * sub + 1]), pk2(y[8 * sub + 2], y[8 * sub + 3]), pk2(y[8 * sub + 4], y[8 * sub + 5]), pk2(y[8 * sub + 6], y[8 * sub + 7])};
        *(u32x4*)(dst + 16 * sub) = o;
      }
    }
    __syncthreads();
  }
  float* A_s = (float*)(smem + GD_RAW);
  bf16_t* qkb = (bf16_t*)(p.ws + OFF_QK) + (size_t)chunk * 4096;
  {
    const int ti = w >> 1, tj = w & 1;
    const int j = 32 * tj + r;
    if (ti == 0 && tj == 1) {
#pragma unroll
      for (int reg = 0; reg < 16; ++reg) qkb[(32 * ti + crow(reg, hh)) * 64 + j] = 0;
    } else {
      f32x16 kk, qk;
#pragma unroll
      for (int i = 0; i < 16; ++i) { kk[i] = 0.f; qk[i] = 0.f; }
#pragma unroll
      for (int s = 0; s < 8; ++s) {
        const bf16x8 bfrag = *(const bf16x8*)(smem + GD_K + (32 * tj + r) * 272 + (16 * s + 8 * hh) * 2);
        const bf16x8 akf = *(const bf16x8*)(smem + GD_K + (32 * ti + r) * 272 + (16 * s + 8 * hh) * 2);
        const bf16x8 aqf = *(const bf16x8*)(smem + GD_Q + (32 * ti + r) * 272 + (16 * s + 8 * hh) * 2);
        kk = mfma32(akf, bfrag, kk); qk = mfma32(aqf, bfrag, qk);
      }
      const float gcj = gc_s[j];
#pragma unroll
      for (int reg = 0; reg < 16; ++reg) {
        const int i = 32 * ti + crow(reg, hh);
        const float dec = (i >= j) ? __expf(gc_s[i] - gcj) : 0.f;
        A_s[i * 68 + j] = (i > j) ? beta_s[i] * kk[reg] * dec : 0.f;
        qkb[i * 64 + j] = f2bf((i >= j) ? qk[reg] * dec : 0.f);
      }
    }
  }
  __syncthreads();
  {
    const int col = tid; const bool isw = col >= 128; const int d = col & 127;
    int vz; asm volatile("v_mov_b32 %0, 0" : "=v"(vz));
    const float* A_v = A_s + vz; const float* gc_v = gc_s + vz; const float* beta_v = beta_s + vz;
    const unsigned char* src = smem + (isw ? GD_K : GD_V) + d * 2;
    float sol[64];
#pragma unroll
    for (int i = 0; i < 64; ++i) {
      float v = bf2f(*(const bf16_t*)(src + i * 272)) * beta_v[i];
      if (isw) v *= __expf(gc_v[i]);
      sol[i] = v;
    }
    SolveRow<1>::run(sol, A_v);
    __syncthreads();
    if (!isw) {
      bf16_t* ut = (bf16_t*)(p.ws + OFF_UT) + (size_t)chunk * 8192 + d * 64;
#pragma unroll
      for (int c8 = 0; c8 < 8; ++c8) {
        u32x4 o = {pk2(sol[8 * c8], sol[8 * c8 + 1]), pk2(sol[8 * c8 + 2], sol[8 * c8 + 3]), pk2(sol[8 * c8 + 4], sol[8 * c8 + 5]), pk2(sol[8 * c8 + 6], sol[8 * c8 + 7])};
        *(u32x4*)(ut + 8 * c8) = o;
      }
      unsigned char* qp = smem + GD_Q + d * 2;
#pragma unroll
      for (int i = 0; i < 64; ++i) { const float v = bf2f(*(const bf16_t*)(qp + i * 272)) * __expf(gc_v[i]); *(bf16_t*)(qp + i * 272) = f2bf(v); }
    } else {
      unsigned char* wp = smem + GD_V + d * 2;
#pragma unroll
      for (int i = 0; i < 64; ++i) *(bf16_t*)(wp + i * 272) = f2bf(-sol[i]);
      bf16_t* kd = (bf16_t*)(p.ws + OFF_KD) + (size_t)chunk * 8192 + d * 64;
      const float gl = gc_v[63];
#pragma unroll
      for (int c8 = 0; c8 < 8; ++c8) {
        float kv[8];
#pragma unroll
        for (int e = 0; e < 8; ++e) kv[e] = bf2f(*(const bf16_t*)(smem + GD_K + (8 * c8 + e) * 272 + d * 2)) * __expf(gl - gc_v[8 * c8 + e]);
        u32x4 o = {pk2(kv[0], kv[1]), pk2(kv[2], kv[3]), pk2(kv[4], kv[5]), pk2(kv[6], kv[7])};
        *(u32x4*)(kd + 8 * c8) = o;
      }
    }
    if (tid == 0) ((float*)(p.ws + OFF_GL))[chunk] = __expf(gc_s[63]);
    __syncthreads();
    {
      bf16_t* wn = (bf16_t*)(p.ws + OFF_WN) + (size_t)chunk * 8192;
      bf16_t* qd = (bf16_t*)(p.ws + OFF_QD) + (size_t)chunk * 8192;
#pragma unroll 1
      for (int i = 0; i < 4; ++i) {
        const int idx = tid + 256 * i; const int lo = (idx >> 4) * 272 + (idx & 15) * 16;
        *(u32x4*)(wn + (size_t)idx * 8) = *(const u32x4*)(smem + GD_V + lo);
        *(u32x4*)(qd + (size_t)idx * 8) = *(const u32x4*)(smem + GD_Q + lo);
      }
    }
  }
}

constexpr int SC_W = 0, SC_QD = 17408, SC_QK = 34816, SC_KD = 34816 + 9216;
DI bf16x8 pack44(const f32x4& a, const f32x4& b) { u32x4 v = {pk2(a.x, a.y), pk2(a.z, a.w), pk2(b.x, b.y), pk2(b.z, b.w)}; return __builtin_bit_cast(bf16x8, v); }
DI void scan_item(const P& p, int item, unsigned char* smem, int tid) {
  const int lane = tid & 63, w = tid >> 6, fr = lane & 15, fq = lane >> 4;
  const int bh = item >> 1, e0 = 64 * (item & 1) + 16 * w;
  const bf16_t* WN = (const bf16_t*)(p.ws + OFF_WN); const bf16_t* QD = (const bf16_t*)(p.ws + OFF_QD);
  const bf16_t* KD = (const bf16_t*)(p.ws + OFF_KD); const bf16_t* QK = (const bf16_t*)(p.ws + OFF_QK);
  const bf16_t* UT = (const bf16_t*)(p.ws + OFF_UT); const float* GL = (const float*)(p.ws + OFF_GL);
  f32x4 S[8];
#pragma unroll
  for (int dt = 0; dt < 8; ++dt) S[dt] = (f32x4){0.f, 0.f, 0.f, 0.f};
  u32x4 st[14];
  const int chunk0 = bh * 64;
#define SC_LOAD(CH) do { \
    const size_t cb = (size_t)(CH) * 8192; \
    _Pragma("unroll") for (int i = 0; i < 4; ++i) { st[i] = *(const u32x4*)(WN + cb + (size_t)(tid + 256 * i) * 8); st[4 + i] = *(const u32x4*)(QD + cb + (size_t)(tid + 256 * i) * 8); st[10 + i] = *(const u32x4*)(KD + cb + (size_t)(tid + 256 * i) * 8); } \
    _Pragma("unroll") for (int i = 0; i < 2; ++i) st[8 + i] = *(const u32x4*)(QK + (size_t)(CH) * 4096 + (size_t)(tid + 256 * i) * 8); \
  } while (0)
#define SC_STORE() do { \
    _Pragma("unroll") for (int i = 0; i < 4; ++i) { const int idx = tid + 256 * i; const int o16 = (idx >> 4) * 272 + (idx & 15) * 16; *(u32x4*)(smem + SC_W + o16) = st[i]; *(u32x4*)(smem + SC_QD + o16) = st[4 + i]; \
      const int o8 = (idx >> 3) * 144 + (idx & 7) * 16; *(u32x4*)(smem + SC_KD + o8) = st[10 + i]; } \
    _Pragma("unroll") for (int i = 0; i < 2; ++i) { const int idx = tid + 256 * i; const int o8 = (idx >> 3) * 144 + (idx & 7) * 16; *(u32x4*)(smem + SC_QK + o8) = st[8 + i]; } \
  } while (0)
  SC_LOAD(chunk0);
  __syncthreads();
  for (int n = 0; n < 64; ++n) {
    const int chunk = chunk0 + n;
    SC_STORE();
    __syncthreads();
    if (n + 1 < 64) SC_LOAD(chunk + 1);
    f32x4 vn[4];
    {
      const bf16_t* up = UT + (size_t)chunk * 8192 + (size_t)(e0 + fr) * 64 + 4 * fq;
#pragma unroll
      for (int ct = 0; ct < 4; ++ct) { const u32x2 u = *(const u32x2*)(up + 16 * ct); vn[ct] = (f32x4){bflo(u.x), bfhi(u.x), bflo(u.y), bfhi(u.y)}; }
    }
    const float gl = GL[chunk];
    bf16x8 Sp[4];
#pragma unroll
    for (int kk = 0; kk < 4; ++kk) Sp[kk] = pack44(S[2 * kk], S[2 * kk + 1]);
#pragma unroll
    for (int ct = 0; ct < 4; ++ct)
#pragma unroll
      for (int kk = 0; kk < 4; ++kk) {
        const unsigned char* ap = smem + SC_W + (16 * ct + fr) * 272 + (32 * kk + 4 * fq) * 2;
        vn[ct] = mfma16(mk8(*(const u32x2*)ap, *(const u32x2*)(ap + 32)), Sp[kk], vn[ct]);
      }
    bf16x8 vp[2];
    vp[0] = pack44(vn[0], vn[1]); vp[1] = pack44(vn[2], vn[3]);
#pragma unroll
    for (int ct = 0; ct < 4; ++ct) {
      f32x4 o = {0.f, 0.f, 0.f, 0.f};
#pragma unroll
      for (int kk = 0; kk < 4; ++kk) {
        const unsigned char* ap = smem + SC_QD + (16 * ct + fr) * 272 + (32 * kk + 4 * fq) * 2;
        o = mfma16(mk8(*(const u32x2*)ap, *(const u32x2*)(ap + 32)), Sp[kk], o);
      }
#pragma unroll
      for (int kc = 0; kc < 2; ++kc) {
        const unsigned char* ap = smem + SC_QK + (16 * ct + fr) * 144 + (32 * kc + 4 * fq) * 2;
        o = mfma16(mk8(*(const u32x2*)ap, *(const u32x2*)(ap + 32)), vp[kc], o);
      }
      bf16_t* op = (bf16_t*)(p.ws + OFF_UT) + (size_t)chunk * 8192 + (size_t)(e0 + fr) * 64 + 16 * ct + 4 * fq;
      *(u32x2*)op = (u32x2){pk2(o.x, o.y), pk2(o.z, o.w)};
    }
#pragma unroll
    for (int dt = 0; dt < 8; ++dt) {
      S[dt] = S[dt] * gl;
#pragma unroll
      for (int kc = 0; kc < 2; ++kc) {
        const unsigned char* ap = smem + SC_KD + (16 * dt + fr) * 144 + (32 * kc + 4 * fq) * 2;
        S[dt] = mfma16(mk8(*(const u32x2*)ap, *(const u32x2*)(ap + 32)), vp[kc], S[dt]);
      }
    }
    __syncthreads();
  }
}

DI void phase_final(const P& p, int tid) {
  const int lane = tid & 63, wid = tid >> 6;
  float* x = p.out; const float* g = p.in[21];
  for (int row = blockIdx.x * 4 + wid; row < NTOK; row += gridDim.x * 4) {
    f32x4 v[4]; float s = 0.f;
#pragma unroll
    for (int i = 0; i < 4; ++i) { v[i] = *(const f32x4*)(x + (size_t)row * 1024 + 256 * i + 4 * lane); s += v[i].x * v[i].x + v[i].y * v[i].y + v[i].z * v[i].z + v[i].w * v[i].w; }
#pragma unroll
    for (int off = 32; off > 0; off >>= 1) s += __shfl_xor(s, off);
    const float rs = rsqrtf(s * (1.f / 1024.f) + EPSF);
#pragma unroll
    for (int i = 0; i < 4; ++i) { const f32x4 gg = *(const f32x4*)(g + 256 * i + 4 * lane); *(f32x4*)(x + (size_t)row * 1024 + 256 * i + 4 * lane) = v[i] * rs * gg; }
  }
}


#define XB_TMO      128
#define XB_XCNT(j)  (256  + 64 * (j))
#define XB_XSUB(j)  (1280 + 64 * (j))
#define XB_XGEN(j)  (2304 + 64 * (j))
#define XB_TOP      3328
#define XB_TOPGEN   3392
#define XCD_BAR_WORDS 3456
#define XB_SPIN_CAP (1u << 18)
#define LAS __attribute__((address_space(3)))
DI unsigned xb_ld(unsigned* p)              { return __hip_atomic_load(p, __ATOMIC_RELAXED, __HIP_MEMORY_SCOPE_AGENT); }
DI unsigned xb_add(unsigned* p, unsigned v) { return __hip_atomic_fetch_add(p, v, __ATOMIC_RELAXED, __HIP_MEMORY_SCOPE_AGENT); }
DI unsigned xb_xcc_id() { return (unsigned)__builtin_amdgcn_s_getreg((3 << 11) | 20) & 0xFu; }
#define XB_SPIN(cond, bar) do { unsigned _sp = 0; while (cond) { __builtin_amdgcn_s_sleep(1); \
    if ((++_sp & 255u) == 0u) { if (xb_ld(&(bar)[XB_TMO])) break; if (_sp > XB_SPIN_CAP) { atomicAdd(&(bar)[XB_TMO], 1u); break; } } } } while (0)
struct XcdBarrier { unsigned* bar; unsigned x; volatile LAS unsigned* st; };
DI XcdBarrier xcd_barrier_post(unsigned* bar, volatile LAS unsigned* st) {
  XcdBarrier b; b.bar = bar; b.x = xb_xcc_id(); b.st = st;
  if (threadIdx.x == 0) (void)xb_add(&bar[XB_XCNT(b.x)], 1u);
  return b;
}
DI void xcd_barrier_complete(unsigned* bar, unsigned x, unsigned& nloc, unsigned& nx) {
  const unsigned G = gridDim.x * gridDim.y * gridDim.z;
  unsigned sum, cnt, mine, sp = 0u;
  for (;;) {
    sum = 0u; cnt = 0u; mine = 0u;
#pragma unroll
    for (unsigned j = 0; j < 16; ++j) { const unsigned c = xb_ld(&bar[XB_XCNT(j)]); sum += c; cnt += (c > 0u) ? 1u : 0u; mine = (j == x) ? c : mine; }
    if (sum == G) break;
    __builtin_amdgcn_s_sleep(1);
    if ((++sp & 255u) == 0u) { if (xb_ld(&bar[XB_TMO])) break; if (sp > XB_SPIN_CAP) { atomicAdd(&bar[XB_TMO], 1u); break; } }
  }
  nloc = mine > 0u ? mine : 1u; nx = cnt > 0u ? cnt : 1u;
}
DI void xcd_barrier(const XcdBarrier& b) {
  asm volatile("s_waitcnt vmcnt(0)" ::: "memory");
  __syncthreads();
  if (threadIdx.x == 0) {
    unsigned* bar = b.bar;
    asm volatile("" : "+s"(bar));
    __builtin_amdgcn_s_waitcnt(0);
    unsigned nloc = b.st[0], nx = b.st[1];
    if (nloc == 0u) { xcd_barrier_complete(bar, b.x, nloc, nx); b.st[0] = nloc; b.st[1] = nx; }
    const unsigned old = xb_add(&bar[XB_XSUB(b.x)], 1u);
    const unsigned gen = old / nloc;
    if (old + 1u == (gen + 1u) * nloc) {
      __builtin_amdgcn_fence(__ATOMIC_RELEASE, "agent");
      asm volatile("s_waitcnt vmcnt(0)" ::: "memory");
      const unsigned og = xb_add(&bar[XB_TOP], 1u);
      const unsigned tg = og / nx;
      if (og + 1u == (tg + 1u) * nx) xb_add(&bar[XB_TOPGEN], 1u);
      else XB_SPIN(xb_ld(&bar[XB_TOPGEN]) == tg, bar);
      __builtin_amdgcn_fence(__ATOMIC_ACQUIRE, "agent");
      xb_add(&bar[XB_XGEN(b.x)], 1u);
      asm volatile("s_waitcnt vmcnt(0)" ::: "memory");
    } else {
      XB_SPIN(xb_ld(&bar[XB_XGEN(b.x)]) == gen, bar);
      __builtin_amdgcn_fence(__ATOMIC_ACQUIRE, "agent");
      asm volatile("s_waitcnt vmcnt(0)" ::: "memory");
    }
  }
  __syncthreads();
}

constexpr int N_PHASES = 24;
typedef const __attribute__((address_space(4))) P* KP;
DI P loadP(KP kp) {
  P p;
#pragma unroll
  for (int i = 0; i < 22; ++i) p.in[i] = kp->in[i];
  p.out = kp->out; p.ws = kp->ws;
  return p;
}
#define SSP(k) ((float*)(p.ws + OFF_SS) + (k) * NTOK)
#define PH_BEGIN { KP kp = (KP)__builtin_amdgcn_kernarg_segment_ptr(); asm volatile("" : "+s"(kp)); \
    unsigned zz_; asm volatile("v_mov_b32 %0, 0" : "=v"(zz_)); \
    int tid = wbase + (int)__builtin_amdgcn_mbcnt_hi(~0u, __builtin_amdgcn_mbcnt_lo(~0u, zz_)); asm volatile("" : "+v"(tid)); \
    const P p = loadP(kp);
#define PH_END } xcd_barrier(xb);

__global__ void __launch_bounds__(256, 2) mega(P p_arg, int ph_lo, int ph_hi) {
  extern __shared__ __attribute__((aligned(16))) unsigned char smem[];
  __shared__ uint4 xb_words;
  cg::grid_group grid = cg::this_grid();
  if (threadIdx.x == 0) xb_words = make_uint4(0u, 0u, 0u, 0u);
  __syncthreads();
  const int wbase = __builtin_amdgcn_readfirstlane((int)(threadIdx.x & ~63u));
  XcdBarrier xb = xcd_barrier_post((unsigned*)(p_arg.ws + OFF_BAR), (volatile LAS unsigned*)&xb_words);
  if (ph_hi < 0) grid.sync();

  PH_BEGIN phase_prologue(p, smem, tid); PH_END
#if REP_PHASE == 0
  PH_BEGIN phase_prologue(p, smem, tid); PH_END
#endif
#pragma unroll 1
  for (int layer = 0; layer < 2; ++layer) {
    if (layer == 0) {
      PH_BEGIN phase_in_e(p, smem, tid); PH_END
      PH_BEGIN for (int i = blockIdx.x; i < 2048 + 1024; i += gridDim.x) { if (i < 2048) attn_item(p, i, smem, tid); else pool_item(p, i - 2048, smem, tid); } PH_END
#if REP_PHASE == 2
      PH_BEGIN for (int i = blockIdx.x; i < 2048 + 1024; i += gridDim.x) { if (i < 2048) attn_item(p, i, smem, tid); else pool_item(p, i - 2048, smem, tid); } PH_END
#endif
    } else {
#pragma unroll 1
      for (int qi = 0; qi < 4; ++qi) {
        PH_BEGIN phase_in_o(p, qi, smem, tid); PH_END
        PH_BEGIN for (int i = blockIdx.x; i < 1024; i += gridDim.x) gdn_chunk_item(p, qi, i, smem, tid); PH_END
#if REP_PHASE == 9
        if (qi == 0) { PH_BEGIN for (int i = blockIdx.x; i < 1024; i += gridDim.x) gdn_chunk_item(p, qi, i, smem, tid); PH_END }
#endif
      }
      PH_BEGIN for (int i = blockIdx.x; i < 128; i += gridDim.x) scan_item(p, i, smem, tid); PH_END
      PH_BEGIN phase_z_gate(p, smem, tid); PH_END
    }
    PH_BEGIN
      phase_resid(p, (const bf16_t*)(p.ws + (layer ? OFF_OB : OFF_CAT)), 1024, (const bf16_t*)(p.ws + (layer ? OFF_WT_OUTO : OFF_WT_OUTE)), layer ? p.out : p.in[0], SSP(1 + 3 * layer), smem, tid);
    PH_END
    PH_BEGIN phase_ffn_up(p, layer, SSP(1 + 3 * layer), smem, tid); PH_END
#if REP_PHASE == 4
    if (layer == 0) { PH_BEGIN phase_ffn_up(p, layer, SSP(1 + 3 * layer), smem, tid); PH_END }
#endif
    PH_BEGIN phase_resid(p, (const bf16_t*)(p.ws + OFF_ACT), 2816, (const bf16_t*)(p.ws + OFF_WT_DOWN) + (size_t)layer * 1024 * 2816, p.out, SSP(2 + 3 * layer), smem, tid); PH_END
    PH_BEGIN phase_ple_gate(p, layer, SSP(2 + 3 * layer), smem, tid); PH_END
#if REP_PHASE == 6
    if (layer == 0) { PH_BEGIN phase_ple_gate(p, layer, SSP(2 + 3 * layer), smem, tid); PH_END }
#endif
    PH_BEGIN phase_ple_add(p, layer, SSP(3 + 3 * layer), smem, tid); PH_END
  }
#if DUMMY_MODE >= 0
  PH_BEGIN phase_dummy(p, DUMMY_MODE, smem, tid); PH_END
#endif
  PH_BEGIN phase_final(p, tid); }
}

extern "C" void kernel_launch(void* const* d_in, const int* in_sizes, int n_in, void* d_out, int out_size, void* d_ws, size_t ws_size, hipStream_t stream) {
  static int grid_blocks = 0;
  if (!grid_blocks) {
    int dev = 0, cus = 0, per_cu = 0;
    hipGetDevice(&dev);
    hipDeviceGetAttribute(&cus, hipDeviceAttributeMultiprocessorCount, dev);
    hipFuncSetAttribute((const void*)mega, hipFuncAttributeMaxDynamicSharedMemorySize, SMEM_BYTES);
    hipOccupancyMaxActiveBlocksPerMultiprocessor(&per_cu, mega, 256, SMEM_BYTES);
    if (per_cu > 2) per_cu = 2;
    if (per_cu < 1) per_cu = 1;
    grid_blocks = cus * per_cu;
  }
  P p{};
  for (int i = 0; i < 22; ++i) p.in[i] = (const float*)d_in[i];
  p.out = (float*)d_out;
  p.ws = (unsigned char*)d_ws;
  hipMemsetAsync(p.ws + OFF_BAR, 0, XCD_BAR_WORDS * 4, stream);
#if MULTI_LAUNCH
  for (int ph = 0; ph < N_PHASES; ++ph) {
    int lo = ph, hi = ph + 1;
    void* args[] = {&p, &lo, &hi};
    hipError_t e = hipLaunchCooperativeKernel((const void*)mega, dim3(grid_blocks), dim3(256), args, SMEM_BYTES, stream);
    if (e != hipSuccess) fprintf(stderr, "launch failed: %s\n", hipGetErrorString(e));
  }
#else
  int lo = 0, hi = N_PHASES;
  void* args[] = {&p, &lo, &hi};
  hipError_t e = hipLaunchCooperativeKernel((const void*)mega, dim3(grid_blocks), dim3(256), args, SMEM_BYTES, stream);
  if (e != hipSuccess) fprintf(stderr, "launch failed: %s (grid %d)\n", hipGetErrorString(e), grid_blocks);
#endif
}
```

```cpp
#include <hip/hip_runtime.h>
#include <hip/hip_cooperative_groups.h>
#include <stdint.h>
#include <cstdio>
namespace cg = cooperative_groups;

#ifndef REP_PHASE
#define REP_PHASE -1
#endif
#ifndef MULTI_LAUNCH
#define MULTI_LAUNCH 0
#endif

#define DI __device__ __forceinline__
typedef unsigned short bf16_t;
typedef short bf16x8 __attribute__((ext_vector_type(8)));
typedef float f32x4 __attribute__((ext_vector_type(4)));
typedef float f32x2 __attribute__((ext_vector_type(2)));
typedef float f32x16 __attribute__((ext_vector_type(16)));
typedef unsigned u32x4 __attribute__((ext_vector_type(4)));
typedef unsigned u32x2 __attribute__((ext_vector_type(2)));
typedef __bf16 hbf2 __attribute__((ext_vector_type(2)));

DI unsigned pk2(float lo, float hi) { f32x2 v = {lo, hi}; hbf2 r = __builtin_convertvector(v, hbf2); return __builtin_bit_cast(unsigned, r); }
DI bf16_t f2bf(float x) { return (bf16_t)(pk2(x, 0.f) & 0xffffu); }
DI float bf2f(bf16_t v) { return __uint_as_float(((unsigned)v) << 16); }
DI float bflo(unsigned u) { return __uint_as_float(u << 16); }
DI float bfhi(unsigned u) { return __uint_as_float(u & 0xffff0000u); }
DI f32x4 mfma16(bf16x8 a, bf16x8 b, f32x4 c) { return __builtin_amdgcn_mfma_f32_16x16x32_bf16(a, b, c, 0, 0, 0); }
DI f32x16 mfma32(bf16x8 a, bf16x8 b, f32x16 c) { return __builtin_amdgcn_mfma_f32_32x32x16_bf16(a, b, c, 0, 0, 0); }
DI int crow(int reg, int hh) { return (reg & 3) + 8 * (reg >> 2) + 4 * hh; }
DI float fexp2(float x) { return __builtin_amdgcn_exp2f(x); }
DI float flog2(float x) { return __builtin_amdgcn_logf(x); }
DI float frcp(float x) { return __builtin_amdgcn_rcpf(x); }
DI float fexp(float x) { return __builtin_amdgcn_exp2f(x * 1.4426950408889634f); }
DI float sigmoidf_(float x) { return frcp(1.f + fexp(-x)); }
DI float siluf_(float x) { return x * frcp(1.f + fexp(-x)); }
DI bf16x8 mk8(u32x2 lo, u32x2 hi) { u32x4 v = {lo.x, lo.y, hi.x, hi.y}; return __builtin_bit_cast(bf16x8, v); }
DI bf16x8 pack_step(const f32x16& x, int s) {
  u32x4 v;
  v.x = pk2(x[8 * s + 0], x[8 * s + 1]); v.y = pk2(x[8 * s + 2], x[8 * s + 3]);
  v.z = pk2(x[8 * s + 4], x[8 * s + 5]); v.w = pk2(x[8 * s + 6], x[8 * s + 7]);
  return __builtin_bit_cast(bf16x8, v);
}

constexpr int SEQ = 4096, DM = 1024, NTOK = 32768;
constexpr int SMEM_BYTES = 73728;
constexpr float EPSF = 1e-6f;

constexpr size_t OFF_WT_INE = 0;
constexpr size_t OFF_WT_OUTE = OFF_WT_INE + 2048ull * 1024 * 2;
constexpr size_t OFF_WT_INO = OFF_WT_OUTE + 1024ull * 1024 * 2;
constexpr size_t OFF_WT_Z = OFF_WT_INO + 3328ull * 1024 * 2;
constexpr size_t OFF_WT_OUTO = OFF_WT_Z + 1024ull * 1024 * 2;
constexpr size_t OFF_WT_UP = OFF_WT_OUTO + 1024ull * 1024 * 2;
constexpr size_t OFF_WT_DOWN = OFF_WT_UP + 2ull * 5632 * 1024 * 2;
constexpr size_t OFF_WT_PLEG = OFF_WT_DOWN + 2ull * 1024 * 2816 * 2;
constexpr size_t OFF_WT_PLE = OFF_WT_PLEG + 2ull * 1024 * 1024 * 2;
constexpr size_t OFF_WT_POOL = OFF_WT_PLE + 2ull * 1024 * 256 * 2;
constexpr size_t OFF_XB = OFF_WT_POOL + 4ull * 128 * 128 * 2;
constexpr size_t OFF_PB = OFF_XB + 32768ull * 1024 * 2;
constexpr size_t OFF_SS = OFF_PB + 2ull * 32768 * 256 * 2;
constexpr size_t OFF_GB = OFF_SS + 7ull * 32768 * 4;
constexpr size_t OFF_GL = OFF_GB + 32768ull * 16 * 4;
constexpr size_t OFF_BAR = OFF_GL + 4096 * 4;
constexpr size_t OFF_R1 = OFF_BAR + 16384;
constexpr size_t OFF_PROJ0 = OFF_R1;
constexpr size_t OFF_VT = OFF_PROJ0 + 32768ull * 1536 * 2;
constexpr size_t OFF_CAT = OFF_VT + 32768ull * 512 * 2;
constexpr size_t OFF_ACT = OFF_R1;
constexpr size_t OFF_UT = OFF_R1;
constexpr size_t OFF_WN = OFF_UT + 67108864ull;
constexpr size_t OFF_QD = OFF_WN + 67108864ull;
constexpr size_t OFF_KD = OFF_QD + 67108864ull;
constexpr size_t OFF_QK = OFF_KD + 67108864ull;
constexpr size_t OFF_QKV = OFF_QK + 33554432ull;
constexpr size_t OFF_GATE = OFF_R1;
constexpr size_t OFF_OB = OFF_WN;

struct P {
  const float* in[22];
  float* out;
  unsigned char* ws;
};

DI void mma_stage(f32x4 (&acc)[4][4], const unsigned char* cA, const unsigned char* cB, int a_rd, int b_rd, int sw0, int sw1) {
#pragma unroll
  for (int ks = 0; ks < 2; ++ks) {
    const int sw = ks ? sw1 : sw0;
    bf16x8 af[4], bfr[4];
#pragma unroll
    for (int m = 0; m < 4; ++m) af[m] = *(const bf16x8*)(cA + a_rd + m * 2048 + sw);
#pragma unroll
    for (int n = 0; n < 4; ++n) bfr[n] = *(const bf16x8*)(cB + b_rd + n * 2048 + sw);
#pragma unroll
    for (int m = 0; m < 4; ++m)
#pragma unroll
      for (int n = 0; n < 4; ++n) acc[m][n] = mfma16(bfr[n], af[m], acc[m][n]);
  }
}
DI void zero_acc(f32x4 (&acc)[4][4]) {
#pragma unroll
  for (int m = 0; m < 4; ++m)
#pragma unroll
    for (int n = 0; n < 4; ++n) acc[m][n] = (f32x4){0.f, 0.f, 0.f, 0.f};
}

constexpr int G_STAGE = 24576, G_AB = 8192;
DI void glds16(const bf16_t* g, unsigned char* l) { __builtin_amdgcn_global_load_lds((const unsigned*)g, (unsigned*)l, 16, 0, 0); }
DI void zero_acc8(f32x4 (&acc)[4][8]) {
#pragma unroll
  for (int m = 0; m < 4; ++m)
#pragma unroll
    for (int n = 0; n < 8; ++n) acc[m][n] = (f32x4){0.f, 0.f, 0.f, 0.f};
}
DI void gemm_core(f32x4 (&acc)[4][8], const bf16_t* pa0, const bf16_t* pa1, const bf16_t* pb0, long ldb64, int nk, unsigned char* smem, int tid) {
  const int lane = tid & 63, wid = tid >> 6, wr = wid >> 1, wc = wid & 1, fr = lane & 15, fq = lane >> 4;
  const int lrow = tid >> 2, lc = tid & 3;
  const int csrc = 8 * (lc ^ ((-(lrow >> 2)) & 3));
  pa0 += csrc; pa1 += csrc; pb0 += csrc;
  unsigned char* dA = smem + tid * 16; unsigned char* dB = smem + G_AB + tid * 16;
  asm volatile("s_waitcnt vmcnt(0)" ::: "memory");
  __builtin_amdgcn_s_barrier();
#define G_ISSUE(KT, ST) do { const int ko_ = (KT) * 32; unsigned char* a_ = dA + (ST) * G_STAGE; unsigned char* b_ = dB + (ST) * G_STAGE; \
    glds16(pa0 + ko_, a_); glds16(pa1 + ko_, a_ + 4096); \
    glds16(pb0 + ko_, b_); glds16(pb0 + ldb64 + ko_, b_ + 4096); glds16(pb0 + 2 * ldb64 + ko_, b_ + 8192); glds16(pb0 + 3 * ldb64 + ko_, b_ + 12288); } while (0)
  G_ISSUE(0, 0);
  G_ISSUE(1, 1);
  const int swz = (fq ^ ((-(fr >> 2)) & 3)) << 4;
  const int a_rd = (64 * wr + fr) * 64 + swz, b_rd = G_AB + (128 * wc + fr) * 64 + swz;
  int st = 0;
#pragma unroll 1
  for (int kt = 0; kt < nk; ++kt) {
    if (kt + 1 < nk) asm volatile("s_waitcnt vmcnt(6)" ::: "memory"); else asm volatile("s_waitcnt vmcnt(0)" ::: "memory");
    __builtin_amdgcn_s_barrier();
    if (kt + 2 < nk) { const int s2 = (st >= 1) ? st - 1 : 2; G_ISSUE(kt + 2, s2); }
    const unsigned char* cs = smem + st * G_STAGE;
    bf16x8 af[4], bfr[8];
#pragma unroll
    for (int m = 0; m < 4; ++m) af[m] = *(const bf16x8*)(cs + a_rd + m * 1024);
#pragma unroll
    for (int n = 0; n < 8; ++n) bfr[n] = *(const bf16x8*)(cs + b_rd + n * 1024);
    __builtin_amdgcn_s_setprio(1);
#pragma unroll
    for (int m = 0; m < 4; ++m)
#pragma unroll
      for (int n = 0; n < 8; ++n) acc[m][n] = mfma16(bfr[n], af[m], acc[m][n]);
    __builtin_amdgcn_s_setprio(0);
    st = (st == 2) ? 0 : st + 1;
  }
  __syncthreads();
}

DI int permrow(int r) { const int s = r & 31; return (r & ~31) | (((s >> 2) & 3) << 3) | ((s >> 4) << 2) | (s & 3); }
DI void tile_decode(int i, int MT, int NT, int& mt, int& nt) {
  const int g = i / (64 * NT); const int il = i - g * 64 * NT; int gm = MT - 64 * g; gm = gm < 64 ? gm : 64;
  nt = il / gm; mt = 64 * g + (il - nt * gm);
}

DI void transpose_convert(const float* __restrict__ W, int ldw, int K, int mode, int coloff, const float* __restrict__ gain,
                          bf16_t* __restrict__ dst, int kt, int ntile, float* tile, int tid) {
  const int n0 = ntile * 64;
  const int tx = tid & 63, ty = tid >> 6;
  const int n = n0 + tx;
  int src; bool valid = true;
  if (mode == 0) { src = coloff + n; }
  else if (mode == 1) { const int j = n >> 8, nl = n & 255, wc = nl >> 7, hp = (nl >> 6) & 1, nt4 = (nl & 63) >> 4, fr = nl & 15; const int ch = 128 * j + 64 * wc + 32 * hp + 16 * (nt4 & 1) + fr; src = (nt4 < 2) ? ch : 2816 + ch; }
  else { if (n < 3072) src = n; else if (n < 3088) src = 4096 + (n - 3072); else { src = 0; valid = false; } }
  __syncthreads();
#pragma unroll
  for (int i = 0; i < 16; ++i) {
    const int kl = ty + 4 * i, k = 64 * kt + kl;
    float v = 0.f;
    if (valid) { v = W[(size_t)k * ldw + src]; if (gain) v *= gain[k]; }
    tile[kl * 65 + tx] = v;
  }
  __syncthreads();
  const int nl = tid >> 2, kc = tid & 3;
#pragma unroll
  for (int cc = 0; cc < 2; ++cc) {
    const int kch = kc * 2 + cc;
    float v[8];
#pragma unroll
    for (int i = 0; i < 8; ++i) v[i] = tile[(8 * kch + i) * 65 + nl];
    u32x4 o = {pk2(v[0], v[1]), pk2(v[2], v[3]), pk2(v[4], v[5]), pk2(v[6], v[7])};
    *(u32x4*)(dst + (size_t)(n0 + nl) * K + 64 * kt + 8 * kch) = o;
  }
}

DI void phase_prologue(const P& p, unsigned char* smem, int tid) {
  float* tile = (float*)smem;
  bf16_t* wsb = (bf16_t*)p.ws;
  for (int g = blockIdx.x; g < 6992; g += gridDim.x) {
    int task, base;
    if (g < 512) { task = 0; base = 0; } else if (g < 768) { task = 1; base = 512; } else if (g < 1600) { task = 2; base = 768; }
    else if (g < 1856) { task = 3; base = 1600; } else if (g < 2112) { task = 4; base = 1856; } else if (g < 3520) { task = 5; base = 2112; }
    else if (g < 4928) { task = 6; base = 3520; } else if (g < 5632) { task = 7; base = 4928; } else if (g < 6336) { task = 8; base = 5632; }
    else if (g < 6592) { task = 9; base = 6336; } else if (g < 6848) { task = 10; base = 6592; } else if (g < 6912) { task = 11; base = 6848; }
    else if (g < 6976) { task = 12; base = 6912; } else { task = 13 + ((g - 6976) >> 2); base = 6976 + 4 * (task - 13); }
    const float* W; int ldw, K, mode = 0, coloff = 0; const float* gain = nullptr; size_t doff;
    switch (task) {
      case 0: W = p.in[3]; ldw = 2048; K = 1024; gain = p.in[2]; doff = OFF_WT_INE; break;
      case 1: W = p.in[6]; ldw = 1024; K = 1024; doff = OFF_WT_OUTE; break;
      case 2: W = p.in[8]; ldw = 4112; K = 1024; mode = 2; gain = p.in[7]; doff = OFF_WT_INO; break;
      case 3: W = p.in[8]; ldw = 4112; K = 1024; coloff = 3072; gain = p.in[7]; doff = OFF_WT_Z; break;
      case 4: W = p.in[13]; ldw = 1024; K = 1024; doff = OFF_WT_OUTO; break;
      case 5: W = p.in[15]; ldw = 5632; K = 1024; mode = 1; gain = p.in[14]; doff = OFF_WT_UP; break;
      case 6: W = p.in[15] + 1024ull * 5632; ldw = 5632; K = 1024; mode = 1; gain = p.in[14] + 1024; doff = OFF_WT_UP + 5632ull * 1024 * 2; break;
      case 7: W = p.in[17]; ldw = 1024; K = 2816; doff = OFF_WT_DOWN; break;
      case 8: W = p.in[17] + 2816ull * 1024; ldw = 1024; K = 2816; doff = OFF_WT_DOWN + 1024ull * 2816 * 2; break;
      case 9: W = p.in[19]; ldw = 1024; K = 1024; gain = p.in[18]; doff = OFF_WT_PLEG; break;
      case 10: W = p.in[19] + 1024ull * 1024; ldw = 1024; K = 1024; gain = p.in[18] + 1024; doff = OFF_WT_PLEG + 1024ull * 1024 * 2; break;
      case 11: W = p.in[20]; ldw = 1024; K = 256; doff = OFF_WT_PLE; break;
      case 12: W = p.in[20] + 256ull * 1024; ldw = 1024; K = 256; doff = OFF_WT_PLE + 1024ull * 256 * 2; break;
      default: W = p.in[4] + (size_t)(task - 13) * 128 * 128; ldw = 128; K = 128; doff = OFF_WT_POOL + (size_t)(task - 13) * 128 * 128 * 2; break;
    }
    const int nkt = K / 64; const int t = g - base;
    transpose_convert(W, ldw, K, mode, coloff, gain, (bf16_t*)(p.ws + doff), t % nkt, t / nkt, tile, tid);
  }
  {
    const float* x = p.in[0]; bf16_t* xb = (bf16_t*)(p.ws + OFF_XB); float* ss = (float*)(p.ws + OFF_SS);
    const int lane = tid & 63, wid = tid >> 6;
    for (int row = blockIdx.x * 4 + wid; row < NTOK; row += gridDim.x * 4) {
      float s = 0.f;
#pragma unroll
      for (int i = 0; i < 4; ++i) {
        const f32x4 v = *(const f32x4*)(x + (size_t)row * 1024 + 256 * i + 4 * lane);
        s += v.x * v.x + v.y * v.y + v.z * v.z + v.w * v.w;
        u32x2 o = {pk2(v.x, v.y), pk2(v.z, v.w)};
        *(u32x2*)(xb + (size_t)row * 1024 + 256 * i + 4 * lane) = o;
      }
#pragma unroll
      for (int off = 32; off > 0; off >>= 1) s += __shfl_xor(s, off);
      if (lane == 0) ss[row] = s;
    }
    for (int i = blockIdx.x * 256 + tid; i < 6 * NTOK; i += gridDim.x * 256) ss[NTOK + i] = 0.f;
    const float* pp = p.in[1]; bf16_t* pb = (bf16_t*)(p.ws + OFF_PB);
    const size_t n4 = 2ull * 32768 * 256 / 4;
    for (size_t i = (size_t)blockIdx.x * 256 + tid; i < n4; i += (size_t)gridDim.x * 256) {
      const f32x4 v = *(const f32x4*)(pp + 4 * i);
      u32x2 o = {pk2(v.x, v.y), pk2(v.z, v.w)};
      *(u32x2*)(pb + 4 * i) = o;
    }
  }
}

#define GEMM_IDS const int lrow = tid >> 2;
#define EPI_IDS int tid_e = tid; asm volatile("" : "+v"(tid_e)); const int lane = tid_e & 63, wid = tid_e >> 6, wr = wid >> 1, wc = wid & 1, fr = lane & 15, fq = lane >> 4; (void)lane; (void)wr; (void)wc; (void)fr; (void)fq;

DI void phase_in_e(const P& p, unsigned char* smem, int tid) {
  GEMM_IDS
  const bf16_t* xb = (const bf16_t*)(p.ws + OFF_XB); const bf16_t* wt = (const bf16_t*)(p.ws + OFF_WT_INE);
  const float* ss = (const float*)(p.ws + OFF_SS);
  bf16_t* proj = (bf16_t*)(p.ws + OFF_PROJ0); bf16_t* vT = (bf16_t*)(p.ws + OFF_VT);
  for (int i = blockIdx.x; i < 256 * 8; i += gridDim.x) {
    int mt, nt; tile_decode(i, 256, 8, mt, nt);
    const int m0 = mt * 128, n0 = nt * 256;
    const bf16_t* pa = xb + (size_t)(m0 + lrow) * 1024;
    f32x4 acc[4][8]; zero_acc8(acc);
    gemm_core(acc, pa, pa + 64 * 1024, wt + (size_t)(n0 + permrow(lrow)) * 1024, 64 * 1024, 32, smem, tid);
    EPI_IDS
    const float qs = (n0 >= 512 && n0 < 1024) ? 0.18033688011112042f : 1.f;
#pragma unroll
    for (int m = 0; m < 4; ++m) {
      const int row = m0 + 64 * wr + 16 * m + fr;
      const float rs = rsqrtf(ss[row] * (1.f / 1024.f) + EPSF) * qs;
#pragma unroll
      for (int q = 0; q < 4; ++q) {
        const int col = n0 + 128 * wc + 32 * q + 8 * fq;
        const f32x4 v0 = acc[m][2 * q] * rs, v1 = acc[m][2 * q + 1] * rs;
        if (n0 < 1536) {
          u32x4 o = {pk2(v0.x, v0.y), pk2(v0.z, v0.w), pk2(v1.x, v1.y), pk2(v1.z, v1.w)};
          *(u32x4*)(proj + (size_t)row * 1536 + col) = o;
        } else {
          const int cc = col - 1536; const int bh = (row >> 12) * 8 + (cc >> 6), d = cc & 63, t = row & 4095;
          bf16_t* vp = vT + ((size_t)bh * 64 + d) * 4096 + t;
          vp[0] = f2bf(v0.x); vp[4096] = f2bf(v0.y); vp[8192] = f2bf(v0.z); vp[12288] = f2bf(v0.w);
          vp[16384] = f2bf(v1.x); vp[20480] = f2bf(v1.y); vp[24576] = f2bf(v1.z); vp[28672] = f2bf(v1.w);
        }
      }
    }
  }
}

DI void phase_resid(const P& p, const bf16_t* A, int K, const bf16_t* wt, const float* xold, float* ssn, unsigned char* smem, int tid) {
  GEMM_IDS
  bf16_t* xb = (bf16_t*)(p.ws + OFF_XB); float* xnew = p.out;
  for (int i = blockIdx.x; i < 256 * 4; i += gridDim.x) {
    int mt, nt; tile_decode(i, 256, 4, mt, nt);
    const int m0 = mt * 128, n0 = nt * 256;
    const bf16_t* pa = A + (size_t)(m0 + lrow) * K;
    f32x4 acc[4][8]; zero_acc8(acc);
    gemm_core(acc, pa, pa + 64 * (size_t)K, wt + (size_t)(n0 + permrow(lrow)) * K, 64 * (long)K, K / 32, smem, tid);
    EPI_IDS
#pragma unroll
    for (int m = 0; m < 4; ++m) {
      const int row = m0 + 64 * wr + 16 * m + fr;
      float s = 0.f;
#pragma unroll
      for (int q = 0; q < 4; ++q) {
        const int col = n0 + 128 * wc + 32 * q + 8 * fq;
        const f32x4 v0 = *(const f32x4*)(xold + (size_t)row * 1024 + col) + acc[m][2 * q];
        const f32x4 v1 = *(const f32x4*)(xold + (size_t)row * 1024 + col + 4) + acc[m][2 * q + 1];
        *(f32x4*)(xnew + (size_t)row * 1024 + col) = v0;
        *(f32x4*)(xnew + (size_t)row * 1024 + col + 4) = v1;
        u32x4 o = {pk2(v0.x, v0.y), pk2(v0.z, v0.w), pk2(v1.x, v1.y), pk2(v1.z, v1.w)};
        *(u32x4*)(xb + (size_t)row * 1024 + col) = o;
        s += v0.x * v0.x + v0.y * v0.y + v0.z * v0.z + v0.w * v0.w + v1.x * v1.x + v1.y * v1.y + v1.z * v1.z + v1.w * v1.w;
      }
      s += __shfl_xor(s, 16); s += __shfl_xor(s, 32);
      if (fq == 0) atomicAdd(ssn + row, s);
      __builtin_amdgcn_sched_barrier(0);
    }
  }
}

DI void phase_ffn_up(const P& p, int layer, const float* ssc, unsigned char* smem, int tid) {
  GEMM_IDS
  const bf16_t* xb = (const bf16_t*)(p.ws + OFF_XB); const bf16_t* wt = (const bf16_t*)(p.ws + OFF_WT_UP) + (size_t)layer * 5632 * 1024;
  bf16_t* act = (bf16_t*)(p.ws + OFF_ACT);
  const float* cw = p.in[16] + (size_t)layer * 3 * 5632;
  float* Cs = (float*)smem;
  for (int i = blockIdx.x; i < 264 * 22; i += gridDim.x) {
    int mt, nt; tile_decode(i, 264, 22, mt, nt);
    const int b = mt / 33, mi = mt - b * 33;
    const int t0 = 126 * mi - 2;
    const bf16_t* pa[2];
#pragma unroll
    for (int j = 0; j < 2; ++j) { int t = t0 + lrow + 64 * j; t = t < 0 ? 0 : (t > 4095 ? 4095 : t); pa[j] = xb + (size_t)(b * 4096 + t) * 1024; }
    f32x4 acc[4][8]; zero_acc8(acc);
    gemm_core(acc, pa[0], pa[1], wt + (size_t)(nt * 256 + lrow) * 1024, 64 * 1024, 32, smem, tid);
    EPI_IDS
    float rsv[4];
#pragma unroll
    for (int m = 0; m < 4; ++m) {
      int t = t0 + 64 * wr + 16 * m + fr; const bool neg = t < 0; t = t < 0 ? 0 : (t > 4095 ? 4095 : t);
      rsv[m] = neg ? 0.f : rsqrtf(ssc[b * 4096 + t] * (1.f / 1024.f) + EPSF);
    }
#pragma unroll
    for (int hp = 0; hp < 2; ++hp) {
      if (hp) __syncthreads();
#pragma unroll
      for (int m = 0; m < 4; ++m) {
        const int lr = 64 * wr + 16 * m + fr;
#pragma unroll
        for (int n = 0; n < 4; ++n) *(f32x4*)(Cs + lr * 132 + 64 * wc + 16 * n + 4 * fq) = acc[m][4 * hp + n] * rsv[m];
      }
      __syncthreads();
      const int cl = tid & 63, rg = tid >> 6;
      const int gcol = 64 * (cl >> 5) + 16 * ((cl & 31) >> 4) + (cl & 15), vcol = gcol + 32;
      const int ch = nt * 128 + 64 * (cl >> 5) + 32 * hp + (cl & 31);
      const float wg0 = cw[ch], wg1 = cw[5632 + ch], wg2 = cw[2 * 5632 + ch];
      const float wv0 = cw[2816 + ch], wv1 = cw[5632 + 2816 + ch], wv2 = cw[2 * 5632 + 2816 + ch];
      const int lr0 = 2 + 32 * rg;
      float g2 = Cs[(lr0 - 2) * 132 + gcol], g1 = Cs[(lr0 - 1) * 132 + gcol];
      float v2 = Cs[(lr0 - 2) * 132 + vcol], v1 = Cs[(lr0 - 1) * 132 + vcol];
      for (int r = 0; r < 32; ++r) {
        const int lr = lr0 + r; const int t = t0 + lr;
        if (lr >= 128 || t > 4095) break;
        const float g0 = Cs[lr * 132 + gcol], v0 = Cs[lr * 132 + vcol];
        const float yg = wg0 * g2 + wg1 * g1 + wg2 * g0;
        const float yv = wv0 * v2 + wv1 * v1 + wv2 * v0;
        act[(size_t)(b * 4096 + t) * 2816 + ch] = f2bf(siluf_(yg) * yv);
        g2 = g1; g1 = g0; v2 = v1; v1 = v0;
      }
    }
  }
}

DI void phase_ple_gate(const P& p, int layer, const float* ssc, unsigned char* smem, int tid) {
  GEMM_IDS
  const bf16_t* xb = (const bf16_t*)(p.ws + OFF_XB);
  const bf16_t* wg = (const bf16_t*)(p.ws + OFF_WT_PLEG) + (size_t)layer * 1024 * 1024;
  bf16_t* gate = (bf16_t*)(p.ws + OFF_GATE);
  for (int i = blockIdx.x; i < 256 * 4; i += gridDim.x) {
    int mt, nt; tile_decode(i, 256, 4, mt, nt);
    const int m0 = mt * 128, n0 = nt * 256;
    const bf16_t* pa = xb + (size_t)(m0 + lrow) * 1024;
    f32x4 acc[4][8]; zero_acc8(acc);
    gemm_core(acc, pa, pa + 64 * 1024, wg + (size_t)(n0 + permrow(lrow)) * 1024, 64 * 1024, 32, smem, tid);
    EPI_IDS
#pragma unroll
    for (int m = 0; m < 4; ++m) {
      const int row = m0 + 64 * wr + 16 * m + fr;
      const float rs = rsqrtf(ssc[row] * (1.f / 1024.f) + EPSF);
#pragma unroll
      for (int q = 0; q < 4; ++q) {
        const int col = n0 + 128 * wc + 32 * q + 8 * fq;
        const f32x4 v0 = acc[m][2 * q] * rs, v1 = acc[m][2 * q + 1] * rs;
        u32x4 o = {pk2(sigmoidf_(v0.x), sigmoidf_(v0.y)), pk2(sigmoidf_(v0.z), sigmoidf_(v0.w)), pk2(sigmoidf_(v1.x), sigmoidf_(v1.y)), pk2(sigmoidf_(v1.z), sigmoidf_(v1.w))};
        *(u32x4*)(gate + (size_t)row * 1024 + col) = o;
      }
    }
  }
}

DI void phase_ple_add(const P& p, int layer, float* ssn, unsigned char* smem, int tid) {
  GEMM_IDS
  bf16_t* xb = (bf16_t*)(p.ws + OFF_XB);
  const bf16_t* wp = (const bf16_t*)(p.ws + OFF_WT_PLE) + (size_t)layer * 1024 * 256;
  const bf16_t* pb = (const bf16_t*)(p.ws + OFF_PB) + (size_t)layer * 32768 * 256;
  const bf16_t* gate = (const bf16_t*)(p.ws + OFF_GATE);
  float* x = p.out;
  for (int i = blockIdx.x; i < 256 * 4; i += gridDim.x) {
    int mt, nt; tile_decode(i, 256, 4, mt, nt);
    const int m0 = mt * 128, n0 = nt * 256;
    const bf16_t* pa = pb + (size_t)(m0 + lrow) * 256;
    f32x4 acc[4][8]; zero_acc8(acc);
    gemm_core(acc, pa, pa + 64 * 256, wp + (size_t)(n0 + permrow(lrow)) * 256, 64 * 256, 8, smem, tid);
    EPI_IDS
#pragma unroll
    for (int m = 0; m < 4; ++m) {
      const int row = m0 + 64 * wr + 16 * m + fr;
      float s = 0.f;
#pragma unroll
      for (int q = 0; q < 4; ++q) {
        const int col = n0 + 128 * wc + 32 * q + 8 * fq;
        const u32x4 gp = *(const u32x4*)(gate + (size_t)row * 1024 + col);
        const f32x4 g0 = {bflo(gp.x), bfhi(gp.x), bflo(gp.y), bfhi(gp.y)}, g1 = {bflo(gp.z), bfhi(gp.z), bflo(gp.w), bfhi(gp.w)};
        const f32x4 v0 = *(const f32x4*)(x + (size_t)row * 1024 + col) + acc[m][2 * q] * g0;
        const f32x4 v1 = *(const f32x4*)(x + (size_t)row * 1024 + col + 4) + acc[m][2 * q + 1] * g1;
        *(f32x4*)(x + (size_t)row * 1024 + col) = v0;
        *(f32x4*)(x + (size_t)row * 1024 + col + 4) = v1;
        u32x4 o = {pk2(v0.x, v0.y), pk2(v0.z, v0.w), pk2(v1.x, v1.y), pk2(v1.z, v1.w)};
        *(u32x4*)(xb + (size_t)row * 1024 + col) = o;
        s += v0.x * v0.x + v0.y * v0.y + v0.z * v0.z + v0.w * v0.w + v1.x * v1.x + v1.y * v1.y + v1.z * v1.z + v1.w * v1.w;
      }
      s += __shfl_xor(s, 16); s += __shfl_xor(s, 32);
      if (fq == 0) atomicAdd(ssn + row, s);
      __builtin_amdgcn_sched_barrier(0);
    }
  }
}

DI void phase_in_o(const P& p, int qi, unsigned char* smem, int tid) {
  GEMM_IDS
  const bf16_t* xb = (const bf16_t*)(p.ws + OFF_XB); const bf16_t* wt = (const bf16_t*)(p.ws + OFF_WT_INO);
  const float* ssc = (const float*)(p.ws + OFF_SS) + 3 * NTOK;
  bf16_t* qkv = (bf16_t*)(p.ws + OFF_QKV); float* gb = (float*)(p.ws + OFF_GB);
  const float* a_log = p.in[10]; const float* dt_bias = p.in[11];
  for (int i = blockIdx.x; i < 64 * 13; i += gridDim.x) {
    int mt, nt; tile_decode(i, 64, 13, mt, nt);
    const int mq0 = mt * 128, m0 = qi * 8192 + mq0, n0 = nt * 256;
    const bf16_t* pa = xb + (size_t)(m0 + lrow) * 1024;
    f32x4 acc[4][8]; zero_acc8(acc);
    gemm_core(acc, pa, pa + 64 * 1024, wt + (size_t)(n0 + permrow(lrow)) * 1024, 64 * 1024, 32, smem, tid);
    EPI_IDS
#pragma unroll
    for (int m = 0; m < 4; ++m) {
      const int rl = 64 * wr + 16 * m + fr;
      const float rs = rsqrtf(ssc[m0 + rl] * (1.f / 1024.f) + EPSF);
      if (nt < 12) {
#pragma unroll
        for (int q = 0; q < 4; ++q) {
          const int col = n0 + 128 * wc + 32 * q + 8 * fq;
          const f32x4 v0 = acc[m][2 * q] * rs, v1 = acc[m][2 * q + 1] * rs;
          u32x4 o = {pk2(v0.x, v0.y), pk2(v0.z, v0.w), pk2(v1.x, v1.y), pk2(v1.z, v1.w)};
          *(u32x4*)(qkv + (size_t)(mq0 + rl) * 3072 + col) = o;
        }
      } else if (wc == 0 && fq < 2) {
        const f32x4 v0 = acc[m][0] * rs, v1 = acc[m][1] * rs;
        float o[8];
#pragma unroll
        for (int j = 0; j < 8; ++j) {
          const float vv = j < 4 ? v0[j] : v1[j - 4];
          if (fq == 0) o[j] = sigmoidf_(vv);
          else {
            const float xx = vv + dt_bias[j];
            const float sp = fmaxf(xx, 0.f) + log1pf(__expf(-fabsf(xx)));
            o[j] = -__expf(a_log[j]) * sp;
          }
        }
        float* gp = gb + (size_t)(m0 + rl) * 16 + 8 * fq;
        *(f32x4*)gp = (f32x4){o[0], o[1], o[2], o[3]}; *(f32x4*)(gp + 4) = (f32x4){o[4], o[5], o[6], o[7]};
      }
    }
  }
}

DI void phase_z_gate(const P& p, unsigned char* smem, int tid) {
  GEMM_IDS
  const bf16_t* xb = (const bf16_t*)(p.ws + OFF_XB); const bf16_t* wt = (const bf16_t*)(p.ws + OFF_WT_Z);
  const float* ssc = (const float*)(p.ws + OFF_SS) + 3 * NTOK;
  const bf16_t* ob_in = (const bf16_t*)(p.ws + OFF_UT);
  bf16_t* ob = (bf16_t*)(p.ws + OFF_OB);
  const float* nw = p.in[12];
  for (int i = blockIdx.x; i < 256 * 4; i += gridDim.x) {
    int mt, nt; tile_decode(i, 256, 4, mt, nt);
    const int m0 = mt * 128, n0 = nt * 256;
    const bf16_t* pa = xb + (size_t)(m0 + lrow) * 1024;
    f32x4 acc[4][8]; zero_acc8(acc);
    gemm_core(acc, pa, pa + 64 * 1024, wt + (size_t)(n0 + permrow(lrow)) * 1024, 64 * 1024, 32, smem, tid);
    EPI_IDS
    const int hd = 2 * nt + wc;
#pragma unroll
    for (int m = 0; m < 4; ++m) {
      const int row = m0 + 64 * wr + 16 * m + fr;
      const int chunk = ((row >> 12) * 8 + hd) * 64 + ((row & 4095) >> 6);
      const bf16_t* op = ob_in + (size_t)chunk * 8192 + (row & 63) * 64 + 8 * fq;
      u32x4 ov[4];
      float s = 0.f;
#pragma unroll
      for (int q = 0; q < 4; ++q) {
        ov[q] = *(const u32x4*)(op + (q >> 1) * 4096 + 32 * (q & 1));
        const float a0 = bflo(ov[q].x), a1 = bfhi(ov[q].x), a2 = bflo(ov[q].y), a3 = bfhi(ov[q].y), a4 = bflo(ov[q].z), a5 = bfhi(ov[q].z), a6 = bflo(ov[q].w), a7 = bfhi(ov[q].w);
        s += a0 * a0 + a1 * a1 + a2 * a2 + a3 * a3 + a4 * a4 + a5 * a5 + a6 * a6 + a7 * a7;
      }
      s += __shfl_xor(s, 16); s += __shfl_xor(s, 32);
      const float on = rsqrtf(s * (1.f / 128.f) + EPSF);
      const float rs = rsqrtf(ssc[row] * (1.f / 1024.f) + EPSF);
#pragma unroll
      for (int q = 0; q < 4; ++q) {
        const int cl = 32 * q + 8 * fq;
        const f32x4 z0 = acc[m][2 * q] * rs, z1 = acc[m][2 * q + 1] * rs;
        const f32x4 w0 = *(const f32x4*)(nw + cl), w1 = *(const f32x4*)(nw + cl + 4);
        const f32x4 o0 = {bflo(ov[q].x), bfhi(ov[q].x), bflo(ov[q].y), bfhi(ov[q].y)}, o1 = {bflo(ov[q].z), bfhi(ov[q].z), bflo(ov[q].w), bfhi(ov[q].w)};
        float r[8];
#pragma unroll
        for (int j = 0; j < 4; ++j) { r[j] = o0[j] * on * w0[j] * siluf_(z0[j]); r[4 + j] = o1[j] * on * w1[j] * siluf_(z1[j]); }
        u32x4 o = {pk2(r[0], r[1]), pk2(r[2], r[3]), pk2(r[4], r[5]), pk2(r[6], r[7])};
        *(u32x4*)(ob + (size_t)row * 1024 + n0 + 128 * wc + cl) = o;
      }
      __builtin_amdgcn_sched_barrier(0);
    }
  }
}

#ifndef DUMMY_MODE
#define DUMMY_MODE -1
#endif
DI void phase_dummy(const P& p, int mode, unsigned char* smem, int tid) {
  GEMM_IDS
  const bf16_t* xb = (const bf16_t*)(p.ws + OFF_XB);
  const bf16_t* wg = (const bf16_t*)(p.ws + OFF_WT_PLEG);
  for (int i = blockIdx.x; i < 256 * 4; i += gridDim.x) {
    int mt, nt; tile_decode(i, 256, 4, mt, nt);
    if (mode == 1) { mt = 0; nt = 0; }
    if (mode == 2) { mt = blockIdx.x & 255; nt = 0; }
    const int m0 = mt * 128, n0 = nt * 256;
    const bf16_t* pa = xb + (size_t)(m0 + lrow) * 1024;
    f32x4 acc[4][8]; zero_acc8(acc);
    gemm_core(acc, pa, pa + 64 * 1024, wg + (size_t)(n0 + lrow) * 1024, 64 * 1024, 32, smem, tid);
    EPI_IDS
    float s = 0.f;
#pragma unroll
    for (int m = 0; m < 4; ++m)
#pragma unroll
      for (int n = 0; n < 8; ++n) s += acc[m][n].x + acc[m][n].y + acc[m][n].z + acc[m][n].w;
    if (s == 123456.789f) ((float*)(p.ws + OFF_GL))[0] = s;
  }
}

DI void attn_item(const P& p, int item, unsigned char* smem, int tid) {
  const int lane = tid & 63, w = tid >> 6, r = lane & 31, hh = lane >> 5;
  const int bh = item & 63, jj = item >> 6;
  int qb; { const int a = jj & 7, grp = jj >> 3; qb = grp == 0 ? 31 - a : grp == 1 ? 16 + a : grp == 2 ? 15 - a : a; }
  const int b = bh >> 3, h = bh & 7;
  const int q0 = qb * 128, qw = q0 + 32 * w;
  const bf16_t* proj = (const bf16_t*)(p.ws + OFF_PROJ0);
  const bf16_t* vT = (const bf16_t*)(p.ws + OFF_VT) + (size_t)bh * 64 * 4096;
  bf16x8 qf[4];
  {
    const bf16_t* qp = proj + (size_t)(b * 4096 + qw + r) * 1536 + 512 + h * 64 + 8 * hh;
#pragma unroll
    for (int s = 0; s < 4; ++s) qf[s] = *(const bf16x8*)(qp + 16 * s);
  }
  f32x16 oacc[2];
#pragma unroll
  for (int i = 0; i < 16; ++i) { oacc[0][i] = 0.f; oacc[1][i] = 0.f; }
  float carry = 0.f;
  const int ntile = q0 / 64 + 2;
  const int lrow = tid >> 3, lc = tid & 7;
  const bf16_t* kbase = proj + (size_t)(b * 4096 + lrow) * 1536 + 1024 + h * 64 + 8 * lc;
  const bf16_t* vbase = vT + (size_t)lrow * 4096 + 8 * lc;
  unsigned char* sK = smem;
  unsigned char* sV = smem + 16384;
  const int kst = lrow * 128 + ((lc ^ (lrow & 7)) << 4);
  const int vst = lrow * 136 + lc * 16;
  u32x4 rk[2], rv[2];
  int kt = ntile - 1;
#pragma unroll
  for (int i = 0; i < 2; ++i) { rk[i] = *(const u32x4*)(kbase + (size_t)(kt * 64 + 32 * i) * 1536); rv[i] = *(const u32x4*)(vbase + (size_t)(32 * i) * 4096 + kt * 64); }
  __syncthreads();
#pragma unroll
  for (int i = 0; i < 2; ++i) {
    *(u32x4*)(sK + kst + i * 4096) = rk[i];
    *(u32x2*)(sV + vst + i * 4352) = (u32x2){rv[i].x, rv[i].y}; *(u32x2*)(sV + vst + i * 4352 + 8) = (u32x2){rv[i].z, rv[i].w};
  }
  __syncthreads();
  int cur = 0;
  for (; kt >= 0; --kt) {
    if (kt > 0) {
#pragma unroll
      for (int i = 0; i < 2; ++i) { rk[i] = *(const u32x4*)(kbase + (size_t)((kt - 1) * 64 + 32 * i) * 1536); rv[i] = *(const u32x4*)(vbase + (size_t)(32 * i) * 4096 + (kt - 1) * 64); }
    }
    const unsigned char* cK = sK + cur * 8192; const unsigned char* cV = sV + cur * 8704;
    const int s0 = kt * 64;
#pragma unroll
    for (int sub = 1; sub >= 0; --sub) {
      const int ks = s0 + 32 * sub;
      if (ks <= qw) {
        f32x16 sc;
#pragma unroll
        for (int i = 0; i < 16; ++i) sc[i] = 0.f;
#pragma unroll
        for (int s = 0; s < 4; ++s) {
          const bf16x8 kf = *(const bf16x8*)(cK + (32 * sub + r) * 128 + (((2 * s + hh) ^ (r & 7)) << 4));
          sc = mfma32(kf, qf[s], sc);
        }
        float sp[16], ls[16];
#pragma unroll
        for (int i = 0; i < 16; ++i) {
          const float z = sc[i];
          sp[i] = flog2(1.f + fexp2(z));
          ls[i] = z - sp[i];
        }
        if (ks == qw) {
#pragma unroll
          for (int i = 0; i < 16; ++i) { const bool valid = crow(i, hh) < r; sp[i] = valid ? sp[i] : 0.f; ls[i] = valid ? ls[i] : -1e30f; }
        }
        float G[4], Pp[4], Tt[4];
#pragma unroll
        for (int g = 0; g < 4; ++g) { G[g] = (sp[4 * g] + sp[4 * g + 1]) + (sp[4 * g + 2] + sp[4 * g + 3]); Pp[g] = __shfl_xor(G[g], 32); Tt[g] = G[g] + Pp[g]; }
        float after = carry;
        f32x16 av;
#pragma unroll
        for (int g = 3; g >= 0; --g) {
          float base = after + (hh == 0 ? Pp[g] : 0.f);
          float k3 = base, k2 = k3 + sp[4 * g + 3], k1 = k2 + sp[4 * g + 2], k0 = k1 + sp[4 * g + 1];
          av[4 * g + 3] = fexp2(ls[4 * g + 3] - k3); av[4 * g + 2] = fexp2(ls[4 * g + 2] - k2);
          av[4 * g + 1] = fexp2(ls[4 * g + 1] - k1); av[4 * g + 0] = fexp2(ls[4 * g + 0] - k0);
          after += Tt[g];
        }
        carry = after;
#pragma unroll
        for (int s = 0; s < 2; ++s) {
          const bf16x8 ap = pack_step(av, s);
#pragma unroll
          for (int dt = 0; dt < 2; ++dt) {
            const unsigned char* vp = cV + (32 * dt + r) * 136 + (32 * sub + 16 * s + 4 * hh) * 2;
            const bf16x8 vf = mk8(*(const u32x2*)vp, *(const u32x2*)(vp + 16));
            oacc[dt] = mfma32(vf, ap, oacc[dt]);
          }
        }
      }
    }
    if (kt > 0) {
      unsigned char* nK = sK + (cur ^ 1) * 8192; unsigned char* nV = sV + (cur ^ 1) * 8704;
#pragma unroll
      for (int i = 0; i < 2; ++i) {
        *(u32x4*)(nK + kst + i * 4096) = rk[i];
        *(u32x2*)(nV + vst + i * 4352) = (u32x2){rv[i].x, rv[i].y}; *(u32x2*)(nV + vst + i * 4352 + 8) = (u32x2){rv[i].z, rv[i].w};
      }
    }
    __syncthreads();
    cur ^= 1;
  }
  bf16_t* cat = (bf16_t*)(p.ws + OFF_CAT) + (size_t)(b * 4096 + qw + r) * 1024 + 512 + h * 64;
#pragma unroll
  for (int dt = 0; dt < 2; ++dt)
#pragma unroll
    for (int g = 0; g < 4; ++g) {
      u32x2 o = {pk2(oacc[dt][4 * g], oacc[dt][4 * g + 1]), pk2(oacc[dt][4 * g + 2], oacc[dt][4 * g + 3])};
      *(u32x2*)(cat + 32 * dt + 8 * g + 4 * hh) = o;
    }
}

DI void pool_item(const P& p, int item, unsigned char* smem, int tid) {
  const int lane = tid & 63, wid = tid >> 6, wr = wid >> 1, wc = wid & 1, fr = lane & 15, fq = lane >> 4; const int lrow = tid >> 3, lc = tid & 7; (void)lane;
  const int g = item & 3, mt = item >> 2;
  const int m0 = mt * 128;
  const bf16_t* proj = (const bf16_t*)(p.ws + OFF_PROJ0);
  const bf16_t* wt = (const bf16_t*)(p.ws + OFF_WT_POOL) + (size_t)g * 128 * 128;
  unsigned char* sA = smem; unsigned char* sB = smem + 32768;
  __syncthreads();
  {
    const int st_off = lrow * 128 + ((lc ^ (lrow & 7)) << 4);
#pragma unroll
    for (int kt = 0; kt < 2; ++kt)
#pragma unroll
      for (int i = 0; i < 4; ++i) *(u32x4*)(sB + kt * 16384 + st_off + i * 4096) = *(const u32x4*)(wt + (size_t)(lrow + 32 * i) * 128 + kt * 64 + 8 * lc);
  }
  {
    const int c = tid & 127, half = tid >> 7;
    const int w = 2 << g;
    const int tb = (m0 & 4095) + 64 * half;
    const bf16_t* up = proj + (size_t)(m0 - (m0 & 4095)) * 1536 + g * 128 + c;
    float run = 0.f;
    for (int k = 1; k < w; ++k) { const int t = tb - k; if (t >= 0) run += bf2f(up[(size_t)t * 1536]); }
    const int stg = c >> 6, kk = c & 63, chk = kk >> 3, wi = kk & 7;
    for (int rr = 0; rr < 64; ++rr) {
      const int t = tb + rr; const int lr = 64 * half + rr;
      const float ut = bf2f(up[(size_t)t * 1536]);
      run += ut;
      const int cnt = (t + 1 < w) ? (t + 1) : w;
      const float y = run / (float)cnt - ut;
      *(bf16_t*)(sA + stg * 16384 + lr * 128 + ((chk ^ (lr & 7)) << 4) + wi * 2) = f2bf(y);
      if (t - w + 1 >= 0) run -= bf2f(up[(size_t)(t - w + 1) * 1536]);
    }
  }
  __syncthreads();
  f32x4 acc[4][4]; zero_acc(acc);
  const int a_rd = (64 * wr + fr) * 128, b_rd = (64 * wc + fr) * 128;
  const int sw0 = (fq ^ (fr & 7)) << 4, sw1 = ((4 + fq) ^ (fr & 7)) << 4;
  mma_stage(acc, sA, sB, a_rd, b_rd, sw0, sw1);
  mma_stage(acc, sA + 16384, sB + 16384, a_rd, b_rd, sw0, sw1);
  const float* psc = p.in[5] + g * 128;
  bf16_t* cat = (bf16_t*)(p.ws + OFF_CAT);
#pragma unroll
  for (int m = 0; m < 4; ++m) {
    const int row = m0 + 64 * wr + 16 * m + fr;
#pragma unroll
    for (int n = 0; n < 4; ++n) {
      const int cl = 64 * wc + 16 * n + 4 * fq;
      const f32x4 s4 = *(const f32x4*)(psc + cl);
      const f32x4 v = acc[m][n] * s4;
      u32x2 o = {pk2(v.x, v.y), pk2(v.z, v.w)};
      *(u32x2*)(cat + (size_t)row * 1024 + g * 128 + cl) = o;
    }
  }
}


template <int I> struct SolveRow {
  static DI void run(float (&sol)[64], const float* A_v) {
    float s = sol[I];
#pragma unroll
    for (int g8 = 0; g8 < (I + 31) / 32; ++g8) {
      f32x4 a[8];
#pragma unroll
      for (int q = 0; q < 8; ++q) if (32 * g8 + 4 * q < I) a[q] = *(const f32x4*)(A_v + I * 68 + 32 * g8 + 4 * q);
#pragma unroll
      for (int q = 0; q < 8; ++q) {
        const int j = 32 * g8 + 4 * q;
        if (j + 0 < I) s -= a[q].x * sol[j + 0];
        if (j + 1 < I) s -= a[q].y * sol[j + 1];
        if (j + 2 < I) s -= a[q].z * sol[j + 2];
        if (j + 3 < I) s -= a[q].w * sol[j + 3];
      }
      __builtin_amdgcn_sched_barrier(0);
    }
    sol[I] = s;
    SolveRow<I + 1>::run(sol, A_v);
  }
};
template <> struct SolveRow<64> { static DI void run(float (&)[64], const float*) {} };

constexpr int GD_RAW = 0, GD_Q = 18224, GD_K = GD_Q + 17408, GD_V = GD_K + 17408, GD_GC = GD_V + 17408, GD_BETA = GD_GC + 256, GD_CW = GD_BETA + 256;
DI void gdn_chunk_item(const P& p, int qi, int item, unsigned char* smem, int tid) {
  const int lane = tid & 63, w = tid >> 6, r = lane & 31, hh = lane >> 5;
  const int h = item & 7, n = (item >> 3) & 63, bq = item >> 9;
  const int b = 2 * qi + bq;
  const int chunk = (b * 8 + h) * 64 + n;
  const bf16_t* qkv = (const bf16_t*)(p.ws + OFF_QKV) + (size_t)(bq * 4096) * 3072;
  const float* gb = (const float*)(p.ws + OFF_GB);
  const float* cw = p.in[9];
  float* gc_s = (float*)(smem + GD_GC); float* beta_s = (float*)(smem + GD_BETA);
  __syncthreads();
  if (w == 0) {
    const int tok = b * 4096 + 64 * n + lane;
    float g = gb[(size_t)tok * 16 + 8 + h]; const float be = gb[(size_t)tok * 16 + h];
#pragma unroll
    for (int off = 1; off < 64; off <<= 1) { const float t = __shfl_up(g, off); if (lane >= off) g += t; }
    gc_s[lane] = g; beta_s[lane] = be;
  }
#pragma unroll 1
  for (int pp = 0; pp < 3; ++pp) {
    for (int i = 0; i < 5; ++i) {
      const int idx = tid + 256 * i;
      if (idx < 1072) {
        const int rr = idx >> 4, c = idx & 15; const int t = 64 * n - 3 + rr;
        u32x4 v = {0u, 0u, 0u, 0u};
        if (t >= 0) v = *(const u32x4*)(qkv + (size_t)t * 3072 + pp * 1024 + h * 128 + 8 * c);
        *(u32x4*)(smem + GD_RAW + rr * 272 + 16 * c) = v;
      }
    }
#pragma unroll
    for (int i = 0; i < 2; ++i) { const int idx = tid + 256 * i; ((float*)(smem + GD_CW))[idx] = cw[(size_t)(idx >> 7) * 3072 + pp * 1024 + h * 128 + (idx & 127)]; }
    __syncthreads();
    {
      const int row = tid >> 2, qtr = tid & 3; const int ch0 = 32 * qtr;
      float y[32];
#pragma unroll
      for (int sub = 0; sub < 4; ++sub) {
        float a[8];
#pragma unroll
        for (int e = 0; e < 8; ++e) a[e] = 0.f;
#pragma unroll
        for (int tap = 0; tap < 4; ++tap) {
          const u32x4 xv = *(const u32x4*)(smem + GD_RAW + (row + tap) * 272 + (ch0 + 8 * sub) * 2);
          const float* wp = (const float*)(smem + GD_CW) + tap * 128 + ch0 + 8 * sub;
          const f32x4 w0 = *(const f32x4*)wp, w1 = *(const f32x4*)(wp + 4);
          a[0] += w0.x * bflo(xv.x); a[1] += w0.y * bfhi(xv.x); a[2] += w0.z * bflo(xv.y); a[3] += w0.w * bfhi(xv.y);
          a[4] += w1.x * bflo(xv.z); a[5] += w1.y * bfhi(xv.z); a[6] += w1.z * bflo(xv.w); a[7] += w1.w * bfhi(xv.w);
        }
#pragma unroll
        for (int e = 0; e < 8; ++e) y[8 * sub + e] = siluf_(a[e]);
        __builtin_amdgcn_sched_barrier(0);
      }
      if (pp < 2) {
        float s = 0.f;
#pragma unroll
        for (int e = 0; e < 32; ++e) s += y[e] * y[e];
        s += __shfl_xor(s, 1); s += __shfl_xor(s, 2);
        const float inv = rsqrtf(s + EPSF) * (pp == 0 ? 0.08838834764831845f : 1.f);
#pragma unroll
        for (int e = 0; e < 32; ++e) y[e] *= inv;
      }
      unsigned char* dst = smem + (pp == 0 ? GD_Q : pp == 1 ? GD_K : GD_V) + row * 272 + ch0 * 2;
#pragma unroll
      for (int sub = 0; sub < 4; ++sub) {
        u32x4 o = {pk2(y[8 * sub], y[8 * sub + 1]), pk2(y[8 * sub + 2], y[8 * sub + 3]), pk2(y[8 * sub + 4], y[8 * sub + 5]), pk2(y[8 * sub + 6], y[8 * sub + 7])};
        *(u32x4*)(dst + 16 * sub) = o;
      }
    }
    __syncthreads();
  }
  float* A_s = (float*)(smem + GD_RAW);
  bf16_t* qkb = (bf16_t*)(p.ws + OFF_QK) + (size_t)chunk * 4096;
  {
    const int ti = w >> 1, tj = w & 1;
    const int j = 32 * tj + r;
    if (ti == 0 && tj == 1) {
#pragma unroll
      for (int reg = 0; reg < 16; ++reg) qkb[(32 * ti + crow(reg, hh)) * 64 + j] = 0;
    } else {
      f32x16 kk, qk;
#pragma unroll
      for (int i = 0; i < 16; ++i) { kk[i] = 0.f; qk[i] = 0.f; }
#pragma unroll
      for (int s = 0; s < 8; ++s) {
        const bf16x8 bfrag = *(const bf16x8*)(smem + GD_K + (32 * tj + r) * 272 + (16 * s + 8 * hh) * 2);
        const bf16x8 akf = *(const bf16x8*)(smem + GD_K + (32 * ti + r) * 272 + (16 * s + 8 * hh) * 2);
        const bf16x8 aqf = *(const bf16x8*)(smem + GD_Q + (32 * ti + r) * 272 + (16 * s + 8 * hh) * 2);
        kk = mfma32(akf, bfrag, kk); qk = mfma32(aqf, bfrag, qk);
      }
      const float gcj = gc_s[j];
#pragma unroll
      for (int reg = 0; reg < 16; ++reg) {
        const int i = 32 * ti + crow(reg, hh);
        const float dec = (i >= j) ? __expf(gc_s[i] - gcj) : 0.f;
        A_s[i * 68 + j] = (i > j) ? beta_s[i] * kk[reg] * dec : 0.f;
        qkb[i * 64 + j] = f2bf((i >= j) ? qk[reg] * dec : 0.f);
      }
    }
  }
  __syncthreads();
  {
    const int col = tid; const bool isw = col >= 128; const int d = col & 127;
    int vz; asm volatile("v_mov_b32 %0, 0" : "=v"(vz));
    const float* A_v = A_s + vz; const float* gc_v = gc_s + vz; const float* beta_v = beta_s + vz;
    const unsigned char* src = smem + (isw ? GD_K : GD_V) + d * 2;
    float sol[64];
#pragma unroll
    for (int i = 0; i < 64; ++i) {
      float v = bf2f(*(const bf16_t*)(src + i * 272)) * beta_v[i];
      if (isw) v *= __expf(gc_v[i]);
      sol[i] = v;
    }
    SolveRow<1>::run(sol, A_v);
    __syncthreads();
    if (!isw) {
      bf16_t* ut = (bf16_t*)(p.ws + OFF_UT) + (size_t)chunk * 8192 + d * 64;
#pragma unroll
      for (int c8 = 0; c8 < 8; ++c8) {
        u32x4 o = {pk2(sol[8 * c8], sol[8 * c8 + 1]), pk2(sol[8 * c8 + 2], sol[8 * c8 + 3]), pk2(sol[8 * c8 + 4], sol[8 * c8 + 5]), pk2(sol[8 * c8 + 6], sol[8 * c8 + 7])};
        *(u32x4*)(ut + 8 * c8) = o;
      }
      unsigned char* qp = smem + GD_Q + d * 2;
#pragma unroll
      for (int i = 0; i < 64; ++i) { const float v = bf2f(*(const bf16_t*)(qp + i * 272)) * __expf(gc_v[i]); *(bf16_t*)(qp + i * 272) = f2bf(v); }
    } else {
      unsigned char* wp = smem + GD_V + d * 2;
#pragma unroll
      for (int i = 0; i < 64; ++i) *(bf16_t*)(wp + i * 272) = f2bf(-sol[i]);
      bf16_t* kd = (bf16_t*)(p.ws + OFF_KD) + (size_t)chunk * 8192 + d * 64;
      const float gl = gc_v[63];
#pragma unroll
      for (int c8 = 0; c8 < 8; ++c8) {
        float kv[8];
#pragma unroll
        for (int e = 0; e < 8; ++e) kv[e] = bf2f(*(const bf16_t*)(smem + GD_K + (8 * c8 + e) * 272 + d * 2)) * __expf(gl - gc_v[8 * c8 + e]);
        u32x4 o = {pk2(kv[0], kv[1]), pk2(kv[2], kv[3]), pk2(kv[4], kv[5]), pk2(kv[6], kv[7])};
        *(u32x4*)(kd + 8 * c8) = o;
      }
    }
    if (tid == 0) ((float*)(p.ws + OFF_GL))[chunk] = __expf(gc_s[63]);
    __syncthreads();
    {
      bf16_t* wn = (bf16_t*)(p.ws + OFF_WN) + (size_t)chunk * 8192;
      bf16_t* qd = (bf16_t*)(p.ws + OFF_QD) + (size_t)chunk * 8192;
#pragma unroll 1
      for (int i = 0; i < 4; ++i) {
        const int idx = tid + 256 * i; const int lo = (idx >> 4) * 272 + (idx & 15) * 16;
        *(u32x4*)(wn + (size_t)idx * 8) = *(const u32x4*)(smem + GD_V + lo);
        *(u32x4*)(qd + (size_t)idx * 8) = *(const u32x4*)(smem + GD_Q + lo);
      }
    }
  }
}

constexpr int SC_W = 0, SC_QD = 17408, SC_QK = 34816, SC_KD = 34816 + 9216, SC_U = 34816 + 9216 + 18432;
DI bf16x8 pack44(const f32x4& a, const f32x4& b) { u32x4 v = {pk2(a.x, a.y), pk2(a.z, a.w), pk2(b.x, b.y), pk2(b.z, b.w)}; return __builtin_bit_cast(bf16x8, v); }
DI void scan_item(const P& p, int item, unsigned char* smem, int tid) {
  const int lane = tid & 63, w = tid >> 6, fr = lane & 15, fq = lane >> 4;
  const int bh = item >> 1, hf = item & 1;
  const bf16_t* WN = (const bf16_t*)(p.ws + OFF_WN); const bf16_t* QD = (const bf16_t*)(p.ws + OFF_QD);
  const bf16_t* KD = (const bf16_t*)(p.ws + OFF_KD); const bf16_t* QK = (const bf16_t*)(p.ws + OFF_QK);
  bf16_t* UT = (bf16_t*)(p.ws + OFF_UT) + hf * 4096; const float* GL = (const float*)(p.ws + OFF_GL);
  f32x4 S[8];
#pragma unroll
  for (int dt = 0; dt < 8; ++dt) S[dt] = (f32x4){0.f, 0.f, 0.f, 0.f};
  u32x4 st[16];
  const int chunk0 = bh * 64;
#define SC_LOAD(CH) do { \
    const size_t cb = (size_t)(CH) * 8192; \
    _Pragma("unroll") for (int i = 0; i < 4; ++i) { st[i] = *(const u32x4*)(WN + cb + (size_t)(tid + 256 * i) * 8); st[4 + i] = *(const u32x4*)(QD + cb + (size_t)(tid + 256 * i) * 8); st[10 + i] = *(const u32x4*)(KD + cb + (size_t)(tid + 256 * i) * 8); } \
    _Pragma("unroll") for (int i = 0; i < 2; ++i) { st[8 + i] = *(const u32x4*)(QK + (size_t)(CH) * 4096 + (size_t)(tid + 256 * i) * 8); st[14 + i] = *(const u32x4*)(UT + cb + (size_t)(tid + 256 * i) * 8); } \
  } while (0)
#define SC_STORE() do { \
    _Pragma("unroll") for (int i = 0; i < 4; ++i) { const int idx = tid + 256 * i; const int o16 = (idx >> 4) * 272 + (idx & 15) * 16; *(u32x4*)(smem + SC_W + o16) = st[i]; *(u32x4*)(smem + SC_QD + o16) = st[4 + i]; \
      const int o8 = (idx >> 3) * 144 + (idx & 7) * 16; *(u32x4*)(smem + SC_KD + o8) = st[10 + i]; } \
    _Pragma("unroll") for (int i = 0; i < 2; ++i) { const int idx = tid + 256 * i; const int o8 = (idx >> 3) * 144 + (idx & 7) * 16; *(u32x4*)(smem + SC_QK + o8) = st[8 + i]; *(u32x4*)(smem + SC_U + o8) = st[14 + i]; } \
  } while (0)
  SC_LOAD(chunk0);
  __syncthreads();
  for (int n = 0; n < 64; ++n) {
    const int chunk = chunk0 + n;
    SC_STORE();
    __syncthreads();
    if (n + 1 < 64) SC_LOAD(chunk + 1);
    f32x4 vn[4];
#pragma unroll
    for (int ct = 0; ct < 4; ++ct) { const u32x2 u = *(const u32x2*)(smem + SC_U + (16 * w + fr) * 144 + (16 * ct + 4 * fq) * 2); vn[ct] = (f32x4){bflo(u.x), bfhi(u.x), bflo(u.y), bfhi(u.y)}; }
    const float gl = GL[chunk];
    bf16x8 Sp[4];
#pragma unroll
    for (int kk = 0; kk < 4; ++kk) Sp[kk] = pack44(S[2 * kk], S[2 * kk + 1]);
#pragma unroll
    for (int ct = 0; ct < 4; ++ct)
#pragma unroll
      for (int kk = 0; kk < 4; ++kk) {
        const unsigned char* ap = smem + SC_W + (16 * ct + fr) * 272 + (32 * kk + 4 * fq) * 2;
        vn[ct] = mfma16(mk8(*(const u32x2*)ap, *(const u32x2*)(ap + 32)), Sp[kk], vn[ct]);
      }
    bf16x8 vp[2];
    vp[0] = pack44(vn[0], vn[1]); vp[1] = pack44(vn[2], vn[3]);
#pragma unroll
    for (int ct = 0; ct < 4; ++ct) {
      f32x4 o = {0.f, 0.f, 0.f, 0.f};
#pragma unroll
      for (int kk = 0; kk < 4; ++kk) {
        const unsigned char* ap = smem + SC_QD + (16 * ct + fr) * 272 + (32 * kk + 4 * fq) * 2;
        o = mfma16(mk8(*(const u32x2*)ap, *(const u32x2*)(ap + 32)), Sp[kk], o);
      }
#pragma unroll
      for (int kc = 0; kc < 2; ++kc) {
        const unsigned char* ap = smem + SC_QK + (16 * ct + fr) * 144 + (32 * kc + 4 * fq) * 2;
        o = mfma16(mk8(*(const u32x2*)ap, *(const u32x2*)(ap + 32)), vp[kc], o);
      }
      bf16_t* op = UT + (size_t)chunk * 8192 + (size_t)(16 * ct + 4 * fq) * 64 + 16 * w + fr;
      op[0] = f2bf(o.x); op[64] = f2bf(o.y); op[128] = f2bf(o.z); op[192] = f2bf(o.w);
    }
#pragma unroll
    for (int dt = 0; dt < 8; ++dt) {
      S[dt] = S[dt] * gl;
#pragma unroll
      for (int kc = 0; kc < 2; ++kc) {
        const unsigned char* ap = smem + SC_KD + (16 * dt + fr) * 144 + (32 * kc + 4 * fq) * 2;
        S[dt] = mfma16(mk8(*(const u32x2*)ap, *(const u32x2*)(ap + 32)), vp[kc], S[dt]);
      }
    }
    __syncthreads();
  }
}

DI void phase_final(const P& p, int tid) {
  const int lane = tid & 63, wid = tid >> 6;
  float* x = p.out; const float* g = p.in[21];
  for (int row = blockIdx.x * 4 + wid; row < NTOK; row += gridDim.x * 4) {
    f32x4 v[4]; float s = 0.f;
#pragma unroll
    for (int i = 0; i < 4; ++i) { v[i] = *(const f32x4*)(x + (size_t)row * 1024 + 256 * i + 4 * lane); s += v[i].x * v[i].x + v[i].y * v[i].y + v[i].z * v[i].z + v[i].w * v[i].w; }
#pragma unroll
    for (int off = 32; off > 0; off >>= 1) s += __shfl_xor(s, off);
    const float rs = rsqrtf(s * (1.f / 1024.f) + EPSF);
#pragma unroll
    for (int i = 0; i < 4; ++i) { const f32x4 gg = *(const f32x4*)(g + 256 * i + 4 * lane); *(f32x4*)(x + (size_t)row * 1024 + 256 * i + 4 * lane) = v[i] * rs * gg; }
  }
}


#define XB_TMO      128
#define XB_XCNT(j)  (256  + 64 * (j))
#define XB_XSUB(j)  (1280 + 64 * (j))
#define XB_XGEN(j)  (2304 + 64 * (j))
#define XB_TOP      3328
#define XB_TOPGEN   3392
#define XCD_BAR_WORDS 3456
#define XB_SPIN_CAP (1u << 18)
#define LAS __attribute__((address_space(3)))
DI unsigned xb_ld(unsigned* p)              { return __hip_atomic_load(p, __ATOMIC_RELAXED, __HIP_MEMORY_SCOPE_AGENT); }
DI unsigned xb_add(unsigned* p, unsigned v) { return __hip_atomic_fetch_add(p, v, __ATOMIC_RELAXED, __HIP_MEMORY_SCOPE_AGENT); }
DI unsigned xb_xcc_id() { return (unsigned)__builtin_amdgcn_s_getreg((3 << 11) | 20) & 0xFu; }
#define XB_SPIN(cond, bar) do { unsigned _sp = 0; while (cond) { __builtin_amdgcn_s_sleep(1); \
    if ((++_sp & 255u) == 0u) { if (xb_ld(&(bar)[XB_TMO])) break; if (_sp > XB_SPIN_CAP) { atomicAdd(&(bar)[XB_TMO], 1u); break; } } } } while (0)
struct XcdBarrier { unsigned* bar; unsigned x; volatile LAS unsigned* st; };
DI XcdBarrier xcd_barrier_post(unsigned* bar, volatile LAS unsigned* st) {
  XcdBarrier b; b.bar = bar; b.x = xb_xcc_id(); b.st = st;
  if (threadIdx.x == 0) (void)xb_add(&bar[XB_XCNT(b.x)], 1u);
  return b;
}
DI void xcd_barrier_complete(unsigned* bar, unsigned x, unsigned& nloc, unsigned& nx) {
  const unsigned G = gridDim.x * gridDim.y * gridDim.z;
  unsigned sum, cnt, mine, sp = 0u;
  for (;;) {
    sum = 0u; cnt = 0u; mine = 0u;
#pragma unroll
    for (unsigned j = 0; j < 16; ++j) { const unsigned c = xb_ld(&bar[XB_XCNT(j)]); sum += c; cnt += (c > 0u) ? 1u : 0u; mine = (j == x) ? c : mine; }
    if (sum == G) break;
    __builtin_amdgcn_s_sleep(1);
    if ((++sp & 255u) == 0u) { if (xb_ld(&bar[XB_TMO])) break; if (sp > XB_SPIN_CAP) { atomicAdd(&bar[XB_TMO], 1u); break; } }
  }
  nloc = mine > 0u ? mine : 1u; nx = cnt > 0u ? cnt : 1u;
}
DI void xcd_barrier(const XcdBarrier& b) {
  asm volatile("s_waitcnt vmcnt(0)" ::: "memory");
  __syncthreads();
  if (threadIdx.x == 0) {
    unsigned* bar = b.bar;
    unsigned bx = b.x;
    asm volatile("" : "+s"(bar), "+s"(bx));
    __builtin_amdgcn_s_waitcnt(0);
    unsigned nloc = b.st[0], nx = b.st[1];
    if (nloc == 0u) { xcd_barrier_complete(bar, bx, nloc, nx); b.st[0] = nloc; b.st[1] = nx; }
    const unsigned old = xb_add(&bar[XB_XSUB(bx)], 1u);
    const unsigned gen = old / nloc;
    if (old + 1u == (gen + 1u) * nloc) {
      __builtin_amdgcn_fence(__ATOMIC_RELEASE, "agent");
      asm volatile("s_waitcnt vmcnt(0)" ::: "memory");
      const unsigned og = xb_add(&bar[XB_TOP], 1u);
      const unsigned tg = og / nx;
      if (og + 1u == (tg + 1u) * nx) xb_add(&bar[XB_TOPGEN], 1u);
      else XB_SPIN(xb_ld(&bar[XB_TOPGEN]) == tg, bar);
      __builtin_amdgcn_fence(__ATOMIC_ACQUIRE, "agent");
      xb_add(&bar[XB_XGEN(bx)], 1u);
      asm volatile("s_waitcnt vmcnt(0)" ::: "memory");
    } else {
      XB_SPIN(xb_ld(&bar[XB_XGEN(bx)]) == gen, bar);
      __builtin_amdgcn_fence(__ATOMIC_ACQUIRE, "agent");
      asm volatile("s_waitcnt vmcnt(0)" ::: "memory");
    }
  }
  __syncthreads();
}

constexpr int N_PHASES = 24;
typedef const __attribute__((address_space(4))) P* KP;
DI P loadP(KP kp) {
  P p;
#pragma unroll
  for (int i = 0; i < 22; ++i) p.in[i] = kp->in[i];
  p.out = kp->out; p.ws = kp->ws;
  return p;
}
#define SSP(k) ((float*)(p.ws + OFF_SS) + (k) * NTOK)
#define PH_BEGIN { KP kp = (KP)__builtin_amdgcn_kernarg_segment_ptr(); asm volatile("" : "+s"(kp)); \
    unsigned zz_; asm volatile("v_mov_b32 %0, 0" : "=v"(zz_)); \
    int tid = wbase + (int)__builtin_amdgcn_mbcnt_hi(~0u, __builtin_amdgcn_mbcnt_lo(~0u, zz_)); asm volatile("" : "+v"(tid)); \
    const P p = loadP(kp);
#define PH_END } xcd_barrier(xb);

__global__ void __launch_bounds__(256, 2) mega(P p_arg, int ph_lo, int ph_hi) {
  extern __shared__ __attribute__((aligned(16))) unsigned char smem[];
  __shared__ uint4 xb_words;
  cg::grid_group grid = cg::this_grid();
  if (threadIdx.x == 0) xb_words = make_uint4(0u, 0u, 0u, 0u);
  __syncthreads();
  const int wbase = __builtin_amdgcn_readfirstlane((int)(threadIdx.x & ~63u));
  XcdBarrier xb = xcd_barrier_post((unsigned*)(p_arg.ws + OFF_BAR), (volatile LAS unsigned*)&xb_words);
  if (ph_hi < 0) grid.sync();

  PH_BEGIN phase_prologue(p, smem, tid); PH_END
#if REP_PHASE == 0
  PH_BEGIN phase_prologue(p, smem, tid); PH_END
#endif
#pragma unroll 1
  for (int layer = 0; layer < 2; ++layer) {
    if (layer == 0) {
      PH_BEGIN phase_in_e(p, smem, tid); PH_END
      PH_BEGIN for (int i = blockIdx.x; i < 2048 + 1024; i += gridDim.x) { if (i < 2048) attn_item(p, i, smem, tid); else pool_item(p, i - 2048, smem, tid); } PH_END
#if REP_PHASE == 2
      PH_BEGIN for (int i = blockIdx.x; i < 2048 + 1024; i += gridDim.x) { if (i < 2048) attn_item(p, i, smem, tid); else pool_item(p, i - 2048, smem, tid); } PH_END
#endif
    } else {
#pragma unroll 1
      for (int qi = 0; qi < 4; ++qi) {
        PH_BEGIN phase_in_o(p, qi, smem, tid); PH_END
        PH_BEGIN for (int i = blockIdx.x; i < 1024; i += gridDim.x) gdn_chunk_item(p, qi, i, smem, tid); PH_END
#if REP_PHASE == 9
        if (qi == 0) { PH_BEGIN for (int i = blockIdx.x; i < 1024; i += gridDim.x) gdn_chunk_item(p, qi, i, smem, tid); PH_END }
#endif
      }
      PH_BEGIN for (int i = blockIdx.x; i < 128; i += gridDim.x) scan_item(p, i, smem, tid); PH_END
      PH_BEGIN phase_z_gate(p, smem, tid); PH_END
    }
    PH_BEGIN
      phase_resid(p, (const bf16_t*)(p.ws + (layer ? OFF_OB : OFF_CAT)), 1024, (const bf16_t*)(p.ws + (layer ? OFF_WT_OUTO : OFF_WT_OUTE)), layer ? p.out : p.in[0], SSP(1 + 3 * layer), smem, tid);
    PH_END
    PH_BEGIN phase_ffn_up(p, layer, SSP(1 + 3 * layer), smem, tid); PH_END
#if REP_PHASE == 4
    if (layer == 0) { PH_BEGIN phase_ffn_up(p, layer, SSP(1 + 3 * layer), smem, tid); PH_END }
#endif
    PH_BEGIN phase_resid(p, (const bf16_t*)(p.ws + OFF_ACT), 2816, (const bf16_t*)(p.ws + OFF_WT_DOWN) + (size_t)layer * 1024 * 2816, p.out, SSP(2 + 3 * layer), smem, tid); PH_END
    PH_BEGIN phase_ple_gate(p, layer, SSP(2 + 3 * layer), smem, tid); PH_END
#if REP_PHASE == 6
    if (layer == 0) { PH_BEGIN phase_ple_gate(p, layer, SSP(2 + 3 * layer), smem, tid); PH_END }
#endif
    PH_BEGIN phase_ple_add(p, layer, SSP(3 + 3 * layer), smem, tid); PH_END
  }
#if DUMMY_MODE >= 0
  PH_BEGIN phase_dummy(p, DUMMY_MODE, smem, tid); PH_END
#endif
  PH_BEGIN phase_final(p, tid); }
}

extern "C" void kernel_launch(void* const* d_in, const int* in_sizes, int n_in, void* d_out, int out_size, void* d_ws, size_t ws_size, hipStream_t stream) {
  static int grid_blocks = 0;
  if (!grid_blocks) {
    int dev = 0, cus = 0, per_cu = 0;
    hipGetDevice(&dev);
    hipDeviceGetAttribute(&cus, hipDeviceAttributeMultiprocessorCount, dev);
    hipFuncSetAttribute((const void*)mega, hipFuncAttributeMaxDynamicSharedMemorySize, SMEM_BYTES);
    hipOccupancyMaxActiveBlocksPerMultiprocessor(&per_cu, mega, 256, SMEM_BYTES);
    if (per_cu > 2) per_cu = 2;
    if (per_cu < 1) per_cu = 1;
    grid_blocks = cus * per_cu;
  }
  P p{};
  for (int i = 0; i < 22; ++i) p.in[i] = (const float*)d_in[i];
  p.out = (float*)d_out;
  p.ws = (unsigned char*)d_ws;
  hipMemsetAsync(p.ws + OFF_BAR, 0, XCD_BAR_WORDS * 4, stream);
#if MULTI_LAUNCH
  for (int ph = 0; ph < N_PHASES; ++ph) {
    int lo = ph, hi = ph + 1;
    void* args[] = {&p, &lo, &hi};
    hipError_t e = hipLaunchCooperativeKernel((const void*)mega, dim3(grid_blocks), dim3(256), args, SMEM_BYTES, stream);
    if (e != hipSuccess) fprintf(stderr, "launch failed: %s\n", hipGetErrorString(e));
  }
#else
  int lo = 0, hi = N_PHASES;
  void* args[] = {&p, &lo, &hi};
  hipError_t e = hipLaunchCooperativeKernel((const void*)mega, dim3(grid_blocks), dim3(256), args, SMEM_BYTES, stream);
  if (e != hipSuccess) fprintf(stderr, "launch failed: %s (grid %d)\n", hipGetErrorString(e), grid_blocks);
#endif
}
```

```cpp
#include <hip/hip_runtime.h>
#include <hip/hip_cooperative_groups.h>
#include <stdint.h>
#include <cstdio>
namespace cg = cooperative_groups;

#ifndef REP_PHASE
#define REP_PHASE -1
#endif
#ifndef MULTI_LAUNCH
#define MULTI_LAUNCH 0
#endif

#define DI __device__ __forceinline__
typedef unsigned short bf16_t;
typedef short bf16x8 __attribute__((ext_vector_type(8)));
typedef float f32x4 __attribute__((ext_vector_type(4)));
typedef float f32x2 __attribute__((ext_vector_type(2)));
typedef float f32x16 __attribute__((ext_vector_type(16)));
typedef unsigned u32x4 __attribute__((ext_vector_type(4)));
typedef unsigned u32x2 __attribute__((ext_vector_type(2)));
typedef __bf16 hbf2 __attribute__((ext_vector_type(2)));

DI unsigned pk2(float lo, float hi) { f32x2 v = {lo, hi}; hbf2 r = __builtin_convertvector(v, hbf2); return __builtin_bit_cast(unsigned, r); }
DI bf16_t f2bf(float x) { return (bf16_t)(pk2(x, 0.f) & 0xffffu); }
DI float bf2f(bf16_t v) { return __uint_as_float(((unsigned)v) << 16); }
DI float bflo(unsigned u) { return __uint_as_float(u << 16); }
DI float bfhi(unsigned u) { return __uint_as_float(u & 0xffff0000u); }
DI f32x4 mfma16(bf16x8 a, bf16x8 b, f32x4 c) { return __builtin_amdgcn_mfma_f32_16x16x32_bf16(a, b, c, 0, 0, 0); }
DI f32x16 mfma32(bf16x8 a, bf16x8 b, f32x16 c) { return __builtin_amdgcn_mfma_f32_32x32x16_bf16(a, b, c, 0, 0, 0); }
DI int crow(int reg, int hh) { return (reg & 3) + 8 * (reg >> 2) + 4 * hh; }
DI float fexp2(float x) { return __builtin_amdgcn_exp2f(x); }
DI float flog2(float x) { return __builtin_amdgcn_logf(x); }
DI float frcp(float x) { return __builtin_amdgcn_rcpf(x); }
DI float fexp(float x) { return __builtin_amdgcn_exp2f(x * 1.4426950408889634f); }
DI float sigmoidf_(float x) { return frcp(1.f + fexp(-x)); }
DI float siluf_(float x) { return x * frcp(1.f + fexp(-x)); }
DI bf16x8 mk8(u32x2 lo, u32x2 hi) { u32x4 v = {lo.x, lo.y, hi.x, hi.y}; return __builtin_bit_cast(bf16x8, v); }
DI bf16x8 pack_step(const f32x16& x, int s) {
  u32x4 v;
  v.x = pk2(x[8 * s + 0], x[8 * s + 1]); v.y = pk2(x[8 * s + 2], x[8 * s + 3]);
  v.z = pk2(x[8 * s + 4], x[8 * s + 5]); v.w = pk2(x[8 * s + 6], x[8 * s + 7]);
  return __builtin_bit_cast(bf16x8, v);
}

constexpr int SEQ = 4096, DM = 1024, NTOK = 32768;
constexpr int SMEM_BYTES = 73728;
constexpr float EPSF = 1e-6f;

constexpr size_t OFF_WT_INE = 0;
constexpr size_t OFF_WT_OUTE = OFF_WT_INE + 2048ull * 1024 * 2;
constexpr size_t OFF_WT_INO = OFF_WT_OUTE + 1024ull * 1024 * 2;
constexpr size_t OFF_WT_Z = OFF_WT_INO + 3328ull * 1024 * 2;
constexpr size_t OFF_WT_OUTO = OFF_WT_Z + 1024ull * 1024 * 2;
constexpr size_t OFF_WT_UP = OFF_WT_OUTO + 1024ull * 1024 * 2;
constexpr size_t OFF_WT_DOWN = OFF_WT_UP + 2ull * 5632 * 1024 * 2;
constexpr size_t OFF_WT_PLEG = OFF_WT_DOWN + 2ull * 1024 * 2816 * 2;
constexpr size_t OFF_WT_PLE = OFF_WT_PLEG + 2ull * 1024 * 1024 * 2;
constexpr size_t OFF_WT_POOL = OFF_WT_PLE + 2ull * 1024 * 256 * 2;
constexpr size_t OFF_XB = OFF_WT_POOL + 4ull * 128 * 128 * 2;
constexpr size_t OFF_PB = OFF_XB + 32768ull * 1024 * 2;
constexpr size_t OFF_SS = OFF_PB + 2ull * 32768 * 256 * 2;
constexpr size_t OFF_GB = OFF_SS + 7ull * 32768 * 4;
constexpr size_t OFF_GL = OFF_GB + 32768ull * 16 * 4;
constexpr size_t OFF_BAR = OFF_GL + 4096 * 4;
constexpr size_t OFF_R1 = OFF_BAR + 16384;
constexpr size_t OFF_PROJ0 = OFF_R1;
constexpr size_t OFF_VT = OFF_PROJ0 + 32768ull * 1536 * 2;
constexpr size_t OFF_CAT = OFF_VT + 32768ull * 512 * 2;
constexpr size_t OFF_ACT = OFF_R1;
constexpr size_t OFF_UT = OFF_R1;
constexpr size_t OFF_WN = OFF_UT + 67108864ull;
constexpr size_t OFF_QD = OFF_WN + 67108864ull;
constexpr size_t OFF_KD = OFF_QD + 67108864ull;
constexpr size_t OFF_QK = OFF_KD + 67108864ull;
constexpr size_t OFF_QKV = OFF_QK + 33554432ull;
constexpr size_t OFF_GATE = OFF_R1;
constexpr size_t OFF_OB = OFF_WN;

struct P {
  const float* in[22];
  float* out;
  unsigned char* ws;
};

DI void mma_stage(f32x4 (&acc)[4][4], const unsigned char* cA, const unsigned char* cB, int a_rd, int b_rd, int sw0, int sw1) {
#pragma unroll
  for (int ks = 0; ks < 2; ++ks) {
    const int sw = ks ? sw1 : sw0;
    bf16x8 af[4], bfr[4];
#pragma unroll
    for (int m = 0; m < 4; ++m) af[m] = *(const bf16x8*)(cA + a_rd + m * 2048 + sw);
#pragma unroll
    for (int n = 0; n < 4; ++n) bfr[n] = *(const bf16x8*)(cB + b_rd + n * 2048 + sw);
#pragma unroll
    for (int m = 0; m < 4; ++m)
#pragma unroll
      for (int n = 0; n < 4; ++n) acc[m][n] = mfma16(bfr[n], af[m], acc[m][n]);
  }
}
DI void zero_acc(f32x4 (&acc)[4][4]) {
#pragma unroll
  for (int m = 0; m < 4; ++m)
#pragma unroll
    for (int n = 0; n < 4; ++n) acc[m][n] = (f32x4){0.f, 0.f, 0.f, 0.f};
}

constexpr int G_STAGE = 24576, G_AB = 8192;
DI void glds16(const bf16_t* g, unsigned char* l) { __builtin_amdgcn_global_load_lds((const unsigned*)g, (unsigned*)l, 16, 0, 0); }
DI void zero_acc8(f32x4 (&acc)[4][8]) {
#pragma unroll
  for (int m = 0; m < 4; ++m)
#pragma unroll
    for (int n = 0; n < 8; ++n) acc[m][n] = (f32x4){0.f, 0.f, 0.f, 0.f};
}
DI void gemm_core(f32x4 (&acc)[4][8], const bf16_t* pa0, const bf16_t* pa1, const bf16_t* pb0, long ldb64, int nk, unsigned char* smem, int tid) {
  const int lane = tid & 63, wid = tid >> 6, wr = wid >> 1, wc = wid & 1, fr = lane & 15, fq = lane >> 4;
  const int lrow = tid >> 2, lc = tid & 3;
  const int csrc = 8 * (lc ^ ((-(lrow >> 2)) & 3));
  pa0 += csrc; pa1 += csrc; pb0 += csrc;
  unsigned char* dA = smem + tid * 16; unsigned char* dB = smem + G_AB + tid * 16;
  asm volatile("s_waitcnt vmcnt(0)" ::: "memory");
  __builtin_amdgcn_s_barrier();
#define G_ISSUE(KT, ST) do { const int ko_ = (KT) * 32; unsigned char* a_ = dA + (ST) * G_STAGE; unsigned char* b_ = dB + (ST) * G_STAGE; \
    glds16(pa0 + ko_, a_); glds16(pa1 + ko_, a_ + 4096); \
    glds16(pb0 + ko_, b_); glds16(pb0 + ldb64 + ko_, b_ + 4096); glds16(pb0 + 2 * ldb64 + ko_, b_ + 8192); glds16(pb0 + 3 * ldb64 + ko_, b_ + 12288); } while (0)
  G_ISSUE(0, 0);
  G_ISSUE(1, 1);
  const int swz = (fq ^ ((-(fr >> 2)) & 3)) << 4;
  const int a_rd = (64 * wr + fr) * 64 + swz, b_rd = G_AB + (128 * wc + fr) * 64 + swz;
  int st = 0;
#pragma unroll 1
  for (int kt = 0; kt < nk; ++kt) {
    if (kt + 1 < nk) asm volatile("s_waitcnt vmcnt(6)" ::: "memory"); else asm volatile("s_waitcnt vmcnt(0)" ::: "memory");
    __builtin_amdgcn_s_barrier();
    if (kt + 2 < nk) { const int s2 = (st >= 1) ? st - 1 : 2; G_ISSUE(kt + 2, s2); }
    const unsigned char* cs = smem + st * G_STAGE;
    bf16x8 af[4], bfr[8];
#pragma unroll
    for (int m = 0; m < 4; ++m) af[m] = *(const bf16x8*)(cs + a_rd + m * 1024);
#pragma unroll
    for (int n = 0; n < 8; ++n) bfr[n] = *(const bf16x8*)(cs + b_rd + n * 1024);
    __builtin_amdgcn_s_setprio(1);
#pragma unroll
    for (int m = 0; m < 4; ++m)
#pragma unroll
      for (int n = 0; n < 8; ++n) acc[m][n] = mfma16(bfr[n], af[m], acc[m][n]);
    __builtin_amdgcn_s_setprio(0);
    st = (st == 2) ? 0 : st + 1;
  }
  __syncthreads();
}

DI int permrow(int r) { const int s = r & 31; return (r & ~31) | (((s >> 2) & 3) << 3) | ((s >> 4) << 2) | (s & 3); }
DI void tile_decode(int i, int MT, int NT, int& mt, int& nt) {
  const int g = i / (64 * NT); const int il = i - g * 64 * NT; int gm = MT - 64 * g; gm = gm < 64 ? gm : 64;
  nt = il / gm; mt = 64 * g + (il - nt * gm);
}

DI void transpose_convert(const float* __restrict__ W, int ldw, int K, int mode, int coloff, const float* __restrict__ gain,
                          bf16_t* __restrict__ dst, int kt, int ntile, float* tile, int tid) {
  const int n0 = ntile * 64;
  const int tx = tid & 63, ty = tid >> 6;
  const int n = n0 + tx;
  int src; bool valid = true;
  if (mode == 0) { src = coloff + n; }
  else if (mode == 1) { const int j = n >> 8, nl = n & 255, wc = nl >> 7, hp = (nl >> 6) & 1, nt4 = (nl & 63) >> 4, fr = nl & 15; const int ch = 128 * j + 64 * wc + 32 * hp + 16 * (nt4 & 1) + fr; src = (nt4 < 2) ? ch : 2816 + ch; }
  else { if (n < 3072) src = n; else if (n < 3088) src = 4096 + (n - 3072); else { src = 0; valid = false; } }
  __syncthreads();
#pragma unroll
  for (int i = 0; i < 16; ++i) {
    const int kl = ty + 4 * i, k = 64 * kt + kl;
    float v = 0.f;
    if (valid) { v = W[(size_t)k * ldw + src]; if (gain) v *= gain[k]; }
    tile[kl * 65 + tx] = v;
  }
  __syncthreads();
  const int nl = tid >> 2, kc = tid & 3;
#pragma unroll
  for (int cc = 0; cc < 2; ++cc) {
    const int kch = kc * 2 + cc;
    float v[8];
#pragma unroll
    for (int i = 0; i < 8; ++i) v[i] = tile[(8 * kch + i) * 65 + nl];
    u32x4 o = {pk2(v[0], v[1]), pk2(v[2], v[3]), pk2(v[4], v[5]), pk2(v[6], v[7])};
    *(u32x4*)(dst + (size_t)(n0 + nl) * K + 64 * kt + 8 * kch) = o;
  }
}

DI void phase_prologue(const P& p, unsigned char* smem, int tid) {
  float* tile = (float*)smem;
  bf16_t* wsb = (bf16_t*)p.ws;
  for (int g = blockIdx.x; g < 6992; g += gridDim.x) {
    int task, base;
    if (g < 512) { task = 0; base = 0; } else if (g < 768) { task = 1; base = 512; } else if (g < 1600) { task = 2; base = 768; }
    else if (g < 1856) { task = 3; base = 1600; } else if (g < 2112) { task = 4; base = 1856; } else if (g < 3520) { task = 5; base = 2112; }
    else if (g < 4928) { task = 6; base = 3520; } else if (g < 5632) { task = 7; base = 4928; } else if (g < 6336) { task = 8; base = 5632; }
    else if (g < 6592) { task = 9; base = 6336; } else if (g < 6848) { task = 10; base = 6592; } else if (g < 6912) { task = 11; base = 6848; }
    else if (g < 6976) { task = 12; base = 6912; } else { task = 13 + ((g - 6976) >> 2); base = 6976 + 4 * (task - 13); }
    const float* W; int ldw, K, mode = 0, coloff = 0; const float* gain = nullptr; size_t doff;
    switch (task) {
      case 0: W = p.in[3]; ldw = 2048; K = 1024; gain = p.in[2]; doff = OFF_WT_INE; break;
      case 1: W = p.in[6]; ldw = 1024; K = 1024; doff = OFF_WT_OUTE; break;
      case 2: W = p.in[8]; ldw = 4112; K = 1024; mode = 2; gain = p.in[7]; doff = OFF_WT_INO; break;
      case 3: W = p.in[8]; ldw = 4112; K = 1024; coloff = 3072; gain = p.in[7]; doff = OFF_WT_Z; break;
      case 4: W = p.in[13]; ldw = 1024; K = 1024; doff = OFF_WT_OUTO; break;
      case 5: W = p.in[15]; ldw = 5632; K = 1024; mode = 1; gain = p.in[14]; doff = OFF_WT_UP; break;
      case 6: W = p.in[15] + 1024ull * 5632; ldw = 5632; K = 1024; mode = 1; gain = p.in[14] + 1024; doff = OFF_WT_UP + 5632ull * 1024 * 2; break;
      case 7: W = p.in[17]; ldw = 1024; K = 2816; doff = OFF_WT_DOWN; break;
      case 8: W = p.in[17] + 2816ull * 1024; ldw = 1024; K = 2816; doff = OFF_WT_DOWN + 1024ull * 2816 * 2; break;
      case 9: W = p.in[19]; ldw = 1024; K = 1024; gain = p.in[18]; doff = OFF_WT_PLEG; break;
      case 10: W = p.in[19] + 1024ull * 1024; ldw = 1024; K = 1024; gain = p.in[18] + 1024; doff = OFF_WT_PLEG + 1024ull * 1024 * 2; break;
      case 11: W = p.in[20]; ldw = 1024; K = 256; doff = OFF_WT_PLE; break;
      case 12: W = p.in[20] + 256ull * 1024; ldw = 1024; K = 256; doff = OFF_WT_PLE + 1024ull * 256 * 2; break;
      default: W = p.in[4] + (size_t)(task - 13) * 128 * 128; ldw = 128; K = 128; doff = OFF_WT_POOL + (size_t)(task - 13) * 128 * 128 * 2; break;
    }
    const int nkt = K / 64; const int t = g - base;
    transpose_convert(W, ldw, K, mode, coloff, gain, (bf16_t*)(p.ws + doff), t % nkt, t / nkt, tile, tid);
  }
  {
    const float* x = p.in[0]; bf16_t* xb = (bf16_t*)(p.ws + OFF_XB); float* ss = (float*)(p.ws + OFF_SS);
    const int lane = tid & 63, wid = tid >> 6;
    for (int row = blockIdx.x * 4 + wid; row < NTOK; row += gridDim.x * 4) {
      float s = 0.f;
#pragma unroll
      for (int i = 0; i < 4; ++i) {
        const f32x4 v = *(const f32x4*)(x + (size_t)row * 1024 + 256 * i + 4 * lane);
        s += v.x * v.x + v.y * v.y + v.z * v.z + v.w * v.w;
        u32x2 o = {pk2(v.x, v.y), pk2(v.z, v.w)};
        *(u32x2*)(xb + (size_t)row * 1024 + 256 * i + 4 * lane) = o;
      }
#pragma unroll
      for (int off = 32; off > 0; off >>= 1) s += __shfl_xor(s, off);
      if (lane == 0) ss[row] = s;
    }
    for (int i = blockIdx.x * 256 + tid; i < 6 * NTOK; i += gridDim.x * 256) ss[NTOK + i] = 0.f;
    const float* pp = p.in[1]; bf16_t* pb = (bf16_t*)(p.ws + OFF_PB);
    const size_t n4 = 2ull * 32768 * 256 / 4;
    for (size_t i = (size_t)blockIdx.x * 256 + tid; i < n4; i += (size_t)gridDim.x * 256) {
      const f32x4 v = *(const f32x4*)(pp + 4 * i);
      u32x2 o = {pk2(v.x, v.y), pk2(v.z, v.w)};
      *(u32x2*)(pb + 4 * i) = o;
    }
  }
}

#define GEMM_IDS const int lrow = tid >> 2;
#define EPI_IDS int tid_e = tid; asm volatile("" : "+v"(tid_e)); const int lane = tid_e & 63, wid = tid_e >> 6, wr = wid >> 1, wc = wid & 1, fr = lane & 15, fq = lane >> 4; (void)lane; (void)wr; (void)wc; (void)fr; (void)fq;

DI void phase_in_e(const P& p, unsigned char* smem, int tid) {
  GEMM_IDS
  const bf16_t* xb = (const bf16_t*)(p.ws + OFF_XB); const bf16_t* wt = (const bf16_t*)(p.ws + OFF_WT_INE);
  const float* ss = (const float*)(p.ws + OFF_SS);
  bf16_t* proj = (bf16_t*)(p.ws + OFF_PROJ0); bf16_t* vT = (bf16_t*)(p.ws + OFF_VT);
  for (int i = blockIdx.x; i < 256 * 8; i += gridDim.x) {
    int mt, nt; tile_decode(i, 256, 8, mt, nt);
    const int m0 = mt * 128, n0 = nt * 256;
    const bf16_t* pa = xb + (size_t)(m0 + lrow) * 1024;
    f32x4 acc[4][8]; zero_acc8(acc);
    gemm_core(acc, pa, pa + 64 * 1024, wt + (size_t)(n0 + permrow(lrow)) * 1024, 64 * 1024, 32, smem, tid);
    EPI_IDS
    const float qs = (n0 >= 512 && n0 < 1024) ? 0.18033688011112042f : 1.f;
#pragma unroll
    for (int m = 0; m < 4; ++m) {
      const int row = m0 + 64 * wr + 16 * m + fr;
      const float rs = rsqrtf(ss[row] * (1.f / 1024.f) + EPSF) * qs;
#pragma unroll
      for (int q = 0; q < 4; ++q) {
        const int col = n0 + 128 * wc + 32 * q + 8 * fq;
        const f32x4 v0 = acc[m][2 * q] * rs, v1 = acc[m][2 * q + 1] * rs;
        if (n0 < 1536) {
          u32x4 o = {pk2(v0.x, v0.y), pk2(v0.z, v0.w), pk2(v1.x, v1.y), pk2(v1.z, v1.w)};
          *(u32x4*)(proj + (size_t)row * 1536 + col) = o;
        } else {
          const int cc = col - 1536; const int bh = (row >> 12) * 8 + (cc >> 6), d = cc & 63, t = row & 4095;
          bf16_t* vp = vT + ((size_t)bh * 64 + d) * 4096 + t;
          vp[0] = f2bf(v0.x); vp[4096] = f2bf(v0.y); vp[8192] = f2bf(v0.z); vp[12288] = f2bf(v0.w);
          vp[16384] = f2bf(v1.x); vp[20480] = f2bf(v1.y); vp[24576] = f2bf(v1.z); vp[28672] = f2bf(v1.w);
        }
      }
    }
  }
}

DI void phase_resid(const P& p, const bf16_t* A, int K, const bf16_t* wt, const float* xold, float* ssn, unsigned char* smem, int tid) {
  GEMM_IDS
  bf16_t* xb = (bf16_t*)(p.ws + OFF_XB); float* xnew = p.out;
  for (int i = blockIdx.x; i < 256 * 4; i += gridDim.x) {
    int mt, nt; tile_decode(i, 256, 4, mt, nt);
    const int m0 = mt * 128, n0 = nt * 256;
    const bf16_t* pa = A + (size_t)(m0 + lrow) * K;
    f32x4 acc[4][8]; zero_acc8(acc);
    gemm_core(acc, pa, pa + 64 * (size_t)K, wt + (size_t)(n0 + permrow(lrow)) * K, 64 * (long)K, K / 32, smem, tid);
    EPI_IDS
#pragma unroll
    for (int m = 0; m < 4; ++m) {
      const int row = m0 + 64 * wr + 16 * m + fr;
      float s = 0.f;
#pragma unroll
      for (int q = 0; q < 4; ++q) {
        const int col = n0 + 128 * wc + 32 * q + 8 * fq;
        const f32x4 v0 = *(const f32x4*)(xold + (size_t)row * 1024 + col) + acc[m][2 * q];
        const f32x4 v1 = *(const f32x4*)(xold + (size_t)row * 1024 + col + 4) + acc[m][2 * q + 1];
        *(f32x4*)(xnew + (size_t)row * 1024 + col) = v0;
        *(f32x4*)(xnew + (size_t)row * 1024 + col + 4) = v1;
        u32x4 o = {pk2(v0.x, v0.y), pk2(v0.z, v0.w), pk2(v1.x, v1.y), pk2(v1.z, v1.w)};
        *(u32x4*)(xb + (size_t)row * 1024 + col) = o;
        s += v0.x * v0.x + v0.y * v0.y + v0.z * v0.z + v0.w * v0.w + v1.x * v1.x + v1.y * v1.y + v1.z * v1.z + v1.w * v1.w;
      }
      s += __shfl_xor(s, 16); s += __shfl_xor(s, 32);
      if (fq == 0) atomicAdd(ssn + row, s);
      __builtin_amdgcn_sched_barrier(0);
    }
  }
}

DI void phase_ffn_up(const P& p, int layer, const float* ssc, unsigned char* smem, int tid) {
  GEMM_IDS
  const bf16_t* xb = (const bf16_t*)(p.ws + OFF_XB); const bf16_t* wt = (const bf16_t*)(p.ws + OFF_WT_UP) + (size_t)layer * 5632 * 1024;
  bf16_t* act = (bf16_t*)(p.ws + OFF_ACT);
  const float* cw = p.in[16] + (size_t)layer * 3 * 5632;
  float* Cs = (float*)smem;
  for (int i = blockIdx.x; i < 264 * 22; i += gridDim.x) {
    int mt, nt; tile_decode(i, 264, 22, mt, nt);
    const int b = mt / 33, mi = mt - b * 33;
    const int t0 = 126 * mi - 2;
    const bf16_t* pa[2];
#pragma unroll
    for (int j = 0; j < 2; ++j) { int t = t0 + lrow + 64 * j; t = t < 0 ? 0 : (t > 4095 ? 4095 : t); pa[j] = xb + (size_t)(b * 4096 + t) * 1024; }
    f32x4 acc[4][8]; zero_acc8(acc);
    gemm_core(acc, pa[0], pa[1], wt + (size_t)(nt * 256 + lrow) * 1024, 64 * 1024, 32, smem, tid);
    EPI_IDS
    float rsv[4];
#pragma unroll
    for (int m = 0; m < 4; ++m) {
      int t = t0 + 64 * wr + 16 * m + fr; const bool neg = t < 0; t = t < 0 ? 0 : (t > 4095 ? 4095 : t);
      rsv[m] = neg ? 0.f : rsqrtf(ssc[b * 4096 + t] * (1.f / 1024.f) + EPSF);
    }
#pragma unroll
    for (int hp = 0; hp < 2; ++hp) {
      if (hp) __syncthreads();
#pragma unroll
      for (int m = 0; m < 4; ++m) {
        const int lr = 64 * wr + 16 * m + fr;
#pragma unroll
        for (int n = 0; n < 4; ++n) *(f32x4*)(Cs + lr * 132 + 64 * wc + 16 * n + 4 * fq) = acc[m][4 * hp + n] * rsv[m];
      }
      __syncthreads();
      const int cl = tid & 63, rg = tid >> 6;
      const int gcol = 64 * (cl >> 5) + 16 * ((cl & 31) >> 4) + (cl & 15), vcol = gcol + 32;
      const int ch = nt * 128 + 64 * (cl >> 5) + 32 * hp + (cl & 31);
      const float wg0 = cw[ch], wg1 = cw[5632 + ch], wg2 = cw[2 * 5632 + ch];
      const float wv0 = cw[2816 + ch], wv1 = cw[5632 + 2816 + ch], wv2 = cw[2 * 5632 + 2816 + ch];
      const int lr0 = 2 + 32 * rg;
      float g2 = Cs[(lr0 - 2) * 132 + gcol], g1 = Cs[(lr0 - 1) * 132 + gcol];
      float v2 = Cs[(lr0 - 2) * 132 + vcol], v1 = Cs[(lr0 - 1) * 132 + vcol];
      for (int r = 0; r < 32; ++r) {
        const int lr = lr0 + r; const int t = t0 + lr;
        if (lr >= 128 || t > 4095) break;
        const float g0 = Cs[lr * 132 + gcol], v0 = Cs[lr * 132 + vcol];
        const float yg = wg0 * g2 + wg1 * g1 + wg2 * g0;
        const float yv = wv0 * v2 + wv1 * v1 + wv2 * v0;
        act[(size_t)(b * 4096 + t) * 2816 + ch] = f2bf(siluf_(yg) * yv);
        g2 = g1; g1 = g0; v2 = v1; v1 = v0;
      }
    }
  }
}

DI void phase_ple_gate(const P& p, int layer, const float* ssc, unsigned char* smem, int tid) {
  GEMM_IDS
  const bf16_t* xb = (const bf16_t*)(p.ws + OFF_XB);
  const bf16_t* wg = (const bf16_t*)(p.ws + OFF_WT_PLEG) + (size_t)layer * 1024 * 1024;
  bf16_t* gate = (bf16_t*)(p.ws + OFF_GATE);
  for (int i = blockIdx.x; i < 256 * 4; i += gridDim.x) {
    int mt, nt; tile_decode(i, 256, 4, mt, nt);
    const int m0 = mt * 128, n0 = nt * 256;
    const bf16_t* pa = xb + (size_t)(m0 + lrow) * 1024;
    f32x4 acc[4][8]; zero_acc8(acc);
    gemm_core(acc, pa, pa + 64 * 1024, wg + (size_t)(n0 + permrow(lrow)) * 1024, 64 * 1024, 32, smem, tid);
    EPI_IDS
#pragma unroll
    for (int m = 0; m < 4; ++m) {
      const int row = m0 + 64 * wr + 16 * m + fr;
      const float rs = rsqrtf(ssc[row] * (1.f / 1024.f) + EPSF);
#pragma unroll
      for (int q = 0; q < 4; ++q) {
        const int col = n0 + 128 * wc + 32 * q + 8 * fq;
        const f32x4 v0 = acc[m][2 * q] * rs, v1 = acc[m][2 * q + 1] * rs;
        u32x4 o = {pk2(sigmoidf_(v0.x), sigmoidf_(v0.y)), pk2(sigmoidf_(v0.z), sigmoidf_(v0.w)), pk2(sigmoidf_(v1.x), sigmoidf_(v1.y)), pk2(sigmoidf_(v1.z), sigmoidf_(v1.w))};
        *(u32x4*)(gate + (size_t)row * 1024 + col) = o;
      }
    }
  }
}

DI void phase_ple_add(const P& p, int layer, float* ssn, unsigned char* smem, int tid) {
  GEMM_IDS
  bf16_t* xb = (bf16_t*)(p.ws + OFF_XB);
  const bf16_t* wp = (const bf16_t*)(p.ws + OFF_WT_PLE) + (size_t)layer * 1024 * 256;
  const bf16_t* pb = (const bf16_t*)(p.ws + OFF_PB) + (size_t)layer * 32768 * 256;
  const bf16_t* gate = (const bf16_t*)(p.ws + OFF_GATE);
  float* x = p.out;
  for (int i = blockIdx.x; i < 256 * 4; i += gridDim.x) {
    int mt, nt; tile_decode(i, 256, 4, mt, nt);
    const int m0 = mt * 128, n0 = nt * 256;
    const bf16_t* pa = pb + (size_t)(m0 + lrow) * 256;
    f32x4 acc[4][8]; zero_acc8(acc);
    gemm_core(acc, pa, pa + 64 * 256, wp + (size_t)(n0 + permrow(lrow)) * 256, 64 * 256, 8, smem, tid);
    EPI_IDS
#pragma unroll
    for (int m = 0; m < 4; ++m) {
      const int row = m0 + 64 * wr + 16 * m + fr;
      float s = 0.f;
#pragma unroll
      for (int q = 0; q < 4; ++q) {
        const int col = n0 + 128 * wc + 32 * q + 8 * fq;
        const u32x4 gp = *(const u32x4*)(gate + (size_t)row * 1024 + col);
        const f32x4 g0 = {bflo(gp.x), bfhi(gp.x), bflo(gp.y), bfhi(gp.y)}, g1 = {bflo(gp.z), bfhi(gp.z), bflo(gp.w), bfhi(gp.w)};
        const f32x4 v0 = *(const f32x4*)(x + (size_t)row * 1024 + col) + acc[m][2 * q] * g0;
        const f32x4 v1 = *(const f32x4*)(x + (size_t)row * 1024 + col + 4) + acc[m][2 * q + 1] * g1;
        *(f32x4*)(x + (size_t)row * 1024 + col) = v0;
        *(f32x4*)(x + (size_t)row * 1024 + col + 4) = v1;
        u32x4 o = {pk2(v0.x, v0.y), pk2(v0.z, v0.w), pk2(v1.x, v1.y), pk2(v1.z, v1.w)};
        *(u32x4*)(xb + (size_t)row * 1024 + col) = o;
        s += v0.x * v0.x + v0.y * v0.y + v0.z * v0.z + v0.w * v0.w + v1.x * v1.x + v1.y * v1.y + v1.z * v1.z + v1.w * v1.w;
      }
      s += __shfl_xor(s, 16); s += __shfl_xor(s, 32);
      if (fq == 0) atomicAdd(ssn + row, s);
      __builtin_amdgcn_sched_barrier(0);
    }
  }
}

DI void phase_in_o(const P& p, int qi, unsigned char* smem, int tid) {
  GEMM_IDS
  const bf16_t* xb = (const bf16_t*)(p.ws + OFF_XB); const bf16_t* wt = (const bf16_t*)(p.ws + OFF_WT_INO);
  const float* ssc = (const float*)(p.ws + OFF_SS) + 3 * NTOK;
  bf16_t* qkv = (bf16_t*)(p.ws + OFF_QKV); float* gb = (float*)(p.ws + OFF_GB);
  const float* a_log = p.in[10]; const float* dt_bias = p.in[11];
  for (int i = blockIdx.x; i < 64 * 13; i += gridDim.x) {
    int mt, nt; tile_decode(i, 64, 13, mt, nt);
    const int mq0 = mt * 128, m0 = qi * 8192 + mq0, n0 = nt * 256;
    const bf16_t* pa = xb + (size_t)(m0 + lrow) * 1024;
    f32x4 acc[4][8]; zero_acc8(acc);
    gemm_core(acc, pa, pa + 64 * 1024, wt + (size_t)(n0 + permrow(lrow)) * 1024, 64 * 1024, 32, smem, tid);
    EPI_IDS
#pragma unroll
    for (int m = 0; m < 4; ++m) {
      const int rl = 64 * wr + 16 * m + fr;
      const float rs = rsqrtf(ssc[m0 + rl] * (1.f / 1024.f) + EPSF);
      if (nt < 12) {
#pragma unroll
        for (int q = 0; q < 4; ++q) {
          const int col = n0 + 128 * wc + 32 * q + 8 * fq;
          const f32x4 v0 = acc[m][2 * q] * rs, v1 = acc[m][2 * q + 1] * rs;
          u32x4 o = {pk2(v0.x, v0.y), pk2(v0.z, v0.w), pk2(v1.x, v1.y), pk2(v1.z, v1.w)};
          *(u32x4*)(qkv + (size_t)(mq0 + rl) * 3072 + col) = o;
        }
      } else if (wc == 0 && fq < 2) {
        const f32x4 v0 = acc[m][0] * rs, v1 = acc[m][1] * rs;
        float o[8];
#pragma unroll
        for (int j = 0; j < 8; ++j) {
          const float vv = j < 4 ? v0[j] : v1[j - 4];
          if (fq == 0) o[j] = sigmoidf_(vv);
          else {
            const float xx = vv + dt_bias[j];
            const float sp = fmaxf(xx, 0.f) + log1pf(__expf(-fabsf(xx)));
            o[j] = -__expf(a_log[j]) * sp;
          }
        }
        float* gp = gb + (size_t)(m0 + rl) * 16 + 8 * fq;
        *(f32x4*)gp = (f32x4){o[0], o[1], o[2], o[3]}; *(f32x4*)(gp + 4) = (f32x4){o[4], o[5], o[6], o[7]};
      }
    }
  }
}

DI void phase_z_gate(const P& p, unsigned char* smem, int tid) {
  GEMM_IDS
  const bf16_t* xb = (const bf16_t*)(p.ws + OFF_XB); const bf16_t* wt = (const bf16_t*)(p.ws + OFF_WT_Z);
  const float* ssc = (const float*)(p.ws + OFF_SS) + 3 * NTOK;
  const bf16_t* ob_in = (const bf16_t*)(p.ws + OFF_UT);
  bf16_t* ob = (bf16_t*)(p.ws + OFF_OB);
  const float* nw = p.in[12];
  for (int i = blockIdx.x; i < 256 * 4; i += gridDim.x) {
    int mt, nt; tile_decode(i, 256, 4, mt, nt);
    const int m0 = mt * 128, n0 = nt * 256;
    const bf16_t* pa = xb + (size_t)(m0 + lrow) * 1024;
    f32x4 acc[4][8]; zero_acc8(acc);
    gemm_core(acc, pa, pa + 64 * 1024, wt + (size_t)(n0 + permrow(lrow)) * 1024, 64 * 1024, 32, smem, tid);
    EPI_IDS
    const int hd = 2 * nt + wc;
#pragma unroll
    for (int m = 0; m < 4; ++m) {
      const int row = m0 + 64 * wr + 16 * m + fr;
      const int chunk = ((row >> 12) * 8 + hd) * 64 + ((row & 4095) >> 6);
      const bf16_t* op = ob_in + (size_t)chunk * 8192 + (row & 63) * 64 + 8 * fq;
      u32x4 ov[4];
      float s = 0.f;
#pragma unroll
      for (int q = 0; q < 4; ++q) {
        ov[q] = *(const u32x4*)(op + (q >> 1) * 4096 + 32 * (q & 1));
        const float a0 = bflo(ov[q].x), a1 = bfhi(ov[q].x), a2 = bflo(ov[q].y), a3 = bfhi(ov[q].y), a4 = bflo(ov[q].z), a5 = bfhi(ov[q].z), a6 = bflo(ov[q].w), a7 = bfhi(ov[q].w);
        s += a0 * a0 + a1 * a1 + a2 * a2 + a3 * a3 + a4 * a4 + a5 * a5 + a6 * a6 + a7 * a7;
      }
      s += __shfl_xor(s, 16); s += __shfl_xor(s, 32);
      const float on = rsqrtf(s * (1.f / 128.f) + EPSF);
      const float rs = rsqrtf(ssc[row] * (1.f / 1024.f) + EPSF);
#pragma unroll
      for (int q = 0; q < 4; ++q) {
        const int cl = 32 * q + 8 * fq;
        const f32x4 z0 = acc[m][2 * q] * rs, z1 = acc[m][2 * q + 1] * rs;
        const f32x4 w0 = *(const f32x4*)(nw + cl), w1 = *(const f32x4*)(nw + cl + 4);
        const f32x4 o0 = {bflo(ov[q].x), bfhi(ov[q].x), bflo(ov[q].y), bfhi(ov[q].y)}, o1 = {bflo(ov[q].z), bfhi(ov[q].z), bflo(ov[q].w), bfhi(ov[q].w)};
        float r[8];
#pragma unroll
        for (int j = 0; j < 4; ++j) { r[j] = o0[j] * on * w0[j] * siluf_(z0[j]); r[4 + j] = o1[j] * on * w1[j] * siluf_(z1[j]); }
        u32x4 o = {pk2(r[0], r[1]), pk2(r[2], r[3]), pk2(r[4], r[5]), pk2(r[6], r[7])};
        *(u32x4*)(ob + (size_t)row * 1024 + n0 + 128 * wc + cl) = o;
      }
      __builtin_amdgcn_sched_barrier(0);
    }
  }
}

#ifndef DUMMY_MODE
#define DUMMY_MODE -1
#endif
DI void phase_dummy(const P& p, int mode, unsigned char* smem, int tid) {
  GEMM_IDS
  const bf16_t* xb = (const bf16_t*)(p.ws + OFF_XB);
  const bf16_t* wg = (const bf16_t*)(p.ws + OFF_WT_PLEG);
  for (int i = blockIdx.x; i < 256 * 4; i += gridDim.x) {
    int mt, nt; tile_decode(i, 256, 4, mt, nt);
    if (mode == 1) { mt = 0; nt = 0; }
    if (mode == 2) { mt = blockIdx.x & 255; nt = 0; }
    const int m0 = mt * 128, n0 = nt * 256;
    const bf16_t* pa = xb + (size_t)(m0 + lrow) * 1024;
    f32x4 acc[4][8]; zero_acc8(acc);
    gemm_core(acc, pa, pa + 64 * 1024, wg + (size_t)(n0 + lrow) * 1024, 64 * 1024, 32, smem, tid);
    EPI_IDS
    float s = 0.f;
#pragma unroll
    for (int m = 0; m < 4; ++m)
#pragma unroll
      for (int n = 0; n < 8; ++n) s += acc[m][n].x + acc[m][n].y + acc[m][n].z + acc[m][n].w;
    if (s == 123456.789f) ((float*)(p.ws + OFF_GL))[0] = s;
  }
}

DI void attn_item(const P& p, int item, unsigned char* smem, int tid) {
  const int lane = tid & 63, w = tid >> 6, r = lane & 31, hh = lane >> 5;
  const int bh = item & 63, jj = item >> 6;
  int qb; { const int a = jj & 7, grp = jj >> 3; qb = grp == 0 ? 31 - a : grp == 1 ? 16 + a : grp == 2 ? 15 - a : a; }
  const int b = bh >> 3, h = bh & 7;
  const int q0 = qb * 128, qw = q0 + 32 * w;
  const bf16_t* proj = (const bf16_t*)(p.ws + OFF_PROJ0);
  const bf16_t* vT = (const bf16_t*)(p.ws + OFF_VT) + (size_t)bh * 64 * 4096;
  bf16x8 qf[4];
  {
    const bf16_t* qp = proj + (size_t)(b * 4096 + qw + r) * 1536 + 512 + h * 64 + 8 * hh;
#pragma unroll
    for (int s = 0; s < 4; ++s) qf[s] = *(const bf16x8*)(qp + 16 * s);
  }
  f32x16 oacc[2];
#pragma unroll
  for (int i = 0; i < 16; ++i) { oacc[0][i] = 0.f; oacc[1][i] = 0.f; }
  float carry = 0.f;
  const int ntile = q0 / 64 + 2;
  const int lrow = tid >> 3, lc = tid & 7;
  const bf16_t* kbase = proj + (size_t)(b * 4096 + lrow) * 1536 + 1024 + h * 64 + 8 * lc;
  const bf16_t* vbase = vT + (size_t)lrow * 4096 + 8 * lc;
  unsigned char* sK = smem;
  unsigned char* sV = smem + 16384;
  const int kst = lrow * 128 + ((lc ^ (lrow & 7)) << 4);
  const int vst = lrow * 136 + lc * 16;
  u32x4 rk[2], rv[2];
  int kt = ntile - 1;
#pragma unroll
  for (int i = 0; i < 2; ++i) { rk[i] = *(const u32x4*)(kbase + (size_t)(kt * 64 + 32 * i) * 1536); rv[i] = *(const u32x4*)(vbase + (size_t)(32 * i) * 4096 + kt * 64); }
  __syncthreads();
#pragma unroll
  for (int i = 0; i < 2; ++i) {
    *(u32x4*)(sK + kst + i * 4096) = rk[i];
    *(u32x2*)(sV + vst + i * 4352) = (u32x2){rv[i].x, rv[i].y}; *(u32x2*)(sV + vst + i * 4352 + 8) = (u32x2){rv[i].z, rv[i].w};
  }
  __syncthreads();
  int cur = 0;
  for (; kt >= 0; --kt) {
    if (kt > 0) {
#pragma unroll
      for (int i = 0; i < 2; ++i) { rk[i] = *(const u32x4*)(kbase + (size_t)((kt - 1) * 64 + 32 * i) * 1536); rv[i] = *(const u32x4*)(vbase + (size_t)(32 * i) * 4096 + (kt - 1) * 64); }
    }
    const unsigned char* cK = sK + cur * 8192; const unsigned char* cV = sV + cur * 8704;
    const int s0 = kt * 64;
#pragma unroll
    for (int sub = 1; sub >= 0; --sub) {
      const int ks = s0 + 32 * sub;
      if (ks <= qw) {
        f32x16 sc;
#pragma unroll
        for (int i = 0; i < 16; ++i) sc[i] = 0.f;
#pragma unroll
        for (int s = 0; s < 4; ++s) {
          const bf16x8 kf = *(const bf16x8*)(cK + (32 * sub + r) * 128 + (((2 * s + hh) ^ (r & 7)) << 4));
          sc = mfma32(kf, qf[s], sc);
        }
        float sp[16], ls[16];
#pragma unroll
        for (int i = 0; i < 16; ++i) {
          const float z = sc[i];
          sp[i] = flog2(1.f + fexp2(z));
          ls[i] = z - sp[i];
        }
        if (ks == qw) {
#pragma unroll
          for (int i = 0; i < 16; ++i) { const bool valid = crow(i, hh) < r; sp[i] = valid ? sp[i] : 0.f; ls[i] = valid ? ls[i] : -1e30f; }
        }
        float G[4], Pp[4], Tt[4];
#pragma unroll
        for (int g = 0; g < 4; ++g) { G[g] = (sp[4 * g] + sp[4 * g + 1]) + (sp[4 * g + 2] + sp[4 * g + 3]); Pp[g] = __shfl_xor(G[g], 32); Tt[g] = G[g] + Pp[g]; }
        float after = carry;
        f32x16 av;
#pragma unroll
        for (int g = 3; g >= 0; --g) {
          float base = after + (hh == 0 ? Pp[g] : 0.f);
          float k3 = base, k2 = k3 + sp[4 * g + 3], k1 = k2 + sp[4 * g + 2], k0 = k1 + sp[4 * g + 1];
          av[4 * g + 3] = fexp2(ls[4 * g + 3] - k3); av[4 * g + 2] = fexp2(ls[4 * g + 2] - k2);
          av[4 * g + 1] = fexp2(ls[4 * g + 1] - k1); av[4 * g + 0] = fexp2(ls[4 * g + 0] - k0);
          after += Tt[g];
        }
        carry = after;
#pragma unroll
        for (int s = 0; s < 2; ++s) {
          const bf16x8 ap = pack_step(av, s);
#pragma unroll
          for (int dt = 0; dt < 2; ++dt) {
            const unsigned char* vp = cV + (32 * dt + r) * 136 + (32 * sub + 16 * s + 4 * hh) * 2;
            const bf16x8 vf = mk8(*(const u32x2*)vp, *(const u32x2*)(vp + 16));
            oacc[dt] = mfma32(vf, ap, oacc[dt]);
          }
        }
      }
    }
    if (kt > 0) {
      unsigned char* nK = sK + (cur ^ 1) * 8192; unsigned char* nV = sV + (cur ^ 1) * 8704;
#pragma unroll
      for (int i = 0; i < 2; ++i) {
        *(u32x4*)(nK + kst + i * 4096) = rk[i];
        *(u32x2*)(nV + vst + i * 4352) = (u32x2){rv[i].x, rv[i].y}; *(u32x2*)(nV + vst + i * 4352 + 8) = (u32x2){rv[i].z, rv[i].w};
      }
    }
    int* flg = (int*)(smem + 34816) + 4 * cur;
    { const bool wdone = (__ballot(carry < 160.f) == 0ull); if (lane == 0) flg[w] = wdone ? 1 : 0; }
    __syncthreads();
    if (flg[0] + flg[1] + flg[2] + flg[3] == 4) break;
    cur ^= 1;
  }
  bf16_t* cat = (bf16_t*)(p.ws + OFF_CAT) + (size_t)(b * 4096 + qw + r) * 1024 + 512 + h * 64;
#pragma unroll
  for (int dt = 0; dt < 2; ++dt)
#pragma unroll
    for (int g = 0; g < 4; ++g) {
      u32x2 o = {pk2(oacc[dt][4 * g], oacc[dt][4 * g + 1]), pk2(oacc[dt][4 * g + 2], oacc[dt][4 * g + 3])};
      *(u32x2*)(cat + 32 * dt + 8 * g + 4 * hh) = o;
    }
}

DI void pool_item(const P& p, int item, unsigned char* smem, int tid) {
  const int lane = tid & 63, wid = tid >> 6, wr = wid >> 1, wc = wid & 1, fr = lane & 15, fq = lane >> 4; const int lrow = tid >> 3, lc = tid & 7; (void)lane;
  const int g = item & 3, mt = item >> 2;
  const int m0 = mt * 128;
  const bf16_t* proj = (const bf16_t*)(p.ws + OFF_PROJ0);
  const bf16_t* wt = (const bf16_t*)(p.ws + OFF_WT_POOL) + (size_t)g * 128 * 128;
  unsigned char* sA = smem; unsigned char* sB = smem + 32768;
  __syncthreads();
  {
    const int st_off = lrow * 128 + ((lc ^ (lrow & 7)) << 4);
#pragma unroll
    for (int kt = 0; kt < 2; ++kt)
#pragma unroll
      for (int i = 0; i < 4; ++i) *(u32x4*)(sB + kt * 16384 + st_off + i * 4096) = *(const u32x4*)(wt + (size_t)(lrow + 32 * i) * 128 + kt * 64 + 8 * lc);
  }
  {
    const int c = tid & 127, half = tid >> 7;
    const int w = 2 << g;
    const int tb = (m0 & 4095) + 64 * half;
    const bf16_t* up = proj + (size_t)(m0 - (m0 & 4095)) * 1536 + g * 128 + c;
    float run = 0.f;
    for (int k = 1; k < w; ++k) { const int t = tb - k; if (t >= 0) run += bf2f(up[(size_t)t * 1536]); }
    const int stg = c >> 6, kk = c & 63, chk = kk >> 3, wi = kk & 7;
    for (int rr = 0; rr < 64; ++rr) {
      const int t = tb + rr; const int lr = 64 * half + rr;
      const float ut = bf2f(up[(size_t)t * 1536]);
      run += ut;
      const int cnt = (t + 1 < w) ? (t + 1) : w;
      const float y = run / (float)cnt - ut;
      *(bf16_t*)(sA + stg * 16384 + lr * 128 + ((chk ^ (lr & 7)) << 4) + wi * 2) = f2bf(y);
      if (t - w + 1 >= 0) run -= bf2f(up[(size_t)(t - w + 1) * 1536]);
    }
  }
  __syncthreads();
  f32x4 acc[4][4]; zero_acc(acc);
  const int a_rd = (64 * wr + fr) * 128, b_rd = (64 * wc + fr) * 128;
  const int sw0 = (fq ^ (fr & 7)) << 4, sw1 = ((4 + fq) ^ (fr & 7)) << 4;
  mma_stage(acc, sA, sB, a_rd, b_rd, sw0, sw1);
  mma_stage(acc, sA + 16384, sB + 16384, a_rd, b_rd, sw0, sw1);
  const float* psc = p.in[5] + g * 128;
  bf16_t* cat = (bf16_t*)(p.ws + OFF_CAT);
#pragma unroll
  for (int m = 0; m < 4; ++m) {
    const int row = m0 + 64 * wr + 16 * m + fr;
#pragma unroll
    for (int n = 0; n < 4; ++n) {
      const int cl = 64 * wc + 16 * n + 4 * fq;
      const f32x4 s4 = *(const f32x4*)(psc + cl);
      const f32x4 v = acc[m][n] * s4;
      u32x2 o = {pk2(v.x, v.y), pk2(v.z, v.w)};
      *(u32x2*)(cat + (size_t)row * 1024 + g * 128 + cl) = o;
    }
  }
}


template <int I> struct SolveRow {
  static DI void run(float (&sol)[64], const float* A_v) {
    float s = sol[I];
#pragma unroll
    for (int g8 = 0; g8 < (I + 31) / 32; ++g8) {
      f32x4 a[8];
#pragma unroll
      for (int q = 0; q < 8; ++q) if (32 * g8 + 4 * q < I) a[q] = *(const f32x4*)(A_v + I * 68 + 32 * g8 + 4 * q);
#pragma unroll
      for (int q = 0; q < 8; ++q) {
        const int j = 32 * g8 + 4 * q;
        if (j + 0 < I) s -= a[q].x * sol[j + 0];
        if (j + 1 < I) s -= a[q].y * sol[j + 1];
        if (j + 2 < I) s -= a[q].z * sol[j + 2];
        if (j + 3 < I) s -= a[q].w * sol[j + 3];
      }
      __builtin_amdgcn_sched_barrier(0);
    }
    sol[I] = s;
    SolveRow<I + 1>::run(sol, A_v);
  }
};
template <> struct SolveRow<64> { static DI void run(float (&)[64], const float*) {} };

constexpr int GD_RAW = 0, GD_Q = 18224, GD_K = GD_Q + 17408, GD_V = GD_K + 17408, GD_GC = GD_V + 17408, GD_BETA = GD_GC + 256, GD_CW = GD_BETA + 256;
DI void gdn_chunk_item(const P& p, int qi, int item, unsigned char* smem, int tid) {
  const int lane = tid & 63, w = tid >> 6, r = lane & 31, hh = lane >> 5;
  const int h = item & 7, n = (item >> 3) & 63, bq = item >> 9;
  const int b = 2 * qi + bq;
  const int chunk = (b * 8 + h) * 64 + n;
  const bf16_t* qkv = (const bf16_t*)(p.ws + OFF_QKV) + (size_t)(bq * 4096) * 3072;
  const float* gb = (const float*)(p.ws + OFF_GB);
  const float* cw = p.in[9];
  float* gc_s = (float*)(smem + GD_GC); float* beta_s = (float*)(smem + GD_BETA);
  __syncthreads();
  if (w == 0) {
    const int tok = b * 4096 + 64 * n + lane;
    float g = gb[(size_t)tok * 16 + 8 + h]; const float be = gb[(size_t)tok * 16 + h];
#pragma unroll
    for (int off = 1; off < 64; off <<= 1) { const float t = __shfl_up(g, off); if (lane >= off) g += t; }
    gc_s[lane] = g; beta_s[lane] = be;
  }
#pragma unroll 1
  for (int pp = 0; pp < 3; ++pp) {
    for (int i = 0; i < 5; ++i) {
      const int idx = tid + 256 * i;
      if (idx < 1072) {
        const int rr = idx >> 4, c = idx & 15; const int t = 64 * n - 3 + rr;
        u32x4 v = {0u, 0u, 0u, 0u};
        if (t >= 0) v = *(const u32x4*)(qkv + (size_t)t * 3072 + pp * 1024 + h * 128 + 8 * c);
        *(u32x4*)(smem + GD_RAW + rr * 272 + 16 * c) = v;
      }
    }
#pragma unroll
    for (int i = 0; i < 2; ++i) { const int idx = tid + 256 * i; ((float*)(smem + GD_CW))[idx] = cw[(size_t)(idx >> 7) * 3072 + pp * 1024 + h * 128 + (idx & 127)]; }
    __syncthreads();
    {
      const int row = tid >> 2, qtr = tid & 3; const int ch0 = 32 * qtr;
      float y[32];
#pragma unroll
      for (int sub = 0; sub < 4; ++sub) {
        float a[8];
#pragma unroll
        for (int e = 0; e < 8; ++e) a[e] = 0.f;
#pragma unroll
        for (int tap = 0; tap < 4; ++tap) {
          const u32x4 xv = *(const u32x4*)(smem + GD_RAW + (row + tap) * 272 + (ch0 + 8 * sub) * 2);
          const float* wp = (const float*)(smem + GD_CW) + tap * 128 + ch0 + 8 * sub;
          const f32x4 w0 = *(const f32x4*)wp, w1 = *(const f32x4*)(wp + 4);
          a[0] += w0.x * bflo(xv.x); a[1] += w0.y * bfhi(xv.x); a[2] += w0.z * bflo(xv.y); a[3] += w0.w * bfhi(xv.y);
          a[4] += w1.x * bflo(xv.z); a[5] += w1.y * bfhi(xv.z); a[6] += w1.z * bflo(xv.w); a[7] += w1.w * bfhi(xv.w);
        }
#pragma unroll
        for (int e = 0; e < 8; ++e) y[8 * sub + e] = siluf_(a[e]);
        __builtin_amdgcn_sched_barrier(0);
      }
      if (pp < 2) {
        float s = 0.f;
#pragma unroll
        for (int e = 0; e < 32; ++e) s += y[e] * y[e];
        s += __shfl_xor(s, 1); s += __shfl_xor(s, 2);
        const float inv = rsqrtf(s + EPSF) * (pp == 0 ? 0.08838834764831845f : 1.f);
#pragma unroll
        for (int e = 0; e < 32; ++e) y[e] *= inv;
      }
      unsigned char* dst = smem + (pp == 0 ? GD_Q : pp == 1 ? GD_K : GD_V) + row * 272 + ch0 * 2;
#pragma unroll
      for (int sub = 0; sub < 4; ++sub) {
        u32x4 o = {pk2(y[8 * sub], y[8 * sub + 1]), pk2(y[8 * sub + 2], y[8 * sub + 3]), pk2(y[8 * sub + 4], y[8 * sub + 5]), pk2(y[8 * sub + 6], y[8 * sub + 7])};
        *(u32x4*)(dst + 16 * sub) = o;
      }
    }
    __syncthreads();
  }
  float* A_s = (float*)(smem + GD_RAW);
  bf16_t* qkb = (bf16_t*)(p.ws + OFF_QK) + (size_t)chunk * 4096;
  {
    const int ti = w >> 1, tj = w & 1;
    const int j = 32 * tj + r;
    if (ti == 0 && tj == 1) {
#pragma unroll
      for (int reg = 0; reg < 16; ++reg) qkb[(32 * ti + crow(reg, hh)) * 64 + j] = 0;
    } else {
      f32x16 kk, qk;
#pragma unroll
      for (int i = 0; i < 16; ++i) { kk[i] = 0.f; qk[i] = 0.f; }
#pragma unroll
      for (int s = 0; s < 8; ++s) {
        const bf16x8 bfrag = *(const bf16x8*)(smem + GD_K + (32 * tj + r) * 272 + (16 * s + 8 * hh) * 2);
        const bf16x8 akf = *(const bf16x8*)(smem + GD_K + (32 * ti + r) * 272 + (16 * s + 8 * hh) * 2);
        const bf16x8 aqf = *(const bf16x8*)(smem + GD_Q + (32 * ti + r) * 272 + (16 * s + 8 * hh) * 2);
        kk = mfma32(akf, bfrag, kk); qk = mfma32(aqf, bfrag, qk);
      }
      const float gcj = gc_s[j];
#pragma unroll
      for (int reg = 0; reg < 16; ++reg) {
        const int i = 32 * ti + crow(reg, hh);
        const float dec = (i >= j) ? __expf(gc_s[i] - gcj) : 0.f;
        A_s[i * 68 + j] = (i > j) ? beta_s[i] * kk[reg] * dec : 0.f;
        qkb[i * 64 + j] = f2bf((i >= j) ? qk[reg] * dec : 0.f);
      }
    }
  }
  __syncthreads();
  {
    const int col = tid; const bool isw = col >= 128; const int d = col & 127;
    int vz; asm volatile("v_mov_b32 %0, 0" : "=v"(vz));
    const float* A_v = A_s + vz; const float* gc_v = gc_s + vz; const float* beta_v = beta_s + vz;
    const unsigned char* src = smem + (isw ? GD_K : GD_V) + d * 2;
    float sol[64];
#pragma unroll
    for (int i = 0; i < 64; ++i) {
      float v = bf2f(*(const bf16_t*)(src + i * 272)) * beta_v[i];
      if (isw) v *= __expf(gc_v[i]);
      sol[i] = v;
    }
    SolveRow<1>::run(sol, A_v);
    __syncthreads();
    if (!isw) {
      bf16_t* ut = (bf16_t*)(p.ws + OFF_UT) + (size_t)chunk * 8192 + d * 64;
#pragma unroll
      for (int c8 = 0; c8 < 8; ++c8) {
        u32x4 o = {pk2(sol[8 * c8], sol[8 * c8 + 1]), pk2(sol[8 * c8 + 2], sol[8 * c8 + 3]), pk2(sol[8 * c8 + 4], sol[8 * c8 + 5]), pk2(sol[8 * c8 + 6], sol[8 * c8 + 7])};
        *(u32x4*)(ut + 8 * c8) = o;
      }
      unsigned char* qp = smem + GD_Q + d * 2;
#pragma unroll
      for (int i = 0; i < 64; ++i) { const float v = bf2f(*(const bf16_t*)(qp + i * 272)) * __expf(gc_v[i]); *(bf16_t*)(qp + i * 272) = f2bf(v); }
    } else {
      unsigned char* wp = smem + GD_V + d * 2;
#pragma unroll
      for (int i = 0; i < 64; ++i) *(bf16_t*)(wp + i * 272) = f2bf(-sol[i]);
      bf16_t* kd = (bf16_t*)(p.ws + OFF_KD) + (size_t)chunk * 8192 + d * 64;
      const float gl = gc_v[63];
#pragma unroll
      for (int c8 = 0; c8 < 8; ++c8) {
        float kv[8];
#pragma unroll
        for (int e = 0; e < 8; ++e) kv[e] = bf2f(*(const bf16_t*)(smem + GD_K + (8 * c8 + e) * 272 + d * 2)) * __expf(gl - gc_v[8 * c8 + e]);
        u32x4 o = {pk2(kv[0], kv[1]), pk2(kv[2], kv[3]), pk2(kv[4], kv[5]), pk2(kv[6], kv[7])};
        *(u32x4*)(kd + 8 * c8) = o;
      }
    }
    if (tid == 0) ((float*)(p.ws + OFF_GL))[chunk] = __expf(gc_s[63]);
    __syncthreads();
    {
      bf16_t* wn = (bf16_t*)(p.ws + OFF_WN) + (size_t)chunk * 8192;
      bf16_t* qd = (bf16_t*)(p.ws + OFF_QD) + (size_t)chunk * 8192;
#pragma unroll 1
      for (int i = 0; i < 4; ++i) {
        const int idx = tid + 256 * i; const int lo = (idx >> 4) * 272 + (idx & 15) * 16;
        *(u32x4*)(wn + (size_t)idx * 8) = *(const u32x4*)(smem + GD_V + lo);
        *(u32x4*)(qd + (size_t)idx * 8) = *(const u32x4*)(smem + GD_Q + lo);
      }
    }
  }
}

constexpr int SC_W = 0, SC_QD = 17408, SC_QK = 34816, SC_KD = 34816 + 9216, SC_U = 34816 + 9216 + 18432;
DI bf16x8 pack44(const f32x4& a, const f32x4& b) { u32x4 v = {pk2(a.x, a.y), pk2(a.z, a.w), pk2(b.x, b.y), pk2(b.z, b.w)}; return __builtin_bit_cast(bf16x8, v); }
DI void scan_item(const P& p, int item, unsigned char* smem, int tid) {
  const int lane = tid & 63, w = tid >> 6, fr = lane & 15, fq = lane >> 4;
  const int bh = item >> 1, hf = item & 1;
  const bf16_t* WN = (const bf16_t*)(p.ws + OFF_WN); const bf16_t* QD = (const bf16_t*)(p.ws + OFF_QD);
  const bf16_t* KD = (const bf16_t*)(p.ws + OFF_KD); const bf16_t* QK = (const bf16_t*)(p.ws + OFF_QK);
  bf16_t* UT = (bf16_t*)(p.ws + OFF_UT) + hf * 4096; const float* GL = (const float*)(p.ws + OFF_GL);
  f32x4 S[8];
#pragma unroll
  for (int dt = 0; dt < 8; ++dt) S[dt] = (f32x4){0.f, 0.f, 0.f, 0.f};
  u32x4 st[16];
  const int chunk0 = bh * 64;
#define SC_LOAD(CH) do { \
    const size_t cb = (size_t)(CH) * 8192; \
    _Pragma("unroll") for (int i = 0; i < 4; ++i) { st[i] = *(const u32x4*)(WN + cb + (size_t)(tid + 256 * i) * 8); st[4 + i] = *(const u32x4*)(QD + cb + (size_t)(tid + 256 * i) * 8); st[10 + i] = *(const u32x4*)(KD + cb + (size_t)(tid + 256 * i) * 8); } \
    _Pragma("unroll") for (int i = 0; i < 2; ++i) { st[8 + i] = *(const u32x4*)(QK + (size_t)(CH) * 4096 + (size_t)(tid + 256 * i) * 8); st[14 + i] = *(const u32x4*)(UT + cb + (size_t)(tid + 256 * i) * 8); } \
  } while (0)
#define SC_STORE() do { \
    _Pragma("unroll") for (int i = 0; i < 4; ++i) { const int idx = tid + 256 * i; const int o16 = (idx >> 4) * 272 + (idx & 15) * 16; *(u32x4*)(smem + SC_W + o16) = st[i]; *(u32x4*)(smem + SC_QD + o16) = st[4 + i]; \
      const int o8 = (idx >> 3) * 144 + (idx & 7) * 16; *(u32x4*)(smem + SC_KD + o8) = st[10 + i]; } \
    _Pragma("unroll") for (int i = 0; i < 2; ++i) { const int idx = tid + 256 * i; const int o8 = (idx >> 3) * 144 + (idx & 7) * 16; *(u32x4*)(smem + SC_QK + o8) = st[8 + i]; *(u32x4*)(smem + SC_U + o8) = st[14 + i]; } \
  } while (0)
  SC_LOAD(chunk0);
  __syncthreads();
  for (int n = 0; n < 64; ++n) {
    const int chunk = chunk0 + n;
    SC_STORE();
    __syncthreads();
    if (n + 1 < 64) SC_LOAD(chunk + 1);
    f32x4 vn[4];
#pragma unroll
    for (int ct = 0; ct < 4; ++ct) { const u32x2 u = *(const u32x2*)(smem + SC_U + (16 * w + fr) * 144 + (16 * ct + 4 * fq) * 2); vn[ct] = (f32x4){bflo(u.x), bfhi(u.x), bflo(u.y), bfhi(u.y)}; }
    const float gl = GL[chunk];
    bf16x8 Sp[4];
#pragma unroll
    for (int kk = 0; kk < 4; ++kk) Sp[kk] = pack44(S[2 * kk], S[2 * kk + 1]);
#pragma unroll
    for (int ct = 0; ct < 4; ++ct)
#pragma unroll
      for (int kk = 0; kk < 4; ++kk) {
        const unsigned char* ap = smem + SC_W + (16 * ct + fr) * 272 + (32 * kk + 4 * fq) * 2;
        vn[ct] = mfma16(mk8(*(const u32x2*)ap, *(const u32x2*)(ap + 32)), Sp[kk], vn[ct]);
      }
    bf16x8 vp[2];
    vp[0] = pack44(vn[0], vn[1]); vp[1] = pack44(vn[2], vn[3]);
#pragma unroll
    for (int ct = 0; ct < 4; ++ct) {
      f32x4 o = {0.f, 0.f, 0.f, 0.f};
#pragma unroll
      for (int kk = 0; kk < 4; ++kk) {
        const unsigned char* ap = smem + SC_QD + (16 * ct + fr) * 272 + (32 * kk + 4 * fq) * 2;
        o = mfma16(mk8(*(const u32x2*)ap, *(const u32x2*)(ap + 32)), Sp[kk], o);
      }
#pragma unroll
      for (int kc = 0; kc < 2; ++kc) {
        const unsigned char* ap = smem + SC_QK + (16 * ct + fr) * 144 + (32 * kc + 4 * fq) * 2;
        o = mfma16(mk8(*(const u32x2*)ap, *(const u32x2*)(ap + 32)), vp[kc], o);
      }
      bf16_t* op = UT + (size_t)chunk * 8192 + (size_t)(16 * ct + 4 * fq) * 64 + 16 * w + fr;
      op[0] = f2bf(o.x); op[64] = f2bf(o.y); op[128] = f2bf(o.z); op[192] = f2bf(o.w);
    }
#pragma unroll
    for (int dt = 0; dt < 8; ++dt) {
      S[dt] = S[dt] * gl;
#pragma unroll
      for (int kc = 0; kc < 2; ++kc) {
        const unsigned char* ap = smem + SC_KD + (16 * dt + fr) * 144 + (32 * kc + 4 * fq) * 2;
        S[dt] = mfma16(mk8(*(const u32x2*)ap, *(const u32x2*)(ap + 32)), vp[kc], S[dt]);
      }
    }
    __syncthreads();
  }
}

DI void phase_final(const P& p, int tid) {
  const int lane = tid & 63, wid = tid >> 6;
  float* x = p.out; const float* g = p.in[21];
  for (int row = blockIdx.x * 4 + wid; row < NTOK; row += gridDim.x * 4) {
    f32x4 v[4]; float s = 0.f;
#pragma unroll
    for (int i = 0; i < 4; ++i) { v[i] = *(const f32x4*)(x + (size_t)row * 1024 + 256 * i + 4 * lane); s += v[i].x * v[i].x + v[i].y * v[i].y + v[i].z * v[i].z + v[i].w * v[i].w; }
#pragma unroll
    for (int off = 32; off > 0; off >>= 1) s += __shfl_xor(s, off);
    const float rs = rsqrtf(s * (1.f / 1024.f) + EPSF);
#pragma unroll
    for (int i = 0; i < 4; ++i) { const f32x4 gg = *(const f32x4*)(g + 256 * i + 4 * lane); *(f32x4*)(x + (size_t)row * 1024 + 256 * i + 4 * lane) = v[i] * rs * gg; }
  }
}


#define XB_TMO      128
#define XB_XCNT(j)  (256  + 64 * (j))
#define XB_XSUB(j)  (1280 + 64 * (j))
#define XB_XGEN(j)  (2304 + 64 * (j))
#define XB_TOP      3328
#define XB_TOPGEN   3392
#define XCD_BAR_WORDS 3456
#define XB_SPIN_CAP (1u << 18)
#define LAS __attribute__((address_space(3)))
DI unsigned xb_ld(unsigned* p)              { return __hip_atomic_load(p, __ATOMIC_RELAXED, __HIP_MEMORY_SCOPE_AGENT); }
DI unsigned xb_add(unsigned* p, unsigned v) { return __hip_atomic_fetch_add(p, v, __ATOMIC_RELAXED, __HIP_MEMORY_SCOPE_AGENT); }
DI unsigned xb_xcc_id() { return (unsigned)__builtin_amdgcn_s_getreg((3 << 11) | 20) & 0xFu; }
#define XB_SPIN(cond, bar) do { unsigned _sp = 0; while (cond) { __builtin_amdgcn_s_sleep(1); \
    if ((++_sp & 255u) == 0u) { if (xb_ld(&(bar)[XB_TMO])) break; if (_sp > XB_SPIN_CAP) { atomicAdd(&(bar)[XB_TMO], 1u); break; } } } } while (0)
struct XcdBarrier { unsigned* bar; unsigned x; volatile LAS unsigned* st; };
DI XcdBarrier xcd_barrier_post(unsigned* bar, volatile LAS unsigned* st) {
  XcdBarrier b; b.bar = bar; b.x = xb_xcc_id(); b.st = st;
  if (threadIdx.x == 0) (void)xb_add(&bar[XB_XCNT(b.x)], 1u);
  return b;
}
DI void xcd_barrier_complete(unsigned* bar, unsigned x, unsigned& nloc, unsigned& nx) {
  const unsigned G = gridDim.x * gridDim.y * gridDim.z;
  unsigned sum, cnt, mine, sp = 0u;
  for (;;) {
    sum = 0u; cnt = 0u; mine = 0u;
#pragma unroll
    for (unsigned j = 0; j < 16; ++j) { const unsigned c = xb_ld(&bar[XB_XCNT(j)]); sum += c; cnt += (c > 0u) ? 1u : 0u; mine = (j == x) ? c : mine; }
    if (sum == G) break;
    __builtin_amdgcn_s_sleep(1);
    if ((++sp & 255u) == 0u) { if (xb_ld(&bar[XB_TMO])) break; if (sp > XB_SPIN_CAP) { atomicAdd(&bar[XB_TMO], 1u); break; } }
  }
  nloc = mine > 0u ? mine : 1u; nx = cnt > 0u ? cnt : 1u;
}
DI void xcd_barrier(const XcdBarrier& b) {
  asm volatile("s_waitcnt vmcnt(0)" ::: "memory");
  __syncthreads();
  if (threadIdx.x == 0) {
    unsigned* bar = b.bar;
    unsigned bx = b.x;
    asm volatile("" : "+s"(bar), "+s"(bx));
    __builtin_amdgcn_s_waitcnt(0);
    unsigned nloc = b.st[0], nx = b.st[1];
    if (nloc == 0u) { xcd_barrier_complete(bar, bx, nloc, nx); b.st[0] = nloc; b.st[1] = nx; }
    const unsigned old = xb_add(&bar[XB_XSUB(bx)], 1u);
    const unsigned gen = old / nloc;
    if (old + 1u == (gen + 1u) * nloc) {
      __builtin_amdgcn_fence(__ATOMIC_RELEASE, "agent");
      asm volatile("s_waitcnt vmcnt(0)" ::: "memory");
      const unsigned og = xb_add(&bar[XB_TOP], 1u);
      const unsigned tg = og / nx;
      if (og + 1u == (tg + 1u) * nx) xb_add(&bar[XB_TOPGEN], 1u);
      else XB_SPIN(xb_ld(&bar[XB_TOPGEN]) == tg, bar);
      __builtin_amdgcn_fence(__ATOMIC_ACQUIRE, "agent");
      xb_add(&bar[XB_XGEN(bx)], 1u);
      asm volatile("s_waitcnt vmcnt(0)" ::: "memory");
    } else {
      XB_SPIN(xb_ld(&bar[XB_XGEN(bx)]) == gen, bar);
      __builtin_amdgcn_fence(__ATOMIC_ACQUIRE, "agent");
      asm volatile("s_waitcnt vmcnt(0)" ::: "memory");
    }
  }
  __syncthreads();
}

constexpr int N_PHASES = 24;
typedef const __attribute__((address_space(4))) P* KP;
DI P loadP(KP kp) {
  P p;
#pragma unroll
  for (int i = 0; i < 22; ++i) p.in[i] = kp->in[i];
  p.out = kp->out; p.ws = kp->ws;
  return p;
}
#define SSP(k) ((float*)(p.ws + OFF_SS) + (k) * NTOK)
#define PH_BEGIN { KP kp = (KP)__builtin_amdgcn_kernarg_segment_ptr(); asm volatile("" : "+s"(kp)); \
    unsigned zz_; asm volatile("v_mov_b32 %0, 0" : "=v"(zz_)); \
    int tid = wbase + (int)__builtin_amdgcn_mbcnt_hi(~0u, __builtin_amdgcn_mbcnt_lo(~0u, zz_)); asm volatile("" : "+v"(tid)); \
    const P p = loadP(kp);
#define PH_END } xcd_barrier(xb);

__global__ void __launch_bounds__(256, 2) mega(P p_arg, int ph_lo, int ph_hi) {
  extern __shared__ __attribute__((aligned(16))) unsigned char smem[];
  __shared__ uint4 xb_words;
  cg::grid_group grid = cg::this_grid();
  if (threadIdx.x == 0) xb_words = make_uint4(0u, 0u, 0u, 0u);
  __syncthreads();
  const int wbase = __builtin_amdgcn_readfirstlane((int)(threadIdx.x & ~63u));
  XcdBarrier xb = xcd_barrier_post((unsigned*)(p_arg.ws + OFF_BAR), (volatile LAS unsigned*)&xb_words);
  if (ph_hi < 0) grid.sync();

  PH_BEGIN phase_prologue(p, smem, tid); PH_END
#if REP_PHASE == 0
  PH_BEGIN phase_prologue(p, smem, tid); PH_END
#endif
#pragma unroll 1
  for (int layer = 0; layer < 2; ++layer) {
    if (layer == 0) {
      PH_BEGIN phase_in_e(p, smem, tid); PH_END
      PH_BEGIN for (int i = blockIdx.x; i < 2048 + 1024; i += gridDim.x) { if (i < 2048) attn_item(p, i, smem, tid); else pool_item(p, i - 2048, smem, tid); } PH_END
#if REP_PHASE == 2
      PH_BEGIN for (int i = blockIdx.x; i < 2048 + 1024; i += gridDim.x) { if (i < 2048) attn_item(p, i, smem, tid); else pool_item(p, i - 2048, smem, tid); } PH_END
#endif
    } else {
#pragma unroll 1
      for (int qi = 0; qi < 4; ++qi) {
        PH_BEGIN phase_in_o(p, qi, smem, tid); PH_END
        PH_BEGIN for (int i = blockIdx.x; i < 1024; i += gridDim.x) gdn_chunk_item(p, qi, i, smem, tid); PH_END
#if REP_PHASE == 9
        if (qi == 0) { PH_BEGIN for (int i = blockIdx.x; i < 1024; i += gridDim.x) gdn_chunk_item(p, qi, i, smem, tid); PH_END }
#endif
      }
      PH_BEGIN for (int i = blockIdx.x; i < 128; i += gridDim.x) scan_item(p, i, smem, tid); PH_END
      PH_BEGIN phase_z_gate(p, smem, tid); PH_END
    }
    PH_BEGIN
      phase_resid(p, (const bf16_t*)(p.ws + (layer ? OFF_OB : OFF_CAT)), 1024, (const bf16_t*)(p.ws + (layer ? OFF_WT_OUTO : OFF_WT_OUTE)), layer ? p.out : p.in[0], SSP(1 + 3 * layer), smem, tid);
    PH_END
    PH_BEGIN phase_ffn_up(p, layer, SSP(1 + 3 * layer), smem, tid); PH_END
#if REP_PHASE == 4
    if (layer == 0) { PH_BEGIN phase_ffn_up(p, layer, SSP(1 + 3 * layer), smem, tid); PH_END }
#endif
    PH_BEGIN phase_resid(p, (const bf16_t*)(p.ws + OFF_ACT), 2816, (const bf16_t*)(p.ws + OFF_WT_DOWN) + (size_t)layer * 1024 * 2816, p.out, SSP(2 + 3 * layer), smem, tid); PH_END
    PH_BEGIN phase_ple_gate(p, layer, SSP(2 + 3 * layer), smem, tid); PH_END
#if REP_PHASE == 6
    if (layer == 0) { PH_BEGIN phase_ple_gate(p, layer, SSP(2 + 3 * layer), smem, tid); PH_END }
#endif
    PH_BEGIN phase_ple_add(p, layer, SSP(3 + 3 * layer), smem, tid); PH_END
  }
#if DUMMY_MODE >= 0
  PH_BEGIN phase_dummy(p, DUMMY_MODE, smem, tid); PH_END
#endif
  PH_BEGIN phase_final(p, tid); }
}

extern "C" void kernel_launch(void* const* d_in, const int* in_sizes, int n_in, void* d_out, int out_size, void* d_ws, size_t ws_size, hipStream_t stream) {
  static int grid_blocks = 0;
  if (!grid_blocks) {
    int dev = 0, cus = 0, per_cu = 0;
    hipGetDevice(&dev);
    hipDeviceGetAttribute(&cus, hipDeviceAttributeMultiprocessorCount, dev);
    hipFuncSetAttribute((const void*)mega, hipFuncAttributeMaxDynamicSharedMemorySize, SMEM_BYTES);
    hipOccupancyMaxActiveBlocksPerMultiprocessor(&per_cu, mega, 256, SMEM_BYTES);
    if (per_cu > 2) per_cu = 2;
    if (per_cu < 1) per_cu = 1;
    grid_blocks = cus * per_cu;
  }
  P p{};
  for (int i = 0; i < 22; ++i) p.in[i] = (const float*)d_in[i];
  p.out = (float*)d_out;
  p.ws = (unsigned char*)d_ws;
  hipMemsetAsync(p.ws + OFF_BAR, 0, XCD_BAR_WORDS * 4, stream);
#if MULTI_LAUNCH
  for (int ph = 0; ph < N_PHASES; ++ph) {
    int lo = ph, hi = ph + 1;
    void* args[] = {&p, &lo, &hi};
    hipError_t e = hipLaunchCooperativeKernel((const void*)mega, dim3(grid_blocks), dim3(256), args, SMEM_BYTES, stream);
    if (e != hipSuccess) fprintf(stderr, "launch failed: %s\n", hipGetErrorString(e));
  }
#else
  int lo = 0, hi = N_PHASES;
  void* args[] = {&p, &lo, &hi};
  hipError_t e = hipLaunchCooperativeKernel((const void*)mega, dim3(grid_blocks), dim3(256), args, SMEM_BYTES, stream);
  if (e != hipSuccess) fprintf(stderr, "launch failed: %s (grid %d)\n", hipGetErrorString(e), grid_blocks);
#endif
}
```

```cpp
#include <hip/hip_runtime.h>
#include <hip/hip_cooperative_groups.h>
#include <stdint.h>
#include <cstdio>
namespace cg = cooperative_groups;

#ifndef REP_PHASE
#define REP_PHASE -1
#endif
#ifndef MULTI_LAUNCH
#define MULTI_LAUNCH 0
#endif

#define DI __device__ __forceinline__
typedef unsigned short bf16_t;
typedef short bf16x8 __attribute__((ext_vector_type(8)));
typedef float f32x4 __attribute__((ext_vector_type(4)));
typedef float f32x2 __attribute__((ext_vector_type(2)));
typedef float f32x16 __attribute__((ext_vector_type(16)));
typedef unsigned u32x4 __attribute__((ext_vector_type(4)));
typedef unsigned u32x2 __attribute__((ext_vector_type(2)));
typedef __bf16 hbf2 __attribute__((ext_vector_type(2)));

DI unsigned pk2(float lo, float hi) { f32x2 v = {lo, hi}; hbf2 r = __builtin_convertvector(v, hbf2); return __builtin_bit_cast(unsigned, r); }
DI bf16_t f2bf(float x) { return (bf16_t)(pk2(x, 0.f) & 0xffffu); }
DI float bf2f(bf16_t v) { return __uint_as_float(((unsigned)v) << 16); }
DI float bflo(unsigned u) { return __uint_as_float(u << 16); }
DI float bfhi(unsigned u) { return __uint_as_float(u & 0xffff0000u); }
DI f32x4 mfma16(bf16x8 a, bf16x8 b, f32x4 c) { return __builtin_amdgcn_mfma_f32_16x16x32_bf16(a, b, c, 0, 0, 0); }
DI f32x16 mfma32(bf16x8 a, bf16x8 b, f32x16 c) { return __builtin_amdgcn_mfma_f32_32x32x16_bf16(a, b, c, 0, 0, 0); }
DI int crow(int reg, int hh) { return (reg & 3) + 8 * (reg >> 2) + 4 * hh; }
DI float fexp2(float x) { return __builtin_amdgcn_exp2f(x); }
DI float flog2(float x) { return __builtin_amdgcn_logf(x); }
DI float frcp(float x) { return __builtin_amdgcn_rcpf(x); }
DI float fexp(float x) { return __builtin_amdgcn_exp2f(x * 1.4426950408889634f); }
DI float sigmoidf_(float x) { return frcp(1.f + fexp(-x)); }
DI float siluf_(float x) { return x * frcp(1.f + fexp(-x)); }
DI bf16x8 mk8(u32x2 lo, u32x2 hi) { u32x4 v = {lo.x, lo.y, hi.x, hi.y}; return __builtin_bit_cast(bf16x8, v); }
DI bf16x8 pack_step(const f32x16& x, int s) {
  u32x4 v;
  v.x = pk2(x[8 * s + 0], x[8 * s + 1]); v.y = pk2(x[8 * s + 2], x[8 * s + 3]);
  v.z = pk2(x[8 * s + 4], x[8 * s + 5]); v.w = pk2(x[8 * s + 6], x[8 * s + 7]);
  return __builtin_bit_cast(bf16x8, v);
}

constexpr int SEQ = 4096, DM = 1024, NTOK = 32768;
constexpr int SMEM_BYTES = 73728;
constexpr float EPSF = 1e-6f;

constexpr size_t OFF_WT_INE = 0;
constexpr size_t OFF_WT_OUTE = OFF_WT_INE + 2048ull * 1024 * 2;
constexpr size_t OFF_WT_INO = OFF_WT_OUTE + 1024ull * 1024 * 2;
constexpr size_t OFF_WT_Z = OFF_WT_INO + 3328ull * 1024 * 2;
constexpr size_t OFF_WT_OUTO = OFF_WT_Z + 1024ull * 1024 * 2;
constexpr size_t OFF_WT_UP = OFF_WT_OUTO + 1024ull * 1024 * 2;
constexpr size_t OFF_WT_DOWN = OFF_WT_UP + 2ull * 5632 * 1024 * 2;
constexpr size_t OFF_WT_PLEG = OFF_WT_DOWN + 2ull * 1024 * 2816 * 2;
constexpr size_t OFF_WT_PLE = OFF_WT_PLEG + 2ull * 1024 * 1024 * 2;
constexpr size_t OFF_WT_POOL = OFF_WT_PLE + 2ull * 1024 * 256 * 2;
constexpr size_t OFF_XB = OFF_WT_POOL + 4ull * 128 * 128 * 2;
constexpr size_t OFF_PB = OFF_XB + 32768ull * 1024 * 2;
constexpr size_t OFF_SS = OFF_PB + 2ull * 32768 * 256 * 2;
constexpr size_t OFF_GB = OFF_SS + 7ull * 32768 * 4;
constexpr size_t OFF_GL = OFF_GB + 32768ull * 16 * 4;
constexpr size_t OFF_BAR = OFF_GL + 4096 * 4;
constexpr size_t OFF_R1 = OFF_BAR + 16384;
constexpr size_t OFF_PROJ0 = OFF_R1;
constexpr size_t OFF_VT = OFF_PROJ0 + 32768ull * 1536 * 2;
constexpr size_t OFF_CAT = OFF_VT + 32768ull * 512 * 2;
constexpr size_t OFF_ACT = OFF_R1;
constexpr size_t OFF_UT = OFF_R1;
constexpr size_t OFF_WN = OFF_UT + 67108864ull;
constexpr size_t OFF_QD = OFF_WN + 67108864ull;
constexpr size_t OFF_KD = OFF_QD + 67108864ull;
constexpr size_t OFF_QK = OFF_KD + 67108864ull;
constexpr size_t OFF_QKV = OFF_QK + 33554432ull;
constexpr size_t OFF_GATE = OFF_R1;
constexpr size_t OFF_OB = OFF_WN;

struct P {
  const float* in[22];
  float* out;
  unsigned char* ws;
};

DI void mma_stage(f32x4 (&acc)[4][4], const unsigned char* cA, const unsigned char* cB, int a_rd, int b_rd, int sw0, int sw1) {
#pragma unroll
  for (int ks = 0; ks < 2; ++ks) {
    const int sw = ks ? sw1 : sw0;
    bf16x8 af[4], bfr[4];
#pragma unroll
    for (int m = 0; m < 4; ++m) af[m] = *(const bf16x8*)(cA + a_rd + m * 2048 + sw);
#pragma unroll
    for (int n = 0; n < 4; ++n) bfr[n] = *(const bf16x8*)(cB + b_rd + n * 2048 + sw);
#pragma unroll
    for (int m = 0; m < 4; ++m)
#pragma unroll
      for (int n = 0; n < 4; ++n) acc[m][n] = mfma16(bfr[n], af[m], acc[m][n]);
  }
}
DI void zero_acc(f32x4 (&acc)[4][4]) {
#pragma unroll
  for (int m = 0; m < 4; ++m)
#pragma unroll
    for (int n = 0; n < 4; ++n) acc[m][n] = (f32x4){0.f, 0.f, 0.f, 0.f};
}

constexpr int G_STAGE = 24576, G_AB = 8192;
DI void glds16(const bf16_t* g, unsigned char* l) { __builtin_amdgcn_global_load_lds((const unsigned*)g, (unsigned*)l, 16, 0, 0); }
DI void zero_acc8(f32x4 (&acc)[4][8]) {
#pragma unroll
  for (int m = 0; m < 4; ++m)
#pragma unroll
    for (int n = 0; n < 8; ++n) acc[m][n] = (f32x4){0.f, 0.f, 0.f, 0.f};
}
DI void gemm_core(f32x4 (&acc)[4][8], const bf16_t* pa0, const bf16_t* pa1, const bf16_t* pb0, long ldb64, int nk, unsigned char* smem, int tid) {
  const int lane = tid & 63, wid = tid >> 6, wr = wid >> 1, wc = wid & 1, fr = lane & 15, fq = lane >> 4;
  const int lrow = tid >> 2, lc = tid & 3;
  const int csrc = 8 * (lc ^ ((-(lrow >> 2)) & 3));
  pa0 += csrc; pa1 += csrc; pb0 += csrc;
  unsigned char* dA = smem + tid * 16; unsigned char* dB = smem + G_AB + tid * 16;
  asm volatile("s_waitcnt vmcnt(0)" ::: "memory");
  __builtin_amdgcn_s_barrier();
#define G_ISSUE(KT, ST) do { const int ko_ = (KT) * 32; unsigned char* a_ = dA + (ST) * G_STAGE; unsigned char* b_ = dB + (ST) * G_STAGE; \
    glds16(pa0 + ko_, a_); glds16(pa1 + ko_, a_ + 4096); \
    glds16(pb0 + ko_, b_); glds16(pb0 + ldb64 + ko_, b_ + 4096); glds16(pb0 + 2 * ldb64 + ko_, b_ + 8192); glds16(pb0 + 3 * ldb64 + ko_, b_ + 12288); } while (0)
  G_ISSUE(0, 0);
  G_ISSUE(1, 1);
  const int swz = (fq ^ ((-(fr >> 2)) & 3)) << 4;
  const int a_rd = (64 * wr + fr) * 64 + swz, b_rd = G_AB + (128 * wc + fr) * 64 + swz;
  int st = 0;
#pragma unroll 1
  for (int kt = 0; kt < nk; ++kt) {
    if (kt + 1 < nk) asm volatile("s_waitcnt vmcnt(6)" ::: "memory"); else asm volatile("s_waitcnt vmcnt(0)" ::: "memory");
    __builtin_amdgcn_s_barrier();
    if (kt + 2 < nk) { const int s2 = (st >= 1) ? st - 1 : 2; G_ISSUE(kt + 2, s2); }
    const unsigned char* cs = smem + st * G_STAGE;
    bf16x8 af[4], bfr[8];
#pragma unroll
    for (int m = 0; m < 4; ++m) af[m] = *(const bf16x8*)(cs + a_rd + m * 1024);
#pragma unroll
    for (int n = 0; n < 8; ++n) bfr[n] = *(const bf16x8*)(cs + b_rd + n * 1024);
    __builtin_amdgcn_s_setprio(1);
#pragma unroll
    for (int m = 0; m < 4; ++m)
#pragma unroll
      for (int n = 0; n < 8; ++n) acc[m][n] = mfma16(bfr[n], af[m], acc[m][n]);
    __builtin_amdgcn_s_setprio(0);
    st = (st == 2) ? 0 : st + 1;
  }
  __syncthreads();
}

DI int permrow(int r) { const int s = r & 31; return (r & ~31) | (((s >> 2) & 3) << 3) | ((s >> 4) << 2) | (s & 3); }
DI void tile_decode(int i, int MT, int NT, int& mt, int& nt) {
  const int g = i / (64 * NT); const int il = i - g * 64 * NT; int gm = MT - 64 * g; gm = gm < 64 ? gm : 64;
  nt = il / gm; mt = 64 * g + (il - nt * gm);
}

DI void transpose_convert(const float* __restrict__ W, int ldw, int K, int mode, int coloff, const float* __restrict__ gain,
                          bf16_t* __restrict__ dst, int kt, int ntile, float* tile, int tid) {
  const int n0 = ntile * 64;
  const int tx = tid & 63, ty = tid >> 6;
  const int n = n0 + tx;
  int src; bool valid = true;
  if (mode == 0) { src = coloff + n; }
  else if (mode == 1) { const int j = n >> 8, nl = n & 255, wc = nl >> 7, hp = (nl >> 6) & 1, nt4 = (nl & 63) >> 4, fr = nl & 15; const int ch = 128 * j + 64 * wc + 32 * hp + 16 * (nt4 & 1) + fr; src = (nt4 < 2) ? ch : 2816 + ch; }
  else { if (n < 3072) src = n; else if (n < 3088) src = 4096 + (n - 3072); else { src = 0; valid = false; } }
  __syncthreads();
#pragma unroll
  for (int i = 0; i < 16; ++i) {
    const int kl = ty + 4 * i, k = 64 * kt + kl;
    float v = 0.f;
    if (valid) { v = W[(size_t)k * ldw + src]; if (gain) v *= gain[k]; }
    tile[kl * 65 + tx] = v;
  }
  __syncthreads();
  const int nl = tid >> 2, kc = tid & 3;
#pragma unroll
  for (int cc = 0; cc < 2; ++cc) {
    const int kch = kc * 2 + cc;
    float v[8];
#pragma unroll
    for (int i = 0; i < 8; ++i) v[i] = tile[(8 * kch + i) * 65 + nl];
    u32x4 o = {pk2(v[0], v[1]), pk2(v[2], v[3]), pk2(v[4], v[5]), pk2(v[6], v[7])};
    *(u32x4*)(dst + (size_t)(n0 + nl) * K + 64 * kt + 8 * kch) = o;
  }
}

DI void phase_prologue(const P& p, unsigned char* smem, int tid) {
  float* tile = (float*)smem;
  bf16_t* wsb = (bf16_t*)p.ws;
  for (int g = blockIdx.x; g < 6992; g += gridDim.x) {
    int task, base;
    if (g < 512) { task = 0; base = 0; } else if (g < 768) { task = 1; base = 512; } else if (g < 1600) { task = 2; base = 768; }
    else if (g < 1856) { task = 3; base = 1600; } else if (g < 2112) { task = 4; base = 1856; } else if (g < 3520) { task = 5; base = 2112; }
    else if (g < 4928) { task = 6; base = 3520; } else if (g < 5632) { task = 7; base = 4928; } else if (g < 6336) { task = 8; base = 5632; }
    else if (g < 6592) { task = 9; base = 6336; } else if (g < 6848) { task = 10; base = 6592; } else if (g < 6912) { task = 11; base = 6848; }
    else if (g < 6976) { task = 12; base = 6912; } else { task = 13 + ((g - 6976) >> 2); base = 6976 + 4 * (task - 13); }
    const float* W; int ldw, K, mode = 0, coloff = 0; const float* gain = nullptr; size_t doff;
    switch (task) {
      case 0: W = p.in[3]; ldw = 2048; K = 1024; gain = p.in[2]; doff = OFF_WT_INE; break;
      case 1: W = p.in[6]; ldw = 1024; K = 1024; doff = OFF_WT_OUTE; break;
      case 2: W = p.in[8]; ldw = 4112; K = 1024; mode = 2; gain = p.in[7]; doff = OFF_WT_INO; break;
      case 3: W = p.in[8]; ldw = 4112; K = 1024; coloff = 3072; gain = p.in[7]; doff = OFF_WT_Z; break;
      case 4: W = p.in[13]; ldw = 1024; K = 1024; doff = OFF_WT_OUTO; break;
      case 5: W = p.in[15]; ldw = 5632; K = 1024; mode = 1; gain = p.in[14]; doff = OFF_WT_UP; break;
      case 6: W = p.in[15] + 1024ull * 5632; ldw = 5632; K = 1024; mode = 1; gain = p.in[14] + 1024; doff = OFF_WT_UP + 5632ull * 1024 * 2; break;
      case 7: W = p.in[17]; ldw = 1024; K = 2816; doff = OFF_WT_DOWN; break;
      case 8: W = p.in[17] + 2816ull * 1024; ldw = 1024; K = 2816; doff = OFF_WT_DOWN + 1024ull * 2816 * 2; break;
      case 9: W = p.in[19]; ldw = 1024; K = 1024; gain = p.in[18]; doff = OFF_WT_PLEG; break;
      case 10: W = p.in[19] + 1024ull * 1024; ldw = 1024; K = 1024; gain = p.in[18] + 1024; doff = OFF_WT_PLEG + 1024ull * 1024 * 2; break;
      case 11: W = p.in[20]; ldw = 1024; K = 256; doff = OFF_WT_PLE; break;
      case 12: W = p.in[20] + 256ull * 1024; ldw = 1024; K = 256; doff = OFF_WT_PLE + 1024ull * 256 * 2; break;
      default: W = p.in[4] + (size_t)(task - 13) * 128 * 128; ldw = 128; K = 128; doff = OFF_WT_POOL + (size_t)(task - 13) * 128 * 128 * 2; break;
    }
    const int nkt = K / 64; const int t = g - base;
    transpose_convert(W, ldw, K, mode, coloff, gain, (bf16_t*)(p.ws + doff), t % nkt, t / nkt, tile, tid);
  }
  {
    const float* x = p.in[0]; bf16_t* xb = (bf16_t*)(p.ws + OFF_XB); float* ss = (float*)(p.ws + OFF_SS);
    const int lane = tid & 63, wid = tid >> 6;
    for (int row = blockIdx.x * 4 + wid; row < NTOK; row += gridDim.x * 4) {
      float s = 0.f;
#pragma unroll
      for (int i = 0; i < 4; ++i) {
        const f32x4 v = *(const f32x4*)(x + (size_t)row * 1024 + 256 * i + 4 * lane);
        s += v.x * v.x + v.y * v.y + v.z * v.z + v.w * v.w;
        u32x2 o = {pk2(v.x, v.y), pk2(v.z, v.w)};
        *(u32x2*)(xb + (size_t)row * 1024 + 256 * i + 4 * lane) = o;
      }
#pragma unroll
      for (int off = 32; off > 0; off >>= 1) s += __shfl_xor(s, off);
      if (lane == 0) ss[row] = s;
    }
    for (int i = blockIdx.x * 256 + tid; i < 6 * NTOK; i += gridDim.x * 256) ss[NTOK + i] = 0.f;
    const float* pp = p.in[1]; bf16_t* pb = (bf16_t*)(p.ws + OFF_PB);
    const size_t n4 = 2ull * 32768 * 256 / 4;
    for (size_t i = (size_t)blockIdx.x * 256 + tid; i < n4; i += (size_t)gridDim.x * 256) {
      const f32x4 v = *(const f32x4*)(pp + 4 * i);
      u32x2 o = {pk2(v.x, v.y), pk2(v.z, v.w)};
      *(u32x2*)(pb + 4 * i) = o;
    }
  }
}

#define GEMM_IDS const int lrow = tid >> 2;
#define EPI_IDS int tid_e = tid; asm volatile("" : "+v"(tid_e)); const int lane = tid_e & 63, wid = tid_e >> 6, wr = wid >> 1, wc = wid & 1, fr = lane & 15, fq = lane >> 4; (void)lane; (void)wr; (void)wc; (void)fr; (void)fq;

DI void phase_in_e(const P& p, unsigned char* smem, int tid) {
  GEMM_IDS
  const bf16_t* xb = (const bf16_t*)(p.ws + OFF_XB); const bf16_t* wt = (const bf16_t*)(p.ws + OFF_WT_INE);
  const float* ss = (const float*)(p.ws + OFF_SS);
  bf16_t* proj = (bf16_t*)(p.ws + OFF_PROJ0); bf16_t* vT = (bf16_t*)(p.ws + OFF_VT);
  for (int i = blockIdx.x; i < 256 * 8; i += gridDim.x) {
    int mt, nt; tile_decode(i, 256, 8, mt, nt);
    const int m0 = mt * 128, n0 = nt * 256;
    const bf16_t* pa = xb + (size_t)(m0 + lrow) * 1024;
    f32x4 acc[4][8]; zero_acc8(acc);
    gemm_core(acc, pa, pa + 64 * 1024, wt + (size_t)(n0 + permrow(lrow)) * 1024, 64 * 1024, 32, smem, tid);
    EPI_IDS
    const float qs = (n0 >= 512 && n0 < 1024) ? 0.18033688011112042f : 1.f;
#pragma unroll
    for (int m = 0; m < 4; ++m) {
      const int row = m0 + 64 * wr + 16 * m + fr;
      const float rs = rsqrtf(ss[row] * (1.f / 1024.f) + EPSF) * qs;
#pragma unroll
      for (int q = 0; q < 4; ++q) {
        const int col = n0 + 128 * wc + 32 * q + 8 * fq;
        const f32x4 v0 = acc[m][2 * q] * rs, v1 = acc[m][2 * q + 1] * rs;
        if (n0 < 1536) {
          u32x4 o = {pk2(v0.x, v0.y), pk2(v0.z, v0.w), pk2(v1.x, v1.y), pk2(v1.z, v1.w)};
          *(u32x4*)(proj + (size_t)row * 1536 + col) = o;
        } else {
          const int cc = col - 1536; const int bh = (row >> 12) * 8 + (cc >> 6), d = cc & 63, t = row & 4095;
          bf16_t* vp = vT + ((size_t)bh * 64 + d) * 4096 + t;
          vp[0] = f2bf(v0.x); vp[4096] = f2bf(v0.y); vp[8192] = f2bf(v0.z); vp[12288] = f2bf(v0.w);
          vp[16384] = f2bf(v1.x); vp[20480] = f2bf(v1.y); vp[24576] = f2bf(v1.z); vp[28672] = f2bf(v1.w);
        }
      }
    }
  }
}

DI void phase_resid(const P& p, const bf16_t* A, int K, const bf16_t* wt, const float* xold, float* ssn, unsigned char* smem, int tid) {
  GEMM_IDS
  bf16_t* xb = (bf16_t*)(p.ws + OFF_XB); float* xnew = p.out;
  for (int i = blockIdx.x; i < 256 * 4; i += gridDim.x) {
    int mt, nt; tile_decode(i, 256, 4, mt, nt);
    const int m0 = mt * 128, n0 = nt * 256;
    const bf16_t* pa = A + (size_t)(m0 + lrow) * K;
    f32x4 acc[4][8]; zero_acc8(acc);
    gemm_core(acc, pa, pa + 64 * (size_t)K, wt + (size_t)(n0 + permrow(lrow)) * K, 64 * (long)K, K / 32, smem, tid);
    EPI_IDS
#pragma unroll
    for (int m = 0; m < 4; ++m) {
      const int row = m0 + 64 * wr + 16 * m + fr;
      float s = 0.f;
#pragma unroll
      for (int q = 0; q < 4; ++q) {
        const int col = n0 + 128 * wc + 32 * q + 8 * fq;
        const f32x4 v0 = *(const f32x4*)(xold + (size_t)row * 1024 + col) + acc[m][2 * q];
        const f32x4 v1 = *(const f32x4*)(xold + (size_t)row * 1024 + col + 4) + acc[m][2 * q + 1];
        *(f32x4*)(xnew + (size_t)row * 1024 + col) = v0;
        *(f32x4*)(xnew + (size_t)row * 1024 + col + 4) = v1;
        u32x4 o = {pk2(v0.x, v0.y), pk2(v0.z, v0.w), pk2(v1.x, v1.y), pk2(v1.z, v1.w)};
        *(u32x4*)(xb + (size_t)row * 1024 + col) = o;
        s += v0.x * v0.x + v0.y * v0.y + v0.z * v0.z + v0.w * v0.w + v1.x * v1.x + v1.y * v1.y + v1.z * v1.z + v1.w * v1.w;
      }
      s += __shfl_xor(s, 16); s += __shfl_xor(s, 32);
      if (fq == 0) atomicAdd(ssn + row, s);
      __builtin_amdgcn_sched_barrier(0);
    }
  }
}

DI void phase_ffn_up(const P& p, int layer, const float* ssc, unsigned char* smem, int tid) {
  GEMM_IDS
  const bf16_t* xb = (const bf16_t*)(p.ws + OFF_XB); const bf16_t* wt = (const bf16_t*)(p.ws + OFF_WT_UP) + (size_t)layer * 5632 * 1024;
  bf16_t* act = (bf16_t*)(p.ws + OFF_ACT);
  const float* cw = p.in[16] + (size_t)layer * 3 * 5632;
  float* Cs = (float*)smem;
  for (int i = blockIdx.x; i < 264 * 22; i += gridDim.x) {
    int mt, nt; tile_decode(i, 264, 22, mt, nt);
    const int b = mt / 33, mi = mt - b * 33;
    const int t0 = 126 * mi - 2;
    const bf16_t* pa[2];
#pragma unroll
    for (int j = 0; j < 2; ++j) { int t = t0 + lrow + 64 * j; t = t < 0 ? 0 : (t > 4095 ? 4095 : t); pa[j] = xb + (size_t)(b * 4096 + t) * 1024; }
    f32x4 acc[4][8]; zero_acc8(acc);
    gemm_core(acc, pa[0], pa[1], wt + (size_t)(nt * 256 + lrow) * 1024, 64 * 1024, 32, smem, tid);
    EPI_IDS
    float rsv[4];
#pragma unroll
    for (int m = 0; m < 4; ++m) {
      int t = t0 + 64 * wr + 16 * m + fr; const bool neg = t < 0; t = t < 0 ? 0 : (t > 4095 ? 4095 : t);
      rsv[m] = neg ? 0.f : rsqrtf(ssc[b * 4096 + t] * (1.f / 1024.f) + EPSF);
    }
#pragma unroll
    for (int hp = 0; hp < 2; ++hp) {
      if (hp) __syncthreads();
#pragma unroll
      for (int m = 0; m < 4; ++m) {
        const int lr = 64 * wr + 16 * m + fr;
#pragma unroll
        for (int n = 0; n < 4; ++n) *(f32x4*)(Cs + lr * 132 + 64 * wc + 16 * n + 4 * fq) = acc[m][4 * hp + n] * rsv[m];
      }
      __syncthreads();
      const int cl = tid & 63, rg = tid >> 6;
      const int gcol = 64 * (cl >> 5) + 16 * ((cl & 31) >> 4) + (cl & 15), vcol = gcol + 32;
      const int ch = nt * 128 + 64 * (cl >> 5) + 32 * hp + (cl & 31);
      const float wg0 = cw[ch], wg1 = cw[5632 + ch], wg2 = cw[2 * 5632 + ch];
      const float wv0 = cw[2816 + ch], wv1 = cw[5632 + 2816 + ch], wv2 = cw[2 * 5632 + 2816 + ch];
      const int lr0 = 2 + 32 * rg;
      float g2 = Cs[(lr0 - 2) * 132 + gcol], g1 = Cs[(lr0 - 1) * 132 + gcol];
      float v2 = Cs[(lr0 - 2) * 132 + vcol], v1 = Cs[(lr0 - 1) * 132 + vcol];
      for (int r = 0; r < 32; ++r) {
        const int lr = lr0 + r; const int t = t0 + lr;
        if (lr >= 128 || t > 4095) break;
        const float g0 = Cs[lr * 132 + gcol], v0 = Cs[lr * 132 + vcol];
        const float yg = wg0 * g2 + wg1 * g1 + wg2 * g0;
        const float yv = wv0 * v2 + wv1 * v1 + wv2 * v0;
        act[(size_t)(b * 4096 + t) * 2816 + ch] = f2bf(siluf_(yg) * yv);
        g2 = g1; g1 = g0; v2 = v1; v1 = v0;
      }
    }
  }
}

DI void phase_ple_gate(const P& p, int layer, const float* ssc, unsigned char* smem, int tid) {
  GEMM_IDS
  const bf16_t* xb = (const bf16_t*)(p.ws + OFF_XB);
  const bf16_t* wg = (const bf16_t*)(p.ws + OFF_WT_PLEG) + (size_t)layer * 1024 * 1024;
  bf16_t* gate = (bf16_t*)(p.ws + OFF_GATE);
  for (int i = blockIdx.x; i < 256 * 4; i += gridDim.x) {
    int mt, nt; tile_decode(i, 256, 4, mt, nt);
    const int m0 = mt * 128, n0 = nt * 256;
    const bf16_t* pa = xb + (size_t)(m0 + lrow) * 1024;
    f32x4 acc[4][8]; zero_acc8(acc);
    gemm_core(acc, pa, pa + 64 * 1024, wg + (size_t)(n0 + permrow(lrow)) * 1024, 64 * 1024, 32, smem, tid);
    EPI_IDS
#pragma unroll
    for (int m = 0; m < 4; ++m) {
      const int row = m0 + 64 * wr + 16 * m + fr;
      const float rs = rsqrtf(ssc[row] * (1.f / 1024.f) + EPSF);
#pragma unroll
      for (int q = 0; q < 4; ++q) {
        const int col = n0 + 128 * wc + 32 * q + 8 * fq;
        const f32x4 v0 = acc[m][2 * q] * rs, v1 = acc[m][2 * q + 1] * rs;
        u32x4 o = {pk2(sigmoidf_(v0.x), sigmoidf_(v0.y)), pk2(sigmoidf_(v0.z), sigmoidf_(v0.w)), pk2(sigmoidf_(v1.x), sigmoidf_(v1.y)), pk2(sigmoidf_(v1.z), sigmoidf_(v1.w))};
        *(u32x4*)(gate + (size_t)row * 1024 + col) = o;
      }
    }
  }
}

DI void phase_ple_add(const P& p, int layer, float* ssn, unsigned char* smem, int tid) {
  GEMM_IDS
  bf16_t* xb = (bf16_t*)(p.ws + OFF_XB);
  const bf16_t* wp = (const bf16_t*)(p.ws + OFF_WT_PLE) + (size_t)layer * 1024 * 256;
  const bf16_t* pb = (const bf16_t*)(p.ws + OFF_PB) + (size_t)layer * 32768 * 256;
  const bf16_t* gate = (const bf16_t*)(p.ws + OFF_GATE);
  float* x = p.out;
  for (int i = blockIdx.x; i < 256 * 4; i += gridDim.x) {
    int mt, nt; tile_decode(i, 256, 4, mt, nt);
    const int m0 = mt * 128, n0 = nt * 256;
    const bf16_t* pa = pb + (size_t)(m0 + lrow) * 256;
    f32x4 acc[4][8]; zero_acc8(acc);
    gemm_core(acc, pa, pa + 64 * 256, wp + (size_t)(n0 + permrow(lrow)) * 256, 64 * 256, 8, smem, tid);
    EPI_IDS
#pragma unroll
    for (int m = 0; m < 4; ++m) {
      const int row = m0 + 64 * wr + 16 * m + fr;
      float s = 0.f;
#pragma unroll
      for (int q = 0; q < 4; ++q) {
        const int col = n0 + 128 * wc + 32 * q + 8 * fq;
        const u32x4 gp = *(const u32x4*)(gate + (size_t)row * 1024 + col);
        const f32x4 g0 = {bflo(gp.x), bfhi(gp.x), bflo(gp.y), bfhi(gp.y)}, g1 = {bflo(gp.z), bfhi(gp.z), bflo(gp.w), bfhi(gp.w)};
        const f32x4 v0 = *(const f32x4*)(x + (size_t)row * 1024 + col) + acc[m][2 * q] * g0;
        const f32x4 v1 = *(const f32x4*)(x + (size_t)row * 1024 + col + 4) + acc[m][2 * q + 1] * g1;
        *(f32x4*)(x + (size_t)row * 1024 + col) = v0;
        *(f32x4*)(x + (size_t)row * 1024 + col + 4) = v1;
        u32x4 o = {pk2(v0.x, v0.y), pk2(v0.z, v0.w), pk2(v1.x, v1.y), pk2(v1.z, v1.w)};
        *(u32x4*)(xb + (size_t)row * 1024 + col) = o;
        s += v0.x * v0.x + v0.y * v0.y + v0.z * v0.z + v0.w * v0.w + v1.x * v1.x + v1.y * v1.y + v1.z * v1.z + v1.w * v1.w;
      }
      s += __shfl_xor(s, 16); s += __shfl_xor(s, 32);
      if (fq == 0) atomicAdd(ssn + row, s);
      __builtin_amdgcn_sched_barrier(0);
    }
  }
}

DI void phase_in_o(const P& p, int qi, unsigned char* smem, int tid) {
  GEMM_IDS
  const bf16_t* xb = (const bf16_t*)(p.ws + OFF_XB); const bf16_t* wt = (const bf16_t*)(p.ws + OFF_WT_INO);
  const float* ssc = (const float*)(p.ws + OFF_SS) + 3 * NTOK;
  bf16_t* qkv = (bf16_t*)(p.ws + OFF_QKV); float* gb = (float*)(p.ws + OFF_GB);
  const float* a_log = p.in[10]; const float* dt_bias = p.in[11];
  for (int i = blockIdx.x; i < 64 * 13; i += gridDim.x) {
    int mt, nt; tile_decode(i, 64, 13, mt, nt);
    const int mq0 = mt * 128, m0 = qi * 8192 + mq0, n0 = nt * 256;
    const bf16_t* pa = xb + (size_t)(m0 + lrow) * 1024;
    f32x4 acc[4][8]; zero_acc8(acc);
    gemm_core(acc, pa, pa + 64 * 1024, wt + (size_t)(n0 + permrow(lrow)) * 1024, 64 * 1024, 32, smem, tid);
    EPI_IDS
#pragma unroll
    for (int m = 0; m < 4; ++m) {
      const int rl = 64 * wr + 16 * m + fr;
      const float rs = rsqrtf(ssc[m0 + rl] * (1.f / 1024.f) + EPSF);
      if (nt < 12) {
#pragma unroll
        for (int q = 0; q < 4; ++q) {
          const int col = n0 + 128 * wc + 32 * q + 8 * fq;
          const f32x4 v0 = acc[m][2 * q] * rs, v1 = acc[m][2 * q + 1] * rs;
          u32x4 o = {pk2(v0.x, v0.y), pk2(v0.z, v0.w), pk2(v1.x, v1.y), pk2(v1.z, v1.w)};
          *(u32x4*)(qkv + (size_t)(mq0 + rl) * 3072 + col) = o;
        }
      } else if (wc == 0 && fq < 2) {
        const f32x4 v0 = acc[m][0] * rs, v1 = acc[m][1] * rs;
        float o[8];
#pragma unroll
        for (int j = 0; j < 8; ++j) {
          const float vv = j < 4 ? v0[j] : v1[j - 4];
          if (fq == 0) o[j] = sigmoidf_(vv);
          else {
            const float xx = vv + dt_bias[j];
            const float sp = fmaxf(xx, 0.f) + log1pf(__expf(-fabsf(xx)));
            o[j] = -__expf(a_log[j]) * sp;
          }
        }
        float* gp = gb + (size_t)(m0 + rl) * 16 + 8 * fq;
        *(f32x4*)gp = (f32x4){o[0], o[1], o[2], o[3]}; *(f32x4*)(gp + 4) = (f32x4){o[4], o[5], o[6], o[7]};
      }
    }
  }
}

DI void phase_z_gate(const P& p, unsigned char* smem, int tid) {
  GEMM_IDS
  const bf16_t* xb = (const bf16_t*)(p.ws + OFF_XB); const bf16_t* wt = (const bf16_t*)(p.ws + OFF_WT_Z);
  const float* ssc = (const float*)(p.ws + OFF_SS) + 3 * NTOK;
  const bf16_t* ob_in = (const bf16_t*)(p.ws + OFF_UT);
  bf16_t* ob = (bf16_t*)(p.ws + OFF_OB);
  const float* nw = p.in[12];
  for (int i = blockIdx.x; i < 256 * 4; i += gridDim.x) {
    int mt, nt; tile_decode(i, 256, 4, mt, nt);
    const int m0 = mt * 128, n0 = nt * 256;
    const bf16_t* pa = xb + (size_t)(m0 + lrow) * 1024;
    f32x4 acc[4][8]; zero_acc8(acc);
    gemm_core(acc, pa, pa + 64 * 1024, wt + (size_t)(n0 + permrow(lrow)) * 1024, 64 * 1024, 32, smem, tid);
    EPI_IDS
    const int hd = 2 * nt + wc;
#pragma unroll
    for (int m = 0; m < 4; ++m) {
      const int row = m0 + 64 * wr + 16 * m + fr;
      const int chunk = ((row >> 12) * 8 + hd) * 64 + ((row & 4095) >> 6);
      const bf16_t* op = ob_in + (size_t)chunk * 8192 + (row & 63) * 64 + 8 * fq;
      u32x4 ov[4];
      float s = 0.f;
#pragma unroll
      for (int q = 0; q < 4; ++q) {
        ov[q] = *(const u32x4*)(op + (q >> 1) * 4096 + 32 * (q & 1));
        const float a0 = bflo(ov[q].x), a1 = bfhi(ov[q].x), a2 = bflo(ov[q].y), a3 = bfhi(ov[q].y), a4 = bflo(ov[q].z), a5 = bfhi(ov[q].z), a6 = bflo(ov[q].w), a7 = bfhi(ov[q].w);
        s += a0 * a0 + a1 * a1 + a2 * a2 + a3 * a3 + a4 * a4 + a5 * a5 + a6 * a6 + a7 * a7;
      }
      s += __shfl_xor(s, 16); s += __shfl_xor(s, 32);
      const float on = rsqrtf(s * (1.f / 128.f) + EPSF);
      const float rs = rsqrtf(ssc[row] * (1.f / 1024.f) + EPSF);
#pragma unroll
      for (int q = 0; q < 4; ++q) {
        const int cl = 32 * q + 8 * fq;
        const f32x4 z0 = acc[m][2 * q] * rs, z1 = acc[m][2 * q + 1] * rs;
        const f32x4 w0 = *(const f32x4*)(nw + cl), w1 = *(const f32x4*)(nw + cl + 4);
        const f32x4 o0 = {bflo(ov[q].x), bfhi(ov[q].x), bflo(ov[q].y), bfhi(ov[q].y)}, o1 = {bflo(ov[q].z), bfhi(ov[q].z), bflo(ov[q].w), bfhi(ov[q].w)};
        float r[8];
#pragma unroll
        for (int j = 0; j < 4; ++j) { r[j] = o0[j] * on * w0[j] * siluf_(z0[j]); r[4 + j] = o1[j] * on * w1[j] * siluf_(z1[j]); }
        u32x4 o = {pk2(r[0], r[1]), pk2(r[2], r[3]), pk2(r[4], r[5]), pk2(r[6], r[7])};
        *(u32x4*)(ob + (size_t)row * 1024 + n0 + 128 * wc + cl) = o;
      }
      __builtin_amdgcn_sched_barrier(0);
    }
  }
}

#ifndef DUMMY_MODE
#define DUMMY_MODE -1
#endif
DI void phase_dummy(const P& p, int mode, unsigned char* smem, int tid) {
  GEMM_IDS
  const bf16_t* xb = (const bf16_t*)(p.ws + OFF_XB);
  const bf16_t* wg = (const bf16_t*)(p.ws + OFF_WT_PLEG);
  for (int i = blockIdx.x; i < 256 * 4; i += gridDim.x) {
    int mt, nt; tile_decode(i, 256, 4, mt, nt);
    if (mode == 1) { mt = 0; nt = 0; }
    if (mode == 2) { mt = blockIdx.x & 255; nt = 0; }
    const int m0 = mt * 128, n0 = nt * 256;
    const bf16_t* pa = xb + (size_t)(m0 + lrow) * 1024;
    f32x4 acc[4][8]; zero_acc8(acc);
    gemm_core(acc, pa, pa + 64 * 1024, wg + (size_t)(n0 + lrow) * 1024, 64 * 1024, 32, smem, tid);
    EPI_IDS
    float s = 0.f;
#pragma unroll
    for (int m = 0; m < 4; ++m)
#pragma unroll
      for (int n = 0; n < 8; ++n) s += acc[m][n].x + acc[m][n].y + acc[m][n].z + acc[m][n].w;
    if (s == 123456.789f) ((float*)(p.ws + OFF_GL))[0] = s;
  }
}

DI void attn_item(const P& p, int item, unsigned char* smem, int tid) {
  const int lane = tid & 63, w = tid >> 6, r = lane & 31, hh = lane >> 5;
  const int bh = item & 63, jj = item >> 6;
  int qb; { const int a = jj & 7, grp = jj >> 3; qb = grp == 0 ? 31 - a : grp == 1 ? 16 + a : grp == 2 ? 15 - a : a; }
  const int b = bh >> 3, h = bh & 7;
  const int q0 = qb * 128, qw = q0 + 32 * w;
  const bf16_t* proj = (const bf16_t*)(p.ws + OFF_PROJ0);
  const bf16_t* vT = (const bf16_t*)(p.ws + OFF_VT) + (size_t)bh * 64 * 4096;
  bf16x8 qf[4];
  {
    const bf16_t* qp = proj + (size_t)(b * 4096 + qw + r) * 1536 + 512 + h * 64 + 8 * hh;
#pragma unroll
    for (int s = 0; s < 4; ++s) qf[s] = *(const bf16x8*)(qp + 16 * s);
  }
  f32x16 oacc[2];
#pragma unroll
  for (int i = 0; i < 16; ++i) { oacc[0][i] = 0.f; oacc[1][i] = 0.f; }
  float carry = 0.f;
  const int ntile = q0 / 64 + 2;
  const int lrow = tid >> 3, lc = tid & 7;
  const bf16_t* kbase = proj + (size_t)(b * 4096 + lrow) * 1536 + 1024 + h * 64 + 8 * lc;
  const bf16_t* vbase = vT + (size_t)lrow * 4096 + 8 * lc;
  unsigned char* sK = smem;
  unsigned char* sV = smem + 16384;
  const int kst = lrow * 128 + ((lc ^ (lrow & 7)) << 4);
  const int vst = lrow * 136 + lc * 16;
  u32x4 rk[2], rv[2];
  int kt = ntile - 1;
#pragma unroll
  for (int i = 0; i < 2; ++i) { rk[i] = *(const u32x4*)(kbase + (size_t)(kt * 64 + 32 * i) * 1536); rv[i] = *(const u32x4*)(vbase + (size_t)(32 * i) * 4096 + kt * 64); }
  __syncthreads();
#pragma unroll
  for (int i = 0; i < 2; ++i) {
    *(u32x4*)(sK + kst + i * 4096) = rk[i];
    *(u32x2*)(sV + vst + i * 4352) = (u32x2){rv[i].x, rv[i].y}; *(u32x2*)(sV + vst + i * 4352 + 8) = (u32x2){rv[i].z, rv[i].w};
  }
  __syncthreads();
  int cur = 0;
  for (; kt >= 0; --kt) {
    if (kt > 0) {
#pragma unroll
      for (int i = 0; i < 2; ++i) { rk[i] = *(const u32x4*)(kbase + (size_t)((kt - 1) * 64 + 32 * i) * 1536); rv[i] = *(const u32x4*)(vbase + (size_t)(32 * i) * 4096 + (kt - 1) * 64); }
    }
    const unsigned char* cK = sK + cur * 8192; const unsigned char* cV = sV + cur * 8704;
    const int s0 = kt * 64;
#pragma unroll
    for (int sub = 1; sub >= 0; --sub) {
      const int ks = s0 + 32 * sub;
      if (ks <= qw) {
        f32x16 sc;
#pragma unroll
        for (int i = 0; i < 16; ++i) sc[i] = 0.f;
#pragma unroll
        for (int s = 0; s < 4; ++s) {
          const bf16x8 kf = *(const bf16x8*)(cK + (32 * sub + r) * 128 + (((2 * s + hh) ^ (r & 7)) << 4));
          sc = mfma32(kf, qf[s], sc);
        }
        float sp[16], ls[16];
#pragma unroll
        for (int i = 0; i < 16; ++i) {
          const float z = sc[i];
          sp[i] = flog2(1.f + fexp2(z));
          ls[i] = z - sp[i];
        }
        if (ks == qw) {
#pragma unroll
          for (int i = 0; i < 16; ++i) { const bool valid = crow(i, hh) < r; sp[i] = valid ? sp[i] : 0.f; ls[i] = valid ? ls[i] : -1e30f; }
        }
        float G[4], Pp[4], Tt[4];
#pragma unroll
        for (int g = 0; g < 4; ++g) { G[g] = (sp[4 * g] + sp[4 * g + 1]) + (sp[4 * g + 2] + sp[4 * g + 3]); Pp[g] = __shfl_xor(G[g], 32); Tt[g] = G[g] + Pp[g]; }
        float after = carry;
        f32x16 av;
#pragma unroll
        for (int g = 3; g >= 0; --g) {
          float base = after + (hh == 0 ? Pp[g] : 0.f);
          float k3 = base, k2 = k3 + sp[4 * g + 3], k1 = k2 + sp[4 * g + 2], k0 = k1 + sp[4 * g + 1];
          av[4 * g + 3] = fexp2(ls[4 * g + 3] - k3); av[4 * g + 2] = fexp2(ls[4 * g + 2] - k2);
          av[4 * g + 1] = fexp2(ls[4 * g + 1] - k1); av[4 * g + 0] = fexp2(ls[4 * g + 0] - k0);
          after += Tt[g];
        }
        carry = after;
#pragma unroll
        for (int s = 0; s < 2; ++s) {
          const bf16x8 ap = pack_step(av, s);
#pragma unroll
          for (int dt = 0; dt < 2; ++dt) {
            const unsigned char* vp = cV + (32 * dt + r) * 136 + (32 * sub + 16 * s + 4 * hh) * 2;
            const bf16x8 vf = mk8(*(const u32x2*)vp, *(const u32x2*)(vp + 16));
            oacc[dt] = mfma32(vf, ap, oacc[dt]);
          }
        }
      }
    }
    if (kt > 0) {
      unsigned char* nK = sK + (cur ^ 1) * 8192; unsigned char* nV = sV + (cur ^ 1) * 8704;
#pragma unroll
      for (int i = 0; i < 2; ++i) {
        *(u32x4*)(nK + kst + i * 4096) = rk[i];
        *(u32x2*)(nV + vst + i * 4352) = (u32x2){rv[i].x, rv[i].y}; *(u32x2*)(nV + vst + i * 4352 + 8) = (u32x2){rv[i].z, rv[i].w};
      }
    }
    int* flg = (int*)(smem + 34816) + 4 * cur;
    { const bool wdone = (__ballot(carry < 160.f) == 0ull); if (lane == 0) flg[w] = wdone ? 1 : 0; }
    __syncthreads();
    if (flg[0] + flg[1] + flg[2] + flg[3] == 4) break;
    cur ^= 1;
  }
  bf16_t* cat = (bf16_t*)(p.ws + OFF_CAT) + (size_t)(b * 4096 + qw + r) * 1024 + 512 + h * 64;
#pragma unroll
  for (int dt = 0; dt < 2; ++dt)
#pragma unroll
    for (int g = 0; g < 4; ++g) {
      u32x2 o = {pk2(oacc[dt][4 * g], oacc[dt][4 * g + 1]), pk2(oacc[dt][4 * g + 2], oacc[dt][4 * g + 3])};
      *(u32x2*)(cat + 32 * dt + 8 * g + 4 * hh) = o;
    }
}

DI void pool_item(const P& p, int item, unsigned char* smem, int tid) {
  const int lane = tid & 63, wid = tid >> 6, wr = wid >> 1, wc = wid & 1, fr = lane & 15, fq = lane >> 4; const int lrow = tid >> 3, lc = tid & 7; (void)lane;
  const int g = item & 3, mt = item >> 2;
  const int m0 = mt * 128;
  const bf16_t* proj = (const bf16_t*)(p.ws + OFF_PROJ0);
  const bf16_t* wt = (const bf16_t*)(p.ws + OFF_WT_POOL) + (size_t)g * 128 * 128;
  unsigned char* sA = smem; unsigned char* sB = smem + 32768;
  __syncthreads();
  {
    const int st_off = lrow * 128 + ((lc ^ (lrow & 7)) << 4);
#pragma unroll
    for (int kt = 0; kt < 2; ++kt)
#pragma unroll
      for (int i = 0; i < 4; ++i) *(u32x4*)(sB + kt * 16384 + st_off + i * 4096) = *(const u32x4*)(wt + (size_t)(lrow + 32 * i) * 128 + kt * 64 + 8 * lc);
  }
  {
    const int c8 = tid & 15, rg = tid >> 4;
    const int r0 = 8 * rg;
    const int w = 2 << g;
    const int tb = (m0 & 4095) + r0;
    const bf16_t* up = proj + (size_t)(m0 - (m0 & 4095)) * 1536 + g * 128 + 8 * c8;
    u32x4 v[23];
#pragma unroll
    for (int j = 0; j < 23; ++j) {
      const int t = tb - 15 + j;
      v[j] = (u32x4){0u, 0u, 0u, 0u};
      if (t >= 0 && j >= 16 - w) v[j] = *(const u32x4*)(up + (size_t)t * 1536);
    }
    float md[16];
#pragma unroll
    for (int d = 0; d < 16; ++d) md[d] = (d >= 16 - w) ? 1.f : 0.f;
#pragma unroll
    for (int i = 0; i < 8; ++i) {
      float s[8];
#pragma unroll
      for (int e = 0; e < 8; ++e) s[e] = 0.f;
#pragma unroll
      for (int d = 0; d < 16; ++d) {
        const u32x4 x = v[i + d]; const float m = md[d];
        s[0] += m * bflo(x.x); s[1] += m * bfhi(x.x); s[2] += m * bflo(x.y); s[3] += m * bfhi(x.y);
        s[4] += m * bflo(x.z); s[5] += m * bfhi(x.z); s[6] += m * bflo(x.w); s[7] += m * bfhi(x.w);
      }
      const int t = tb + i; const int cnt = (t + 1 < w) ? (t + 1) : w;
      const float inv = 1.f / (float)cnt;
      const u32x4 xc = v[15 + i];
      const float y0 = s[0] * inv - bflo(xc.x), y1 = s[1] * inv - bfhi(xc.x), y2 = s[2] * inv - bflo(xc.y), y3 = s[3] * inv - bfhi(xc.y);
      const float y4 = s[4] * inv - bflo(xc.z), y5 = s[5] * inv - bfhi(xc.z), y6 = s[6] * inv - bflo(xc.w), y7 = s[7] * inv - bfhi(xc.w);
      const int lr = r0 + i;
      u32x4 o = {pk2(y0, y1), pk2(y2, y3), pk2(y4, y5), pk2(y6, y7)};
      *(u32x4*)(sA + (c8 >> 3) * 16384 + lr * 128 + (((c8 & 7) ^ (lr & 7)) << 4)) = o;
    }
  }
  __syncthreads();
  f32x4 acc[4][4]; zero_acc(acc);
  const int a_rd = (64 * wr + fr) * 128, b_rd = (64 * wc + fr) * 128;
  const int sw0 = (fq ^ (fr & 7)) << 4, sw1 = ((4 + fq) ^ (fr & 7)) << 4;
  mma_stage(acc, sA, sB, a_rd, b_rd, sw0, sw1);
  mma_stage(acc, sA + 16384, sB + 16384, a_rd, b_rd, sw0, sw1);
  const float* psc = p.in[5] + g * 128;
  bf16_t* cat = (bf16_t*)(p.ws + OFF_CAT);
#pragma unroll
  for (int m = 0; m < 4; ++m) {
    const int row = m0 + 64 * wr + 16 * m + fr;
#pragma unroll
    for (int n = 0; n < 4; ++n) {
      const int cl = 64 * wc + 16 * n + 4 * fq;
      const f32x4 s4 = *(const f32x4*)(psc + cl);
      const f32x4 v = acc[m][n] * s4;
      u32x2 o = {pk2(v.x, v.y), pk2(v.z, v.w)};
      *(u32x2*)(cat + (size_t)row * 1024 + g * 128 + cl) = o;
    }
  }
}


template <int I> struct SolveRow {
  static DI void run(float (&sol)[64], const float* A_v) {
    float s = sol[I];
#pragma unroll
    for (int g8 = 0; g8 < (I + 31) / 32; ++g8) {
      f32x4 a[8];
#pragma unroll
      for (int q = 0; q < 8; ++q) if (32 * g8 + 4 * q < I) a[q] = *(const f32x4*)(A_v + I * 68 + 32 * g8 + 4 * q);
#pragma unroll
      for (int q = 0; q < 8; ++q) {
        const int j = 32 * g8 + 4 * q;
        if (j + 0 < I) s -= a[q].x * sol[j + 0];
        if (j + 1 < I) s -= a[q].y * sol[j + 1];
        if (j + 2 < I) s -= a[q].z * sol[j + 2];
        if (j + 3 < I) s -= a[q].w * sol[j + 3];
      }
      __builtin_amdgcn_sched_barrier(0);
    }
    sol[I] = s;
    SolveRow<I + 1>::run(sol, A_v);
  }
};
template <> struct SolveRow<64> { static DI void run(float (&)[64], const float*) {} };

constexpr int GD_RAW = 0, GD_Q = 18224, GD_K = GD_Q + 17408, GD_V = GD_K + 17408, GD_GC = GD_V + 17408, GD_BETA = GD_GC + 256, GD_CW = GD_BETA + 256;
DI void gdn_chunk_item(const P& p, int qi, int item, unsigned char* smem, int tid) {
  const int lane = tid & 63, w = tid >> 6, r = lane & 31, hh = lane >> 5;
  const int h = item & 7, n = (item >> 3) & 63, bq = item >> 9;
  const int b = 2 * qi + bq;
  const int chunk = (b * 8 + h) * 64 + n;
  const bf16_t* qkv = (const bf16_t*)(p.ws + OFF_QKV) + (size_t)(bq * 4096) * 3072;
  const float* gb = (const float*)(p.ws + OFF_GB);
  const float* cw = p.in[9];
  float* gc_s = (float*)(smem + GD_GC); float* beta_s = (float*)(smem + GD_BETA);
  __syncthreads();
  u32x4 rawr[5]; float cwr[2];
#define GD_LOADP(PP) do { \
    _Pragma("unroll") for (int i = 0; i < 5; ++i) { const int idx = tid + 256 * i; const int rr_ = idx >> 4, c_ = idx & 15; const int t_ = 64 * n - 3 + rr_; \
      rawr[i] = (u32x4){0u, 0u, 0u, 0u}; if (idx < 1072 && t_ >= 0) rawr[i] = *(const u32x4*)(qkv + (size_t)t_ * 3072 + (PP) * 1024 + h * 128 + 8 * c_); } \
    _Pragma("unroll") for (int i = 0; i < 2; ++i) { const int idx = tid + 256 * i; cwr[i] = cw[(size_t)(idx >> 7) * 3072 + (PP) * 1024 + h * 128 + (idx & 127)]; } \
  } while (0)
  GD_LOADP(0);
  if (w == 0) {
    const int tok = b * 4096 + 64 * n + lane;
    float g = gb[(size_t)tok * 16 + 8 + h]; const float be = gb[(size_t)tok * 16 + h];
#pragma unroll
    for (int off = 1; off < 64; off <<= 1) { const float t = __shfl_up(g, off); if (lane >= off) g += t; }
    gc_s[lane] = g; beta_s[lane] = be;
  }
#pragma unroll 1
  for (int pp = 0; pp < 3; ++pp) {
#pragma unroll
    for (int i = 0; i < 5; ++i) { const int idx = tid + 256 * i; if (idx < 1072) *(u32x4*)(smem + GD_RAW + (idx >> 4) * 272 + 16 * (idx & 15)) = rawr[i]; }
#pragma unroll
    for (int i = 0; i < 2; ++i) ((float*)(smem + GD_CW))[tid + 256 * i] = cwr[i];
    __syncthreads();
    if (pp < 2) GD_LOADP(pp + 1);
    {
      const int row = tid >> 2, qtr = tid & 3; const int ch0 = 32 * qtr;
      float y[32];
#pragma unroll
      for (int sub = 0; sub < 4; ++sub) {
        float a[8];
#pragma unroll
        for (int e = 0; e < 8; ++e) a[e] = 0.f;
#pragma unroll
        for (int tap = 0; tap < 4; ++tap) {
          const u32x4 xv = *(const u32x4*)(smem + GD_RAW + (row + tap) * 272 + (ch0 + 8 * sub) * 2);
          const float* wp = (const float*)(smem + GD_CW) + tap * 128 + ch0 + 8 * sub;
          const f32x4 w0 = *(const f32x4*)wp, w1 = *(const f32x4*)(wp + 4);
          a[0] += w0.x * bflo(xv.x); a[1] += w0.y * bfhi(xv.x); a[2] += w0.z * bflo(xv.y); a[3] += w0.w * bfhi(xv.y);
          a[4] += w1.x * bflo(xv.z); a[5] += w1.y * bfhi(xv.z); a[6] += w1.z * bflo(xv.w); a[7] += w1.w * bfhi(xv.w);
        }
#pragma unroll
        for (int e = 0; e < 8; ++e) y[8 * sub + e] = siluf_(a[e]);
        __builtin_amdgcn_sched_barrier(0);
      }
      if (pp < 2) {
        float s = 0.f;
#pragma unroll
        for (int e = 0; e < 32; ++e) s += y[e] * y[e];
        s += __shfl_xor(s, 1); s += __shfl_xor(s, 2);
        const float inv = rsqrtf(s + EPSF) * (pp == 0 ? 0.08838834764831845f : 1.f);
#pragma unroll
        for (int e = 0; e < 32; ++e) y[e] *= inv;
      }
      unsigned char* dst = smem + (pp == 0 ? GD_Q : pp == 1 ? GD_K : GD_V) + row * 272 + ch0 * 2;
#pragma unroll
      for (int sub = 0; sub < 4; ++sub) {
        u32x4 o = {pk2(y[8 * sub], y[8 * sub + 1]), pk2(y[8 * sub + 2], y[8 * sub + 3]), pk2(y[8 * sub + 4], y[8 * sub + 5]), pk2(y[8 * sub + 6], y[8 * sub + 7])};
        *(u32x4*)(dst + 16 * sub) = o;
      }
    }
    __syncthreads();
  }
  float* A_s = (float*)(smem + GD_RAW);
  bf16_t* qkb = (bf16_t*)(p.ws + OFF_QK) + (size_t)chunk * 4096;
  {
    const int ti = w >> 1, tj = w & 1;
    const int j = 32 * tj + r;
    if (ti == 0 && tj == 1) {
#pragma unroll
      for (int reg = 0; reg < 16; ++reg) qkb[(32 * ti + crow(reg, hh)) * 64 + j] = 0;
    } else {
      f32x16 kk, qk;
#pragma unroll
      for (int i = 0; i < 16; ++i) { kk[i] = 0.f; qk[i] = 0.f; }
#pragma unroll
      for (int s = 0; s < 8; ++s) {
        const bf16x8 bfrag = *(const bf16x8*)(smem + GD_K + (32 * tj + r) * 272 + (16 * s + 8 * hh) * 2);
        const bf16x8 akf = *(const bf16x8*)(smem + GD_K + (32 * ti + r) * 272 + (16 * s + 8 * hh) * 2);
        const bf16x8 aqf = *(const bf16x8*)(smem + GD_Q + (32 * ti + r) * 272 + (16 * s + 8 * hh) * 2);
        kk = mfma32(akf, bfrag, kk); qk = mfma32(aqf, bfrag, qk);
      }
      const float gcj = gc_s[j];
#pragma unroll
      for (int reg = 0; reg < 16; ++reg) {
        const int i = 32 * ti + crow(reg, hh);
        const float dec = (i >= j) ? __expf(gc_s[i] - gcj) : 0.f;
        A_s[i * 68 + j] = (i > j) ? beta_s[i] * kk[reg] * dec : 0.f;
        qkb[i * 64 + j] = f2bf((i >= j) ? qk[reg] * dec : 0.f);
      }
    }
  }
  __syncthreads();
  {
    const int col = tid; const bool isw = col >= 128; const int d = col & 127;
    int vz; asm volatile("v_mov_b32 %0, 0" : "=v"(vz));
    const float* A_v = A_s + vz; const float* gc_v = gc_s + vz; const float* beta_v = beta_s + vz;
    const unsigned char* src = smem + (isw ? GD_K : GD_V) + d * 2;
    float sol[64];
#pragma unroll
    for (int i = 0; i < 64; ++i) {
      float v = bf2f(*(const bf16_t*)(src + i * 272)) * beta_v[i];
      if (isw) v *= __expf(gc_v[i]);
      sol[i] = v;
    }
    SolveRow<1>::run(sol, A_v);
    __syncthreads();
    if (!isw) {
      bf16_t* ut = (bf16_t*)(p.ws + OFF_UT) + (size_t)chunk * 8192 + d * 64;
#pragma unroll
      for (int c8 = 0; c8 < 8; ++c8) {
        u32x4 o = {pk2(sol[8 * c8], sol[8 * c8 + 1]), pk2(sol[8 * c8 + 2], sol[8 * c8 + 3]), pk2(sol[8 * c8 + 4], sol[8 * c8 + 5]), pk2(sol[8 * c8 + 6], sol[8 * c8 + 7])};
        *(u32x4*)(ut + 8 * c8) = o;
      }
      unsigned char* qp = smem + GD_Q + d * 2;
#pragma unroll
      for (int i = 0; i < 64; ++i) { const float v = bf2f(*(const bf16_t*)(qp + i * 272)) * __expf(gc_v[i]); *(bf16_t*)(qp + i * 272) = f2bf(v); }
    } else {
      unsigned char* wp = smem + GD_V + d * 2;
#pragma unroll
      for (int i = 0; i < 64; ++i) *(bf16_t*)(wp + i * 272) = f2bf(-sol[i]);
      bf16_t* kd = (bf16_t*)(p.ws + OFF_KD) + (size_t)chunk * 8192 + d * 64;
      const float gl = gc_v[63];
#pragma unroll
      for (int c8 = 0; c8 < 8; ++c8) {
        float kv[8];
#pragma unroll
        for (int e = 0; e < 8; ++e) kv[e] = bf2f(*(const bf16_t*)(smem + GD_K + (8 * c8 + e) * 272 + d * 2)) * __expf(gl - gc_v[8 * c8 + e]);
        u32x4 o = {pk2(kv[0], kv[1]), pk2(kv[2], kv[3]), pk2(kv[4], kv[5]), pk2(kv[6], kv[7])};
        *(u32x4*)(kd + 8 * c8) = o;
      }
    }
    if (tid == 0) ((float*)(p.ws + OFF_GL))[chunk] = __expf(gc_s[63]);
    __syncthreads();
    {
      bf16_t* wn = (bf16_t*)(p.ws + OFF_WN) + (size_t)chunk * 8192;
      bf16_t* qd = (bf16_t*)(p.ws + OFF_QD) + (size_t)chunk * 8192;
#pragma unroll 1
      for (int i = 0; i < 4; ++i) {
        const int idx = tid + 256 * i; const int lo = (idx >> 4) * 272 + (idx & 15) * 16;
        *(u32x4*)(wn + (size_t)idx * 8) = *(const u32x4*)(smem + GD_V + lo);
        *(u32x4*)(qd + (size_t)idx * 8) = *(const u32x4*)(smem + GD_Q + lo);
      }
    }
  }
}

constexpr int SC_W = 0, SC_QD = 17408, SC_QK = 34816, SC_KD = 34816 + 9216, SC_U = 34816 + 9216 + 18432;
DI bf16x8 pack44(const f32x4& a, const f32x4& b) { u32x4 v = {pk2(a.x, a.y), pk2(a.z, a.w), pk2(b.x, b.y), pk2(b.z, b.w)}; return __builtin_bit_cast(bf16x8, v); }
DI void scan_item(const P& p, int item, unsigned char* smem, int tid) {
  const int lane = tid & 63, w = tid >> 6, fr = lane & 15, fq = lane >> 4;
  const int bh = item >> 1, hf = item & 1;
  const bf16_t* WN = (const bf16_t*)(p.ws + OFF_WN); const bf16_t* QD = (const bf16_t*)(p.ws + OFF_QD);
  const bf16_t* KD = (const bf16_t*)(p.ws + OFF_KD); const bf16_t* QK = (const bf16_t*)(p.ws + OFF_QK);
  bf16_t* UT = (bf16_t*)(p.ws + OFF_UT) + hf * 4096; const float* GL = (const float*)(p.ws + OFF_GL);
  f32x4 S[8];
#pragma unroll
  for (int dt = 0; dt < 8; ++dt) S[dt] = (f32x4){0.f, 0.f, 0.f, 0.f};
  u32x4 st[16];
  const int chunk0 = bh * 64;
#define SC_LOAD(CH) do { \
    const size_t cb = (size_t)(CH) * 8192; \
    _Pragma("unroll") for (int i = 0; i < 4; ++i) { st[i] = *(const u32x4*)(WN + cb + (size_t)(tid + 256 * i) * 8); st[4 + i] = *(const u32x4*)(QD + cb + (size_t)(tid + 256 * i) * 8); st[10 + i] = *(const u32x4*)(KD + cb + (size_t)(tid + 256 * i) * 8); } \
    _Pragma("unroll") for (int i = 0; i < 2; ++i) { st[8 + i] = *(const u32x4*)(QK + (size_t)(CH) * 4096 + (size_t)(tid + 256 * i) * 8); st[14 + i] = *(const u32x4*)(UT + cb + (size_t)(tid + 256 * i) * 8); } \
  } while (0)
#define SC_STORE() do { \
    _Pragma("unroll") for (int i = 0; i < 4; ++i) { const int idx = tid + 256 * i; const int o16 = (idx >> 4) * 272 + (idx & 15) * 16; *(u32x4*)(smem + SC_W + o16) = st[i]; *(u32x4*)(smem + SC_QD + o16) = st[4 + i]; \
      const int o8 = (idx >> 3) * 144 + (idx & 7) * 16; *(u32x4*)(smem + SC_KD + o8) = st[10 + i]; } \
    _Pragma("unroll") for (int i = 0; i < 2; ++i) { const int idx = tid + 256 * i; const int o8 = (idx >> 3) * 144 + (idx & 7) * 16; *(u32x4*)(smem + SC_QK + o8) = st[8 + i]; *(u32x4*)(smem + SC_U + o8) = st[14 + i]; } \
  } while (0)
  SC_LOAD(chunk0);
  __syncthreads();
  for (int n = 0; n < 64; ++n) {
    const int chunk = chunk0 + n;
    SC_STORE();
    __syncthreads();
    if (n + 1 < 64) SC_LOAD(chunk + 1);
    f32x4 vn[4];
#pragma unroll
    for (int ct = 0; ct < 4; ++ct) { const u32x2 u = *(const u32x2*)(smem + SC_U + (16 * w + fr) * 144 + (16 * ct + 4 * fq) * 2); vn[ct] = (f32x4){bflo(u.x), bfhi(u.x), bflo(u.y), bfhi(u.y)}; }
    const float gl = GL[chunk];
    bf16x8 Sp[4];
#pragma unroll
    for (int kk = 0; kk < 4; ++kk) Sp[kk] = pack44(S[2 * kk], S[2 * kk + 1]);
#pragma unroll
    for (int ct = 0; ct < 4; ++ct)
#pragma unroll
      for (int kk = 0; kk < 4; ++kk) {
        const unsigned char* ap = smem + SC_W + (16 * ct + fr) * 272 + (32 * kk + 4 * fq) * 2;
        vn[ct] = mfma16(mk8(*(const u32x2*)ap, *(const u32x2*)(ap + 32)), Sp[kk], vn[ct]);
      }
    bf16x8 vp[2];
    vp[0] = pack44(vn[0], vn[1]); vp[1] = pack44(vn[2], vn[3]);
#pragma unroll
    for (int ct = 0; ct < 4; ++ct) {
      f32x4 o = {0.f, 0.f, 0.f, 0.f};
#pragma unroll
      for (int kk = 0; kk < 4; ++kk) {
        const unsigned char* ap = smem + SC_QD + (16 * ct + fr) * 272 + (32 * kk + 4 * fq) * 2;
        o = mfma16(mk8(*(const u32x2*)ap, *(const u32x2*)(ap + 32)), Sp[kk], o);
      }
#pragma unroll
      for (int kc = 0; kc < 2; ++kc) {
        const unsigned char* ap = smem + SC_QK + (16 * ct + fr) * 144 + (32 * kc + 4 * fq) * 2;
        o = mfma16(mk8(*(const u32x2*)ap, *(const u32x2*)(ap + 32)), vp[kc], o);
      }
      bf16_t* op = UT + (size_t)chunk * 8192 + (size_t)(16 * ct + 4 * fq) * 64 + 16 * w + fr;
      op[0] = f2bf(o.x); op[64] = f2bf(o.y); op[128] = f2bf(o.z); op[192] = f2bf(o.w);
    }
#pragma unroll
    for (int dt = 0; dt < 8; ++dt) {
      S[dt] = S[dt] * gl;
#pragma unroll
      for (int kc = 0; kc < 2; ++kc) {
        const unsigned char* ap = smem + SC_KD + (16 * dt + fr) * 144 + (32 * kc + 4 * fq) * 2;
        S[dt] = mfma16(mk8(*(const u32x2*)ap, *(const u32x2*)(ap + 32)), vp[kc], S[dt]);
      }
    }
    __syncthreads();
  }
}

DI void phase_final(const P& p, int tid) {
  const int lane = tid & 63, wid = tid >> 6;
  float* x = p.out; const float* g = p.in[21];
  for (int row = blockIdx.x * 4 + wid; row < NTOK; row += gridDim.x * 4) {
    f32x4 v[4]; float s = 0.f;
#pragma unroll
    for (int i = 0; i < 4; ++i) { v[i] = *(const f32x4*)(x + (size_t)row * 1024 + 256 * i + 4 * lane); s += v[i].x * v[i].x + v[i].y * v[i].y + v[i].z * v[i].z + v[i].w * v[i].w; }
#pragma unroll
    for (int off = 32; off > 0; off >>= 1) s += __shfl_xor(s, off);
    const float rs = rsqrtf(s * (1.f / 1024.f) + EPSF);
#pragma unroll
    for (int i = 0; i < 4; ++i) { const f32x4 gg = *(const f32x4*)(g + 256 * i + 4 * lane); *(f32x4*)(x + (size_t)row * 1024 + 256 * i + 4 * lane) = v[i] * rs * gg; }
  }
}


#define XB_TMO      128
#define XB_XCNT(j)  (256  + 64 * (j))
#define XB_XSUB(j)  (1280 + 64 * (j))
#define XB_XGEN(j)  (2304 + 64 * (j))
#define XB_TOP      3328
#define XB_TOPGEN   3392
#define XCD_BAR_WORDS 3456
#define XB_SPIN_CAP (1u << 18)
#define LAS __attribute__((address_space(3)))
DI unsigned xb_ld(unsigned* p)              { return __hip_atomic_load(p, __ATOMIC_RELAXED, __HIP_MEMORY_SCOPE_AGENT); }
DI unsigned xb_add(unsigned* p, unsigned v) { return __hip_atomic_fetch_add(p, v, __ATOMIC_RELAXED, __HIP_MEMORY_SCOPE_AGENT); }
DI unsigned xb_xcc_id() { return (unsigned)__builtin_amdgcn_s_getreg((3 << 11) | 20) & 0xFu; }
#define XB_SPIN(cond, bar) do { unsigned _sp = 0; while (cond) { __builtin_amdgcn_s_sleep(1); \
    if ((++_sp & 255u) == 0u) { if (xb_ld(&(bar)[XB_TMO])) break; if (_sp > XB_SPIN_CAP) { atomicAdd(&(bar)[XB_TMO], 1u); break; } } } } while (0)
struct XcdBarrier { unsigned* bar; unsigned x; volatile LAS unsigned* st; };
DI XcdBarrier xcd_barrier_post(unsigned* bar, volatile LAS unsigned* st) {
  XcdBarrier b; b.bar = bar; b.x = xb_xcc_id(); b.st = st;
  if (threadIdx.x == 0) (void)xb_add(&bar[XB_XCNT(b.x)], 1u);
  return b;
}
DI void xcd_barrier_complete(unsigned* bar, unsigned x, unsigned& nloc, unsigned& nx) {
  const unsigned G = gridDim.x * gridDim.y * gridDim.z;
  unsigned sum, cnt, mine, sp = 0u;
  for (;;) {
    sum = 0u; cnt = 0u; mine = 0u;
#pragma unroll
    for (unsigned j = 0; j < 16; ++j) { const unsigned c = xb_ld(&bar[XB_XCNT(j)]); sum += c; cnt += (c > 0u) ? 1u : 0u; mine = (j == x) ? c : mine; }
    if (sum == G) break;
    __builtin_amdgcn_s_sleep(1);
    if ((++sp & 255u) == 0u) { if (xb_ld(&bar[XB_TMO])) break; if (sp > XB_SPIN_CAP) { atomicAdd(&bar[XB_TMO], 1u); break; } }
  }
  nloc = mine > 0u ? mine : 1u; nx = cnt > 0u ? cnt : 1u;
}
DI void xcd_barrier(const XcdBarrier& b) {
  asm volatile("s_waitcnt vmcnt(0)" ::: "memory");
  __syncthreads();
  if (threadIdx.x == 0) {
    unsigned* bar = b.bar;
    unsigned bx = b.x;
    asm volatile("" : "+s"(bar), "+s"(bx));
    __builtin_amdgcn_s_waitcnt(0);
    unsigned nloc = b.st[0], nx = b.st[1];
    if (nloc == 0u) { xcd_barrier_complete(bar, bx, nloc, nx); b.st[0] = nloc; b.st[1] = nx; }
    const unsigned old = xb_add(&bar[XB_XSUB(bx)], 1u);
    const unsigned gen = old / nloc;
    if (old + 1u == (gen + 1u) * nloc) {
      __builtin_amdgcn_fence(__ATOMIC_RELEASE, "agent");
      asm volatile("s_waitcnt vmcnt(0)" ::: "memory");
      const unsigned og = xb_add(&bar[XB_TOP], 1u);
      const unsigned tg = og / nx;
      if (og + 1u == (tg + 1u) * nx) xb_add(&bar[XB_TOPGEN], 1u);
      else XB_SPIN(xb_ld(&bar[XB_TOPGEN]) == tg, bar);
      __builtin_amdgcn_fence(__ATOMIC_ACQUIRE, "agent");
      xb_add(&bar[XB_XGEN(bx)], 1u);
      asm volatile("s_waitcnt vmcnt(0)" ::: "memory");
    } else {
      XB_SPIN(xb_ld(&bar[XB_XGEN(bx)]) == gen, bar);
      __builtin_amdgcn_fence(__ATOMIC_ACQUIRE, "agent");
      asm volatile("s_waitcnt vmcnt(0)" ::: "memory");
    }
  }
  __syncthreads();
}

constexpr int N_PHASES = 24;
typedef const __attribute__((address_space(4))) P* KP;
DI P loadP(KP kp) {
  P p;
#pragma unroll
  for (int i = 0; i < 22; ++i) p.in[i] = kp->in[i];
  p.out = kp->out; p.ws = kp->ws;
  return p;
}
#define SSP(k) ((float*)(p.ws + OFF_SS) + (k) * NTOK)
#define PH_BEGIN { KP kp = (KP)__builtin_amdgcn_kernarg_segment_ptr(); asm volatile("" : "+s"(kp)); \
    unsigned zz_; asm volatile("v_mov_b32 %0, 0" : "=v"(zz_)); \
    int tid = wbase + (int)__builtin_amdgcn_mbcnt_hi(~0u, __builtin_amdgcn_mbcnt_lo(~0u, zz_)); asm volatile("" : "+v"(tid)); \
    const P p = loadP(kp);
#define PH_END } xcd_barrier(xb);

__global__ void __launch_bounds__(256, 2) mega(P p_arg, int ph_lo, int ph_hi) {
  extern __shared__ __attribute__((aligned(16))) unsigned char smem[];
  __shared__ uint4 xb_words;
  cg::grid_group grid = cg::this_grid();
  if (threadIdx.x == 0) xb_words = make_uint4(0u, 0u, 0u, 0u);
  __syncthreads();
  const int wbase = __builtin_amdgcn_readfirstlane((int)(threadIdx.x & ~63u));
  XcdBarrier xb = xcd_barrier_post((unsigned*)(p_arg.ws + OFF_BAR), (volatile LAS unsigned*)&xb_words);
  if (ph_hi < 0) grid.sync();

  PH_BEGIN phase_prologue(p, smem, tid); PH_END
#if REP_PHASE == 0
  PH_BEGIN phase_prologue(p, smem, tid); PH_END
#endif
#pragma unroll 1
  for (int layer = 0; layer < 2; ++layer) {
    if (layer == 0) {
      PH_BEGIN phase_in_e(p, smem, tid); PH_END
      PH_BEGIN for (int i = blockIdx.x; i < 2048 + 1024; i += gridDim.x) { if (i < 2048) attn_item(p, i, smem, tid); else pool_item(p, i - 2048, smem, tid); } PH_END
#if REP_PHASE == 2
      PH_BEGIN for (int i = blockIdx.x; i < 2048 + 1024; i += gridDim.x) { if (i < 2048) attn_item(p, i, smem, tid); else pool_item(p, i - 2048, smem, tid); } PH_END
#endif
    } else {
#pragma unroll 1
      for (int qi = 0; qi < 4; ++qi) {
        PH_BEGIN phase_in_o(p, qi, smem, tid); PH_END
        PH_BEGIN for (int i = blockIdx.x; i < 1024; i += gridDim.x) gdn_chunk_item(p, qi, i, smem, tid); PH_END
#if REP_PHASE == 9
        if (qi == 0) { PH_BEGIN for (int i = blockIdx.x; i < 1024; i += gridDim.x) gdn_chunk_item(p, qi, i, smem, tid); PH_END }
#endif
      }
      PH_BEGIN for (int i = blockIdx.x; i < 128; i += gridDim.x) scan_item(p, i, smem, tid); PH_END
      PH_BEGIN phase_z_gate(p, smem, tid); PH_END
    }
    PH_BEGIN
      phase_resid(p, (const bf16_t*)(p.ws + (layer ? OFF_OB : OFF_CAT)), 1024, (const bf16_t*)(p.ws + (layer ? OFF_WT_OUTO : OFF_WT_OUTE)), layer ? p.out : p.in[0], SSP(1 + 3 * layer), smem, tid);
    PH_END
    PH_BEGIN phase_ffn_up(p, layer, SSP(1 + 3 * layer), smem, tid); PH_END
#if REP_PHASE == 4
    if (layer == 0) { PH_BEGIN phase_ffn_up(p, layer, SSP(1 + 3 * layer), smem, tid); PH_END }
#endif
    PH_BEGIN phase_resid(p, (const bf16_t*)(p.ws + OFF_ACT), 2816, (const bf16_t*)(p.ws + OFF_WT_DOWN) + (size_t)layer * 1024 * 2816, p.out, SSP(2 + 3 * layer), smem, tid); PH_END
    PH_BEGIN phase_ple_gate(p, layer, SSP(2 + 3 * layer), smem, tid); PH_END
#if REP_PHASE == 6
    if (layer == 0) { PH_BEGIN phase_ple_gate(p, layer, SSP(2 + 3 * layer), smem, tid); PH_END }
#endif
    PH_BEGIN phase_ple_add(p, layer, SSP(3 + 3 * layer), smem, tid); PH_END
  }
#if DUMMY_MODE >= 0
  PH_BEGIN phase_dummy(p, DUMMY_MODE, smem, tid); PH_END
#endif
  PH_BEGIN phase_final(p, tid); }
}

extern "C" void kernel_launch(void* const* d_in, const int* in_sizes, int n_in, void* d_out, int out_size, void* d_ws, size_t ws_size, hipStream_t stream) {
  static int grid_blocks = 0;
  if (!grid_blocks) {
    int dev = 0, cus = 0, per_cu = 0;
    hipGetDevice(&dev);
    hipDeviceGetAttribute(&cus, hipDeviceAttributeMultiprocessorCount, dev);
    hipFuncSetAttribute((const void*)mega, hipFuncAttributeMaxDynamicSharedMemorySize, SMEM_BYTES);
    hipOccupancyMaxActiveBlocksPerMultiprocessor(&per_cu, mega, 256, SMEM_BYTES);
    if (per_cu > 2) per_cu = 2;
    if (per_cu < 1) per_cu = 1;
    grid_blocks = cus * per_cu;
  }
  P p{};
  for (int i = 0; i < 22; ++i) p.in[i] = (const float*)d_in[i];
  p.out = (float*)d_out;
  p.ws = (unsigned char*)d_ws;
  hipMemsetAsync(p.ws + OFF_BAR, 0, XCD_BAR_WORDS * 4, stream);
#if MULTI_LAUNCH
  for (int ph = 0; ph < N_PHASES; ++ph) {
    int lo = ph, hi = ph + 1;
    void* args[] = {&p, &lo, &hi};
    hipError_t e = hipLaunchCooperativeKernel((const void*)mega, dim3(grid_blocks), dim3(256), args, SMEM_BYTES, stream);
    if (e != hipSuccess) fprintf(stderr, "launch failed: %s\n", hipGetErrorString(e));
  }
#else
  int lo = 0, hi = N_PHASES;
  void* args[] = {&p, &lo, &hi};
  hipError_t e = hipLaunchCooperativeKernel((const void*)mega, dim3(grid_blocks), dim3(256), args, SMEM_BYTES, stream);
  if (e != hipSuccess) fprintf(stderr, "launch failed: %s (grid %d)\n", hipGetErrorString(e), grid_blocks);
#endif
}
```

```cpp
#include <hip/hip_runtime.h>
#include <hip/hip_cooperative_groups.h>
#include <stdint.h>
#include <cstdio>
namespace cg = cooperative_groups;

#ifndef REP_PHASE
#define REP_PHASE -1
#endif
#ifndef MULTI_LAUNCH
#define MULTI_LAUNCH 0
#endif

#define DI __device__ __forceinline__
typedef unsigned short bf16_t;
typedef short bf16x8 __attribute__((ext_vector_type(8)));
typedef float f32x4 __attribute__((ext_vector_type(4)));
typedef float f32x2 __attribute__((ext_vector_type(2)));
typedef float f32x16 __attribute__((ext_vector_type(16)));
typedef unsigned u32x4 __attribute__((ext_vector_type(4)));
typedef unsigned u32x2 __attribute__((ext_vector_type(2)));
typedef __bf16 hbf2 __attribute__((ext_vector_type(2)));

DI unsigned pk2(float lo, float hi) { f32x2 v = {lo, hi}; hbf2 r = __builtin_convertvector(v, hbf2); return __builtin_bit_cast(unsigned, r); }
DI bf16_t f2bf(float x) { return (bf16_t)(pk2(x, 0.f) & 0xffffu); }
DI float bf2f(bf16_t v) { return __uint_as_float(((unsigned)v) << 16); }
DI float bflo(unsigned u) { return __uint_as_float(u << 16); }
DI float bfhi(unsigned u) { return __uint_as_float(u & 0xffff0000u); }
DI f32x4 mfma16(bf16x8 a, bf16x8 b, f32x4 c) { return __builtin_amdgcn_mfma_f32_16x16x32_bf16(a, b, c, 0, 0, 0); }
DI f32x16 mfma32(bf16x8 a, bf16x8 b, f32x16 c) { return __builtin_amdgcn_mfma_f32_32x32x16_bf16(a, b, c, 0, 0, 0); }
DI int crow(int reg, int hh) { return (reg & 3) + 8 * (reg >> 2) + 4 * hh; }
DI float fexp2(float x) { return __builtin_amdgcn_exp2f(x); }
DI float flog2(float x) { return __builtin_amdgcn_logf(x); }
DI float frcp(float x) { return __builtin_amdgcn_rcpf(x); }
DI float fexp(float x) { return __builtin_amdgcn_exp2f(x * 1.4426950408889634f); }
DI float sigmoidf_(float x) { return frcp(1.f + fexp(-x)); }
DI float siluf_(float x) { return x * frcp(1.f + fexp(-x)); }
DI bf16x8 mk8(u32x2 lo, u32x2 hi) { u32x4 v = {lo.x, lo.y, hi.x, hi.y}; return __builtin_bit_cast(bf16x8, v); }
DI bf16x8 pack_step(const f32x16& x, int s) {
  u32x4 v;
  v.x = pk2(x[8 * s + 0], x[8 * s + 1]); v.y = pk2(x[8 * s + 2], x[8 * s + 3]);
  v.z = pk2(x[8 * s + 4], x[8 * s + 5]); v.w = pk2(x[8 * s + 6], x[8 * s + 7]);
  return __builtin_bit_cast(bf16x8, v);
}

constexpr int SEQ = 4096, DM = 1024, NTOK = 32768;
constexpr int SMEM_BYTES = 73728;
constexpr float EPSF = 1e-6f;

constexpr size_t OFF_WT_INE = 0;
constexpr size_t OFF_WT_OUTE = OFF_WT_INE + 2048ull * 1024 * 2;
constexpr size_t OFF_WT_INO = OFF_WT_OUTE + 1024ull * 1024 * 2;
constexpr size_t OFF_WT_Z = OFF_WT_INO + 3328ull * 1024 * 2;
constexpr size_t OFF_WT_OUTO = OFF_WT_Z + 1024ull * 1024 * 2;
constexpr size_t OFF_WT_UP = OFF_WT_OUTO + 1024ull * 1024 * 2;
constexpr size_t OFF_WT_DOWN = OFF_WT_UP + 2ull * 5632 * 1024 * 2;
constexpr size_t OFF_WT_PLEG = OFF_WT_DOWN + 2ull * 1024 * 2816 * 2;
constexpr size_t OFF_WT_PLE = OFF_WT_PLEG + 2ull * 1024 * 1024 * 2;
constexpr size_t OFF_WT_POOL = OFF_WT_PLE + 2ull * 1024 * 256 * 2;
constexpr size_t OFF_XB = OFF_WT_POOL + 4ull * 128 * 128 * 2;
constexpr size_t OFF_PB = OFF_XB + 32768ull * 1024 * 2;
constexpr size_t OFF_SS = OFF_PB + 2ull * 32768 * 256 * 2;
constexpr size_t OFF_GB = OFF_SS + 7ull * 32768 * 4;
constexpr size_t OFF_GL = OFF_GB + 32768ull * 16 * 4;
constexpr size_t OFF_BAR = OFF_GL + 4096 * 4;
constexpr size_t OFF_R1 = OFF_BAR + 16384;
constexpr size_t OFF_PROJ0 = OFF_R1;
constexpr size_t OFF_VT = OFF_PROJ0 + 32768ull * 1536 * 2;
constexpr size_t OFF_CAT = OFF_VT + 32768ull * 512 * 2;
constexpr size_t OFF_ACT = OFF_R1;
constexpr size_t OFF_UT = OFF_R1;
constexpr size_t OFF_WN = OFF_UT + 67108864ull;
constexpr size_t OFF_QD = OFF_WN + 67108864ull;
constexpr size_t OFF_KD = OFF_QD + 67108864ull;
constexpr size_t OFF_QK = OFF_KD + 67108864ull;
constexpr size_t OFF_QKV = OFF_QK + 33554432ull;
constexpr size_t OFF_GATE = OFF_R1;
constexpr size_t OFF_OB = OFF_WN;

struct P {
  const float* in[22];
  float* out;
  unsigned char* ws;
};

DI void mma_stage(f32x4 (&acc)[4][4], const unsigned char* cA, const unsigned char* cB, int a_rd, int b_rd, int sw0, int sw1) {
#pragma unroll
  for (int ks = 0; ks < 2; ++ks) {
    const int sw = ks ? sw1 : sw0;
    bf16x8 af[4], bfr[4];
#pragma unroll
    for (int m = 0; m < 4; ++m) af[m] = *(const bf16x8*)(cA + a_rd + m * 2048 + sw);
#pragma unroll
    for (int n = 0; n < 4; ++n) bfr[n] = *(const bf16x8*)(cB + b_rd + n * 2048 + sw);
#pragma unroll
    for (int m = 0; m < 4; ++m)
#pragma unroll
      for (int n = 0; n < 4; ++n) acc[m][n] = mfma16(bfr[n], af[m], acc[m][n]);
  }
}
DI void zero_acc(f32x4 (&acc)[4][4]) {
#pragma unroll
  for (int m = 0; m < 4; ++m)
#pragma unroll
    for (int n = 0; n < 4; ++n) acc[m][n] = (f32x4){0.f, 0.f, 0.f, 0.f};
}

constexpr int G_STAGE = 24576, G_AB = 8192;
DI void glds16(const bf16_t* g, unsigned char* l) { __builtin_amdgcn_global_load_lds((const unsigned*)g, (unsigned*)l, 16, 0, 0); }
DI void zero_acc8(f32x4 (&acc)[4][8]) {
#pragma unroll
  for (int m = 0; m < 4; ++m)
#pragma unroll
    for (int n = 0; n < 8; ++n) acc[m][n] = (f32x4){0.f, 0.f, 0.f, 0.f};
}
DI void gemm_core(f32x4 (&acc)[4][8], const bf16_t* pa0, const bf16_t* pa1, const bf16_t* pb0, long ldb64, int nk, unsigned char* smem, int tid) {
  const int lane = tid & 63, wid = tid >> 6, wr = wid >> 1, wc = wid & 1, fr = lane & 15, fq = lane >> 4;
  const int lrow = tid >> 2, lc = tid & 3;
  const int csrc = 8 * (lc ^ ((-(lrow >> 2)) & 3));
  pa0 += csrc; pa1 += csrc; pb0 += csrc;
  unsigned char* dA = smem + tid * 16; unsigned char* dB = smem + G_AB + tid * 16;
  asm volatile("s_waitcnt vmcnt(0)" ::: "memory");
  __builtin_amdgcn_s_barrier();
#define G_ISSUE(KT, ST) do { const int ko_ = (KT) * 32; unsigned char* a_ = dA + (ST) * G_STAGE; unsigned char* b_ = dB + (ST) * G_STAGE; \
    glds16(pa0 + ko_, a_); glds16(pa1 + ko_, a_ + 4096); \
    glds16(pb0 + ko_, b_); glds16(pb0 + ldb64 + ko_, b_ + 4096); glds16(pb0 + 2 * ldb64 + ko_, b_ + 8192); glds16(pb0 + 3 * ldb64 + ko_, b_ + 12288); } while (0)
  G_ISSUE(0, 0);
  G_ISSUE(1, 1);
  const int swz = (fq ^ ((-(fr >> 2)) & 3)) << 4;
  const int a_rd = (64 * wr + fr) * 64 + swz, b_rd = G_AB + (128 * wc + fr) * 64 + swz;
  int st = 0;
#pragma unroll 1
  for (int kt = 0; kt < nk; ++kt) {
    if (kt + 1 < nk) asm volatile("s_waitcnt vmcnt(6)" ::: "memory"); else asm volatile("s_waitcnt vmcnt(0)" ::: "memory");
    __builtin_amdgcn_s_barrier();
    if (kt + 2 < nk) { const int s2 = (st >= 1) ? st - 1 : 2; G_ISSUE(kt + 2, s2); }
    const unsigned char* cs = smem + st * G_STAGE;
    bf16x8 af[4], bfr[8];
#pragma unroll
    for (int m = 0; m < 4; ++m) af[m] = *(const bf16x8*)(cs + a_rd + m * 1024);
#pragma unroll
    for (int n = 0; n < 8; ++n) bfr[n] = *(const bf16x8*)(cs + b_rd + n * 1024);
    __builtin_amdgcn_s_setprio(1);
#pragma unroll
    for (int m = 0; m < 4; ++m)
#pragma unroll
      for (int n = 0; n < 8; ++n) acc[m][n] = mfma16(bfr[n], af[m], acc[m][n]);
    __builtin_amdgcn_s_setprio(0);
    st = (st == 2) ? 0 : st + 1;
  }
  __syncthreads();
}

DI int permrow(int r) { const int s = r & 31; return (r & ~31) | (((s >> 2) & 3) << 3) | ((s >> 4) << 2) | (s & 3); }
DI void tile_decode(int i, int MT, int NT, int& mt, int& nt) {
  const int g = i / (64 * NT); const int il = i - g * 64 * NT; int gm = MT - 64 * g; gm = gm < 64 ? gm : 64;
  nt = il / gm; mt = 64 * g + (il - nt * gm);
}

DI void transpose_convert(const float* __restrict__ W, int ldw, int K, int mode, int coloff, const float* __restrict__ gain,
                          bf16_t* __restrict__ dst, int kt, int ntile, float* tile, int tid) {
  const int n0 = ntile * 64;
  const int tx = tid & 63, ty = tid >> 6;
  const int n = n0 + tx;
  int src; bool valid = true;
  if (mode == 0) { src = coloff + n; }
  else if (mode == 1) { const int j = n >> 8, nl = n & 255, wc = nl >> 7, hp = (nl >> 6) & 1, nt4 = (nl & 63) >> 4, fr = nl & 15; const int ch = 128 * j + 64 * wc + 32 * hp + 16 * (nt4 & 1) + fr; src = (nt4 < 2) ? ch : 2816 + ch; }
  else { if (n < 3072) src = n; else if (n < 3088) src = 4096 + (n - 3072); else { src = 0; valid = false; } }
  __syncthreads();
#pragma unroll
  for (int i = 0; i < 16; ++i) {
    const int kl = ty + 4 * i, k = 64 * kt + kl;
    float v = 0.f;
    if (valid) { v = W[(size_t)k * ldw + src]; if (gain) v *= gain[k]; }
    tile[kl * 65 + tx] = v;
  }
  __syncthreads();
  const int nl = tid >> 2, kc = tid & 3;
#pragma unroll
  for (int cc = 0; cc < 2; ++cc) {
    const int kch = kc * 2 + cc;
    float v[8];
#pragma unroll
    for (int i = 0; i < 8; ++i) v[i] = tile[(8 * kch + i) * 65 + nl];
    u32x4 o = {pk2(v[0], v[1]), pk2(v[2], v[3]), pk2(v[4], v[5]), pk2(v[6], v[7])};
    *(u32x4*)(dst + (size_t)(n0 + nl) * K + 64 * kt + 8 * kch) = o;
  }
}

DI void phase_prologue(const P& p, unsigned char* smem, int tid) {
  float* tile = (float*)smem;
  bf16_t* wsb = (bf16_t*)p.ws;
  for (int g = blockIdx.x; g < 6992; g += gridDim.x) {
    int task, base;
    if (g < 512) { task = 0; base = 0; } else if (g < 768) { task = 1; base = 512; } else if (g < 1600) { task = 2; base = 768; }
    else if (g < 1856) { task = 3; base = 1600; } else if (g < 2112) { task = 4; base = 1856; } else if (g < 3520) { task = 5; base = 2112; }
    else if (g < 4928) { task = 6; base = 3520; } else if (g < 5632) { task = 7; base = 4928; } else if (g < 6336) { task = 8; base = 5632; }
    else if (g < 6592) { task = 9; base = 6336; } else if (g < 6848) { task = 10; base = 6592; } else if (g < 6912) { task = 11; base = 6848; }
    else if (g < 6976) { task = 12; base = 6912; } else { task = 13 + ((g - 6976) >> 2); base = 6976 + 4 * (task - 13); }
    const float* W; int ldw, K, mode = 0, coloff = 0; const float* gain = nullptr; size_t doff;
    switch (task) {
      case 0: W = p.in[3]; ldw = 2048; K = 1024; gain = p.in[2]; doff = OFF_WT_INE; break;
      case 1: W = p.in[6]; ldw = 1024; K = 1024; doff = OFF_WT_OUTE; break;
      case 2: W = p.in[8]; ldw = 4112; K = 1024; mode = 2; gain = p.in[7]; doff = OFF_WT_INO; break;
      case 3: W = p.in[8]; ldw = 4112; K = 1024; coloff = 3072; gain = p.in[7]; doff = OFF_WT_Z; break;
      case 4: W = p.in[13]; ldw = 1024; K = 1024; doff = OFF_WT_OUTO; break;
      case 5: W = p.in[15]; ldw = 5632; K = 1024; mode = 1; gain = p.in[14]; doff = OFF_WT_UP; break;
      case 6: W = p.in[15] + 1024ull * 5632; ldw = 5632; K = 1024; mode = 1; gain = p.in[14] + 1024; doff = OFF_WT_UP + 5632ull * 1024 * 2; break;
      case 7: W = p.in[17]; ldw = 1024; K = 2816; doff = OFF_WT_DOWN; break;
      case 8: W = p.in[17] + 2816ull * 1024; ldw = 1024; K = 2816; doff = OFF_WT_DOWN + 1024ull * 2816 * 2; break;
      case 9: W = p.in[19]; ldw = 1024; K = 1024; gain = p.in[18]; doff = OFF_WT_PLEG; break;
      case 10: W = p.in[19] + 1024ull * 1024; ldw = 1024; K = 1024; gain = p.in[18] + 1024; doff = OFF_WT_PLEG + 1024ull * 1024 * 2; break;
      case 11: W = p.in[20]; ldw = 1024; K = 256; doff = OFF_WT_PLE; break;
      case 12: W = p.in[20] + 256ull * 1024; ldw = 1024; K = 256; doff = OFF_WT_PLE + 1024ull * 256 * 2; break;
      default: W = p.in[4] + (size_t)(task - 13) * 128 * 128; ldw = 128; K = 128; doff = OFF_WT_POOL + (size_t)(task - 13) * 128 * 128 * 2; break;
    }
    const int nkt = K / 64; const int t = g - base;
    transpose_convert(W, ldw, K, mode, coloff, gain, (bf16_t*)(p.ws + doff), t % nkt, t / nkt, tile, tid);
  }
  {
    const float* x = p.in[0]; bf16_t* xb = (bf16_t*)(p.ws + OFF_XB); float* ss = (float*)(p.ws + OFF_SS);
    const int lane = tid & 63, wid = tid >> 6;
    for (int row = blockIdx.x * 4 + wid; row < NTOK; row += gridDim.x * 4) {
      float s = 0.f;
#pragma unroll
      for (int i = 0; i < 4; ++i) {
        const f32x4 v = *(const f32x4*)(x + (size_t)row * 1024 + 256 * i + 4 * lane);
        s += v.x * v.x + v.y * v.y + v.z * v.z + v.w * v.w;
        u32x2 o = {pk2(v.x, v.y), pk2(v.z, v.w)};
        *(u32x2*)(xb + (size_t)row * 1024 + 256 * i + 4 * lane) = o;
      }
#pragma unroll
      for (int off = 32; off > 0; off >>= 1) s += __shfl_xor(s, off);
      if (lane == 0) ss[row] = s;
    }
    for (int i = blockIdx.x * 256 + tid; i < 6 * NTOK; i += gridDim.x * 256) ss[NTOK + i] = 0.f;
    const float* pp = p.in[1]; bf16_t* pb = (bf16_t*)(p.ws + OFF_PB);
    const size_t n4 = 2ull * 32768 * 256 / 4;
    for (size_t i = (size_t)blockIdx.x * 256 + tid; i < n4; i += (size_t)gridDim.x * 256) {
      const f32x4 v = *(const f32x4*)(pp + 4 * i);
      u32x2 o = {pk2(v.x, v.y), pk2(v.z, v.w)};
      *(u32x2*)(pb + 4 * i) = o;
    }
  }
}

#define GEMM_IDS const int lrow = tid >> 2;
#define EPI_IDS int tid_e = tid; asm volatile("" : "+v"(tid_e)); const int lane = tid_e & 63, wid = tid_e >> 6, wr = wid >> 1, wc = wid & 1, fr = lane & 15, fq = lane >> 4; (void)lane; (void)wr; (void)wc; (void)fr; (void)fq;

DI void phase_in_e(const P& p, unsigned char* smem, int tid) {
  GEMM_IDS
  const bf16_t* xb = (const bf16_t*)(p.ws + OFF_XB); const bf16_t* wt = (const bf16_t*)(p.ws + OFF_WT_INE);
  const float* ss = (const float*)(p.ws + OFF_SS);
  bf16_t* proj = (bf16_t*)(p.ws + OFF_PROJ0); bf16_t* vT = (bf16_t*)(p.ws + OFF_VT);
  for (int i = blockIdx.x; i < 256 * 8; i += gridDim.x) {
    int mt, nt; tile_decode(i, 256, 8, mt, nt);
    const int m0 = mt * 128, n0 = nt * 256;
    const bf16_t* pa = xb + (size_t)(m0 + lrow) * 1024;
    f32x4 acc[4][8]; zero_acc8(acc);
    gemm_core(acc, pa, pa + 64 * 1024, wt + (size_t)(n0 + permrow(lrow)) * 1024, 64 * 1024, 32, smem, tid);
    EPI_IDS
    const float qs = (n0 >= 512 && n0 < 1024) ? 0.18033688011112042f : 1.f;
#pragma unroll
    for (int m = 0; m < 4; ++m) {
      const int row = m0 + 64 * wr + 16 * m + fr;
      const float rs = rsqrtf(ss[row] * (1.f / 1024.f) + EPSF) * qs;
#pragma unroll
      for (int q = 0; q < 4; ++q) {
        const int col = n0 + 128 * wc + 32 * q + 8 * fq;
        const f32x4 v0 = acc[m][2 * q] * rs, v1 = acc[m][2 * q + 1] * rs;
        if (n0 < 1536) {
          u32x4 o = {pk2(v0.x, v0.y), pk2(v0.z, v0.w), pk2(v1.x, v1.y), pk2(v1.z, v1.w)};
          *(u32x4*)(proj + (size_t)row * 1536 + col) = o;
        } else {
          const int cc = col - 1536; const int bh = (row >> 12) * 8 + (cc >> 6), d = cc & 63, t = row & 4095;
          bf16_t* vp = vT + ((size_t)bh * 64 + d) * 4096 + t;
          vp[0] = f2bf(v0.x); vp[4096] = f2bf(v0.y); vp[8192] = f2bf(v0.z); vp[12288] = f2bf(v0.w);
          vp[16384] = f2bf(v1.x); vp[20480] = f2bf(v1.y); vp[24576] = f2bf(v1.z); vp[28672] = f2bf(v1.w);
        }
      }
    }
  }
}

DI void phase_resid(const P& p, const bf16_t* A, int K, const bf16_t* wt, const float* xold, float* ssn, unsigned char* smem, int tid) {
  GEMM_IDS
  bf16_t* xb = (bf16_t*)(p.ws + OFF_XB); float* xnew = p.out;
  for (int i = blockIdx.x; i < 256 * 4; i += gridDim.x) {
    int mt, nt; tile_decode(i, 256, 4, mt, nt);
    const int m0 = mt * 128, n0 = nt * 256;
    const bf16_t* pa = A + (size_t)(m0 + lrow) * K;
    f32x4 acc[4][8]; zero_acc8(acc);
    gemm_core(acc, pa, pa + 64 * (size_t)K, wt + (size_t)(n0 + permrow(lrow)) * K, 64 * (long)K, K / 32, smem, tid);
    EPI_IDS
#pragma unroll
    for (int m = 0; m < 4; ++m) {
      const int row = m0 + 64 * wr + 16 * m + fr;
      float s = 0.f;
#pragma unroll
      for (int q = 0; q < 4; ++q) {
        const int col = n0 + 128 * wc + 32 * q + 8 * fq;
        const f32x4 v0 = *(const f32x4*)(xold + (size_t)row * 1024 + col) + acc[m][2 * q];
        const f32x4 v1 = *(const f32x4*)(xold + (size_t)row * 1024 + col + 4) + acc[m][2 * q + 1];
        *(f32x4*)(xnew + (size_t)row * 1024 + col) = v0;
        *(f32x4*)(xnew + (size_t)row * 1024 + col + 4) = v1;
        u32x4 o = {pk2(v0.x, v0.y), pk2(v0.z, v0.w), pk2(v1.x, v1.y), pk2(v1.z, v1.w)};
        *(u32x4*)(xb + (size_t)row * 1024 + col) = o;
        s += v0.x * v0.x + v0.y * v0.y + v0.z * v0.z + v0.w * v0.w + v1.x * v1.x + v1.y * v1.y + v1.z * v1.z + v1.w * v1.w;
      }
      s += __shfl_xor(s, 16); s += __shfl_xor(s, 32);
      if (fq == 0) atomicAdd(ssn + row, s);
      __builtin_amdgcn_sched_barrier(0);
    }
  }
}

DI void phase_ffn_up(const P& p, int layer, const float* ssc, unsigned char* smem, int tid) {
  GEMM_IDS
  const bf16_t* xb = (const bf16_t*)(p.ws + OFF_XB); const bf16_t* wt = (const bf16_t*)(p.ws + OFF_WT_UP) + (size_t)layer * 5632 * 1024;
  bf16_t* act = (bf16_t*)(p.ws + OFF_ACT);
  const float* cw = p.in[16] + (size_t)layer * 3 * 5632;
  float* Cs = (float*)smem;
  for (int i = blockIdx.x; i < 264 * 22; i += gridDim.x) {
    int mt, nt; tile_decode(i, 264, 22, mt, nt);
    const int b = mt / 33, mi = mt - b * 33;
    const int t0 = 126 * mi - 2;
    const bf16_t* pa[2];
#pragma unroll
    for (int j = 0; j < 2; ++j) { int t = t0 + lrow + 64 * j; t = t < 0 ? 0 : (t > 4095 ? 4095 : t); pa[j] = xb + (size_t)(b * 4096 + t) * 1024; }
    f32x4 acc[4][8]; zero_acc8(acc);
    gemm_core(acc, pa[0], pa[1], wt + (size_t)(nt * 256 + lrow) * 1024, 64 * 1024, 32, smem, tid);
    EPI_IDS
    float rsv[4];
#pragma unroll
    for (int m = 0; m < 4; ++m) {
      int t = t0 + 64 * wr + 16 * m + fr; const bool neg = t < 0; t = t < 0 ? 0 : (t > 4095 ? 4095 : t);
      rsv[m] = neg ? 0.f : rsqrtf(ssc[b * 4096 + t] * (1.f / 1024.f) + EPSF);
    }
#pragma unroll
    for (int hp = 0; hp < 2; ++hp) {
      if (hp) __syncthreads();
#pragma unroll
      for (int m = 0; m < 4; ++m) {
        const int lr = 64 * wr + 16 * m + fr;
#pragma unroll
        for (int n = 0; n < 4; ++n) *(f32x4*)(Cs + lr * 132 + 64 * wc + 16 * n + 4 * fq) = acc[m][4 * hp + n] * rsv[m];
      }
      __syncthreads();
      const int cl = tid & 63, rg = tid >> 6;
      const int gcol = 64 * (cl >> 5) + 16 * ((cl & 31) >> 4) + (cl & 15), vcol = gcol + 32;
      const int ch = nt * 128 + 64 * (cl >> 5) + 32 * hp + (cl & 31);
      const float wg0 = cw[ch], wg1 = cw[5632 + ch], wg2 = cw[2 * 5632 + ch];
      const float wv0 = cw[2816 + ch], wv1 = cw[5632 + 2816 + ch], wv2 = cw[2 * 5632 + 2816 + ch];
      const int lr0 = 2 + 32 * rg;
      float g2 = Cs[(lr0 - 2) * 132 + gcol], g1 = Cs[(lr0 - 1) * 132 + gcol];
      float v2 = Cs[(lr0 - 2) * 132 + vcol], v1 = Cs[(lr0 - 1) * 132 + vcol];
      for (int r = 0; r < 32; ++r) {
        const int lr = lr0 + r; const int t = t0 + lr;
        if (lr >= 128 || t > 4095) break;
        const float g0 = Cs[lr * 132 + gcol], v0 = Cs[lr * 132 + vcol];
        const float yg = wg0 * g2 + wg1 * g1 + wg2 * g0;
        const float yv = wv0 * v2 + wv1 * v1 + wv2 * v0;
        act[(size_t)(b * 4096 + t) * 2816 + ch] = f2bf(siluf_(yg) * yv);
        g2 = g1; g1 = g0; v2 = v1; v1 = v0;
      }
    }
  }
}

DI void phase_ple_gate(const P& p, int layer, const float* ssc, unsigned char* smem, int tid) {
  GEMM_IDS
  const bf16_t* xb = (const bf16_t*)(p.ws + OFF_XB);
  const bf16_t* wg = (const bf16_t*)(p.ws + OFF_WT_PLEG) + (size_t)layer * 1024 * 1024;
  bf16_t* gate = (bf16_t*)(p.ws + OFF_GATE);
  for (int i = blockIdx.x; i < 256 * 4; i += gridDim.x) {
    int mt, nt; tile_decode(i, 256, 4, mt, nt);
    const int m0 = mt * 128, n0 = nt * 256;
    const bf16_t* pa = xb + (size_t)(m0 + lrow) * 1024;
    f32x4 acc[4][8]; zero_acc8(acc);
    gemm_core(acc, pa, pa + 64 * 1024, wg + (size_t)(n0 + permrow(lrow)) * 1024, 64 * 1024, 32, smem, tid);
    EPI_IDS
#pragma unroll
    for (int m = 0; m < 4; ++m) {
      const int row = m0 + 64 * wr + 16 * m + fr;
      const float rs = rsqrtf(ssc[row] * (1.f / 1024.f) + EPSF);
#pragma unroll
      for (int q = 0; q < 4; ++q) {
        const int col = n0 + 128 * wc + 32 * q + 8 * fq;
        const f32x4 v0 = acc[m][2 * q] * rs, v1 = acc[m][2 * q + 1] * rs;
        u32x4 o = {pk2(sigmoidf_(v0.x), sigmoidf_(v0.y)), pk2(sigmoidf_(v0.z), sigmoidf_(v0.w)), pk2(sigmoidf_(v1.x), sigmoidf_(v1.y)), pk2(sigmoidf_(v1.z), sigmoidf_(v1.w))};
        *(u32x4*)(gate + (size_t)row * 1024 + col) = o;
      }
    }
  }
}

DI void phase_ple_add(const P& p, int layer, float* ssn, unsigned char* smem, int tid) {
  GEMM_IDS
  bf16_t* xb = (bf16_t*)(p.ws + OFF_XB);
  const bf16_t* wp = (const bf16_t*)(p.ws + OFF_WT_PLE) + (size_t)layer * 1024 * 256;
  const bf16_t* pb = (const bf16_t*)(p.ws + OFF_PB) + (size_t)layer * 32768 * 256;
  const bf16_t* gate = (const bf16_t*)(p.ws + OFF_GATE);
  float* x = p.out;
  for (int i = blockIdx.x; i < 256 * 4; i += gridDim.x) {
    int mt, nt; tile_decode(i, 256, 4, mt, nt);
    const int m0 = mt * 128, n0 = nt * 256;
    const bf16_t* pa = pb + (size_t)(m0 + lrow) * 256;
    f32x4 acc[4][8]; zero_acc8(acc);
    gemm_core(acc, pa, pa + 64 * 256, wp + (size_t)(n0 + permrow(lrow)) * 256, 64 * 256, 8, smem, tid);
    EPI_IDS
#pragma unroll
    for (int m = 0; m < 4; ++m) {
      const int row = m0 + 64 * wr + 16 * m + fr;
      float s = 0.f;
#pragma unroll
      for (int q = 0; q < 4; ++q) {
        const int col = n0 + 128 * wc + 32 * q + 8 * fq;
        const u32x4 gp = *(const u32x4*)(gate + (size_t)row * 1024 + col);
        const f32x4 g0 = {bflo(gp.x), bfhi(gp.x), bflo(gp.y), bfhi(gp.y)}, g1 = {bflo(gp.z), bfhi(gp.z), bflo(gp.w), bfhi(gp.w)};
        const f32x4 v0 = *(const f32x4*)(x + (size_t)row * 1024 + col) + acc[m][2 * q] * g0;
        const f32x4 v1 = *(const f32x4*)(x + (size_t)row * 1024 + col + 4) + acc[m][2 * q + 1] * g1;
        *(f32x4*)(x + (size_t)row * 1024 + col) = v0;
        *(f32x4*)(x + (size_t)row * 1024 + col + 4) = v1;
        if (layer == 0) {
          u32x4 o = {pk2(v0.x, v0.y), pk2(v0.z, v0.w), pk2(v1.x, v1.y), pk2(v1.z, v1.w)};
          *(u32x4*)(xb + (size_t)row * 1024 + col) = o;
        }
        s += v0.x * v0.x + v0.y * v0.y + v0.z * v0.z + v0.w * v0.w + v1.x * v1.x + v1.y * v1.y + v1.z * v1.z + v1.w * v1.w;
      }
      s += __shfl_xor(s, 16); s += __shfl_xor(s, 32);
      if (fq == 0 && layer == 0) atomicAdd(ssn + row, s);
      __builtin_amdgcn_sched_barrier(0);
    }
  }
}

DI void phase_in_o(const P& p, int qi, unsigned char* smem, int tid) {
  GEMM_IDS
  const bf16_t* xb = (const bf16_t*)(p.ws + OFF_XB); const bf16_t* wt = (const bf16_t*)(p.ws + OFF_WT_INO);
  const float* ssc = (const float*)(p.ws + OFF_SS) + 3 * NTOK;
  bf16_t* qkv = (bf16_t*)(p.ws + OFF_QKV); float* gb = (float*)(p.ws + OFF_GB);
  const float* a_log = p.in[10]; const float* dt_bias = p.in[11];
  for (int i = blockIdx.x; i < 64 * 13; i += gridDim.x) {
    int mt, nt; tile_decode(i, 64, 13, mt, nt);
    const int mq0 = mt * 128, m0 = qi * 8192 + mq0, n0 = nt * 256;
    const bf16_t* pa = xb + (size_t)(m0 + lrow) * 1024;
    f32x4 acc[4][8]; zero_acc8(acc);
    gemm_core(acc, pa, pa + 64 * 1024, wt + (size_t)(n0 + permrow(lrow)) * 1024, 64 * 1024, 32, smem, tid);
    EPI_IDS
#pragma unroll
    for (int m = 0; m < 4; ++m) {
      const int rl = 64 * wr + 16 * m + fr;
      const float rs = rsqrtf(ssc[m0 + rl] * (1.f / 1024.f) + EPSF);
      if (nt < 12) {
#pragma unroll
        for (int q = 0; q < 4; ++q) {
          const int col = n0 + 128 * wc + 32 * q + 8 * fq;
          const f32x4 v0 = acc[m][2 * q] * rs, v1 = acc[m][2 * q + 1] * rs;
          u32x4 o = {pk2(v0.x, v0.y), pk2(v0.z, v0.w), pk2(v1.x, v1.y), pk2(v1.z, v1.w)};
          *(u32x4*)(qkv + (size_t)(mq0 + rl) * 3072 + col) = o;
        }
      } else if (wc == 0 && fq < 2) {
        const f32x4 v0 = acc[m][0] * rs, v1 = acc[m][1] * rs;
        float o[8];
#pragma unroll
        for (int j = 0; j < 8; ++j) {
          const float vv = j < 4 ? v0[j] : v1[j - 4];
          if (fq == 0) o[j] = sigmoidf_(vv);
          else {
            const float xx = vv + dt_bias[j];
            const float sp = fmaxf(xx, 0.f) + log1pf(__expf(-fabsf(xx)));
            o[j] = -__expf(a_log[j]) * sp;
          }
        }
        float* gp = gb + (size_t)(m0 + rl) * 16 + 8 * fq;
        *(f32x4*)gp = (f32x4){o[0], o[1], o[2], o[3]}; *(f32x4*)(gp + 4) = (f32x4){o[4], o[5], o[6], o[7]};
      }
    }
  }
}

DI void phase_z_gate(const P& p, unsigned char* smem, int tid) {
  GEMM_IDS
  const bf16_t* xb = (const bf16_t*)(p.ws + OFF_XB); const bf16_t* wt = (const bf16_t*)(p.ws + OFF_WT_Z);
  const float* ssc = (const float*)(p.ws + OFF_SS) + 3 * NTOK;
  const bf16_t* ob_in = (const bf16_t*)(p.ws + OFF_UT);
  bf16_t* ob = (bf16_t*)(p.ws + OFF_OB);
  const float* nw = p.in[12];
  for (int i = blockIdx.x; i < 256 * 4; i += gridDim.x) {
    int mt, nt; tile_decode(i, 256, 4, mt, nt);
    const int m0 = mt * 128, n0 = nt * 256;
    const bf16_t* pa = xb + (size_t)(m0 + lrow) * 1024;
    f32x4 acc[4][8]; zero_acc8(acc);
    gemm_core(acc, pa, pa + 64 * 1024, wt + (size_t)(n0 + permrow(lrow)) * 1024, 64 * 1024, 32, smem, tid);
    EPI_IDS
    const int hd = 2 * nt + wc;
#pragma unroll
    for (int m = 0; m < 4; ++m) {
      const int row = m0 + 64 * wr + 16 * m + fr;
      const int chunk = ((row >> 12) * 8 + hd) * 64 + ((row & 4095) >> 6);
      const bf16_t* op = ob_in + (size_t)chunk * 8192 + (row & 63) * 64 + 8 * fq;
      u32x4 ov[4];
      float s = 0.f;
#pragma unroll
      for (int q = 0; q < 4; ++q) {
        ov[q] = *(const u32x4*)(op + (q >> 1) * 4096 + 32 * (q & 1));
        const float a0 = bflo(ov[q].x), a1 = bfhi(ov[q].x), a2 = bflo(ov[q].y), a3 = bfhi(ov[q].y), a4 = bflo(ov[q].z), a5 = bfhi(ov[q].z), a6 = bflo(ov[q].w), a7 = bfhi(ov[q].w);
        s += a0 * a0 + a1 * a1 + a2 * a2 + a3 * a3 + a4 * a4 + a5 * a5 + a6 * a6 + a7 * a7;
      }
      s += __shfl_xor(s, 16); s += __shfl_xor(s, 32);
      const float on = rsqrtf(s * (1.f / 128.f) + EPSF);
      const float rs = rsqrtf(ssc[row] * (1.f / 1024.f) + EPSF);
#pragma unroll
      for (int q = 0; q < 4; ++q) {
        const int cl = 32 * q + 8 * fq;
        const f32x4 z0 = acc[m][2 * q] * rs, z1 = acc[m][2 * q + 1] * rs;
        const f32x4 w0 = *(const f32x4*)(nw + cl), w1 = *(const f32x4*)(nw + cl + 4);
        const f32x4 o0 = {bflo(ov[q].x), bfhi(ov[q].x), bflo(ov[q].y), bfhi(ov[q].y)}, o1 = {bflo(ov[q].z), bfhi(ov[q].z), bflo(ov[q].w), bfhi(ov[q].w)};
        float r[8];
#pragma unroll
        for (int j = 0; j < 4; ++j) { r[j] = o0[j] * on * w0[j] * siluf_(z0[j]); r[4 + j] = o1[j] * on * w1[j] * siluf_(z1[j]); }
        u32x4 o = {pk2(r[0], r[1]), pk2(r[2], r[3]), pk2(r[4], r[5]), pk2(r[6], r[7])};
        *(u32x4*)(ob + (size_t)row * 1024 + n0 + 128 * wc + cl) = o;
      }
      __builtin_amdgcn_sched_barrier(0);
    }
  }
}

#ifndef DUMMY_MODE
#define DUMMY_MODE -1
#endif
DI void phase_dummy(const P& p, int mode, unsigned char* smem, int tid) {
  GEMM_IDS
  const bf16_t* xb = (const bf16_t*)(p.ws + OFF_XB);
  const bf16_t* wg = (const bf16_t*)(p.ws + OFF_WT_PLEG);
  for (int i = blockIdx.x; i < 256 * 4; i += gridDim.x) {
    int mt, nt; tile_decode(i, 256, 4, mt, nt);
    if (mode == 1) { mt = 0; nt = 0; }
    if (mode == 2) { mt = blockIdx.x & 255; nt = 0; }
    const int m0 = mt * 128, n0 = nt * 256;
    const bf16_t* pa = xb + (size_t)(m0 + lrow) * 1024;
    f32x4 acc[4][8]; zero_acc8(acc);
    gemm_core(acc, pa, pa + 64 * 1024, wg + (size_t)(n0 + lrow) * 1024, 64 * 1024, 32, smem, tid);
    EPI_IDS
    float s = 0.f;
#pragma unroll
    for (int m = 0; m < 4; ++m)
#pragma unroll
      for (int n = 0; n < 8; ++n) s += acc[m][n].x + acc[m][n].y + acc[m][n].z + acc[m][n].w;
    if (s == 123456.789f) ((float*)(p.ws + OFF_GL))[0] = s;
  }
}

DI void attn_item(const P& p, int item, unsigned char* smem, int tid) {
  const int lane = tid & 63, w = tid >> 6, r = lane & 31, hh = lane >> 5;
  const int bh = item & 63, jj = item >> 6;
  int qb; { const int a = jj & 7, grp = jj >> 3; qb = grp == 0 ? 31 - a : grp == 1 ? 16 + a : grp == 2 ? 15 - a : a; }
  const int b = bh >> 3, h = bh & 7;
  const int q0 = qb * 128, qw = q0 + 32 * w;
  const bf16_t* proj = (const bf16_t*)(p.ws + OFF_PROJ0);
  const bf16_t* vT = (const bf16_t*)(p.ws + OFF_VT) + (size_t)bh * 64 * 4096;
  bf16x8 qf[4];
  {
    const bf16_t* qp = proj + (size_t)(b * 4096 + qw + r) * 1536 + 512 + h * 64 + 8 * hh;
#pragma unroll
    for (int s = 0; s < 4; ++s) qf[s] = *(const bf16x8*)(qp + 16 * s);
  }
  f32x16 oacc[2];
#pragma unroll
  for (int i = 0; i < 16; ++i) { oacc[0][i] = 0.f; oacc[1][i] = 0.f; }
  float carry = 0.f;
  const int ntile = q0 / 64 + 2;
  const int lrow = tid >> 3, lc = tid & 7;
  const bf16_t* kbase = proj + (size_t)(b * 4096 + lrow) * 1536 + 1024 + h * 64 + 8 * lc;
  const bf16_t* vbase = vT + (size_t)lrow * 4096 + 8 * lc;
  unsigned char* sK = smem;
  unsigned char* sV = smem + 16384;
  const int kst = lrow * 128 + ((lc ^ (lrow & 7)) << 4);
  const int vst = lrow * 136 + lc * 16;
  u32x4 rk[2], rv[2];
  int kt = ntile - 1;
#pragma unroll
  for (int i = 0; i < 2; ++i) { rk[i] = *(const u32x4*)(kbase + (size_t)(kt * 64 + 32 * i) * 1536); rv[i] = *(const u32x4*)(vbase + (size_t)(32 * i) * 4096 + kt * 64); }
  __syncthreads();
#pragma unroll
  for (int i = 0; i < 2; ++i) {
    *(u32x4*)(sK + kst + i * 4096) = rk[i];
    *(u32x2*)(sV + vst + i * 4352) = (u32x2){rv[i].x, rv[i].y}; *(u32x2*)(sV + vst + i * 4352 + 8) = (u32x2){rv[i].z, rv[i].w};
  }
  __syncthreads();
  int cur = 0;
  for (; kt >= 0; --kt) {
    if (kt > 0) {
#pragma unroll
      for (int i = 0; i < 2; ++i) { rk[i] = *(const u32x4*)(kbase + (size_t)((kt - 1) * 64 + 32 * i) * 1536); rv[i] = *(const u32x4*)(vbase + (size_t)(32 * i) * 4096 + (kt - 1) * 64); }
    }
    const unsigned char* cK = sK + cur * 8192; const unsigned char* cV = sV + cur * 8704;
    const int s0 = kt * 64;
#pragma unroll
    for (int sub = 1; sub >= 0; --sub) {
      const int ks = s0 + 32 * sub;
      if (ks <= qw) {
        f32x16 sc;
#pragma unroll
        for (int i = 0; i < 16; ++i) sc[i] = 0.f;
#pragma unroll
        for (int s = 0; s < 4; ++s) {
          const bf16x8 kf = *(const bf16x8*)(cK + (32 * sub + r) * 128 + (((2 * s + hh) ^ (r & 7)) << 4));
          sc = mfma32(kf, qf[s], sc);
        }
        float sp[16], ls[16];
#pragma unroll
        for (int i = 0; i < 16; ++i) {
          const float z = sc[i];
          sp[i] = flog2(1.f + fexp2(z));
          ls[i] = z - sp[i];
        }
        if (ks == qw) {
#pragma unroll
          for (int i = 0; i < 16; ++i) { const bool valid = crow(i, hh) < r; sp[i] = valid ? sp[i] : 0.f; ls[i] = valid ? ls[i] : -1e30f; }
        }
        float G[4], Pp[4], Tt[4];
#pragma unroll
        for (int g = 0; g < 4; ++g) { G[g] = (sp[4 * g] + sp[4 * g + 1]) + (sp[4 * g + 2] + sp[4 * g + 3]); Pp[g] = __shfl_xor(G[g], 32); Tt[g] = G[g] + Pp[g]; }
        float after = carry;
        f32x16 av;
#pragma unroll
        for (int g = 3; g >= 0; --g) {
          float base = after + (hh == 0 ? Pp[g] : 0.f);
          float k3 = base, k2 = k3 + sp[4 * g + 3], k1 = k2 + sp[4 * g + 2], k0 = k1 + sp[4 * g + 1];
          av[4 * g + 3] = fexp2(ls[4 * g + 3] - k3); av[4 * g + 2] = fexp2(ls[4 * g + 2] - k2);
          av[4 * g + 1] = fexp2(ls[4 * g + 1] - k1); av[4 * g + 0] = fexp2(ls[4 * g + 0] - k0);
          after += Tt[g];
        }
        carry = after;
#pragma unroll
        for (int s = 0; s < 2; ++s) {
          const bf16x8 ap = pack_step(av, s);
#pragma unroll
          for (int dt = 0; dt < 2; ++dt) {
            const unsigned char* vp = cV + (32 * dt + r) * 136 + (32 * sub + 16 * s + 4 * hh) * 2;
            const bf16x8 vf = mk8(*(const u32x2*)vp, *(const u32x2*)(vp + 16));
            oacc[dt] = mfma32(vf, ap, oacc[dt]);
          }
        }
      }
    }
    if (kt > 0) {
      unsigned char* nK = sK + (cur ^ 1) * 8192; unsigned char* nV = sV + (cur ^ 1) * 8704;
#pragma unroll
      for (int i = 0; i < 2; ++i) {
        *(u32x4*)(nK + kst + i * 4096) = rk[i];
        *(u32x2*)(nV + vst + i * 4352) = (u32x2){rv[i].x, rv[i].y}; *(u32x2*)(nV + vst + i * 4352 + 8) = (u32x2){rv[i].z, rv[i].w};
      }
    }
    int* flg = (int*)(smem + 34816) + 4 * cur;
    { const bool wdone = (__ballot(carry < 160.f) == 0ull); if (lane == 0) flg[w] = wdone ? 1 : 0; }
    __syncthreads();
    if (flg[0] + flg[1] + flg[2] + flg[3] == 4) break;
    cur ^= 1;
  }
  bf16_t* cat = (bf16_t*)(p.ws + OFF_CAT) + (size_t)(b * 4096 + qw + r) * 1024 + 512 + h * 64;
#pragma unroll
  for (int dt = 0; dt < 2; ++dt)
#pragma unroll
    for (int g = 0; g < 4; ++g) {
      u32x2 o = {pk2(oacc[dt][4 * g], oacc[dt][4 * g + 1]), pk2(oacc[dt][4 * g + 2], oacc[dt][4 * g + 3])};
      *(u32x2*)(cat + 32 * dt + 8 * g + 4 * hh) = o;
    }
}

DI void pool_item(const P& p, int item, unsigned char* smem, int tid) {
  const int lane = tid & 63, wid = tid >> 6, wr = wid >> 1, wc = wid & 1, fr = lane & 15, fq = lane >> 4; const int lrow = tid >> 3, lc = tid & 7; (void)lane;
  const int g = item & 3, mt = item >> 2;
  const int m0 = mt * 128;
  const bf16_t* proj = (const bf16_t*)(p.ws + OFF_PROJ0);
  const bf16_t* wt = (const bf16_t*)(p.ws + OFF_WT_POOL) + (size_t)g * 128 * 128;
  unsigned char* sA = smem; unsigned char* sB = smem + 32768;
  __syncthreads();
  {
    const int st_off = lrow * 128 + ((lc ^ (lrow & 7)) << 4);
#pragma unroll
    for (int kt = 0; kt < 2; ++kt)
#pragma unroll
      for (int i = 0; i < 4; ++i) *(u32x4*)(sB + kt * 16384 + st_off + i * 4096) = *(const u32x4*)(wt + (size_t)(lrow + 32 * i) * 128 + kt * 64 + 8 * lc);
  }
  {
    const int c8 = tid & 15, rg = tid >> 4;
    const int r0 = 8 * rg;
    const int w = 2 << g;
    const int tb = (m0 & 4095) + r0;
    const bf16_t* up = proj + (size_t)(m0 - (m0 & 4095)) * 1536 + g * 128 + 8 * c8;
    u32x4 v[23];
#pragma unroll
    for (int j = 0; j < 23; ++j) {
      const int t = tb - 15 + j;
      v[j] = (u32x4){0u, 0u, 0u, 0u};
      if (t >= 0 && j >= 16 - w) v[j] = *(const u32x4*)(up + (size_t)t * 1536);
    }
    float md[16];
#pragma unroll
    for (int d = 0; d < 16; ++d) md[d] = (d >= 16 - w) ? 1.f : 0.f;
#pragma unroll
    for (int i = 0; i < 8; ++i) {
      float s[8];
#pragma unroll
      for (int e = 0; e < 8; ++e) s[e] = 0.f;
#pragma unroll
      for (int d = 0; d < 16; ++d) {
        const u32x4 x = v[i + d]; const float m = md[d];
        s[0] += m * bflo(x.x); s[1] += m * bfhi(x.x); s[2] += m * bflo(x.y); s[3] += m * bfhi(x.y);
        s[4] += m * bflo(x.z); s[5] += m * bfhi(x.z); s[6] += m * bflo(x.w); s[7] += m * bfhi(x.w);
      }
      const int t = tb + i; const int cnt = (t + 1 < w) ? (t + 1) : w;
      const float inv = 1.f / (float)cnt;
      const u32x4 xc = v[15 + i];
      const float y0 = s[0] * inv - bflo(xc.x), y1 = s[1] * inv - bfhi(xc.x), y2 = s[2] * inv - bflo(xc.y), y3 = s[3] * inv - bfhi(xc.y);
      const float y4 = s[4] * inv - bflo(xc.z), y5 = s[5] * inv - bfhi(xc.z), y6 = s[6] * inv - bflo(xc.w), y7 = s[7] * inv - bfhi(xc.w);
      const int lr = r0 + i;
      u32x4 o = {pk2(y0, y1), pk2(y2, y3), pk2(y4, y5), pk2(y6, y7)};
      *(u32x4*)(sA + (c8 >> 3) * 16384 + lr * 128 + (((c8 & 7) ^ (lr & 7)) << 4)) = o;
    }
  }
  __syncthreads();
  f32x4 acc[4][4]; zero_acc(acc);
  const int a_rd = (64 * wr + fr) * 128, b_rd = (64 * wc + fr) * 128;
  const int sw0 = (fq ^ (fr & 7)) << 4, sw1 = ((4 + fq) ^ (fr & 7)) << 4;
  mma_stage(acc, sA, sB, a_rd, b_rd, sw0, sw1);
  mma_stage(acc, sA + 16384, sB + 16384, a_rd, b_rd, sw0, sw1);
  const float* psc = p.in[5] + g * 128;
  bf16_t* cat = (bf16_t*)(p.ws + OFF_CAT);
#pragma unroll
  for (int m = 0; m < 4; ++m) {
    const int row = m0 + 64 * wr + 16 * m + fr;
#pragma unroll
    for (int n = 0; n < 4; ++n) {
      const int cl = 64 * wc + 16 * n + 4 * fq;
      const f32x4 s4 = *(const f32x4*)(psc + cl);
      const f32x4 v = acc[m][n] * s4;
      u32x2 o = {pk2(v.x, v.y), pk2(v.z, v.w)};
      *(u32x2*)(cat + (size_t)row * 1024 + g * 128 + cl) = o;
    }
  }
}


template <int I> struct SolveRow {
  static DI void run(float (&sol)[64], const float* A_v) {
    float s = sol[I];
#pragma unroll
    for (int g8 = 0; g8 < (I + 31) / 32; ++g8) {
      f32x4 a[8];
#pragma unroll
      for (int q = 0; q < 8; ++q) if (32 * g8 + 4 * q < I) a[q] = *(const f32x4*)(A_v + I * 68 + 32 * g8 + 4 * q);
#pragma unroll
      for (int q = 0; q < 8; ++q) {
        const int j = 32 * g8 + 4 * q;
        if (j + 0 < I) s -= a[q].x * sol[j + 0];
        if (j + 1 < I) s -= a[q].y * sol[j + 1];
        if (j + 2 < I) s -= a[q].z * sol[j + 2];
        if (j + 3 < I) s -= a[q].w * sol[j + 3];
      }
      __builtin_amdgcn_sched_barrier(0);
    }
    sol[I] = s;
    SolveRow<I + 1>::run(sol, A_v);
  }
};
template <> struct SolveRow<64> { static DI void run(float (&)[64], const float*) {} };

constexpr int GD_RAW = 0, GD_Q = 18224, GD_K = GD_Q + 17408, GD_V = GD_K + 17408, GD_GC = GD_V + 17408, GD_BETA = GD_GC + 256, GD_CW = GD_BETA + 256;
DI void gdn_chunk_item(const P& p, int qi, int item, unsigned char* smem, int tid) {
  const int lane = tid & 63, w = tid >> 6, r = lane & 31, hh = lane >> 5;
  const int h = item & 7, n = (item >> 3) & 63, bq = item >> 9;
  const int b = 2 * qi + bq;
  const int chunk = (b * 8 + h) * 64 + n;
  const bf16_t* qkv = (const bf16_t*)(p.ws + OFF_QKV) + (size_t)(bq * 4096) * 3072;
  const float* gb = (const float*)(p.ws + OFF_GB);
  const float* cw = p.in[9];
  float* gc_s = (float*)(smem + GD_GC); float* beta_s = (float*)(smem + GD_BETA);
  __syncthreads();
  u32x4 rawr[5]; float cwr[2];
#define GD_LOADP(PP) do { \
    _Pragma("unroll") for (int i = 0; i < 5; ++i) { const int idx = tid + 256 * i; const int rr_ = idx >> 4, c_ = idx & 15; const int t_ = 64 * n - 3 + rr_; \
      rawr[i] = (u32x4){0u, 0u, 0u, 0u}; if (idx < 1072 && t_ >= 0) rawr[i] = *(const u32x4*)(qkv + (size_t)t_ * 3072 + (PP) * 1024 + h * 128 + 8 * c_); } \
    _Pragma("unroll") for (int i = 0; i < 2; ++i) { const int idx = tid + 256 * i; cwr[i] = cw[(size_t)(idx >> 7) * 3072 + (PP) * 1024 + h * 128 + (idx & 127)]; } \
  } while (0)
  GD_LOADP(0);
  if (w == 0) {
    const int tok = b * 4096 + 64 * n + lane;
    float g = gb[(size_t)tok * 16 + 8 + h]; const float be = gb[(size_t)tok * 16 + h];
#pragma unroll
    for (int off = 1; off < 64; off <<= 1) { const float t = __shfl_up(g, off); if (lane >= off) g += t; }
    gc_s[lane] = g; beta_s[lane] = be;
  }
#pragma unroll 1
  for (int pp = 0; pp < 3; ++pp) {
#pragma unroll
    for (int i = 0; i < 5; ++i) { const int idx = tid + 256 * i; if (idx < 1072) *(u32x4*)(smem + GD_RAW + (idx >> 4) * 272 + 16 * (idx & 15)) = rawr[i]; }
#pragma unroll
    for (int i = 0; i < 2; ++i) ((float*)(smem + GD_CW))[tid + 256 * i] = cwr[i];
    __syncthreads();
    if (pp < 2) GD_LOADP(pp + 1);
    {
      const int row = tid >> 2, qtr = tid & 3; const int ch0 = 32 * qtr;
      float y[32];
#pragma unroll
      for (int sub = 0; sub < 4; ++sub) {
        float a[8];
#pragma unroll
        for (int e = 0; e < 8; ++e) a[e] = 0.f;
#pragma unroll
        for (int tap = 0; tap < 4; ++tap) {
          const u32x4 xv = *(const u32x4*)(smem + GD_RAW + (row + tap) * 272 + (ch0 + 8 * sub) * 2);
          const float* wp = (const float*)(smem + GD_CW) + tap * 128 + ch0 + 8 * sub;
          const f32x4 w0 = *(const f32x4*)wp, w1 = *(const f32x4*)(wp + 4);
          a[0] += w0.x * bflo(xv.x); a[1] += w0.y * bfhi(xv.x); a[2] += w0.z * bflo(xv.y); a[3] += w0.w * bfhi(xv.y);
          a[4] += w1.x * bflo(xv.z); a[5] += w1.y * bfhi(xv.z); a[6] += w1.z * bflo(xv.w); a[7] += w1.w * bfhi(xv.w);
        }
#pragma unroll
        for (int e = 0; e < 8; ++e) y[8 * sub + e] = siluf_(a[e]);
        __builtin_amdgcn_sched_barrier(0);
      }
      if (pp < 2) {
        float s = 0.f;
#pragma unroll
        for (int e = 0; e < 32; ++e) s += y[e] * y[e];
        s += __shfl_xor(s, 1); s += __shfl_xor(s, 2);
        const float inv = rsqrtf(s + EPSF) * (pp == 0 ? 0.08838834764831845f : 1.f);
#pragma unroll
        for (int e = 0; e < 32; ++e) y[e] *= inv;
      }
      unsigned char* dst = smem + (pp == 0 ? GD_Q : pp == 1 ? GD_K : GD_V) + row * 272 + ch0 * 2;
#pragma unroll
      for (int sub = 0; sub < 4; ++sub) {
        u32x4 o = {pk2(y[8 * sub], y[8 * sub + 1]), pk2(y[8 * sub + 2], y[8 * sub + 3]), pk2(y[8 * sub + 4], y[8 * sub + 5]), pk2(y[8 * sub + 6], y[8 * sub + 7])};
        *(u32x4*)(dst + 16 * sub) = o;
      }
    }
    __syncthreads();
  }
  float* A_s = (float*)(smem + GD_RAW);
  bf16_t* qkb = (bf16_t*)(p.ws + OFF_QK) + (size_t)chunk * 4096;
  {
    const int ti = w >> 1, tj = w & 1;
    const int j = 32 * tj + r;
    if (ti == 0 && tj == 1) {
#pragma unroll
      for (int reg = 0; reg < 16; ++reg) qkb[(32 * ti + crow(reg, hh)) * 64 + j] = 0;
    } else {
      f32x16 kk, qk;
#pragma unroll
      for (int i = 0; i < 16; ++i) { kk[i] = 0.f; qk[i] = 0.f; }
#pragma unroll
      for (int s = 0; s < 8; ++s) {
        const bf16x8 bfrag = *(const bf16x8*)(smem + GD_K + (32 * tj + r) * 272 + (16 * s + 8 * hh) * 2);
        const bf16x8 akf = *(const bf16x8*)(smem + GD_K + (32 * ti + r) * 272 + (16 * s + 8 * hh) * 2);
        const bf16x8 aqf = *(const bf16x8*)(smem + GD_Q + (32 * ti + r) * 272 + (16 * s + 8 * hh) * 2);
        kk = mfma32(akf, bfrag, kk); qk = mfma32(aqf, bfrag, qk);
      }
      const float gcj = gc_s[j];
#pragma unroll
      for (int reg = 0; reg < 16; ++reg) {
        const int i = 32 * ti + crow(reg, hh);
        const float dec = (i >= j) ? __expf(gc_s[i] - gcj) : 0.f;
        A_s[i * 68 + j] = (i > j) ? beta_s[i] * kk[reg] * dec : 0.f;
        qkb[i * 64 + j] = f2bf((i >= j) ? qk[reg] * dec : 0.f);
      }
    }
  }
  __syncthreads();
  {
    const int col = tid; const bool isw = col >= 128; const int d = col & 127;
    int vz; asm volatile("v_mov_b32 %0, 0" : "=v"(vz));
    const float* A_v = A_s + vz; const float* gc_v = gc_s + vz; const float* beta_v = beta_s + vz;
    const unsigned char* src = smem + (isw ? GD_K : GD_V) + d * 2;
    float sol[64];
#pragma unroll
    for (int i = 0; i < 64; ++i) {
      float v = bf2f(*(const bf16_t*)(src + i * 272)) * beta_v[i];
      if (isw) v *= __expf(gc_v[i]);
      sol[i] = v;
    }
    SolveRow<1>::run(sol, A_v);
    __syncthreads();
    if (!isw) {
      bf16_t* ut = (bf16_t*)(p.ws + OFF_UT) + (size_t)chunk * 8192 + d * 64;
#pragma unroll
      for (int c8 = 0; c8 < 8; ++c8) {
        u32x4 o = {pk2(sol[8 * c8], sol[8 * c8 + 1]), pk2(sol[8 * c8 + 2], sol[8 * c8 + 3]), pk2(sol[8 * c8 + 4], sol[8 * c8 + 5]), pk2(sol[8 * c8 + 6], sol[8 * c8 + 7])};
        *(u32x4*)(ut + 8 * c8) = o;
      }
      unsigned char* qp = smem + GD_Q + d * 2;
#pragma unroll
      for (int i = 0; i < 64; ++i) { const float v = bf2f(*(const bf16_t*)(qp + i * 272)) * __expf(gc_v[i]); *(bf16_t*)(qp + i * 272) = f2bf(v); }
    } else {
      unsigned char* wp = smem + GD_V + d * 2;
#pragma unroll
      for (int i = 0; i < 64; ++i) *(bf16_t*)(wp + i * 272) = f2bf(-sol[i]);
      bf16_t* kd = (bf16_t*)(p.ws + OFF_KD) + (size_t)chunk * 8192 + d * 64;
      const float gl = gc_v[63];
#pragma unroll
      for (int c8 = 0; c8 < 8; ++c8) {
        float kv[8];
#pragma unroll
        for (int e = 0; e < 8; ++e) kv[e] = bf2f(*(const bf16_t*)(smem + GD_K + (8 * c8 + e) * 272 + d * 2)) * __expf(gl - gc_v[8 * c8 + e]);
        u32x4 o = {pk2(kv[0], kv[1]), pk2(kv[2], kv[3]), pk2(kv[4], kv[5]), pk2(kv[6], kv[7])};
        *(u32x4*)(kd + 8 * c8) = o;
      }
    }
    if (tid == 0) ((float*)(p.ws + OFF_GL))[chunk] = __expf(gc_s[63]);
    __syncthreads();
    {
      bf16_t* wn = (bf16_t*)(p.ws + OFF_WN) + (size_t)chunk * 8192;
      bf16_t* qd = (bf16_t*)(p.ws + OFF_QD) + (size_t)chunk * 8192;
#pragma unroll 1
      for (int i = 0; i < 4; ++i) {
        const int idx = tid + 256 * i; const int lo = (idx >> 4) * 272 + (idx & 15) * 16;
        *(u32x4*)(wn + (size_t)idx * 8) = *(const u32x4*)(smem + GD_V + lo);
        *(u32x4*)(qd + (size_t)idx * 8) = *(const u32x4*)(smem + GD_Q + lo);
      }
    }
  }
}

constexpr int SC_W = 0, SC_QD = 17408, SC_QK = 34816, SC_KD = 34816 + 9216, SC_U = 34816 + 9216 + 18432;
DI bf16x8 pack44(const f32x4& a, const f32x4& b) { u32x4 v = {pk2(a.x, a.y), pk2(a.z, a.w), pk2(b.x, b.y), pk2(b.z, b.w)}; return __builtin_bit_cast(bf16x8, v); }
DI void scan_item(const P& p, int item, unsigned char* smem, int tid) {
  const int lane = tid & 63, w = tid >> 6, fr = lane & 15, fq = lane >> 4;
  const int bh = item >> 1, hf = item & 1;
  const bf16_t* WN = (const bf16_t*)(p.ws + OFF_WN); const bf16_t* QD = (const bf16_t*)(p.ws + OFF_QD);
  const bf16_t* KD = (const bf16_t*)(p.ws + OFF_KD); const bf16_t* QK = (const bf16_t*)(p.ws + OFF_QK);
  bf16_t* UT = (bf16_t*)(p.ws + OFF_UT) + hf * 4096; const float* GL = (const float*)(p.ws + OFF_GL);
  f32x4 S[8];
#pragma unroll
  for (int dt = 0; dt < 8; ++dt) S[dt] = (f32x4){0.f, 0.f, 0.f, 0.f};
  u32x4 st[16];
  const int chunk0 = bh * 64;
#define SC_LOAD(CH) do { \
    const size_t cb = (size_t)(CH) * 8192; \
    _Pragma("unroll") for (int i = 0; i < 4; ++i) { st[i] = *(const u32x4*)(WN + cb + (size_t)(tid + 256 * i) * 8); st[4 + i] = *(const u32x4*)(QD + cb + (size_t)(tid + 256 * i) * 8); st[10 + i] = *(const u32x4*)(KD + cb + (size_t)(tid + 256 * i) * 8); } \
    _Pragma("unroll") for (int i = 0; i < 2; ++i) { st[8 + i] = *(const u32x4*)(QK + (size_t)(CH) * 4096 + (size_t)(tid + 256 * i) * 8); st[14 + i] = *(const u32x4*)(UT + cb + (size_t)(tid + 256 * i) * 8); } \
  } while (0)
#define SC_STORE() do { \
    _Pragma("unroll") for (int i = 0; i < 4; ++i) { const int idx = tid + 256 * i; const int o16 = (idx >> 4) * 272 + (idx & 15) * 16; *(u32x4*)(smem + SC_W + o16) = st[i]; *(u32x4*)(smem + SC_QD + o16) = st[4 + i]; \
      const int o8 = (idx >> 3) * 144 + (idx & 7) * 16; *(u32x4*)(smem + SC_KD + o8) = st[10 + i]; } \
    _Pragma("unroll") for (int i = 0; i < 2; ++i) { const int idx = tid + 256 * i; const int o8 = (idx >> 3) * 144 + (idx & 7) * 16; *(u32x4*)(smem + SC_QK + o8) = st[8 + i]; *(u32x4*)(smem + SC_U + o8) = st[14 + i]; } \
  } while (0)
  SC_LOAD(chunk0);
  __syncthreads();
  for (int n = 0; n < 64; ++n) {
    const int chunk = chunk0 + n;
    SC_STORE();
    __syncthreads();
    if (n + 1 < 64) SC_LOAD(chunk + 1);
    f32x4 vn[4];
#pragma unroll
    for (int ct = 0; ct < 4; ++ct) { const u32x2 u = *(const u32x2*)(smem + SC_U + (16 * w + fr) * 144 + (16 * ct + 4 * fq) * 2); vn[ct] = (f32x4){bflo(u.x), bfhi(u.x), bflo(u.y), bfhi(u.y)}; }
    const float gl = GL[chunk];
    bf16x8 Sp[4];
#pragma unroll
    for (int kk = 0; kk < 4; ++kk) Sp[kk] = pack44(S[2 * kk], S[2 * kk + 1]);
#pragma unroll
    for (int ct = 0; ct < 4; ++ct)
#pragma unroll
      for (int kk = 0; kk < 4; ++kk) {
        const unsigned char* ap = smem + SC_W + (16 * ct + fr) * 272 + (32 * kk + 4 * fq) * 2;
        vn[ct] = mfma16(mk8(*(const u32x2*)ap, *(const u32x2*)(ap + 32)), Sp[kk], vn[ct]);
      }
    bf16x8 vp[2];
    vp[0] = pack44(vn[0], vn[1]); vp[1] = pack44(vn[2], vn[3]);
#pragma unroll
    for (int ct = 0; ct < 4; ++ct) {
      f32x4 o = {0.f, 0.f, 0.f, 0.f};
#pragma unroll
      for (int kk = 0; kk < 4; ++kk) {
        const unsigned char* ap = smem + SC_QD + (16 * ct + fr) * 272 + (32 * kk + 4 * fq) * 2;
        o = mfma16(mk8(*(const u32x2*)ap, *(const u32x2*)(ap + 32)), Sp[kk], o);
      }
#pragma unroll
      for (int kc = 0; kc < 2; ++kc) {
        const unsigned char* ap = smem + SC_QK + (16 * ct + fr) * 144 + (32 * kc + 4 * fq) * 2;
        o = mfma16(mk8(*(const u32x2*)ap, *(const u32x2*)(ap + 32)), vp[kc], o);
      }
      bf16_t* op = UT + (size_t)chunk * 8192 + (size_t)(16 * ct + 4 * fq) * 64 + 16 * w + fr;
      op[0] = f2bf(o.x); op[64] = f2bf(o.y); op[128] = f2bf(o.z); op[192] = f2bf(o.w);
    }
#pragma unroll
    for (int dt = 0; dt < 8; ++dt) {
      S[dt] = S[dt] * gl;
#pragma unroll
      for (int kc = 0; kc < 2; ++kc) {
        const unsigned char* ap = smem + SC_KD + (16 * dt + fr) * 144 + (32 * kc + 4 * fq) * 2;
        S[dt] = mfma16(mk8(*(const u32x2*)ap, *(const u32x2*)(ap + 32)), vp[kc], S[dt]);
      }
    }
    __syncthreads();
  }
}

DI void phase_final(const P& p, int tid) {
  const int lane = tid & 63, wid = tid >> 6;
  float* x = p.out; const float* g = p.in[21];
  for (int row = blockIdx.x * 4 + wid; row < NTOK; row += gridDim.x * 4) {
    f32x4 v[4]; float s = 0.f;
#pragma unroll
    for (int i = 0; i < 4; ++i) { v[i] = *(const f32x4*)(x + (size_t)row * 1024 + 256 * i + 4 * lane); s += v[i].x * v[i].x + v[i].y * v[i].y + v[i].z * v[i].z + v[i].w * v[i].w; }
#pragma unroll
    for (int off = 32; off > 0; off >>= 1) s += __shfl_xor(s, off);
    const float rs = rsqrtf(s * (1.f / 1024.f) + EPSF);
#pragma unroll
    for (int i = 0; i < 4; ++i) { const f32x4 gg = *(const f32x4*)(g + 256 * i + 4 * lane); *(f32x4*)(x + (size_t)row * 1024 + 256 * i + 4 * lane) = v[i] * rs * gg; }
  }
}


#define XB_TMO      128
#define XB_XCNT(j)  (256  + 64 * (j))
#define XB_XSUB(j)  (1280 + 64 * (j))
#define XB_XGEN(j)  (2304 + 64 * (j))
#define XB_TOP      3328
#define XB_TOPGEN   3392
#define XCD_BAR_WORDS 3456
#define XB_SPIN_CAP (1u << 18)
#define LAS __attribute__((address_space(3)))
DI unsigned xb_ld(unsigned* p)              { return __hip_atomic_load(p, __ATOMIC_RELAXED, __HIP_MEMORY_SCOPE_AGENT); }
DI unsigned xb_add(unsigned* p, unsigned v) { return __hip_atomic_fetch_add(p, v, __ATOMIC_RELAXED, __HIP_MEMORY_SCOPE_AGENT); }
DI unsigned xb_xcc_id() { return (unsigned)__builtin_amdgcn_s_getreg((3 << 11) | 20) & 0xFu; }
#define XB_SPIN(cond, bar) do { unsigned _sp = 0; while (cond) { __builtin_amdgcn_s_sleep(1); \
    if ((++_sp & 255u) == 0u) { if (xb_ld(&(bar)[XB_TMO])) break; if (_sp > XB_SPIN_CAP) { atomicAdd(&(bar)[XB_TMO], 1u); break; } } } } while (0)
struct XcdBarrier { unsigned* bar; unsigned x; volatile LAS unsigned* st; };
DI XcdBarrier xcd_barrier_post(unsigned* bar, volatile LAS unsigned* st) {
  XcdBarrier b; b.bar = bar; b.x = xb_xcc_id(); b.st = st;
  if (threadIdx.x == 0) (void)xb_add(&bar[XB_XCNT(b.x)], 1u);
  return b;
}
DI void xcd_barrier_complete(unsigned* bar, unsigned x, unsigned& nloc, unsigned& nx) {
  const unsigned G = gridDim.x * gridDim.y * gridDim.z;
  unsigned sum, cnt, mine, sp = 0u;
  for (;;) {
    sum = 0u; cnt = 0u; mine = 0u;
#pragma unroll
    for (unsigned j = 0; j < 16; ++j) { const unsigned c = xb_ld(&bar[XB_XCNT(j)]); sum += c; cnt += (c > 0u) ? 1u : 0u; mine = (j == x) ? c : mine; }
    if (sum == G) break;
    __builtin_amdgcn_s_sleep(1);
    if ((++sp & 255u) == 0u) { if (xb_ld(&bar[XB_TMO])) break; if (sp > XB_SPIN_CAP) { atomicAdd(&bar[XB_TMO], 1u); break; } }
  }
  nloc = mine > 0u ? mine : 1u; nx = cnt > 0u ? cnt : 1u;
}
DI void xcd_barrier(const XcdBarrier& b) {
  asm volatile("s_waitcnt vmcnt(0)" ::: "memory");
  __syncthreads();
  if (threadIdx.x == 0) {
    unsigned* bar = b.bar;
    unsigned bx = b.x;
    asm volatile("" : "+s"(bar), "+s"(bx));
    __builtin_amdgcn_s_waitcnt(0);
    unsigned nloc = b.st[0], nx = b.st[1];
    if (nloc == 0u) { xcd_barrier_complete(bar, bx, nloc, nx); b.st[0] = nloc; b.st[1] = nx; }
    const unsigned old = xb_add(&bar[XB_XSUB(bx)], 1u);
    const unsigned gen = old / nloc;
    if (old + 1u == (gen + 1u) * nloc) {
      __builtin_amdgcn_fence(__ATOMIC_RELEASE, "agent");
      asm volatile("s_waitcnt vmcnt(0)" ::: "memory");
      const unsigned og = xb_add(&bar[XB_TOP], 1u);
      const unsigned tg = og / nx;
      if (og + 1u == (tg + 1u) * nx) xb_add(&bar[XB_TOPGEN], 1u);
      else XB_SPIN(xb_ld(&bar[XB_TOPGEN]) == tg, bar);
      __builtin_amdgcn_fence(__ATOMIC_ACQUIRE, "agent");
      xb_add(&bar[XB_XGEN(bx)], 1u);
      asm volatile("s_waitcnt vmcnt(0)" ::: "memory");
    } else {
      XB_SPIN(xb_ld(&bar[XB_XGEN(bx)]) == gen, bar);
      __builtin_amdgcn_fence(__ATOMIC_ACQUIRE, "agent");
      asm volatile("s_waitcnt vmcnt(0)" ::: "memory");
    }
  }
  __syncthreads();
}

constexpr int N_PHASES = 24;
typedef const __attribute__((address_space(4))) P* KP;
DI P loadP(KP kp) {
  P p;
#pragma unroll
  for (int i = 0; i < 22; ++i) p.in[i] = kp->in[i];
  p.out = kp->out; p.ws = kp->ws;
  return p;
}
#define SSP(k) ((float*)(p.ws + OFF_SS) + (k) * NTOK)
#define PH_BEGIN { KP kp = (KP)__builtin_amdgcn_kernarg_segment_ptr(); asm volatile("" : "+s"(kp)); \
    unsigned zz_; asm volatile("v_mov_b32 %0, 0" : "=v"(zz_)); \
    int tid = wbase + (int)__builtin_amdgcn_mbcnt_hi(~0u, __builtin_amdgcn_mbcnt_lo(~0u, zz_)); asm volatile("" : "+v"(tid)); \
    const P p = loadP(kp);
#define PH_END } xcd_barrier(xb);

__global__ void __launch_bounds__(256, 2) mega(P p_arg, int ph_lo, int ph_hi) {
  extern __shared__ __attribute__((aligned(16))) unsigned char smem[];
  __shared__ uint4 xb_words;
  cg::grid_group grid = cg::this_grid();
  if (threadIdx.x == 0) xb_words = make_uint4(0u, 0u, 0u, 0u);
  __syncthreads();
  const int wbase = __builtin_amdgcn_readfirstlane((int)(threadIdx.x & ~63u));
  XcdBarrier xb = xcd_barrier_post((unsigned*)(p_arg.ws + OFF_BAR), (volatile LAS unsigned*)&xb_words);
  if (ph_hi < 0) grid.sync();

  PH_BEGIN phase_prologue(p, smem, tid); PH_END
#if REP_PHASE == 0
  PH_BEGIN phase_prologue(p, smem, tid); PH_END
#endif
#pragma unroll 1
  for (int layer = 0; layer < 2; ++layer) {
    if (layer == 0) {
      PH_BEGIN phase_in_e(p, smem, tid); PH_END
      PH_BEGIN for (int i = blockIdx.x; i < 2048 + 1024; i += gridDim.x) { if (i < 2048) attn_item(p, i, smem, tid); else pool_item(p, i - 2048, smem, tid); } PH_END
#if REP_PHASE == 2
      PH_BEGIN for (int i = blockIdx.x; i < 2048 + 1024; i += gridDim.x) { if (i < 2048) attn_item(p, i, smem, tid); else pool_item(p, i - 2048, smem, tid); } PH_END
#endif
    } else {
#pragma unroll 1
      for (int qi = 0; qi < 4; ++qi) {
        PH_BEGIN phase_in_o(p, qi, smem, tid); PH_END
        PH_BEGIN for (int i = blockIdx.x; i < 1024; i += gridDim.x) gdn_chunk_item(p, qi, i, smem, tid); PH_END
#if REP_PHASE == 9
        if (qi == 0) { PH_BEGIN for (int i = blockIdx.x; i < 1024; i += gridDim.x) gdn_chunk_item(p, qi, i, smem, tid); PH_END }
#endif
      }
      PH_BEGIN for (int i = blockIdx.x; i < 128; i += gridDim.x) scan_item(p, i, smem, tid); PH_END
      PH_BEGIN phase_z_gate(p, smem, tid); PH_END
    }
    PH_BEGIN
      phase_resid(p, (const bf16_t*)(p.ws + (layer ? OFF_OB : OFF_CAT)), 1024, (const bf16_t*)(p.ws + (layer ? OFF_WT_OUTO : OFF_WT_OUTE)), layer ? p.out : p.in[0], SSP(1 + 3 * layer), smem, tid);
    PH_END
    PH_BEGIN phase_ffn_up(p, layer, SSP(1 + 3 * layer), smem, tid); PH_END
#if REP_PHASE == 4
    if (layer == 0) { PH_BEGIN phase_ffn_up(p, layer, SSP(1 + 3 * layer), smem, tid); PH_END }
#endif
    PH_BEGIN phase_resid(p, (const bf16_t*)(p.ws + OFF_ACT), 2816, (const bf16_t*)(p.ws + OFF_WT_DOWN) + (size_t)layer * 1024 * 2816, p.out, SSP(2 + 3 * layer), smem, tid); PH_END
    PH_BEGIN phase_ple_gate(p, layer, SSP(2 + 3 * layer), smem, tid); PH_END
#if REP_PHASE == 6
    if (layer == 0) { PH_BEGIN phase_ple_gate(p, layer, SSP(2 + 3 * layer), smem, tid); PH_END }
#endif
    PH_BEGIN phase_ple_add(p, layer, SSP(3 + 3 * layer), smem, tid); PH_END
  }
#if DUMMY_MODE >= 0
  PH_BEGIN phase_dummy(p, DUMMY_MODE, smem, tid); PH_END
#endif
  PH_BEGIN phase_final(p, tid); }
}

extern "C" void kernel_launch(void* const* d_in, const int* in_sizes, int n_in, void* d_out, int out_size, void* d_ws, size_t ws_size, hipStream_t stream) {
  static int grid_blocks = 0;
  if (!grid_blocks) {
    int dev = 0, cus = 0, per_cu = 0;
    hipGetDevice(&dev);
    hipDeviceGetAttribute(&cus, hipDeviceAttributeMultiprocessorCount, dev);
    hipFuncSetAttribute((const void*)mega, hipFuncAttributeMaxDynamicSharedMemorySize, SMEM_BYTES);
    hipOccupancyMaxActiveBlocksPerMultiprocessor(&per_cu, mega, 256, SMEM_BYTES);
    if (per_cu > 2) per_cu = 2;
    if (per_cu < 1) per_cu = 1;
    grid_blocks = cus * per_cu;
  }
  P p{};
  for (int i = 0; i < 22; ++i) p.in[i] = (const float*)d_in[i];
  p.out = (float*)d_out;
  p.ws = (unsigned char*)d_ws;
  hipMemsetAsync(p.ws + OFF_BAR, 0, XCD_BAR_WORDS * 4, stream);
#if MULTI_LAUNCH
  for (int ph = 0; ph < N_PHASES; ++ph) {
    int lo = ph, hi = ph + 1;
    void* args[] = {&p, &lo, &hi};
    hipError_t e = hipLaunchCooperativeKernel((const void*)mega, dim3(grid_blocks), dim3(256), args, SMEM_BYTES, stream);
    if (e != hipSuccess) fprintf(stderr, "launch failed: %s\n", hipGetErrorString(e));
  }
#else
  int lo = 0, hi = N_PHASES;
  void* args[] = {&p, &lo, &hi};
  hipError_t e = hipLaunchCooperativeKernel((const void*)mega, dim3(grid_blocks), dim3(256), args, SMEM_BYTES, stream);
  if (e != hipSuccess) fprintf(stderr, "launch failed: %s (grid %d)\n", hipGetErrorString(e), grid_blocks);
#endif
}
```

```cpp
#include <hip/hip_runtime.h>
#include <hip/hip_cooperative_groups.h>
#include <stdint.h>
#include <cstdio>
namespace cg = cooperative_groups;

#ifndef REP_PHASE
#define REP_PHASE -1
#endif
#ifndef MULTI_LAUNCH
#define MULTI_LAUNCH 0
#endif

#define DI __device__ __forceinline__
typedef unsigned short bf16_t;
typedef short bf16x8 __attribute__((ext_vector_type(8)));
typedef float f32x4 __attribute__((ext_vector_type(4)));
typedef float f32x2 __attribute__((ext_vector_type(2)));
typedef float f32x16 __attribute__((ext_vector_type(16)));
typedef unsigned u32x4 __attribute__((ext_vector_type(4)));
typedef unsigned u32x2 __attribute__((ext_vector_type(2)));
typedef __bf16 hbf2 __attribute__((ext_vector_type(2)));

DI unsigned pk2(float lo, float hi) { f32x2 v = {lo, hi}; hbf2 r = __builtin_convertvector(v, hbf2); return __builtin_bit_cast(unsigned, r); }
DI bf16_t f2bf(float x) { return (bf16_t)(pk2(x, 0.f) & 0xffffu); }
DI float bf2f(bf16_t v) { return __uint_as_float(((unsigned)v) << 16); }
DI float bflo(unsigned u) { return __uint_as_float(u << 16); }
DI float bfhi(unsigned u) { return __uint_as_float(u & 0xffff0000u); }
DI f32x4 mfma16(bf16x8 a, bf16x8 b, f32x4 c) { return __builtin_amdgcn_mfma_f32_16x16x32_bf16(a, b, c, 0, 0, 0); }
DI f32x16 mfma32(bf16x8 a, bf16x8 b, f32x16 c) { return __builtin_amdgcn_mfma_f32_32x32x16_bf16(a, b, c, 0, 0, 0); }
DI int crow(int reg, int hh) { return (reg & 3) + 8 * (reg >> 2) + 4 * hh; }
DI float fexp2(float x) { return __builtin_amdgcn_exp2f(x); }
DI float flog2(float x) { return __builtin_amdgcn_logf(x); }
DI float frcp(float x) { return __builtin_amdgcn_rcpf(x); }
DI float fexp(float x) { return __builtin_amdgcn_exp2f(x * 1.4426950408889634f); }
DI float sigmoidf_(float x) { return frcp(1.f + fexp(-x)); }
DI float siluf_(float x) { return x * frcp(1.f + fexp(-x)); }
DI bf16x8 mk8(u32x2 lo, u32x2 hi) { u32x4 v = {lo.x, lo.y, hi.x, hi.y}; return __builtin_bit_cast(bf16x8, v); }
DI bf16x8 pack_step(const f32x16& x, int s) {
  u32x4 v;
  v.x = pk2(x[8 * s + 0], x[8 * s + 1]); v.y = pk2(x[8 * s + 2], x[8 * s + 3]);
  v.z = pk2(x[8 * s + 4], x[8 * s + 5]); v.w = pk2(x[8 * s + 6], x[8 * s + 7]);
  return __builtin_bit_cast(bf16x8, v);
}

constexpr int SEQ = 4096, DM = 1024, NTOK = 32768;
constexpr int SMEM_BYTES = 73728;
constexpr float EPSF = 1e-6f;

constexpr size_t OFF_WT_INE = 0;
constexpr size_t OFF_WT_OUTE = OFF_WT_INE + 2048ull * 1024 * 2;
constexpr size_t OFF_WT_INO = OFF_WT_OUTE + 1024ull * 1024 * 2;
constexpr size_t OFF_WT_Z = OFF_WT_INO + 3328ull * 1024 * 2;
constexpr size_t OFF_WT_OUTO = OFF_WT_Z + 1024ull * 1024 * 2;
constexpr size_t OFF_WT_UP = OFF_WT_OUTO + 1024ull * 1024 * 2;
constexpr size_t OFF_WT_DOWN = OFF_WT_UP + 2ull * 5632 * 1024 * 2;
constexpr size_t OFF_WT_PLEG = OFF_WT_DOWN + 2ull * 1024 * 2816 * 2;
constexpr size_t OFF_WT_PLE = OFF_WT_PLEG + 2ull * 1024 * 1024 * 2;
constexpr size_t OFF_WT_POOL = OFF_WT_PLE + 2ull * 1024 * 256 * 2;
constexpr size_t OFF_XB = OFF_WT_POOL + 4ull * 128 * 128 * 2;
constexpr size_t OFF_PB = OFF_XB + 32768ull * 1024 * 2;
constexpr size_t OFF_SS = OFF_PB + 2ull * 32768 * 256 * 2;
constexpr size_t OFF_GB = OFF_SS + 7ull * 32768 * 4;
constexpr size_t OFF_GL = OFF_GB + 32768ull * 16 * 4;
constexpr size_t OFF_BAR = OFF_GL + 4096 * 4;
constexpr size_t OFF_R1 = OFF_BAR + 16384;
constexpr size_t OFF_PROJ0 = OFF_R1;
constexpr size_t OFF_VT = OFF_PROJ0 + 32768ull * 1536 * 2;
constexpr size_t OFF_CAT = OFF_VT + 32768ull * 512 * 2;
constexpr size_t OFF_ACT = OFF_R1;
constexpr size_t OFF_UT = OFF_R1;
constexpr size_t OFF_WN = OFF_UT + 67108864ull;
constexpr size_t OFF_QD = OFF_WN + 67108864ull;
constexpr size_t OFF_KD = OFF_QD + 67108864ull;
constexpr size_t OFF_QK = OFF_KD + 67108864ull;
constexpr size_t OFF_QKV = OFF_QK + 33554432ull;
constexpr size_t OFF_GATE = OFF_R1;
constexpr size_t OFF_OB = OFF_WN;

struct P {
  const float* in[22];
  float* out;
  unsigned char* ws;
};

DI void mma_stage(f32x4 (&acc)[4][4], const unsigned char* cA, const unsigned char* cB, int a_rd, int b_rd, int sw0, int sw1) {
#pragma unroll
  for (int ks = 0; ks < 2; ++ks) {
    const int sw = ks ? sw1 : sw0;
    bf16x8 af[4], bfr[4];
#pragma unroll
    for (int m = 0; m < 4; ++m) af[m] = *(const bf16x8*)(cA + a_rd + m * 2048 + sw);
#pragma unroll
    for (int n = 0; n < 4; ++n) bfr[n] = *(const bf16x8*)(cB + b_rd + n * 2048 + sw);
#pragma unroll
    for (int m = 0; m < 4; ++m)
#pragma unroll
      for (int n = 0; n < 4; ++n) acc[m][n] = mfma16(bfr[n], af[m], acc[m][n]);
  }
}
DI void zero_acc(f32x4 (&acc)[4][4]) {
#pragma unroll
  for (int m = 0; m < 4; ++m)
#pragma unroll
    for (int n = 0; n < 4; ++n) acc[m][n] = (f32x4){0.f, 0.f, 0.f, 0.f};
}

constexpr int G_STAGE = 24576, G_AB = 8192;
DI void glds16(const bf16_t* g, unsigned char* l) { __builtin_amdgcn_global_load_lds((const unsigned*)g, (unsigned*)l, 16, 0, 0); }
DI void zero_acc8(f32x4 (&acc)[4][8]) {
#pragma unroll
  for (int m = 0; m < 4; ++m)
#pragma unroll
    for (int n = 0; n < 8; ++n) acc[m][n] = (f32x4){0.f, 0.f, 0.f, 0.f};
}
DI void gemm_core(f32x4 (&acc)[4][8], const bf16_t* pa0, const bf16_t* pa1, const bf16_t* pb0, long ldb64, int nk, unsigned char* smem, int tid) {
  const int lane = tid & 63, wid = tid >> 6, wr = wid >> 1, wc = wid & 1, fr = lane & 15, fq = lane >> 4;
  const int lrow = tid >> 2, lc = tid & 3;
  const int csrc = 8 * (lc ^ ((-(lrow >> 2)) & 3));
  pa0 += csrc; pa1 += csrc; pb0 += csrc;
  unsigned char* dA = smem + tid * 16; unsigned char* dB = smem + G_AB + tid * 16;
  asm volatile("s_waitcnt vmcnt(0)" ::: "memory");
  __builtin_amdgcn_s_barrier();
#define G_ISSUE(KT, ST) do { const int ko_ = (KT) * 32; unsigned char* a_ = dA + (ST) * G_STAGE; unsigned char* b_ = dB + (ST) * G_STAGE; \
    glds16(pa0 + ko_, a_); glds16(pa1 + ko_, a_ + 4096); \
    glds16(pb0 + ko_, b_); glds16(pb0 + ldb64 + ko_, b_ + 4096); glds16(pb0 + 2 * ldb64 + ko_, b_ + 8192); glds16(pb0 + 3 * ldb64 + ko_, b_ + 12288); } while (0)
  G_ISSUE(0, 0);
  G_ISSUE(1, 1);
  const int swz = (fq ^ ((-(fr >> 2)) & 3)) << 4;
  const int a_rd = (64 * wr + fr) * 64 + swz, b_rd = G_AB + (128 * wc + fr) * 64 + swz;
  int st = 0;
#pragma unroll 1
  for (int kt = 0; kt < nk; ++kt) {
    if (kt + 1 < nk) asm volatile("s_waitcnt vmcnt(6)" ::: "memory"); else asm volatile("s_waitcnt vmcnt(0)" ::: "memory");
    __builtin_amdgcn_s_barrier();
    if (kt + 2 < nk) { const int s2 = (st >= 1) ? st - 1 : 2; G_ISSUE(kt + 2, s2); }
    const unsigned char* cs = smem + st * G_STAGE;
    bf16x8 af[4], bfr[8];
#pragma unroll
    for (int m = 0; m < 4; ++m) af[m] = *(const bf16x8*)(cs + a_rd + m * 1024);
#pragma unroll
    for (int n = 0; n < 8; ++n) bfr[n] = *(const bf16x8*)(cs + b_rd + n * 1024);
    __builtin_amdgcn_s_setprio(1);
#pragma unroll
    for (int m = 0; m < 4; ++m)
#pragma unroll
      for (int n = 0; n < 8; ++n) acc[m][n] = mfma16(bfr[n], af[m], acc[m][n]);
    __builtin_amdgcn_s_setprio(0);
    st = (st == 2) ? 0 : st + 1;
  }
  __syncthreads();
}

DI int permrow(int r) { const int s = r & 31; return (r & ~31) | (((s >> 2) & 3) << 3) | ((s >> 4) << 2) | (s & 3); }
DI void tile_decode(int i, int MT, int NT, int& mt, int& nt) {
  const int g = i / (64 * NT); const int il = i - g * 64 * NT; int gm = MT - 64 * g; gm = gm < 64 ? gm : 64;
  nt = il / gm; mt = 64 * g + (il - nt * gm);
}

DI void transpose_convert(const float* __restrict__ W, int ldw, int K, int mode, int coloff, const float* __restrict__ gain,
                          bf16_t* __restrict__ dst, int kt, int ntile, float* tile, int tid) {
  const int n0 = ntile * 64;
  const int tx = tid & 63, ty = tid >> 6;
  const int n = n0 + tx;
  int src; bool valid = true;
  if (mode == 0) { src = coloff + n; }
  else if (mode == 1) { const int j = n >> 8, nl = n & 255, wc = nl >> 7, hp = (nl >> 6) & 1, nt4 = (nl & 63) >> 4, fr = nl & 15; const int ch = 128 * j + 64 * wc + 32 * hp + 16 * (nt4 & 1) + fr; src = (nt4 < 2) ? ch : 2816 + ch; }
  else { if (n < 3072) src = n; else if (n < 3088) src = 4096 + (n - 3072); else { src = 0; valid = false; } }
  __syncthreads();
#pragma unroll
  for (int i = 0; i < 16; ++i) {
    const int kl = ty + 4 * i, k = 64 * kt + kl;
    float v = 0.f;
    if (valid) { v = W[(size_t)k * ldw + src]; if (gain) v *= gain[k]; }
    tile[kl * 65 + tx] = v;
  }
  __syncthreads();
  const int nl = tid >> 2, kc = tid & 3;
#pragma unroll
  for (int cc = 0; cc < 2; ++cc) {
    const int kch = kc * 2 + cc;
    float v[8];
#pragma unroll
    for (int i = 0; i < 8; ++i) v[i] = tile[(8 * kch + i) * 65 + nl];
    u32x4 o = {pk2(v[0], v[1]), pk2(v[2], v[3]), pk2(v[4], v[5]), pk2(v[6], v[7])};
    *(u32x4*)(dst + (size_t)(n0 + nl) * K + 64 * kt + 8 * kch) = o;
  }
}

DI void convert_list(const P& p, float* tile, int tid, int list, int g0, int g1, int blk, int nblk) {
  for (int g = g0 + blk; g < g1; g += nblk) {
    int task, base;
    if (list == 0) {
      if (g < 512) { task = 0; base = 0; } else if (g < 768) { task = 1; base = 512; } else if (g < 1600) { task = 2; base = 768; }
      else if (g < 3008) { task = 5; base = 1600; } else if (g < 3712) { task = 7; base = 3008; } else if (g < 3968) { task = 9; base = 3712; }
      else if (g < 4032) { task = 11; base = 3968; } else { task = 13 + ((g - 4032) >> 2); base = 4032 + 4 * (task - 13); }
    } else {
      if (g < 256) { task = 3; base = 0; } else if (g < 512) { task = 4; base = 256; } else if (g < 1920) { task = 6; base = 512; }
      else if (g < 2624) { task = 8; base = 1920; } else if (g < 2880) { task = 10; base = 2624; } else { task = 12; base = 2880; }
    }
    const float* W; int ldw, K, mode = 0, coloff = 0; const float* gain = nullptr; size_t doff;
    switch (task) {
      case 0: W = p.in[3]; ldw = 2048; K = 1024; gain = p.in[2]; doff = OFF_WT_INE; break;
      case 1: W = p.in[6]; ldw = 1024; K = 1024; doff = OFF_WT_OUTE; break;
      case 2: W = p.in[8]; ldw = 4112; K = 1024; mode = 2; gain = p.in[7]; doff = OFF_WT_INO; break;
      case 3: W = p.in[8]; ldw = 4112; K = 1024; coloff = 3072; gain = p.in[7]; doff = OFF_WT_Z; break;
      case 4: W = p.in[13]; ldw = 1024; K = 1024; doff = OFF_WT_OUTO; break;
      case 5: W = p.in[15]; ldw = 5632; K = 1024; mode = 1; gain = p.in[14]; doff = OFF_WT_UP; break;
      case 6: W = p.in[15] + 1024ull * 5632; ldw = 5632; K = 1024; mode = 1; gain = p.in[14] + 1024; doff = OFF_WT_UP + 5632ull * 1024 * 2; break;
      case 7: W = p.in[17]; ldw = 1024; K = 2816; doff = OFF_WT_DOWN; break;
      case 8: W = p.in[17] + 2816ull * 1024; ldw = 1024; K = 2816; doff = OFF_WT_DOWN + 1024ull * 2816 * 2; break;
      case 9: W = p.in[19]; ldw = 1024; K = 1024; gain = p.in[18]; doff = OFF_WT_PLEG; break;
      case 10: W = p.in[19] + 1024ull * 1024; ldw = 1024; K = 1024; gain = p.in[18] + 1024; doff = OFF_WT_PLEG + 1024ull * 1024 * 2; break;
      case 11: W = p.in[20]; ldw = 1024; K = 256; doff = OFF_WT_PLE; break;
      case 12: W = p.in[20] + 256ull * 1024; ldw = 1024; K = 256; doff = OFF_WT_PLE + 1024ull * 256 * 2; break;
      default: W = p.in[4] + (size_t)(task - 13) * 128 * 128; ldw = 128; K = 128; doff = OFF_WT_POOL + (size_t)(task - 13) * 128 * 128 * 2; break;
    }
    const int nkt = K / 64; const int t = g - base;
    transpose_convert(W, ldw, K, mode, coloff, gain, (bf16_t*)(p.ws + doff), t % nkt, t / nkt, tile, tid);
  }
}

DI void phase_prologue(const P& p, unsigned char* smem, int tid) {
  float* tile = (float*)smem;
  bf16_t* wsb = (bf16_t*)p.ws;
  convert_list(p, tile, tid, 0, 0, 4048, (int)blockIdx.x, (int)gridDim.x);
  {
    const float* x = p.in[0]; bf16_t* xb = (bf16_t*)(p.ws + OFF_XB); float* ss = (float*)(p.ws + OFF_SS);
    const int lane = tid & 63, wid = tid >> 6;
    for (int row = blockIdx.x * 4 + wid; row < NTOK; row += gridDim.x * 4) {
      float s = 0.f;
#pragma unroll
      for (int i = 0; i < 4; ++i) {
        const f32x4 v = *(const f32x4*)(x + (size_t)row * 1024 + 256 * i + 4 * lane);
        s += v.x * v.x + v.y * v.y + v.z * v.z + v.w * v.w;
        u32x2 o = {pk2(v.x, v.y), pk2(v.z, v.w)};
        *(u32x2*)(xb + (size_t)row * 1024 + 256 * i + 4 * lane) = o;
      }
#pragma unroll
      for (int off = 32; off > 0; off >>= 1) s += __shfl_xor(s, off);
      if (lane == 0) ss[row] = s;
    }
    for (int i = blockIdx.x * 256 + tid; i < 6 * NTOK; i += gridDim.x * 256) ss[NTOK + i] = 0.f;
    const float* pp = p.in[1]; bf16_t* pb = (bf16_t*)(p.ws + OFF_PB);
    const size_t n4 = 2ull * 32768 * 256 / 4;
    for (size_t i = (size_t)blockIdx.x * 256 + tid; i < n4; i += (size_t)gridDim.x * 256) {
      const f32x4 v = *(const f32x4*)(pp + 4 * i);
      u32x2 o = {pk2(v.x, v.y), pk2(v.z, v.w)};
      *(u32x2*)(pb + 4 * i) = o;
    }
  }
}

#define GEMM_IDS const int lrow = tid >> 2;
#define EPI_IDS int tid_e = tid; asm volatile("" : "+v"(tid_e)); const int lane = tid_e & 63, wid = tid_e >> 6, wr = wid >> 1, wc = wid & 1, fr = lane & 15, fq = lane >> 4; (void)lane; (void)wr; (void)wc; (void)fr; (void)fq;

DI void phase_in_e(const P& p, unsigned char* smem, int tid) {
  GEMM_IDS
  const bf16_t* xb = (const bf16_t*)(p.ws + OFF_XB); const bf16_t* wt = (const bf16_t*)(p.ws + OFF_WT_INE);
  const float* ss = (const float*)(p.ws + OFF_SS);
  bf16_t* proj = (bf16_t*)(p.ws + OFF_PROJ0); bf16_t* vT = (bf16_t*)(p.ws + OFF_VT);
  for (int i = blockIdx.x; i < 256 * 8; i += gridDim.x) {
    int mt, nt; tile_decode(i, 256, 8, mt, nt);
    const int m0 = mt * 128, n0 = nt * 256;
    const bf16_t* pa = xb + (size_t)(m0 + lrow) * 1024;
    f32x4 acc[4][8]; zero_acc8(acc);
    gemm_core(acc, pa, pa + 64 * 1024, wt + (size_t)(n0 + permrow(lrow)) * 1024, 64 * 1024, 32, smem, tid);
    EPI_IDS
    const float qs = (n0 >= 512 && n0 < 1024) ? 0.18033688011112042f : 1.f;
#pragma unroll
    for (int m = 0; m < 4; ++m) {
      const int row = m0 + 64 * wr + 16 * m + fr;
      const float rs = rsqrtf(ss[row] * (1.f / 1024.f) + EPSF) * qs;
#pragma unroll
      for (int q = 0; q < 4; ++q) {
        const int col = n0 + 128 * wc + 32 * q + 8 * fq;
        const f32x4 v0 = acc[m][2 * q] * rs, v1 = acc[m][2 * q + 1] * rs;
        if (n0 < 1536) {
          u32x4 o = {pk2(v0.x, v0.y), pk2(v0.z, v0.w), pk2(v1.x, v1.y), pk2(v1.z, v1.w)};
          *(u32x4*)(proj + (size_t)row * 1536 + col) = o;
        } else {
          const int cc = col - 1536; const int bh = (row >> 12) * 8 + (cc >> 6), d = cc & 63, t = row & 4095;
          bf16_t* vp = vT + ((size_t)bh * 64 + d) * 4096 + t;
          vp[0] = f2bf(v0.x); vp[4096] = f2bf(v0.y); vp[8192] = f2bf(v0.z); vp[12288] = f2bf(v0.w);
          vp[16384] = f2bf(v1.x); vp[20480] = f2bf(v1.y); vp[24576] = f2bf(v1.z); vp[28672] = f2bf(v1.w);
        }
      }
    }
  }
}

DI void phase_resid(const P& p, const bf16_t* A, int K, const bf16_t* wt, const float* xold, float* ssn, unsigned char* smem, int tid) {
  GEMM_IDS
  bf16_t* xb = (bf16_t*)(p.ws + OFF_XB); float* xnew = p.out;
  for (int i = blockIdx.x; i < 256 * 4; i += gridDim.x) {
    int mt, nt; tile_decode(i, 256, 4, mt, nt);
    const int m0 = mt * 128, n0 = nt * 256;
    const bf16_t* pa = A + (size_t)(m0 + lrow) * K;
    f32x4 acc[4][8]; zero_acc8(acc);
    gemm_core(acc, pa, pa + 64 * (size_t)K, wt + (size_t)(n0 + permrow(lrow)) * K, 64 * (long)K, K / 32, smem, tid);
    EPI_IDS
#pragma unroll
    for (int m = 0; m < 4; ++m) {
      const int row = m0 + 64 * wr + 16 * m + fr;
      float s = 0.f;
#pragma unroll
      for (int q = 0; q < 4; ++q) {
        const int col = n0 + 128 * wc + 32 * q + 8 * fq;
        const f32x4 v0 = *(const f32x4*)(xold + (size_t)row * 1024 + col) + acc[m][2 * q];
        const f32x4 v1 = *(const f32x4*)(xold + (size_t)row * 1024 + col + 4) + acc[m][2 * q + 1];
        *(f32x4*)(xnew + (size_t)row * 1024 + col) = v0;
        *(f32x4*)(xnew + (size_t)row * 1024 + col + 4) = v1;
        u32x4 o = {pk2(v0.x, v0.y), pk2(v0.z, v0.w), pk2(v1.x, v1.y), pk2(v1.z, v1.w)};
        *(u32x4*)(xb + (size_t)row * 1024 + col) = o;
        s += v0.x * v0.x + v0.y * v0.y + v0.z * v0.z + v0.w * v0.w + v1.x * v1.x + v1.y * v1.y + v1.z * v1.z + v1.w * v1.w;
      }
      s += __shfl_xor(s, 16); s += __shfl_xor(s, 32);
      if (fq == 0) atomicAdd(ssn + row, s);
      __builtin_amdgcn_sched_barrier(0);
    }
  }
}

DI void phase_ffn_up(const P& p, int layer, const float* ssc, unsigned char* smem, int tid) {
  GEMM_IDS
  const bf16_t* xb = (const bf16_t*)(p.ws + OFF_XB); const bf16_t* wt = (const bf16_t*)(p.ws + OFF_WT_UP) + (size_t)layer * 5632 * 1024;
  bf16_t* act = (bf16_t*)(p.ws + OFF_ACT);
  const float* cw = p.in[16] + (size_t)layer * 3 * 5632;
  float* Cs = (float*)smem;
  for (int i = blockIdx.x; i < 264 * 22; i += gridDim.x) {
    int mt, nt; tile_decode(i, 264, 22, mt, nt);
    const int b = mt / 33, mi = mt - b * 33;
    const int t0 = 126 * mi - 2;
    const bf16_t* pa[2];
#pragma unroll
    for (int j = 0; j < 2; ++j) { int t = t0 + lrow + 64 * j; t = t < 0 ? 0 : (t > 4095 ? 4095 : t); pa[j] = xb + (size_t)(b * 4096 + t) * 1024; }
    f32x4 acc[4][8]; zero_acc8(acc);
    gemm_core(acc, pa[0], pa[1], wt + (size_t)(nt * 256 + lrow) * 1024, 64 * 1024, 32, smem, tid);
    EPI_IDS
    float rsv[4];
#pragma unroll
    for (int m = 0; m < 4; ++m) {
      int t = t0 + 64 * wr + 16 * m + fr; const bool neg = t < 0; t = t < 0 ? 0 : (t > 4095 ? 4095 : t);
      rsv[m] = neg ? 0.f : rsqrtf(ssc[b * 4096 + t] * (1.f / 1024.f) + EPSF);
    }
#pragma unroll
    for (int hp = 0; hp < 2; ++hp) {
      if (hp) __syncthreads();
#pragma unroll
      for (int m = 0; m < 4; ++m) {
        const int lr = 64 * wr + 16 * m + fr;
#pragma unroll
        for (int n = 0; n < 4; ++n) *(f32x4*)(Cs + lr * 132 + 64 * wc + 16 * n + 4 * fq) = acc[m][4 * hp + n] * rsv[m];
      }
      __syncthreads();
      const int cl = tid & 63, rg = tid >> 6;
      const int gcol = 64 * (cl >> 5) + 16 * ((cl & 31) >> 4) + (cl & 15), vcol = gcol + 32;
      const int ch = nt * 128 + 64 * (cl >> 5) + 32 * hp + (cl & 31);
      const float wg0 = cw[ch], wg1 = cw[5632 + ch], wg2 = cw[2 * 5632 + ch];
      const float wv0 = cw[2816 + ch], wv1 = cw[5632 + 2816 + ch], wv2 = cw[2 * 5632 + 2816 + ch];
      const int lr0 = 2 + 32 * rg;
      float g2 = Cs[(lr0 - 2) * 132 + gcol], g1 = Cs[(lr0 - 1) * 132 + gcol];
      float v2 = Cs[(lr0 - 2) * 132 + vcol], v1 = Cs[(lr0 - 1) * 132 + vcol];
      for (int r = 0; r < 32; ++r) {
        const int lr = lr0 + r; const int t = t0 + lr;
        if (lr >= 128 || t > 4095) break;
        const float g0 = Cs[lr * 132 + gcol], v0 = Cs[lr * 132 + vcol];
        const float yg = wg0 * g2 + wg1 * g1 + wg2 * g0;
        const float yv = wv0 * v2 + wv1 * v1 + wv2 * v0;
        act[(size_t)(b * 4096 + t) * 2816 + ch] = f2bf(siluf_(yg) * yv);
        g2 = g1; g1 = g0; v2 = v1; v1 = v0;
      }
    }
  }
}

DI void phase_ple_gate(const P& p, int layer, const float* ssc, unsigned char* smem, int tid) {
  GEMM_IDS
  const bf16_t* xb = (const bf16_t*)(p.ws + OFF_XB);
  const bf16_t* wg = (const bf16_t*)(p.ws + OFF_WT_PLEG) + (size_t)layer * 1024 * 1024;
  bf16_t* gate = (bf16_t*)(p.ws + OFF_GATE);
  for (int i = blockIdx.x; i < 256 * 4; i += gridDim.x) {
    int mt, nt; tile_decode(i, 256, 4, mt, nt);
    const int m0 = mt * 128, n0 = nt * 256;
    const bf16_t* pa = xb + (size_t)(m0 + lrow) * 1024;
    f32x4 acc[4][8]; zero_acc8(acc);
    gemm_core(acc, pa, pa + 64 * 1024, wg + (size_t)(n0 + permrow(lrow)) * 1024, 64 * 1024, 32, smem, tid);
    EPI_IDS
#pragma unroll
    for (int m = 0; m < 4; ++m) {
      const int row = m0 + 64 * wr + 16 * m + fr;
      const float rs = rsqrtf(ssc[row] * (1.f / 1024.f) + EPSF);
#pragma unroll
      for (int q = 0; q < 4; ++q) {
        const int col = n0 + 128 * wc + 32 * q + 8 * fq;
        const f32x4 v0 = acc[m][2 * q] * rs, v1 = acc[m][2 * q + 1] * rs;
        u32x4 o = {pk2(sigmoidf_(v0.x), sigmoidf_(v0.y)), pk2(sigmoidf_(v0.z), sigmoidf_(v0.w)), pk2(sigmoidf_(v1.x), sigmoidf_(v1.y)), pk2(sigmoidf_(v1.z), sigmoidf_(v1.w))};
        *(u32x4*)(gate + (size_t)row * 1024 + col) = o;
      }
    }
  }
}

DI void phase_ple_add(const P& p, int layer, float* ssn, unsigned char* smem, int tid) {
  GEMM_IDS
  bf16_t* xb = (bf16_t*)(p.ws + OFF_XB);
  const bf16_t* wp = (const bf16_t*)(p.ws + OFF_WT_PLE) + (size_t)layer * 1024 * 256;
  const bf16_t* pb = (const bf16_t*)(p.ws + OFF_PB) + (size_t)layer * 32768 * 256;
  const bf16_t* gate = (const bf16_t*)(p.ws + OFF_GATE);
  float* x = p.out;
  for (int i = blockIdx.x; i < 256 * 4; i += gridDim.x) {
    int mt, nt; tile_decode(i, 256, 4, mt, nt);
    const int m0 = mt * 128, n0 = nt * 256;
    const bf16_t* pa = pb + (size_t)(m0 + lrow) * 256;
    f32x4 acc[4][8]; zero_acc8(acc);
    gemm_core(acc, pa, pa + 64 * 256, wp + (size_t)(n0 + permrow(lrow)) * 256, 64 * 256, 8, smem, tid);
    EPI_IDS
#pragma unroll
    for (int m = 0; m < 4; ++m) {
      const int row = m0 + 64 * wr + 16 * m + fr;
      float s = 0.f;
#pragma unroll
      for (int q = 0; q < 4; ++q) {
        const int col = n0 + 128 * wc + 32 * q + 8 * fq;
        const u32x4 gp = *(const u32x4*)(gate + (size_t)row * 1024 + col);
        const f32x4 g0 = {bflo(gp.x), bfhi(gp.x), bflo(gp.y), bfhi(gp.y)}, g1 = {bflo(gp.z), bfhi(gp.z), bflo(gp.w), bfhi(gp.w)};
        const f32x4 v0 = *(const f32x4*)(x + (size_t)row * 1024 + col) + acc[m][2 * q] * g0;
        const f32x4 v1 = *(const f32x4*)(x + (size_t)row * 1024 + col + 4) + acc[m][2 * q + 1] * g1;
        *(f32x4*)(x + (size_t)row * 1024 + col) = v0;
        *(f32x4*)(x + (size_t)row * 1024 + col + 4) = v1;
        if (layer == 0) {
          u32x4 o = {pk2(v0.x, v0.y), pk2(v0.z, v0.w), pk2(v1.x, v1.y), pk2(v1.z, v1.w)};
          *(u32x4*)(xb + (size_t)row * 1024 + col) = o;
        }
        s += v0.x * v0.x + v0.y * v0.y + v0.z * v0.z + v0.w * v0.w + v1.x * v1.x + v1.y * v1.y + v1.z * v1.z + v1.w * v1.w;
      }
      s += __shfl_xor(s, 16); s += __shfl_xor(s, 32);
      if (fq == 0 && layer == 0) atomicAdd(ssn + row, s);
      __builtin_amdgcn_sched_barrier(0);
    }
  }
}

DI void phase_in_o(const P& p, int qi, unsigned char* smem, int tid) {
  GEMM_IDS
  const bf16_t* xb = (const bf16_t*)(p.ws + OFF_XB); const bf16_t* wt = (const bf16_t*)(p.ws + OFF_WT_INO);
  const float* ssc = (const float*)(p.ws + OFF_SS) + 3 * NTOK;
  bf16_t* qkv = (bf16_t*)(p.ws + OFF_QKV); float* gb = (float*)(p.ws + OFF_GB);
  const float* a_log = p.in[10]; const float* dt_bias = p.in[11];
  for (int i = blockIdx.x; i < 64 * 13; i += gridDim.x) {
    int mt, nt; tile_decode(i, 64, 13, mt, nt);
    const int mq0 = mt * 128, m0 = qi * 8192 + mq0, n0 = nt * 256;
    const bf16_t* pa = xb + (size_t)(m0 + lrow) * 1024;
    f32x4 acc[4][8]; zero_acc8(acc);
    gemm_core(acc, pa, pa + 64 * 1024, wt + (size_t)(n0 + permrow(lrow)) * 1024, 64 * 1024, 32, smem, tid);
    EPI_IDS
#pragma unroll
    for (int m = 0; m < 4; ++m) {
      const int rl = 64 * wr + 16 * m + fr;
      const float rs = rsqrtf(ssc[m0 + rl] * (1.f / 1024.f) + EPSF);
      if (nt < 12) {
#pragma unroll
        for (int q = 0; q < 4; ++q) {
          const int col = n0 + 128 * wc + 32 * q + 8 * fq;
          const f32x4 v0 = acc[m][2 * q] * rs, v1 = acc[m][2 * q + 1] * rs;
          u32x4 o = {pk2(v0.x, v0.y), pk2(v0.z, v0.w), pk2(v1.x, v1.y), pk2(v1.z, v1.w)};
          *(u32x4*)(qkv + (size_t)(mq0 + rl) * 3072 + col) = o;
        }
      } else if (wc == 0 && fq < 2) {
        const f32x4 v0 = acc[m][0] * rs, v1 = acc[m][1] * rs;
        float o[8];
#pragma unroll
        for (int j = 0; j < 8; ++j) {
          const float vv = j < 4 ? v0[j] : v1[j - 4];
          if (fq == 0) o[j] = sigmoidf_(vv);
          else {
            const float xx = vv + dt_bias[j];
            const float sp = fmaxf(xx, 0.f) + log1pf(__expf(-fabsf(xx)));
            o[j] = -__expf(a_log[j]) * sp;
          }
        }
        float* gp = gb + (size_t)(m0 + rl) * 16 + 8 * fq;
        *(f32x4*)gp = (f32x4){o[0], o[1], o[2], o[3]}; *(f32x4*)(gp + 4) = (f32x4){o[4], o[5], o[6], o[7]};
      }
    }
  }
}

DI void phase_z_gate(const P& p, unsigned char* smem, int tid) {
  GEMM_IDS
  const bf16_t* xb = (const bf16_t*)(p.ws + OFF_XB); const bf16_t* wt = (const bf16_t*)(p.ws + OFF_WT_Z);
  const float* ssc = (const float*)(p.ws + OFF_SS) + 3 * NTOK;
  const bf16_t* ob_in = (const bf16_t*)(p.ws + OFF_UT);
  bf16_t* ob = (bf16_t*)(p.ws + OFF_OB);
  const float* nw = p.in[12];
  for (int i = blockIdx.x; i < 256 * 4; i += gridDim.x) {
    int mt, nt; tile_decode(i, 256, 4, mt, nt);
    const int m0 = mt * 128, n0 = nt * 256;
    const bf16_t* pa = xb + (size_t)(m0 + lrow) * 1024;
    f32x4 acc[4][8]; zero_acc8(acc);
    gemm_core(acc, pa, pa + 64 * 1024, wt + (size_t)(n0 + permrow(lrow)) * 1024, 64 * 1024, 32, smem, tid);
    EPI_IDS
    const int hd = 2 * nt + wc;
#pragma unroll
    for (int m = 0; m < 4; ++m) {
      const int row = m0 + 64 * wr + 16 * m + fr;
      const int chunk = ((row >> 12) * 8 + hd) * 64 + ((row & 4095) >> 6);
      const bf16_t* op = ob_in + (size_t)chunk * 8192 + (row & 63) * 64 + 8 * fq;
      u32x4 ov[4];
      float s = 0.f;
#pragma unroll
      for (int q = 0; q < 4; ++q) {
        ov[q] = *(const u32x4*)(op + (q >> 1) * 4096 + 32 * (q & 1));
        const float a0 = bflo(ov[q].x), a1 = bfhi(ov[q].x), a2 = bflo(ov[q].y), a3 = bfhi(ov[q].y), a4 = bflo(ov[q].z), a5 = bfhi(ov[q].z), a6 = bflo(ov[q].w), a7 = bfhi(ov[q].w);
        s += a0 * a0 + a1 * a1 + a2 * a2 + a3 * a3 + a4 * a4 + a5 * a5 + a6 * a6 + a7 * a7;
      }
      s += __shfl_xor(s, 16); s += __shfl_xor(s, 32);
      const float on = rsqrtf(s * (1.f / 128.f) + EPSF);
      const float rs = rsqrtf(ssc[row] * (1.f / 1024.f) + EPSF);
#pragma unroll
      for (int q = 0; q < 4; ++q) {
        const int cl = 32 * q + 8 * fq;
        const f32x4 z0 = acc[m][2 * q] * rs, z1 = acc[m][2 * q + 1] * rs;
        const f32x4 w0 = *(const f32x4*)(nw + cl), w1 = *(const f32x4*)(nw + cl + 4);
        const f32x4 o0 = {bflo(ov[q].x), bfhi(ov[q].x), bflo(ov[q].y), bfhi(ov[q].y)}, o1 = {bflo(ov[q].z), bfhi(ov[q].z), bflo(ov[q].w), bfhi(ov[q].w)};
        float r[8];
#pragma unroll
        for (int j = 0; j < 4; ++j) { r[j] = o0[j] * on * w0[j] * siluf_(z0[j]); r[4 + j] = o1[j] * on * w1[j] * siluf_(z1[j]); }
        u32x4 o = {pk2(r[0], r[1]), pk2(r[2], r[3]), pk2(r[4], r[5]), pk2(r[6], r[7])};
        *(u32x4*)(ob + (size_t)row * 1024 + n0 + 128 * wc + cl) = o;
      }
      __builtin_amdgcn_sched_barrier(0);
    }
  }
}

#ifndef DUMMY_MODE
#define DUMMY_MODE -1
#endif
DI void phase_dummy(const P& p, int mode, unsigned char* smem, int tid) {
  GEMM_IDS
  const bf16_t* xb = (const bf16_t*)(p.ws + OFF_XB);
  const bf16_t* wg = (const bf16_t*)(p.ws + OFF_WT_PLEG);
  for (int i = blockIdx.x; i < 256 * 4; i += gridDim.x) {
    int mt, nt; tile_decode(i, 256, 4, mt, nt);
    if (mode == 1) { mt = 0; nt = 0; }
    if (mode == 2) { mt = blockIdx.x & 255; nt = 0; }
    const int m0 = mt * 128, n0 = nt * 256;
    const bf16_t* pa = xb + (size_t)(m0 + lrow) * 1024;
    f32x4 acc[4][8]; zero_acc8(acc);
    gemm_core(acc, pa, pa + 64 * 1024, wg + (size_t)(n0 + lrow) * 1024, 64 * 1024, 32, smem, tid);
    EPI_IDS
    float s = 0.f;
#pragma unroll
    for (int m = 0; m < 4; ++m)
#pragma unroll
      for (int n = 0; n < 8; ++n) s += acc[m][n].x + acc[m][n].y + acc[m][n].z + acc[m][n].w;
    if (s == 123456.789f) ((float*)(p.ws + OFF_GL))[0] = s;
  }
}

DI void attn_item(const P& p, int item, unsigned char* smem, int tid) {
  const int lane = tid & 63, w = tid >> 6, r = lane & 31, hh = lane >> 5;
  const int bh = item & 63, jj = item >> 6;
  int qb; { const int a = jj & 7, grp = jj >> 3; qb = grp == 0 ? 31 - a : grp == 1 ? 16 + a : grp == 2 ? 15 - a : a; }
  const int b = bh >> 3, h = bh & 7;
  const int q0 = qb * 128, qw = q0 + 32 * w;
  const bf16_t* proj = (const bf16_t*)(p.ws + OFF_PROJ0);
  const bf16_t* vT = (const bf16_t*)(p.ws + OFF_VT) + (size_t)bh * 64 * 4096;
  bf16x8 qf[4];
  {
    const bf16_t* qp = proj + (size_t)(b * 4096 + qw + r) * 1536 + 512 + h * 64 + 8 * hh;
#pragma unroll
    for (int s = 0; s < 4; ++s) qf[s] = *(const bf16x8*)(qp + 16 * s);
  }
  f32x16 oacc[2];
#pragma unroll
  for (int i = 0; i < 16; ++i) { oacc[0][i] = 0.f; oacc[1][i] = 0.f; }
  float carry = 0.f;
  const int ntile = q0 / 64 + 2;
  const int lrow = tid >> 3, lc = tid & 7;
  const bf16_t* kbase = proj + (size_t)(b * 4096 + lrow) * 1536 + 1024 + h * 64 + 8 * lc;
  const bf16_t* vbase = vT + (size_t)lrow * 4096 + 8 * lc;
  unsigned char* sK = smem;
  unsigned char* sV = smem + 16384;
  const int kst = lrow * 128 + ((lc ^ (lrow & 7)) << 4);
  const int vst = lrow * 136 + lc * 16;
  u32x4 rk[2], rv[2];
  int kt = ntile - 1;
#pragma unroll
  for (int i = 0; i < 2; ++i) { rk[i] = *(const u32x4*)(kbase + (size_t)(kt * 64 + 32 * i) * 1536); rv[i] = *(const u32x4*)(vbase + (size_t)(32 * i) * 4096 + kt * 64); }
  __syncthreads();
#pragma unroll
  for (int i = 0; i < 2; ++i) {
    *(u32x4*)(sK + kst + i * 4096) = rk[i];
    *(u32x2*)(sV + vst + i * 4352) = (u32x2){rv[i].x, rv[i].y}; *(u32x2*)(sV + vst + i * 4352 + 8) = (u32x2){rv[i].z, rv[i].w};
  }
  __syncthreads();
  int cur = 0;
  for (; kt >= 0; --kt) {
    if (kt > 0) {
#pragma unroll
      for (int i = 0; i < 2; ++i) { rk[i] = *(const u32x4*)(kbase + (size_t)((kt - 1) * 64 + 32 * i) * 1536); rv[i] = *(const u32x4*)(vbase + (size_t)(32 * i) * 4096 + (kt - 1) * 64); }
    }
    const unsigned char* cK = sK + cur * 8192; const unsigned char* cV = sV + cur * 8704;
    const int s0 = kt * 64;
#pragma unroll
    for (int sub = 1; sub >= 0; --sub) {
      const int ks = s0 + 32 * sub;
      if (ks <= qw) {
        f32x16 sc;
#pragma unroll
        for (int i = 0; i < 16; ++i) sc[i] = 0.f;
#pragma unroll
        for (int s = 0; s < 4; ++s) {
          const bf16x8 kf = *(const bf16x8*)(cK + (32 * sub + r) * 128 + (((2 * s + hh) ^ (r & 7)) << 4));
          sc = mfma32(kf, qf[s], sc);
        }
        float sp[16], ls[16];
#pragma unroll
        for (int i = 0; i < 16; ++i) {
          const float z = sc[i];
          sp[i] = flog2(1.f + fexp2(z));
          ls[i] = z - sp[i];
        }
        if (ks == qw) {
#pragma unroll
          for (int i = 0; i < 16; ++i) { const bool valid = crow(i, hh) < r; sp[i] = valid ? sp[i] : 0.f; ls[i] = valid ? ls[i] : -1e30f; }
        }
        float G[4], Pp[4], Tt[4];
#pragma unroll
        for (int g = 0; g < 4; ++g) { G[g] = (sp[4 * g] + sp[4 * g + 1]) + (sp[4 * g + 2] + sp[4 * g + 3]); Pp[g] = __shfl_xor(G[g], 32); Tt[g] = G[g] + Pp[g]; }
        float after = carry;
        f32x16 av;
#pragma unroll
        for (int g = 3; g >= 0; --g) {
          float base = after + (hh == 0 ? Pp[g] : 0.f);
          float k3 = base, k2 = k3 + sp[4 * g + 3], k1 = k2 + sp[4 * g + 2], k0 = k1 + sp[4 * g + 1];
          av[4 * g + 3] = fexp2(ls[4 * g + 3] - k3); av[4 * g + 2] = fexp2(ls[4 * g + 2] - k2);
          av[4 * g + 1] = fexp2(ls[4 * g + 1] - k1); av[4 * g + 0] = fexp2(ls[4 * g + 0] - k0);
          after += Tt[g];
        }
        carry = after;
#pragma unroll
        for (int s = 0; s < 2; ++s) {
          const bf16x8 ap = pack_step(av, s);
#pragma unroll
          for (int dt = 0; dt < 2; ++dt) {
            const unsigned char* vp = cV + (32 * dt + r) * 136 + (32 * sub + 16 * s + 4 * hh) * 2;
            const bf16x8 vf = mk8(*(const u32x2*)vp, *(const u32x2*)(vp + 16));
            oacc[dt] = mfma32(vf, ap, oacc[dt]);
          }
        }
      }
    }
    if (kt > 0) {
      unsigned char* nK = sK + (cur ^ 1) * 8192; unsigned char* nV = sV + (cur ^ 1) * 8704;
#pragma unroll
      for (int i = 0; i < 2; ++i) {
        *(u32x4*)(nK + kst + i * 4096) = rk[i];
        *(u32x2*)(nV + vst + i * 4352) = (u32x2){rv[i].x, rv[i].y}; *(u32x2*)(nV + vst + i * 4352 + 8) = (u32x2){rv[i].z, rv[i].w};
      }
    }
    int* flg = (int*)(smem + 34816) + 4 * cur;
    { const bool wdone = (__ballot(carry < 160.f) == 0ull); if (lane == 0) flg[w] = wdone ? 1 : 0; }
    __syncthreads();
    if (flg[0] + flg[1] + flg[2] + flg[3] == 4) break;
    cur ^= 1;
  }
  bf16_t* cat = (bf16_t*)(p.ws + OFF_CAT) + (size_t)(b * 4096 + qw + r) * 1024 + 512 + h * 64;
#pragma unroll
  for (int dt = 0; dt < 2; ++dt)
#pragma unroll
    for (int g = 0; g < 4; ++g) {
      u32x2 o = {pk2(oacc[dt][4 * g], oacc[dt][4 * g + 1]), pk2(oacc[dt][4 * g + 2], oacc[dt][4 * g + 3])};
      *(u32x2*)(cat + 32 * dt + 8 * g + 4 * hh) = o;
    }
}

DI void pool_item(const P& p, int item, unsigned char* smem, int tid) {
  const int lane = tid & 63, wid = tid >> 6, wr = wid >> 1, wc = wid & 1, fr = lane & 15, fq = lane >> 4; const int lrow = tid >> 3, lc = tid & 7; (void)lane;
  const int g = item & 3, mt = item >> 2;
  const int m0 = mt * 128;
  const bf16_t* proj = (const bf16_t*)(p.ws + OFF_PROJ0);
  const bf16_t* wt = (const bf16_t*)(p.ws + OFF_WT_POOL) + (size_t)g * 128 * 128;
  unsigned char* sA = smem; unsigned char* sB = smem + 32768;
  __syncthreads();
  {
    const int st_off = lrow * 128 + ((lc ^ (lrow & 7)) << 4);
#pragma unroll
    for (int kt = 0; kt < 2; ++kt)
#pragma unroll
      for (int i = 0; i < 4; ++i) *(u32x4*)(sB + kt * 16384 + st_off + i * 4096) = *(const u32x4*)(wt + (size_t)(lrow + 32 * i) * 128 + kt * 64 + 8 * lc);
  }
  {
    const int c8 = tid & 15, rg = tid >> 4;
    const int r0 = 8 * rg;
    const int w = 2 << g;
    const int tb = (m0 & 4095) + r0;
    const bf16_t* up = proj + (size_t)(m0 - (m0 & 4095)) * 1536 + g * 128 + 8 * c8;
    u32x4 v[23];
#pragma unroll
    for (int j = 0; j < 23; ++j) {
      const int t = tb - 15 + j;
      v[j] = (u32x4){0u, 0u, 0u, 0u};
      if (t >= 0 && j >= 16 - w) v[j] = *(const u32x4*)(up + (size_t)t * 1536);
    }
    float md[16];
#pragma unroll
    for (int d = 0; d < 16; ++d) md[d] = (d >= 16 - w) ? 1.f : 0.f;
#pragma unroll
    for (int i = 0; i < 8; ++i) {
      float s[8];
#pragma unroll
      for (int e = 0; e < 8; ++e) s[e] = 0.f;
#pragma unroll
      for (int d = 0; d < 16; ++d) {
        const u32x4 x = v[i + d]; const float m = md[d];
        s[0] += m * bflo(x.x); s[1] += m * bfhi(x.x); s[2] += m * bflo(x.y); s[3] += m * bfhi(x.y);
        s[4] += m * bflo(x.z); s[5] += m * bfhi(x.z); s[6] += m * bflo(x.w); s[7] += m * bfhi(x.w);
      }
      const int t = tb + i; const int cnt = (t + 1 < w) ? (t + 1) : w;
      const float inv = 1.f / (float)cnt;
      const u32x4 xc = v[15 + i];
      const float y0 = s[0] * inv - bflo(xc.x), y1 = s[1] * inv - bfhi(xc.x), y2 = s[2] * inv - bflo(xc.y), y3 = s[3] * inv - bfhi(xc.y);
      const float y4 = s[4] * inv - bflo(xc.z), y5 = s[5] * inv - bfhi(xc.z), y6 = s[6] * inv - bflo(xc.w), y7 = s[7] * inv - bfhi(xc.w);
      const int lr = r0 + i;
      u32x4 o = {pk2(y0, y1), pk2(y2, y3), pk2(y4, y5), pk2(y6, y7)};
      *(u32x4*)(sA + (c8 >> 3) * 16384 + lr * 128 + (((c8 & 7) ^ (lr & 7)) << 4)) = o;
    }
  }
  __syncthreads();
  f32x4 acc[4][4]; zero_acc(acc);
  const int a_rd = (64 * wr + fr) * 128, b_rd = (64 * wc + fr) * 128;
  const int sw0 = (fq ^ (fr & 7)) << 4, sw1 = ((4 + fq) ^ (fr & 7)) << 4;
  mma_stage(acc, sA, sB, a_rd, b_rd, sw0, sw1);
  mma_stage(acc, sA + 16384, sB + 16384, a_rd, b_rd, sw0, sw1);
  const float* psc = p.in[5] + g * 128;
  bf16_t* cat = (bf16_t*)(p.ws + OFF_CAT);
#pragma unroll
  for (int m = 0; m < 4; ++m) {
    const int row = m0 + 64 * wr + 16 * m + fr;
#pragma unroll
    for (int n = 0; n < 4; ++n) {
      const int cl = 64 * wc + 16 * n + 4 * fq;
      const f32x4 s4 = *(const f32x4*)(psc + cl);
      const f32x4 v = acc[m][n] * s4;
      u32x2 o = {pk2(v.x, v.y), pk2(v.z, v.w)};
      *(u32x2*)(cat + (size_t)row * 1024 + g * 128 + cl) = o;
    }
  }
}


template <int I> struct SolveRow {
  static DI void run(float (&sol)[64], const float* A_v) {
    float s = sol[I];
#pragma unroll
    for (int g8 = 0; g8 < (I + 31) / 32; ++g8) {
      f32x4 a[8];
#pragma unroll
      for (int q = 0; q < 8; ++q) if (32 * g8 + 4 * q < I) a[q] = *(const f32x4*)(A_v + I * 68 + 32 * g8 + 4 * q);
#pragma unroll
      for (int q = 0; q < 8; ++q) {
        const int j = 32 * g8 + 4 * q;
        if (j + 0 < I) s -= a[q].x * sol[j + 0];
        if (j + 1 < I) s -= a[q].y * sol[j + 1];
        if (j + 2 < I) s -= a[q].z * sol[j + 2];
        if (j + 3 < I) s -= a[q].w * sol[j + 3];
      }
      __builtin_amdgcn_sched_barrier(0);
    }
    sol[I] = s;
    SolveRow<I + 1>::run(sol, A_v);
  }
};
template <> struct SolveRow<64> { static DI void run(float (&)[64], const float*) {} };

constexpr int GD_RAW = 0, GD_Q = 18224, GD_K = GD_Q + 17408, GD_V = GD_K + 17408, GD_GC = GD_V + 17408, GD_BETA = GD_GC + 256, GD_CW = GD_BETA + 256;
DI void gdn_chunk_item(const P& p, int qi, int item, unsigned char* smem, int tid) {
  const int lane = tid & 63, w = tid >> 6, r = lane & 31, hh = lane >> 5;
  const int h = item & 7, n = (item >> 3) & 63, bq = item >> 9;
  const int b = 2 * qi + bq;
  const int chunk = (b * 8 + h) * 64 + n;
  const bf16_t* qkv = (const bf16_t*)(p.ws + OFF_QKV) + (size_t)(bq * 4096) * 3072;
  const float* gb = (const float*)(p.ws + OFF_GB);
  const float* cw = p.in[9];
  float* gc_s = (float*)(smem + GD_GC); float* beta_s = (float*)(smem + GD_BETA);
  __syncthreads();
  u32x4 rawr[5]; float cwr[2];
#define GD_LOADP(PP) do { \
    _Pragma("unroll") for (int i = 0; i < 5; ++i) { const int idx = tid + 256 * i; const int rr_ = idx >> 4, c_ = idx & 15; const int t_ = 64 * n - 3 + rr_; \
      rawr[i] = (u32x4){0u, 0u, 0u, 0u}; if (idx < 1072 && t_ >= 0) rawr[i] = *(const u32x4*)(qkv + (size_t)t_ * 3072 + (PP) * 1024 + h * 128 + 8 * c_); } \
    _Pragma("unroll") for (int i = 0; i < 2; ++i) { const int idx = tid + 256 * i; cwr[i] = cw[(size_t)(idx >> 7) * 3072 + (PP) * 1024 + h * 128 + (idx & 127)]; } \
  } while (0)
  GD_LOADP(0);
  if (w == 0) {
    const int tok = b * 4096 + 64 * n + lane;
    float g = gb[(size_t)tok * 16 + 8 + h]; const float be = gb[(size_t)tok * 16 + h];
#pragma unroll
    for (int off = 1; off < 64; off <<= 1) { const float t = __shfl_up(g, off); if (lane >= off) g += t; }
    gc_s[lane] = g; beta_s[lane] = be;
  }
#pragma unroll 1
  for (int pp = 0; pp < 3; ++pp) {
#pragma unroll
    for (int i = 0; i < 5; ++i) { const int idx = tid + 256 * i; if (idx < 1072) *(u32x4*)(smem + GD_RAW + (idx >> 4) * 272 + 16 * (idx & 15)) = rawr[i]; }
#pragma unroll
    for (int i = 0; i < 2; ++i) ((float*)(smem + GD_CW))[tid + 256 * i] = cwr[i];
    __syncthreads();
    if (pp < 2) GD_LOADP(pp + 1);
    {
      const int row = tid >> 2, qtr = tid & 3; const int ch0 = 32 * qtr;
      float y[32];
#pragma unroll
      for (int sub = 0; sub < 4; ++sub) {
        float a[8];
#pragma unroll
        for (int e = 0; e < 8; ++e) a[e] = 0.f;
#pragma unroll
        for (int tap = 0; tap < 4; ++tap) {
          const u32x4 xv = *(const u32x4*)(smem + GD_RAW + (row + tap) * 272 + (ch0 + 8 * sub) * 2);
          const float* wp = (const float*)(smem + GD_CW) + tap * 128 + ch0 + 8 * sub;
          const f32x4 w0 = *(const f32x4*)wp, w1 = *(const f32x4*)(wp + 4);
          a[0] += w0.x * bflo(xv.x); a[1] += w0.y * bfhi(xv.x); a[2] += w0.z * bflo(xv.y); a[3] += w0.w * bfhi(xv.y);
          a[4] += w1.x * bflo(xv.z); a[5] += w1.y * bfhi(xv.z); a[6] += w1.z * bflo(xv.w); a[7] += w1.w * bfhi(xv.w);
        }
#pragma unroll
        for (int e = 0; e < 8; ++e) y[8 * sub + e] = siluf_(a[e]);
        __builtin_amdgcn_sched_barrier(0);
      }
      if (pp < 2) {
        float s = 0.f;
#pragma unroll
        for (int e = 0; e < 32; ++e) s += y[e] * y[e];
        s += __shfl_xor(s, 1); s += __shfl_xor(s, 2);
        const float inv = rsqrtf(s + EPSF) * (pp == 0 ? 0.08838834764831845f : 1.f);
#pragma unroll
        for (int e = 0; e < 32; ++e) y[e] *= inv;
      }
      unsigned char* dst = smem + (pp == 0 ? GD_Q : pp == 1 ? GD_K : GD_V) + row * 272 + ch0 * 2;
#pragma unroll
      for (int sub = 0; sub < 4; ++sub) {
        u32x4 o = {pk2(y[8 * sub], y[8 * sub + 1]), pk2(y[8 * sub + 2], y[8 * sub + 3]), pk2(y[8 * sub + 4], y[8 * sub + 5]), pk2(y[8 * sub + 6], y[8 * sub + 7])};
        *(u32x4*)(dst + 16 * sub) = o;
      }
    }
    __syncthreads();
  }
  float* A_s = (float*)(smem + GD_RAW);
  bf16_t* qkb = (bf16_t*)(p.ws + OFF_QK) + (size_t)chunk * 4096;
  {
    const int ti = w >> 1, tj = w & 1;
    const int j = 32 * tj + r;
    if (ti == 0 && tj == 1) {
#pragma unroll
      for (int reg = 0; reg < 16; ++reg) qkb[(32 * ti + crow(reg, hh)) * 64 + j] = 0;
    } else {
      f32x16 kk, qk;
#pragma unroll
      for (int i = 0; i < 16; ++i) { kk[i] = 0.f; qk[i] = 0.f; }
#pragma unroll
      for (int s = 0; s < 8; ++s) {
        const bf16x8 bfrag = *(const bf16x8*)(smem + GD_K + (32 * tj + r) * 272 + (16 * s + 8 * hh) * 2);
        const bf16x8 akf = *(const bf16x8*)(smem + GD_K + (32 * ti + r) * 272 + (16 * s + 8 * hh) * 2);
        const bf16x8 aqf = *(const bf16x8*)(smem + GD_Q + (32 * ti + r) * 272 + (16 * s + 8 * hh) * 2);
        kk = mfma32(akf, bfrag, kk); qk = mfma32(aqf, bfrag, qk);
      }
      const float gcj = gc_s[j];
#pragma unroll
      for (int reg = 0; reg < 16; ++reg) {
        const int i = 32 * ti + crow(reg, hh);
        const float dec = (i >= j) ? __expf(gc_s[i] - gcj) : 0.f;
        A_s[i * 68 + j] = (i > j) ? beta_s[i] * kk[reg] * dec : 0.f;
        qkb[i * 64 + j] = f2bf((i >= j) ? qk[reg] * dec : 0.f);
      }
    }
  }
  __syncthreads();
  {
    const int col = tid; const bool isw = col >= 128; const int d = col & 127;
    int vz; asm volatile("v_mov_b32 %0, 0" : "=v"(vz));
    const float* A_v = A_s + vz; const float* gc_v = gc_s + vz; const float* beta_v = beta_s + vz;
    const unsigned char* src = smem + (isw ? GD_K : GD_V) + d * 2;
    float sol[64];
#pragma unroll
    for (int i = 0; i < 64; ++i) {
      float v = bf2f(*(const bf16_t*)(src + i * 272)) * beta_v[i];
      if (isw) v *= __expf(gc_v[i]);
      sol[i] = v;
    }
    SolveRow<1>::run(sol, A_v);
    __syncthreads();
    if (!isw) {
      bf16_t* ut = (bf16_t*)(p.ws + OFF_UT) + (size_t)chunk * 8192 + d * 64;
#pragma unroll
      for (int c8 = 0; c8 < 8; ++c8) {
        u32x4 o = {pk2(sol[8 * c8], sol[8 * c8 + 1]), pk2(sol[8 * c8 + 2], sol[8 * c8 + 3]), pk2(sol[8 * c8 + 4], sol[8 * c8 + 5]), pk2(sol[8 * c8 + 6], sol[8 * c8 + 7])};
        *(u32x4*)(ut + 8 * c8) = o;
      }
      unsigned char* qp = smem + GD_Q + d * 2;
#pragma unroll
      for (int i = 0; i < 64; ++i) { const float v = bf2f(*(const bf16_t*)(qp + i * 272)) * __expf(gc_v[i]); *(bf16_t*)(qp + i * 272) = f2bf(v); }
    } else {
      unsigned char* wp = smem + GD_V + d * 2;
#pragma unroll
      for (int i = 0; i < 64; ++i) *(bf16_t*)(wp + i * 272) = f2bf(-sol[i]);
      bf16_t* kd = (bf16_t*)(p.ws + OFF_KD) + (size_t)chunk * 8192 + d * 64;
      const float gl = gc_v[63];
#pragma unroll
      for (int c8 = 0; c8 < 8; ++c8) {
        float kv[8];
#pragma unroll
        for (int e = 0; e < 8; ++e) kv[e] = bf2f(*(const bf16_t*)(smem + GD_K + (8 * c8 + e) * 272 + d * 2)) * __expf(gl - gc_v[8 * c8 + e]);
        u32x4 o = {pk2(kv[0], kv[1]), pk2(kv[2], kv[3]), pk2(kv[4], kv[5]), pk2(kv[6], kv[7])};
        *(u32x4*)(kd + 8 * c8) = o;
      }
    }
    if (tid == 0) ((float*)(p.ws + OFF_GL))[chunk] = __expf(gc_s[63]);
    __syncthreads();
    {
      bf16_t* wn = (bf16_t*)(p.ws + OFF_WN) + (size_t)chunk * 8192;
      bf16_t* qd = (bf16_t*)(p.ws + OFF_QD) + (size_t)chunk * 8192;
#pragma unroll 1
      for (int i = 0; i < 4; ++i) {
        const int idx = tid + 256 * i; const int lo = (idx >> 4) * 272 + (idx & 15) * 16;
        *(u32x4*)(wn + (size_t)idx * 8) = *(const u32x4*)(smem + GD_V + lo);
        *(u32x4*)(qd + (size_t)idx * 8) = *(const u32x4*)(smem + GD_Q + lo);
      }
    }
  }
}

constexpr int SC_W = 0, SC_QD = 17408, SC_QK = 34816, SC_KD = 34816 + 9216, SC_U = 34816 + 9216 + 18432;
DI bf16x8 pack44(const f32x4& a, const f32x4& b) { u32x4 v = {pk2(a.x, a.y), pk2(a.z, a.w), pk2(b.x, b.y), pk2(b.z, b.w)}; return __builtin_bit_cast(bf16x8, v); }
DI void scan_item(const P& p, int item, unsigned char* smem, int tid) {
  const int lane = tid & 63, w = tid >> 6, fr = lane & 15, fq = lane >> 4;
  const int bh = item >> 1, hf = item & 1;
  const bf16_t* WN = (const bf16_t*)(p.ws + OFF_WN); const bf16_t* QD = (const bf16_t*)(p.ws + OFF_QD);
  const bf16_t* KD = (const bf16_t*)(p.ws + OFF_KD); const bf16_t* QK = (const bf16_t*)(p.ws + OFF_QK);
  bf16_t* UT = (bf16_t*)(p.ws + OFF_UT) + hf * 4096; const float* GL = (const float*)(p.ws + OFF_GL);
  f32x4 S[8];
#pragma unroll
  for (int dt = 0; dt < 8; ++dt) S[dt] = (f32x4){0.f, 0.f, 0.f, 0.f};
  u32x4 st[16];
  const int chunk0 = bh * 64;
#define SC_LOAD(CH) do { \
    const size_t cb = (size_t)(CH) * 8192; \
    _Pragma("unroll") for (int i = 0; i < 4; ++i) { st[i] = *(const u32x4*)(WN + cb + (size_t)(tid + 256 * i) * 8); st[4 + i] = *(const u32x4*)(QD + cb + (size_t)(tid + 256 * i) * 8); st[10 + i] = *(const u32x4*)(KD + cb + (size_t)(tid + 256 * i) * 8); } \
    _Pragma("unroll") for (int i = 0; i < 2; ++i) { st[8 + i] = *(const u32x4*)(QK + (size_t)(CH) * 4096 + (size_t)(tid + 256 * i) * 8); st[14 + i] = *(const u32x4*)(UT + cb + (size_t)(tid + 256 * i) * 8); } \
  } while (0)
#define SC_STORE() do { \
    _Pragma("unroll") for (int i = 0; i < 4; ++i) { const int idx = tid + 256 * i; const int o16 = (idx >> 4) * 272 + (idx & 15) * 16; *(u32x4*)(smem + SC_W + o16) = st[i]; *(u32x4*)(smem + SC_QD + o16) = st[4 + i]; \
      const int o8 = (idx >> 3) * 144 + (idx & 7) * 16; *(u32x4*)(smem + SC_KD + o8) = st[10 + i]; } \
    _Pragma("unroll") for (int i = 0; i < 2; ++i) { const int idx = tid + 256 * i; const int o8 = (idx >> 3) * 144 + (idx & 7) * 16; *(u32x4*)(smem + SC_QK + o8) = st[8 + i]; *(u32x4*)(smem + SC_U + o8) = st[14 + i]; } \
  } while (0)
  SC_LOAD(chunk0);
  __syncthreads();
  for (int n = 0; n < 64; ++n) {
    const int chunk = chunk0 + n;
    SC_STORE();
    __syncthreads();
    if (n + 1 < 64) SC_LOAD(chunk + 1);
    f32x4 vn[4];
#pragma unroll
    for (int ct = 0; ct < 4; ++ct) { const u32x2 u = *(const u32x2*)(smem + SC_U + (16 * w + fr) * 144 + (16 * ct + 4 * fq) * 2); vn[ct] = (f32x4){bflo(u.x), bfhi(u.x), bflo(u.y), bfhi(u.y)}; }
    const float gl = GL[chunk];
    bf16x8 Sp[4];
#pragma unroll
    for (int kk = 0; kk < 4; ++kk) Sp[kk] = pack44(S[2 * kk], S[2 * kk + 1]);
#pragma unroll
    for (int ct = 0; ct < 4; ++ct)
#pragma unroll
      for (int kk = 0; kk < 4; ++kk) {
        const unsigned char* ap = smem + SC_W + (16 * ct + fr) * 272 + (32 * kk + 4 * fq) * 2;
        vn[ct] = mfma16(mk8(*(const u32x2*)ap, *(const u32x2*)(ap + 32)), Sp[kk], vn[ct]);
      }
    bf16x8 vp[2];
    vp[0] = pack44(vn[0], vn[1]); vp[1] = pack44(vn[2], vn[3]);
#pragma unroll
    for (int ct = 0; ct < 4; ++ct) {
      f32x4 o = {0.f, 0.f, 0.f, 0.f};
#pragma unroll
      for (int kk = 0; kk < 4; ++kk) {
        const unsigned char* ap = smem + SC_QD + (16 * ct + fr) * 272 + (32 * kk + 4 * fq) * 2;
        o = mfma16(mk8(*(const u32x2*)ap, *(const u32x2*)(ap + 32)), Sp[kk], o);
      }
#pragma unroll
      for (int kc = 0; kc < 2; ++kc) {
        const unsigned char* ap = smem + SC_QK + (16 * ct + fr) * 144 + (32 * kc + 4 * fq) * 2;
        o = mfma16(mk8(*(const u32x2*)ap, *(const u32x2*)(ap + 32)), vp[kc], o);
      }
      bf16_t* op = UT + (size_t)chunk * 8192 + (size_t)(16 * ct + 4 * fq) * 64 + 16 * w + fr;
      op[0] = f2bf(o.x); op[64] = f2bf(o.y); op[128] = f2bf(o.z); op[192] = f2bf(o.w);
    }
#pragma unroll
    for (int dt = 0; dt < 8; ++dt) {
      S[dt] = S[dt] * gl;
#pragma unroll
      for (int kc = 0; kc < 2; ++kc) {
        const unsigned char* ap = smem + SC_KD + (16 * dt + fr) * 144 + (32 * kc + 4 * fq) * 2;
        S[dt] = mfma16(mk8(*(const u32x2*)ap, *(const u32x2*)(ap + 32)), vp[kc], S[dt]);
      }
    }
    __syncthreads();
  }
}

DI void phase_final(const P& p, int tid) {
  const int lane = tid & 63, wid = tid >> 6;
  float* x = p.out; const float* g = p.in[21];
  for (int row = blockIdx.x * 4 + wid; row < NTOK; row += gridDim.x * 4) {
    f32x4 v[4]; float s = 0.f;
#pragma unroll
    for (int i = 0; i < 4; ++i) { v[i] = *(const f32x4*)(x + (size_t)row * 1024 + 256 * i + 4 * lane); s += v[i].x * v[i].x + v[i].y * v[i].y + v[i].z * v[i].z + v[i].w * v[i].w; }
#pragma unroll
    for (int off = 32; off > 0; off >>= 1) s += __shfl_xor(s, off);
    const float rs = rsqrtf(s * (1.f / 1024.f) + EPSF);
#pragma unroll
    for (int i = 0; i < 4; ++i) { const f32x4 gg = *(const f32x4*)(g + 256 * i + 4 * lane); *(f32x4*)(x + (size_t)row * 1024 + 256 * i + 4 * lane) = v[i] * rs * gg; }
  }
}


#define XB_TMO      128
#define XB_XCNT(j)  (256  + 64 * (j))
#define XB_XSUB(j)  (1280 + 64 * (j))
#define XB_XGEN(j)  (2304 + 64 * (j))
#define XB_TOP      3328
#define XB_TOPGEN   3392
#define XCD_BAR_WORDS 3456
#define XB_SPIN_CAP (1u << 18)
#define LAS __attribute__((address_space(3)))
DI unsigned xb_ld(unsigned* p)              { return __hip_atomic_load(p, __ATOMIC_RELAXED, __HIP_MEMORY_SCOPE_AGENT); }
DI unsigned xb_add(unsigned* p, unsigned v) { return __hip_atomic_fetch_add(p, v, __ATOMIC_RELAXED, __HIP_MEMORY_SCOPE_AGENT); }
DI unsigned xb_xcc_id() { return (unsigned)__builtin_amdgcn_s_getreg((3 << 11) | 20) & 0xFu; }
#define XB_SPIN(cond, bar) do { unsigned _sp = 0; while (cond) { __builtin_amdgcn_s_sleep(1); \
    if ((++_sp & 255u) == 0u) { if (xb_ld(&(bar)[XB_TMO])) break; if (_sp > XB_SPIN_CAP) { atomicAdd(&(bar)[XB_TMO], 1u); break; } } } } while (0)
struct XcdBarrier { unsigned* bar; unsigned x; volatile LAS unsigned* st; };
DI XcdBarrier xcd_barrier_post(unsigned* bar, volatile LAS unsigned* st) {
  XcdBarrier b; b.bar = bar; b.x = xb_xcc_id(); b.st = st;
  if (threadIdx.x == 0) (void)xb_add(&bar[XB_XCNT(b.x)], 1u);
  return b;
}
DI void xcd_barrier_complete(unsigned* bar, unsigned x, unsigned& nloc, unsigned& nx) {
  const unsigned G = gridDim.x * gridDim.y * gridDim.z;
  unsigned sum, cnt, mine, sp = 0u;
  for (;;) {
    sum = 0u; cnt = 0u; mine = 0u;
#pragma unroll
    for (unsigned j = 0; j < 16; ++j) { const unsigned c = xb_ld(&bar[XB_XCNT(j)]); sum += c; cnt += (c > 0u) ? 1u : 0u; mine = (j == x) ? c : mine; }
    if (sum == G) break;
    __builtin_amdgcn_s_sleep(1);
    if ((++sp & 255u) == 0u) { if (xb_ld(&bar[XB_TMO])) break; if (sp > XB_SPIN_CAP) { atomicAdd(&bar[XB_TMO], 1u); break; } }
  }
  nloc = mine > 0u ? mine : 1u; nx = cnt > 0u ? cnt : 1u;
}
DI void xcd_barrier(const XcdBarrier& b) {
  asm volatile("s_waitcnt vmcnt(0)" ::: "memory");
  __syncthreads();
  if (threadIdx.x == 0) {
    unsigned* bar = b.bar;
    unsigned bx = b.x;
    asm volatile("" : "+s"(bar), "+s"(bx));
    __builtin_amdgcn_s_waitcnt(0);
    unsigned nloc = b.st[0], nx = b.st[1];
    if (nloc == 0u) { xcd_barrier_complete(bar, bx, nloc, nx); b.st[0] = nloc; b.st[1] = nx; }
    const unsigned old = xb_add(&bar[XB_XSUB(bx)], 1u);
    const unsigned gen = old / nloc;
    if (old + 1u == (gen + 1u) * nloc) {
      __builtin_amdgcn_fence(__ATOMIC_RELEASE, "agent");
      asm volatile("s_waitcnt vmcnt(0)" ::: "memory");
      const unsigned og = xb_add(&bar[XB_TOP], 1u);
      const unsigned tg = og / nx;
      if (og + 1u == (tg + 1u) * nx) xb_add(&bar[XB_TOPGEN], 1u);
      else XB_SPIN(xb_ld(&bar[XB_TOPGEN]) == tg, bar);
      __builtin_amdgcn_fence(__ATOMIC_ACQUIRE, "agent");
      xb_add(&bar[XB_XGEN(bx)], 1u);
      asm volatile("s_waitcnt vmcnt(0)" ::: "memory");
    } else {
      XB_SPIN(xb_ld(&bar[XB_XGEN(bx)]) == gen, bar);
      __builtin_amdgcn_fence(__ATOMIC_ACQUIRE, "agent");
      asm volatile("s_waitcnt vmcnt(0)" ::: "memory");
    }
  }
  __syncthreads();
}

constexpr int N_PHASES = 24;
typedef const __attribute__((address_space(4))) P* KP;
DI P loadP(KP kp) {
  P p;
#pragma unroll
  for (int i = 0; i < 22; ++i) p.in[i] = kp->in[i];
  p.out = kp->out; p.ws = kp->ws;
  return p;
}
#define SSP(k) ((float*)(p.ws + OFF_SS) + (k) * NTOK)
#define PH_BEGIN { KP kp = (KP)__builtin_amdgcn_kernarg_segment_ptr(); asm volatile("" : "+s"(kp)); \
    unsigned zz_; asm volatile("v_mov_b32 %0, 0" : "=v"(zz_)); \
    int tid = wbase + (int)__builtin_amdgcn_mbcnt_hi(~0u, __builtin_amdgcn_mbcnt_lo(~0u, zz_)); asm volatile("" : "+v"(tid)); \
    const P p = loadP(kp);
#define PH_END } xcd_barrier(xb);

__global__ void __launch_bounds__(256, 2) mega(P p_arg, int ph_lo, int ph_hi) {
  extern __shared__ __attribute__((aligned(16))) unsigned char smem[];
  __shared__ uint4 xb_words;
  cg::grid_group grid = cg::this_grid();
  if (threadIdx.x == 0) xb_words = make_uint4(0u, 0u, 0u, 0u);
  __syncthreads();
  const int wbase = __builtin_amdgcn_readfirstlane((int)(threadIdx.x & ~63u));
  XcdBarrier xb = xcd_barrier_post((unsigned*)(p_arg.ws + OFF_BAR), (volatile LAS unsigned*)&xb_words);
  if (ph_hi < 0) grid.sync();

  PH_BEGIN phase_prologue(p, smem, tid); PH_END
#if REP_PHASE == 0
  PH_BEGIN phase_prologue(p, smem, tid); PH_END
#endif
#pragma unroll 1
  for (int layer = 0; layer < 2; ++layer) {
    if (layer == 0) {
      PH_BEGIN phase_in_e(p, smem, tid); PH_END
      PH_BEGIN for (int i = blockIdx.x; i < 2048 + 1024; i += gridDim.x) { if (i < 2048) attn_item(p, i, smem, tid); else pool_item(p, i - 2048, smem, tid); } PH_END
#if REP_PHASE == 2
      PH_BEGIN for (int i = blockIdx.x; i < 2048 + 1024; i += gridDim.x) { if (i < 2048) attn_item(p, i, smem, tid); else pool_item(p, i - 2048, smem, tid); } PH_END
#endif
    } else {
#pragma unroll 1
      for (int qi = 0; qi < 4; ++qi) {
        PH_BEGIN
          phase_in_o(p, qi, smem, tid);
          {
            const int G = (int)gridDim.x; const int idle0 = (832 % G == 0 || G >= 832) ? (G >= 832 ? 832 : G) : 832 % G;
            const int g0 = 736 * qi, g1 = 736 * qi + 736;
            if (idle0 < G) { if ((int)blockIdx.x >= idle0) convert_list(p, (float*)smem, tid, 1, g0, g1, (int)blockIdx.x - idle0, G - idle0); }
            else convert_list(p, (float*)smem, tid, 1, g0, g1, (int)blockIdx.x, G);
          }
        PH_END
        PH_BEGIN for (int i = blockIdx.x; i < 1024; i += gridDim.x) gdn_chunk_item(p, qi, i, smem, tid); PH_END
#if REP_PHASE == 9
        if (qi == 0) { PH_BEGIN for (int i = blockIdx.x; i < 1024; i += gridDim.x) gdn_chunk_item(p, qi, i, smem, tid); PH_END }
#endif
      }
      PH_BEGIN for (int i = blockIdx.x; i < 128; i += gridDim.x) scan_item(p, i, smem, tid); PH_END
      PH_BEGIN phase_z_gate(p, smem, tid); PH_END
    }
    PH_BEGIN
      phase_resid(p, (const bf16_t*)(p.ws + (layer ? OFF_OB : OFF_CAT)), 1024, (const bf16_t*)(p.ws + (layer ? OFF_WT_OUTO : OFF_WT_OUTE)), layer ? p.out : p.in[0], SSP(1 + 3 * layer), smem, tid);
    PH_END
    PH_BEGIN phase_ffn_up(p, layer, SSP(1 + 3 * layer), smem, tid); PH_END
#if REP_PHASE == 4
    if (layer == 0) { PH_BEGIN phase_ffn_up(p, layer, SSP(1 + 3 * layer), smem, tid); PH_END }
#endif
    PH_BEGIN phase_resid(p, (const bf16_t*)(p.ws + OFF_ACT), 2816, (const bf16_t*)(p.ws + OFF_WT_DOWN) + (size_t)layer * 1024 * 2816, p.out, SSP(2 + 3 * layer), smem, tid); PH_END
    PH_BEGIN phase_ple_gate(p, layer, SSP(2 + 3 * layer), smem, tid); PH_END
#if REP_PHASE == 6
    if (layer == 0) { PH_BEGIN phase_ple_gate(p, layer, SSP(2 + 3 * layer), smem, tid); PH_END }
#endif
    PH_BEGIN phase_ple_add(p, layer, SSP(3 + 3 * layer), smem, tid); PH_END
  }
#if DUMMY_MODE >= 0
  PH_BEGIN phase_dummy(p, DUMMY_MODE, smem, tid); PH_END
#endif
  PH_BEGIN phase_final(p, tid); }
}

extern "C" void kernel_launch(void* const* d_in, const int* in_sizes, int n_in, void* d_out, int out_size, void* d_ws, size_t ws_size, hipStream_t stream) {
  static int grid_blocks = 0;
  if (!grid_blocks) {
    int dev = 0, cus = 0, per_cu = 0;
    hipGetDevice(&dev);
    hipDeviceGetAttribute(&cus, hipDeviceAttributeMultiprocessorCount, dev);
    hipFuncSetAttribute((const void*)mega, hipFuncAttributeMaxDynamicSharedMemorySize, SMEM_BYTES);
    hipOccupancyMaxActiveBlocksPerMultiprocessor(&per_cu, mega, 256, SMEM_BYTES);
    if (per_cu > 2) per_cu = 2;
    if (per_cu < 1) per_cu = 1;
    grid_blocks = cus * per_cu;
  }
  P p{};
  for (int i = 0; i < 22; ++i) p.in[i] = (const float*)d_in[i];
  p.out = (float*)d_out;
  p.ws = (unsigned char*)d_ws;
  hipMemsetAsync(p.ws + OFF_BAR, 0, XCD_BAR_WORDS * 4, stream);
#if MULTI_LAUNCH
  for (int ph = 0; ph < N_PHASES; ++ph) {
    int lo = ph, hi = ph + 1;
    void* args[] = {&p, &lo, &hi};
    hipError_t e = hipLaunchCooperativeKernel((const void*)mega, dim3(grid_blocks), dim3(256), args, SMEM_BYTES, stream);
    if (e != hipSuccess) fprintf(stderr, "launch failed: %s\n", hipGetErrorString(e));
  }
#else
  int lo = 0, hi = N_PHASES;
  void* args[] = {&p, &lo, &hi};
  hipError_t e = hipLaunchCooperativeKernel((const void*)mega, dim3(grid_blocks), dim3(256), args, SMEM_BYTES, stream);
  if (e != hipSuccess) fprintf(stderr, "launch failed: %s (grid %d)\n", hipGetErrorString(e), grid_blocks);
#endif
}
```

```cpp
#include <hip/hip_runtime.h>
#include <hip/hip_cooperative_groups.h>
#include <stdint.h>
#include <cstdio>
namespace cg = cooperative_groups;

#ifndef REP_PHASE
#define REP_PHASE -1
#endif
#ifndef MULTI_LAUNCH
#define MULTI_LAUNCH 0
#endif

#define DI __device__ __forceinline__
typedef unsigned short bf16_t;
typedef short bf16x8 __attribute__((ext_vector_type(8)));
typedef float f32x4 __attribute__((ext_vector_type(4)));
typedef float f32x2 __attribute__((ext_vector_type(2)));
typedef float f32x16 __attribute__((ext_vector_type(16)));
typedef unsigned u32x4 __attribute__((ext_vector_type(4)));
typedef unsigned u32x2 __attribute__((ext_vector_type(2)));
typedef __bf16 hbf2 __attribute__((ext_vector_type(2)));

DI unsigned pk2(float lo, float hi) { f32x2 v = {lo, hi}; hbf2 r = __builtin_convertvector(v, hbf2); return __builtin_bit_cast(unsigned, r); }
DI bf16_t f2bf(float x) { return (bf16_t)(pk2(x, 0.f) & 0xffffu); }
DI float bf2f(bf16_t v) { return __uint_as_float(((unsigned)v) << 16); }
DI float bflo(unsigned u) { return __uint_as_float(u << 16); }
DI float bfhi(unsigned u) { return __uint_as_float(u & 0xffff0000u); }
DI f32x4 mfma16(bf16x8 a, bf16x8 b, f32x4 c) { return __builtin_amdgcn_mfma_f32_16x16x32_bf16(a, b, c, 0, 0, 0); }
DI f32x16 mfma32(bf16x8 a, bf16x8 b, f32x16 c) { return __builtin_amdgcn_mfma_f32_32x32x16_bf16(a, b, c, 0, 0, 0); }
DI int crow(int reg, int hh) { return (reg & 3) + 8 * (reg >> 2) + 4 * hh; }
DI float fexp2(float x) { return __builtin_amdgcn_exp2f(x); }
DI float flog2(float x) { return __builtin_amdgcn_logf(x); }
DI float frcp(float x) { return __builtin_amdgcn_rcpf(x); }
DI float fexp(float x) { return __builtin_amdgcn_exp2f(x * 1.4426950408889634f); }
DI float sigmoidf_(float x) { return frcp(1.f + fexp(-x)); }
DI float siluf_(float x) { return x * frcp(1.f + fexp(-x)); }
DI bf16x8 mk8(u32x2 lo, u32x2 hi) { u32x4 v = {lo.x, lo.y, hi.x, hi.y}; return __builtin_bit_cast(bf16x8, v); }
DI bf16x8 pack_step(const f32x16& x, int s) {
  u32x4 v;
  v.x = pk2(x[8 * s + 0], x[8 * s + 1]); v.y = pk2(x[8 * s + 2], x[8 * s + 3]);
  v.z = pk2(x[8 * s + 4], x[8 * s + 5]); v.w = pk2(x[8 * s + 6], x[8 * s + 7]);
  return __builtin_bit_cast(bf16x8, v);
}

constexpr int SEQ = 4096, DM = 1024, NTOK = 32768;
constexpr int SMEM_BYTES = 73728;
constexpr float EPSF = 1e-6f;

constexpr size_t OFF_WT_INE = 0;
constexpr size_t OFF_WT_OUTE = OFF_WT_INE + 2048ull * 1024 * 2;
constexpr size_t OFF_WT_INO = OFF_WT_OUTE + 1024ull * 1024 * 2;
constexpr size_t OFF_WT_Z = OFF_WT_INO + 3328ull * 1024 * 2;
constexpr size_t OFF_WT_OUTO = OFF_WT_Z + 1024ull * 1024 * 2;
constexpr size_t OFF_WT_UP = OFF_WT_OUTO + 1024ull * 1024 * 2;
constexpr size_t OFF_WT_DOWN = OFF_WT_UP + 2ull * 5632 * 1024 * 2;
constexpr size_t OFF_WT_PLEG = OFF_WT_DOWN + 2ull * 1024 * 2816 * 2;
constexpr size_t OFF_WT_PLE = OFF_WT_PLEG + 2ull * 1024 * 1024 * 2;
constexpr size_t OFF_WT_POOL = OFF_WT_PLE + 2ull * 1024 * 256 * 2;
constexpr size_t OFF_XB = OFF_WT_POOL + 4ull * 128 * 128 * 2;
constexpr size_t OFF_PB = OFF_XB + 32768ull * 1024 * 2;
constexpr size_t OFF_SS = OFF_PB + 2ull * 32768 * 256 * 2;
constexpr size_t OFF_GB = OFF_SS + 7ull * 32768 * 4;
constexpr size_t OFF_GL = OFF_GB + 32768ull * 16 * 4;
constexpr size_t OFF_BAR = OFF_GL + 4096 * 4;
constexpr size_t OFF_R1 = OFF_BAR + 16384;
constexpr size_t OFF_PROJ0 = OFF_R1;
constexpr size_t OFF_VT = OFF_PROJ0 + 32768ull * 1536 * 2;
constexpr size_t OFF_CAT = OFF_VT + 32768ull * 512 * 2;
constexpr size_t OFF_ACT = OFF_R1;
constexpr size_t OFF_UT = OFF_R1;
constexpr size_t OFF_WN = OFF_UT + 67108864ull;
constexpr size_t OFF_QD = OFF_WN + 67108864ull;
constexpr size_t OFF_KD = OFF_QD + 67108864ull;
constexpr size_t OFF_QK = OFF_KD + 67108864ull;
constexpr size_t OFF_QKV = OFF_QK + 33554432ull;
constexpr size_t OFF_GATE = OFF_R1;
constexpr size_t OFF_OB = OFF_WN;

struct P {
  const float* in[22];
  float* out;
  unsigned char* ws;
};

DI void mma_stage(f32x4 (&acc)[4][4], const unsigned char* cA, const unsigned char* cB, int a_rd, int b_rd, int sw0, int sw1) {
#pragma unroll
  for (int ks = 0; ks < 2; ++ks) {
    const int sw = ks ? sw1 : sw0;
    bf16x8 af[4], bfr[4];
#pragma unroll
    for (int m = 0; m < 4; ++m) af[m] = *(const bf16x8*)(cA + a_rd + m * 2048 + sw);
#pragma unroll
    for (int n = 0; n < 4; ++n) bfr[n] = *(const bf16x8*)(cB + b_rd + n * 2048 + sw);
#pragma unroll
    for (int m = 0; m < 4; ++m)
#pragma unroll
      for (int n = 0; n < 4; ++n) acc[m][n] = mfma16(bfr[n], af[m], acc[m][n]);
  }
}
DI void zero_acc(f32x4 (&acc)[4][4]) {
#pragma unroll
  for (int m = 0; m < 4; ++m)
#pragma unroll
    for (int n = 0; n < 4; ++n) acc[m][n] = (f32x4){0.f, 0.f, 0.f, 0.f};
}

constexpr int G_STAGE = 24576, G_AB = 8192;
DI void glds16(const bf16_t* g, unsigned char* l) { __builtin_amdgcn_global_load_lds((const unsigned*)g, (unsigned*)l, 16, 0, 0); }
DI void zero_acc8(f32x4 (&acc)[4][8]) {
#pragma unroll
  for (int m = 0; m < 4; ++m)
#pragma unroll
    for (int n = 0; n < 8; ++n) acc[m][n] = (f32x4){0.f, 0.f, 0.f, 0.f};
}
DI void gemm_core(f32x4 (&acc)[4][8], const bf16_t* pa0, const bf16_t* pa1, const bf16_t* pb0, long ldb64, int nk, unsigned char* smem, int tid) {
  const int lane = tid & 63, wid = tid >> 6, wr = wid >> 1, wc = wid & 1, fr = lane & 15, fq = lane >> 4;
  const int lrow = tid >> 2, lc = tid & 3;
  const int csrc = 8 * (lc ^ ((-(lrow >> 2)) & 3));
  pa0 += csrc; pa1 += csrc; pb0 += csrc;
  unsigned char* dA = smem + tid * 16; unsigned char* dB = smem + G_AB + tid * 16;
  asm volatile("s_waitcnt vmcnt(0)" ::: "memory");
  __builtin_amdgcn_s_barrier();
#define G_ISSUE(KT, ST) do { const int ko_ = (KT) * 32; unsigned char* a_ = dA + (ST) * G_STAGE; unsigned char* b_ = dB + (ST) * G_STAGE; \
    glds16(pa0 + ko_, a_); glds16(pa1 + ko_, a_ + 4096); \
    glds16(pb0 + ko_, b_); glds16(pb0 + ldb64 + ko_, b_ + 4096); glds16(pb0 + 2 * ldb64 + ko_, b_ + 8192); glds16(pb0 + 3 * ldb64 + ko_, b_ + 12288); } while (0)
  G_ISSUE(0, 0);
  G_ISSUE(1, 1);
  const int swz = (fq ^ ((-(fr >> 2)) & 3)) << 4;
  const int a_rd = (64 * wr + fr) * 64 + swz, b_rd = G_AB + (128 * wc + fr) * 64 + swz;
  int st = 0;
#pragma unroll 1
  for (int kt = 0; kt < nk; ++kt) {
    if (kt + 1 < nk) asm volatile("s_waitcnt vmcnt(6)" ::: "memory"); else asm volatile("s_waitcnt vmcnt(0)" ::: "memory");
    __builtin_amdgcn_s_barrier();
    const unsigned char* cs = smem + st * G_STAGE;
    bf16x8 af[4], bfr[8];
#pragma unroll
    for (int m = 0; m < 4; ++m) af[m] = *(const bf16x8*)(cs + a_rd + m * 1024);
#pragma unroll
    for (int n = 0; n < 8; ++n) bfr[n] = *(const bf16x8*)(cs + b_rd + n * 1024);
    if (kt + 2 < nk) { const int s2 = (st >= 1) ? st - 1 : 2; G_ISSUE(kt + 2, s2); }
    __builtin_amdgcn_s_setprio(1);
#pragma unroll
    for (int m = 0; m < 4; ++m)
#pragma unroll
      for (int n = 0; n < 8; ++n) acc[m][n] = mfma16(bfr[n], af[m], acc[m][n]);
    __builtin_amdgcn_s_setprio(0);
    st = (st == 2) ? 0 : st + 1;
  }
  __syncthreads();
}

DI int permrow(int r) { const int s = r & 31; return (r & ~31) | (((s >> 2) & 3) << 3) | ((s >> 4) << 2) | (s & 3); }
DI void tile_decode(int i, int MT, int NT, int& mt, int& nt) {
  const int g = i / (64 * NT); const int il = i - g * 64 * NT; int gm = MT - 64 * g; gm = gm < 64 ? gm : 64;
  nt = il / gm; mt = 64 * g + (il - nt * gm);
}

DI void transpose_convert(const float* __restrict__ W, int ldw, int K, int mode, int coloff, const float* __restrict__ gain,
                          bf16_t* __restrict__ dst, int kt, int ntile, float* tile, int tid) {
  const int n0 = ntile * 64;
  const int tx = tid & 63, ty = tid >> 6;
  const int n = n0 + tx;
  int src; bool valid = true;
  if (mode == 0) { src = coloff + n; }
  else if (mode == 1) { const int j = n >> 8, nl = n & 255, wc = nl >> 7, hp = (nl >> 6) & 1, nt4 = (nl & 63) >> 4, fr = nl & 15; const int ch = 128 * j + 64 * wc + 32 * hp + 16 * (nt4 & 1) + fr; src = (nt4 < 2) ? ch : 2816 + ch; }
  else { if (n < 3072) src = n; else if (n < 3088) src = 4096 + (n - 3072); else { src = 0; valid = false; } }
  __syncthreads();
#pragma unroll
  for (int i = 0; i < 16; ++i) {
    const int kl = ty + 4 * i, k = 64 * kt + kl;
    float v = 0.f;
    if (valid) { v = W[(size_t)k * ldw + src]; if (gain) v *= gain[k]; }
    tile[kl * 65 + tx] = v;
  }
  __syncthreads();
  const int nl = tid >> 2, kc = tid & 3;
#pragma unroll
  for (int cc = 0; cc < 2; ++cc) {
    const int kch = kc * 2 + cc;
    float v[8];
#pragma unroll
    for (int i = 0; i < 8; ++i) v[i] = tile[(8 * kch + i) * 65 + nl];
    u32x4 o = {pk2(v[0], v[1]), pk2(v[2], v[3]), pk2(v[4], v[5]), pk2(v[6], v[7])};
    *(u32x4*)(dst + (size_t)(n0 + nl) * K + 64 * kt + 8 * kch) = o;
  }
}

DI void convert_list(const P& p, float* tile, int tid, int list, int g0, int g1, int blk, int nblk) {
  for (int g = g0 + blk; g < g1; g += nblk) {
    int task, base;
    if (list == 0) {
      if (g < 512) { task = 0; base = 0; } else if (g < 768) { task = 1; base = 512; } else if (g < 1600) { task = 2; base = 768; }
      else if (g < 3008) { task = 5; base = 1600; } else if (g < 3712) { task = 7; base = 3008; } else if (g < 3968) { task = 9; base = 3712; }
      else if (g < 4032) { task = 11; base = 3968; } else { task = 13 + ((g - 4032) >> 2); base = 4032 + 4 * (task - 13); }
    } else {
      if (g < 256) { task = 3; base = 0; } else if (g < 512) { task = 4; base = 256; } else if (g < 1920) { task = 6; base = 512; }
      else if (g < 2624) { task = 8; base = 1920; } else if (g < 2880) { task = 10; base = 2624; } else { task = 12; base = 2880; }
    }
    const float* W; int ldw, K, mode = 0, coloff = 0; const float* gain = nullptr; size_t doff;
    switch (task) {
      case 0: W = p.in[3]; ldw = 2048; K = 1024; gain = p.in[2]; doff = OFF_WT_INE; break;
      case 1: W = p.in[6]; ldw = 1024; K = 1024; doff = OFF_WT_OUTE; break;
      case 2: W = p.in[8]; ldw = 4112; K = 1024; mode = 2; gain = p.in[7]; doff = OFF_WT_INO; break;
      case 3: W = p.in[8]; ldw = 4112; K = 1024; coloff = 3072; gain = p.in[7]; doff = OFF_WT_Z; break;
      case 4: W = p.in[13]; ldw = 1024; K = 1024; doff = OFF_WT_OUTO; break;
      case 5: W = p.in[15]; ldw = 5632; K = 1024; mode = 1; gain = p.in[14]; doff = OFF_WT_UP; break;
      case 6: W = p.in[15] + 1024ull * 5632; ldw = 5632; K = 1024; mode = 1; gain = p.in[14] + 1024; doff = OFF_WT_UP + 5632ull * 1024 * 2; break;
      case 7: W = p.in[17]; ldw = 1024; K = 2816; doff = OFF_WT_DOWN; break;
      case 8: W = p.in[17] + 2816ull * 1024; ldw = 1024; K = 2816; doff = OFF_WT_DOWN + 1024ull * 2816 * 2; break;
      case 9: W = p.in[19]; ldw = 1024; K = 1024; gain = p.in[18]; doff = OFF_WT_PLEG; break;
      case 10: W = p.in[19] + 1024ull * 1024; ldw = 1024; K = 1024; gain = p.in[18] + 1024; doff = OFF_WT_PLEG + 1024ull * 1024 * 2; break;
      case 11: W = p.in[20]; ldw = 1024; K = 256; doff = OFF_WT_PLE; break;
      case 12: W = p.in[20] + 256ull * 1024; ldw = 1024; K = 256; doff = OFF_WT_PLE + 1024ull * 256 * 2; break;
      default: W = p.in[4] + (size_t)(task - 13) * 128 * 128; ldw = 128; K = 128; doff = OFF_WT_POOL + (size_t)(task - 13) * 128 * 128 * 2; break;
    }
    const int nkt = K / 64; const int t = g - base;
    transpose_convert(W, ldw, K, mode, coloff, gain, (bf16_t*)(p.ws + doff), t % nkt, t / nkt, tile, tid);
  }
}

DI void phase_prologue(const P& p, unsigned char* smem, int tid) {
  float* tile = (float*)smem;
  bf16_t* wsb = (bf16_t*)p.ws;
  convert_list(p, tile, tid, 0, 0, 4048, (int)blockIdx.x, (int)gridDim.x);
  {
    const float* x = p.in[0]; bf16_t* xb = (bf16_t*)(p.ws + OFF_XB); float* ss = (float*)(p.ws + OFF_SS);
    const int lane = tid & 63, wid = tid >> 6;
    for (int row = blockIdx.x * 4 + wid; row < NTOK; row += gridDim.x * 4) {
      float s = 0.f;
#pragma unroll
      for (int i = 0; i < 4; ++i) {
        const f32x4 v = *(const f32x4*)(x + (size_t)row * 1024 + 256 * i + 4 * lane);
        s += v.x * v.x + v.y * v.y + v.z * v.z + v.w * v.w;
        u32x2 o = {pk2(v.x, v.y), pk2(v.z, v.w)};
        *(u32x2*)(xb + (size_t)row * 1024 + 256 * i + 4 * lane) = o;
      }
#pragma unroll
      for (int off = 32; off > 0; off >>= 1) s += __shfl_xor(s, off);
      if (lane == 0) ss[row] = s;
    }
    for (int i = blockIdx.x * 256 + tid; i < 6 * NTOK; i += gridDim.x * 256) ss[NTOK + i] = 0.f;
    const float* pp = p.in[1]; bf16_t* pb = (bf16_t*)(p.ws + OFF_PB);
    const size_t n4 = 2ull * 32768 * 256 / 4;
    for (size_t i = (size_t)blockIdx.x * 256 + tid; i < n4; i += (size_t)gridDim.x * 256) {
      const f32x4 v = *(const f32x4*)(pp + 4 * i);
      u32x2 o = {pk2(v.x, v.y), pk2(v.z, v.w)};
      *(u32x2*)(pb + 4 * i) = o;
    }
  }
}

#define GEMM_IDS const int lrow = tid >> 2;
#define EPI_IDS int tid_e = tid; asm volatile("" : "+v"(tid_e)); const int lane = tid_e & 63, wid = tid_e >> 6, wr = wid >> 1, wc = wid & 1, fr = lane & 15, fq = lane >> 4; (void)lane; (void)wr; (void)wc; (void)fr; (void)fq;

DI void phase_in_e(const P& p, unsigned char* smem, int tid) {
  GEMM_IDS
  const bf16_t* xb = (const bf16_t*)(p.ws + OFF_XB); const bf16_t* wt = (const bf16_t*)(p.ws + OFF_WT_INE);
  const float* ss = (const float*)(p.ws + OFF_SS);
  bf16_t* proj = (bf16_t*)(p.ws + OFF_PROJ0); bf16_t* vT = (bf16_t*)(p.ws + OFF_VT);
  for (int i = blockIdx.x; i < 256 * 8; i += gridDim.x) {
    int mt, nt; tile_decode(i, 256, 8, mt, nt);
    const int m0 = mt * 128, n0 = nt * 256;
    const bf16_t* pa = xb + (size_t)(m0 + lrow) * 1024;
    f32x4 acc[4][8]; zero_acc8(acc);
    gemm_core(acc, pa, pa + 64 * 1024, wt + (size_t)(n0 + permrow(lrow)) * 1024, 64 * 1024, 32, smem, tid);
    EPI_IDS
    const float qs = (n0 >= 512 && n0 < 1024) ? 0.18033688011112042f : 1.f;
#pragma unroll
    for (int m = 0; m < 4; ++m) {
      const int row = m0 + 64 * wr + 16 * m + fr;
      const float rs = rsqrtf(ss[row] * (1.f / 1024.f) + EPSF) * qs;
#pragma unroll
      for (int q = 0; q < 4; ++q) {
        const int col = n0 + 128 * wc + 32 * q + 8 * fq;
        const f32x4 v0 = acc[m][2 * q] * rs, v1 = acc[m][2 * q + 1] * rs;
        if (n0 < 1536) {
          u32x4 o = {pk2(v0.x, v0.y), pk2(v0.z, v0.w), pk2(v1.x, v1.y), pk2(v1.z, v1.w)};
          *(u32x4*)(proj + (size_t)row * 1536 + col) = o;
        } else {
          const int cc = col - 1536; const int bh = (row >> 12) * 8 + (cc >> 6), d = cc & 63, t = row & 4095;
          bf16_t* vp = vT + ((size_t)bh * 64 + d) * 4096 + t;
          vp[0] = f2bf(v0.x); vp[4096] = f2bf(v0.y); vp[8192] = f2bf(v0.z); vp[12288] = f2bf(v0.w);
          vp[16384] = f2bf(v1.x); vp[20480] = f2bf(v1.y); vp[24576] = f2bf(v1.z); vp[28672] = f2bf(v1.w);
        }
      }
    }
  }
}

DI void phase_resid(const P& p, const bf16_t* A, int K, const bf16_t* wt, const float* xold, float* ssn, unsigned char* smem, int tid) {
  GEMM_IDS
  bf16_t* xb = (bf16_t*)(p.ws + OFF_XB); float* xnew = p.out;
  for (int i = blockIdx.x; i < 256 * 4; i += gridDim.x) {
    int mt, nt; tile_decode(i, 256, 4, mt, nt);
    const int m0 = mt * 128, n0 = nt * 256;
    const bf16_t* pa = A + (size_t)(m0 + lrow) * K;
    f32x4 acc[4][8]; zero_acc8(acc);
    gemm_core(acc, pa, pa + 64 * (size_t)K, wt + (size_t)(n0 + permrow(lrow)) * K, 64 * (long)K, K / 32, smem, tid);
    EPI_IDS
#pragma unroll
    for (int m = 0; m < 4; ++m) {
      const int row = m0 + 64 * wr + 16 * m + fr;
      float s = 0.f;
#pragma unroll
      for (int q = 0; q < 4; ++q) {
        const int col = n0 + 128 * wc + 32 * q + 8 * fq;
        const f32x4 v0 = *(const f32x4*)(xold + (size_t)row * 1024 + col) + acc[m][2 * q];
        const f32x4 v1 = *(const f32x4*)(xold + (size_t)row * 1024 + col + 4) + acc[m][2 * q + 1];
        *(f32x4*)(xnew + (size_t)row * 1024 + col) = v0;
        *(f32x4*)(xnew + (size_t)row * 1024 + col + 4) = v1;
        u32x4 o = {pk2(v0.x, v0.y), pk2(v0.z, v0.w), pk2(v1.x, v1.y), pk2(v1.z, v1.w)};
        *(u32x4*)(xb + (size_t)row * 1024 + col) = o;
        s += v0.x * v0.x + v0.y * v0.y + v0.z * v0.z + v0.w * v0.w + v1.x * v1.x + v1.y * v1.y + v1.z * v1.z + v1.w * v1.w;
      }
      s += __shfl_xor(s, 16); s += __shfl_xor(s, 32);
      if (fq == 0) atomicAdd(ssn + row, s);
      __builtin_amdgcn_sched_barrier(0);
    }
  }
}

DI void phase_ffn_up(const P& p, int layer, const float* ssc, unsigned char* smem, int tid) {
  GEMM_IDS
  const bf16_t* xb = (const bf16_t*)(p.ws + OFF_XB); const bf16_t* wt = (const bf16_t*)(p.ws + OFF_WT_UP) + (size_t)layer * 5632 * 1024;
  bf16_t* act = (bf16_t*)(p.ws + OFF_ACT);
  const float* cw = p.in[16] + (size_t)layer * 3 * 5632;
  float* Cs = (float*)smem;
  for (int i = blockIdx.x; i < 264 * 22; i += gridDim.x) {
    int mt, nt; tile_decode(i, 264, 22, mt, nt);
    const int b = mt / 33, mi = mt - b * 33;
    const int t0 = 126 * mi - 2;
    const bf16_t* pa[2];
#pragma unroll
    for (int j = 0; j < 2; ++j) { int t = t0 + lrow + 64 * j; t = t < 0 ? 0 : (t > 4095 ? 4095 : t); pa[j] = xb + (size_t)(b * 4096 + t) * 1024; }
    f32x4 acc[4][8]; zero_acc8(acc);
    gemm_core(acc, pa[0], pa[1], wt + (size_t)(nt * 256 + lrow) * 1024, 64 * 1024, 32, smem, tid);
    EPI_IDS
    float rsv[4];
#pragma unroll
    for (int m = 0; m < 4; ++m) {
      int t = t0 + 64 * wr + 16 * m + fr; const bool neg = t < 0; t = t < 0 ? 0 : (t > 4095 ? 4095 : t);
      rsv[m] = neg ? 0.f : rsqrtf(ssc[b * 4096 + t] * (1.f / 1024.f) + EPSF);
    }
#pragma unroll
    for (int hp = 0; hp < 2; ++hp) {
      if (hp) __syncthreads();
#pragma unroll
      for (int m = 0; m < 4; ++m) {
        const int lr = 64 * wr + 16 * m + fr;
#pragma unroll
        for (int n = 0; n < 4; ++n) *(f32x4*)(Cs + lr * 132 + 64 * wc + 16 * n + 4 * fq) = acc[m][4 * hp + n] * rsv[m];
      }
      __syncthreads();
      const int cl = tid & 63, rg = tid >> 6;
      const int gcol = 64 * (cl >> 5) + 16 * ((cl & 31) >> 4) + (cl & 15), vcol = gcol + 32;
      const int ch = nt * 128 + 64 * (cl >> 5) + 32 * hp + (cl & 31);
      const float wg0 = cw[ch], wg1 = cw[5632 + ch], wg2 = cw[2 * 5632 + ch];
      const float wv0 = cw[2816 + ch], wv1 = cw[5632 + 2816 + ch], wv2 = cw[2 * 5632 + 2816 + ch];
      const int lr0 = 2 + 32 * rg;
      float g2 = Cs[(lr0 - 2) * 132 + gcol], g1 = Cs[(lr0 - 1) * 132 + gcol];
      float v2 = Cs[(lr0 - 2) * 132 + vcol], v1 = Cs[(lr0 - 1) * 132 + vcol];
      for (int r = 0; r < 32; ++r) {
        const int lr = lr0 + r; const int t = t0 + lr;
        if (lr >= 128 || t > 4095) break;
        const float g0 = Cs[lr * 132 + gcol], v0 = Cs[lr * 132 + vcol];
        const float yg = wg0 * g2 + wg1 * g1 + wg2 * g0;
        const float yv = wv0 * v2 + wv1 * v1 + wv2 * v0;
        act[(size_t)(b * 4096 + t) * 2816 + ch] = f2bf(siluf_(yg) * yv);
        g2 = g1; g1 = g0; v2 = v1; v1 = v0;
      }
    }
  }
}

DI void phase_ple_gate(const P& p, int layer, const float* ssc, unsigned char* smem, int tid) {
  GEMM_IDS
  const bf16_t* xb = (const bf16_t*)(p.ws + OFF_XB);
  const bf16_t* wg = (const bf16_t*)(p.ws + OFF_WT_PLEG) + (size_t)layer * 1024 * 1024;
  bf16_t* gate = (bf16_t*)(p.ws + OFF_GATE);
  for (int i = blockIdx.x; i < 256 * 4; i += gridDim.x) {
    int mt, nt; tile_decode(i, 256, 4, mt, nt);
    const int m0 = mt * 128, n0 = nt * 256;
    const bf16_t* pa = xb + (size_t)(m0 + lrow) * 1024;
    f32x4 acc[4][8]; zero_acc8(acc);
    gemm_core(acc, pa, pa + 64 * 1024, wg + (size_t)(n0 + permrow(lrow)) * 1024, 64 * 1024, 32, smem, tid);
    EPI_IDS
#pragma unroll
    for (int m = 0; m < 4; ++m) {
      const int row = m0 + 64 * wr + 16 * m + fr;
      const float rs = rsqrtf(ssc[row] * (1.f / 1024.f) + EPSF);
#pragma unroll
      for (int q = 0; q < 4; ++q) {
        const int col = n0 + 128 * wc + 32 * q + 8 * fq;
        const f32x4 v0 = acc[m][2 * q] * rs, v1 = acc[m][2 * q + 1] * rs;
        u32x4 o = {pk2(sigmoidf_(v0.x), sigmoidf_(v0.y)), pk2(sigmoidf_(v0.z), sigmoidf_(v0.w)), pk2(sigmoidf_(v1.x), sigmoidf_(v1.y)), pk2(sigmoidf_(v1.z), sigmoidf_(v1.w))};
        *(u32x4*)(gate + (size_t)row * 1024 + col) = o;
      }
    }
  }
}

DI void phase_ple_add(const P& p, int layer, float* ssn, unsigned char* smem, int tid) {
  GEMM_IDS
  bf16_t* xb = (bf16_t*)(p.ws + OFF_XB);
  const bf16_t* wp = (const bf16_t*)(p.ws + OFF_WT_PLE) + (size_t)layer * 1024 * 256;
  const bf16_t* pb = (const bf16_t*)(p.ws + OFF_PB) + (size_t)layer * 32768 * 256;
  const bf16_t* gate = (const bf16_t*)(p.ws + OFF_GATE);
  float* x = p.out;
  for (int i = blockIdx.x; i < 256 * 4; i += gridDim.x) {
    int mt, nt; tile_decode(i, 256, 4, mt, nt);
    const int m0 = mt * 128, n0 = nt * 256;
    const bf16_t* pa = pb + (size_t)(m0 + lrow) * 256;
    f32x4 acc[4][8]; zero_acc8(acc);
    gemm_core(acc, pa, pa + 64 * 256, wp + (size_t)(n0 + permrow(lrow)) * 256, 64 * 256, 8, smem, tid);
    EPI_IDS
#pragma unroll
    for (int m = 0; m < 4; ++m) {
      const int row = m0 + 64 * wr + 16 * m + fr;
      float s = 0.f;
#pragma unroll
      for (int q = 0; q < 4; ++q) {
        const int col = n0 + 128 * wc + 32 * q + 8 * fq;
        const u32x4 gp = *(const u32x4*)(gate + (size_t)row * 1024 + col);
        const f32x4 g0 = {bflo(gp.x), bfhi(gp.x), bflo(gp.y), bfhi(gp.y)}, g1 = {bflo(gp.z), bfhi(gp.z), bflo(gp.w), bfhi(gp.w)};
        const f32x4 v0 = *(const f32x4*)(x + (size_t)row * 1024 + col) + acc[m][2 * q] * g0;
        const f32x4 v1 = *(const f32x4*)(x + (size_t)row * 1024 + col + 4) + acc[m][2 * q + 1] * g1;
        *(f32x4*)(x + (size_t)row * 1024 + col) = v0;
        *(f32x4*)(x + (size_t)row * 1024 + col + 4) = v1;
        if (layer == 0) {
          u32x4 o = {pk2(v0.x, v0.y), pk2(v0.z, v0.w), pk2(v1.x, v1.y), pk2(v1.z, v1.w)};
          *(u32x4*)(xb + (size_t)row * 1024 + col) = o;
        }
        s += v0.x * v0.x + v0.y * v0.y + v0.z * v0.z + v0.w * v0.w + v1.x * v1.x + v1.y * v1.y + v1.z * v1.z + v1.w * v1.w;
      }
      s += __shfl_xor(s, 16); s += __shfl_xor(s, 32);
      if (fq == 0 && layer == 0) atomicAdd(ssn + row, s);
      __builtin_amdgcn_sched_barrier(0);
    }
  }
}

DI void phase_in_o(const P& p, int qi, unsigned char* smem, int tid) {
  GEMM_IDS
  const bf16_t* xb = (const bf16_t*)(p.ws + OFF_XB); const bf16_t* wt = (const bf16_t*)(p.ws + OFF_WT_INO);
  const float* ssc = (const float*)(p.ws + OFF_SS) + 3 * NTOK;
  bf16_t* qkv = (bf16_t*)(p.ws + OFF_QKV); float* gb = (float*)(p.ws + OFF_GB);
  const float* a_log = p.in[10]; const float* dt_bias = p.in[11];
  for (int i = blockIdx.x; i < 64 * 13; i += gridDim.x) {
    int mt, nt; tile_decode(i, 64, 13, mt, nt);
    const int mq0 = mt * 128, m0 = qi * 8192 + mq0, n0 = nt * 256;
    const bf16_t* pa = xb + (size_t)(m0 + lrow) * 1024;
    f32x4 acc[4][8]; zero_acc8(acc);
    gemm_core(acc, pa, pa + 64 * 1024, wt + (size_t)(n0 + permrow(lrow)) * 1024, 64 * 1024, 32, smem, tid);
    EPI_IDS
#pragma unroll
    for (int m = 0; m < 4; ++m) {
      const int rl = 64 * wr + 16 * m + fr;
      const float rs = rsqrtf(ssc[m0 + rl] * (1.f / 1024.f) + EPSF);
      if (nt < 12) {
#pragma unroll
        for (int q = 0; q < 4; ++q) {
          const int col = n0 + 128 * wc + 32 * q + 8 * fq;
          const f32x4 v0 = acc[m][2 * q] * rs, v1 = acc[m][2 * q + 1] * rs;
          u32x4 o = {pk2(v0.x, v0.y), pk2(v0.z, v0.w), pk2(v1.x, v1.y), pk2(v1.z, v1.w)};
          *(u32x4*)(qkv + (size_t)(mq0 + rl) * 3072 + col) = o;
        }
      } else if (wc == 0 && fq < 2) {
        const f32x4 v0 = acc[m][0] * rs, v1 = acc[m][1] * rs;
        float o[8];
#pragma unroll
        for (int j = 0; j < 8; ++j) {
          const float vv = j < 4 ? v0[j] : v1[j - 4];
          if (fq == 0) o[j] = sigmoidf_(vv);
          else {
            const float xx = vv + dt_bias[j];
            const float sp = fmaxf(xx, 0.f) + log1pf(__expf(-fabsf(xx)));
            o[j] = -__expf(a_log[j]) * sp;
          }
        }
        float* gp = gb + (size_t)(m0 + rl) * 16 + 8 * fq;
        *(f32x4*)gp = (f32x4){o[0], o[1], o[2], o[3]}; *(f32x4*)(gp + 4) = (f32x4){o[4], o[5], o[6], o[7]};
      }
    }
  }
}

DI void phase_z_gate(const P& p, unsigned char* smem, int tid) {
  GEMM_IDS
  const bf16_t* xb = (const bf16_t*)(p.ws + OFF_XB); const bf16_t* wt = (const bf16_t*)(p.ws + OFF_WT_Z);
  const float* ssc = (const float*)(p.ws + OFF_SS) + 3 * NTOK;
  const bf16_t* ob_in = (const bf16_t*)(p.ws + OFF_UT);
  bf16_t* ob = (bf16_t*)(p.ws + OFF_OB);
  const float* nw = p.in[12];
  for (int i = blockIdx.x; i < 256 * 4; i += gridDim.x) {
    int mt, nt; tile_decode(i, 256, 4, mt, nt);
    const int m0 = mt * 128, n0 = nt * 256;
    const bf16_t* pa = xb + (size_t)(m0 + lrow) * 1024;
    f32x4 acc[4][8]; zero_acc8(acc);
    gemm_core(acc, pa, pa + 64 * 1024, wt + (size_t)(n0 + permrow(lrow)) * 1024, 64 * 1024, 32, smem, tid);
    EPI_IDS
    const int hd = 2 * nt + wc;
#pragma unroll
    for (int m = 0; m < 4; ++m) {
      const int row = m0 + 64 * wr + 16 * m + fr;
      const int chunk = ((row >> 12) * 8 + hd) * 64 + ((row & 4095) >> 6);
      const bf16_t* op = ob_in + (size_t)chunk * 8192 + (row & 63) * 64 + 8 * fq;
      u32x4 ov[4];
      float s = 0.f;
#pragma unroll
      for (int q = 0; q < 4; ++q) {
        ov[q] = *(const u32x4*)(op + (q >> 1) * 4096 + 32 * (q & 1));
        const float a0 = bflo(ov[q].x), a1 = bfhi(ov[q].x), a2 = bflo(ov[q].y), a3 = bfhi(ov[q].y), a4 = bflo(ov[q].z), a5 = bfhi(ov[q].z), a6 = bflo(ov[q].w), a7 = bfhi(ov[q].w);
        s += a0 * a0 + a1 * a1 + a2 * a2 + a3 * a3 + a4 * a4 + a5 * a5 + a6 * a6 + a7 * a7;
      }
      s += __shfl_xor(s, 16); s += __shfl_xor(s, 32);
      const float on = rsqrtf(s * (1.f / 128.f) + EPSF);
      const float rs = rsqrtf(ssc[row] * (1.f / 1024.f) + EPSF);
#pragma unroll
      for (int q = 0; q < 4; ++q) {
        const int cl = 32 * q + 8 * fq;
        const f32x4 z0 = acc[m][2 * q] * rs, z1 = acc[m][2 * q + 1] * rs;
        const f32x4 w0 = *(const f32x4*)(nw + cl), w1 = *(const f32x4*)(nw + cl + 4);
        const f32x4 o0 = {bflo(ov[q].x), bfhi(ov[q].x), bflo(ov[q].y), bfhi(ov[q].y)}, o1 = {bflo(ov[q].z), bfhi(ov[q].z), bflo(ov[q].w), bfhi(ov[q].w)};
        float r[8];
#pragma unroll
        for (int j = 0; j < 4; ++j) { r[j] = o0[j] * on * w0[j] * siluf_(z0[j]); r[4 + j] = o1[j] * on * w1[j] * siluf_(z1[j]); }
        u32x4 o = {pk2(r[0], r[1]), pk2(r[2], r[3]), pk2(r[4], r[5]), pk2(r[6], r[7])};
        *(u32x4*)(ob + (size_t)row * 1024 + n0 + 128 * wc + cl) = o;
      }
      __builtin_amdgcn_sched_barrier(0);
    }
  }
}

#ifndef DUMMY_MODE
#define DUMMY_MODE -1
#endif
DI void phase_dummy(const P& p, int mode, unsigned char* smem, int tid) {
  GEMM_IDS
  const bf16_t* xb = (const bf16_t*)(p.ws + OFF_XB);
  const bf16_t* wg = (const bf16_t*)(p.ws + OFF_WT_PLEG);
  for (int i = blockIdx.x; i < 256 * 4; i += gridDim.x) {
    int mt, nt; tile_decode(i, 256, 4, mt, nt);
    if (mode == 1) { mt = 0; nt = 0; }
    if (mode == 2) { mt = blockIdx.x & 255; nt = 0; }
    const int m0 = mt * 128, n0 = nt * 256;
    const bf16_t* pa = xb + (size_t)(m0 + lrow) * 1024;
    f32x4 acc[4][8]; zero_acc8(acc);
    gemm_core(acc, pa, pa + 64 * 1024, wg + (size_t)(n0 + lrow) * 1024, 64 * 1024, 32, smem, tid);
    EPI_IDS
    float s = 0.f;
#pragma unroll
    for (int m = 0; m < 4; ++m)
#pragma unroll
      for (int n = 0; n < 8; ++n) s += acc[m][n].x + acc[m][n].y + acc[m][n].z + acc[m][n].w;
    if (s == 123456.789f) ((float*)(p.ws + OFF_GL))[0] = s;
  }
}

DI void attn_item(const P& p, int item, unsigned char* smem, int tid) {
  const int lane = tid & 63, w = tid >> 6, r = lane & 31, hh = lane >> 5;
  const int bh = item & 63, jj = item >> 6;
  int qb; { const int a = jj & 7, grp = jj >> 3; qb = grp == 0 ? 31 - a : grp == 1 ? 16 + a : grp == 2 ? 15 - a : a; }
  const int b = bh >> 3, h = bh & 7;
  const int q0 = qb * 128, qw = q0 + 32 * w;
  const bf16_t* proj = (const bf16_t*)(p.ws + OFF_PROJ0);
  const bf16_t* vT = (const bf16_t*)(p.ws + OFF_VT) + (size_t)bh * 64 * 4096;
  bf16x8 qf[4];
  {
    const bf16_t* qp = proj + (size_t)(b * 4096 + qw + r) * 1536 + 512 + h * 64 + 8 * hh;
#pragma unroll
    for (int s = 0; s < 4; ++s) qf[s] = *(const bf16x8*)(qp + 16 * s);
  }
  f32x16 oacc[2];
#pragma unroll
  for (int i = 0; i < 16; ++i) { oacc[0][i] = 0.f; oacc[1][i] = 0.f; }
  float carry = 0.f;
  const int ntile = q0 / 64 + 2;
  const int lrow = tid >> 3, lc = tid & 7;
  const bf16_t* kbase = proj + (size_t)(b * 4096 + lrow) * 1536 + 1024 + h * 64 + 8 * lc;
  const bf16_t* vbase = vT + (size_t)lrow * 4096 + 8 * lc;
  unsigned char* sK = smem;
  unsigned char* sV = smem + 16384;
  const int kst = lrow * 128 + ((lc ^ (lrow & 7)) << 4);
  const int vst = lrow * 136 + lc * 16;
  u32x4 rk[2], rv[2];
  int kt = ntile - 1;
#pragma unroll
  for (int i = 0; i < 2; ++i) { rk[i] = *(const u32x4*)(kbase + (size_t)(kt * 64 + 32 * i) * 1536); rv[i] = *(const u32x4*)(vbase + (size_t)(32 * i) * 4096 + kt * 64); }
  __syncthreads();
#pragma unroll
  for (int i = 0; i < 2; ++i) {
    *(u32x4*)(sK + kst + i * 4096) = rk[i];
    *(u32x2*)(sV + vst + i * 4352) = (u32x2){rv[i].x, rv[i].y}; *(u32x2*)(sV + vst + i * 4352 + 8) = (u32x2){rv[i].z, rv[i].w};
  }
  __syncthreads();
  int cur = 0;
  for (; kt >= 0; --kt) {
    if (kt > 0) {
#pragma unroll
      for (int i = 0; i < 2; ++i) { rk[i] = *(const u32x4*)(kbase + (size_t)((kt - 1) * 64 + 32 * i) * 1536); rv[i] = *(const u32x4*)(vbase + (size_t)(32 * i) * 4096 + (kt - 1) * 64); }
    }
    const unsigned char* cK = sK + cur * 8192; const unsigned char* cV = sV + cur * 8704;
    const int s0 = kt * 64;
#pragma unroll
    for (int sub = 1; sub >= 0; --sub) {
      const int ks = s0 + 32 * sub;
      if (ks <= qw) {
        f32x16 sc;
#pragma unroll
        for (int i = 0; i < 16; ++i) sc[i] = 0.f;
#pragma unroll
        for (int s = 0; s < 4; ++s) {
          const bf16x8 kf = *(const bf16x8*)(cK + (32 * sub + r) * 128 + (((2 * s + hh) ^ (r & 7)) << 4));
          sc = mfma32(kf, qf[s], sc);
        }
        float sp[16], ls[16];
#pragma unroll
        for (int i = 0; i < 16; ++i) {
          const float z = sc[i];
          sp[i] = flog2(1.f + fexp2(z));
          ls[i] = z - sp[i];
        }
        if (ks == qw) {
#pragma unroll
          for (int i = 0; i < 16; ++i) { const bool valid = crow(i, hh) < r; sp[i] = valid ? sp[i] : 0.f; ls[i] = valid ? ls[i] : -1e30f; }
        }
        float G[4], Pp[4], Tt[4];
#pragma unroll
        for (int g = 0; g < 4; ++g) { G[g] = (sp[4 * g] + sp[4 * g + 1]) + (sp[4 * g + 2] + sp[4 * g + 3]); Pp[g] = __shfl_xor(G[g], 32); Tt[g] = G[g] + Pp[g]; }
        float after = carry;
        f32x16 av;
#pragma unroll
        for (int g = 3; g >= 0; --g) {
          float base = after + (hh == 0 ? Pp[g] : 0.f);
          float k3 = base, k2 = k3 + sp[4 * g + 3], k1 = k2 + sp[4 * g + 2], k0 = k1 + sp[4 * g + 1];
          av[4 * g + 3] = fexp2(ls[4 * g + 3] - k3); av[4 * g + 2] = fexp2(ls[4 * g + 2] - k2);
          av[4 * g + 1] = fexp2(ls[4 * g + 1] - k1); av[4 * g + 0] = fexp2(ls[4 * g + 0] - k0);
          after += Tt[g];
        }
        carry = after;
#pragma unroll
        for (int s = 0; s < 2; ++s) {
          const bf16x8 ap = pack_step(av, s);
#pragma unroll
          for (int dt = 0; dt < 2; ++dt) {
            const unsigned char* vp = cV + (32 * dt + r) * 136 + (32 * sub + 16 * s + 4 * hh) * 2;
            const bf16x8 vf = mk8(*(const u32x2*)vp, *(const u32x2*)(vp + 16));
            oacc[dt] = mfma32(vf, ap, oacc[dt]);
          }
        }
      }
    }
    if (kt > 0) {
      unsigned char* nK = sK + (cur ^ 1) * 8192; unsigned char* nV = sV + (cur ^ 1) * 8704;
#pragma unroll
      for (int i = 0; i < 2; ++i) {
        *(u32x4*)(nK + kst + i * 4096) = rk[i];
        *(u32x2*)(nV + vst + i * 4352) = (u32x2){rv[i].x, rv[i].y}; *(u32x2*)(nV + vst + i * 4352 + 8) = (u32x2){rv[i].z, rv[i].w};
      }
    }
    int* flg = (int*)(smem + 34816) + 4 * cur;
    { const bool wdone = (__ballot(carry < 160.f) == 0ull); if (lane == 0) flg[w] = wdone ? 1 : 0; }
    __syncthreads();
    if (flg[0] + flg[1] + flg[2] + flg[3] == 4) break;
    cur ^= 1;
  }
  bf16_t* cat = (bf16_t*)(p.ws + OFF_CAT) + (size_t)(b * 4096 + qw + r) * 1024 + 512 + h * 64;
#pragma unroll
  for (int dt = 0; dt < 2; ++dt)
#pragma unroll
    for (int g = 0; g < 4; ++g) {
      u32x2 o = {pk2(oacc[dt][4 * g], oacc[dt][4 * g + 1]), pk2(oacc[dt][4 * g + 2], oacc[dt][4 * g + 3])};
      *(u32x2*)(cat + 32 * dt + 8 * g + 4 * hh) = o;
    }
}

DI void pool_item(const P& p, int item, unsigned char* smem, int tid) {
  const int lane = tid & 63, wid = tid >> 6, wr = wid >> 1, wc = wid & 1, fr = lane & 15, fq = lane >> 4; const int lrow = tid >> 3, lc = tid & 7; (void)lane;
  const int g = item & 3, mt = item >> 2;
  const int m0 = mt * 128;
  const bf16_t* proj = (const bf16_t*)(p.ws + OFF_PROJ0);
  const bf16_t* wt = (const bf16_t*)(p.ws + OFF_WT_POOL) + (size_t)g * 128 * 128;
  unsigned char* sA = smem; unsigned char* sB = smem + 32768;
  __syncthreads();
  {
    const int st_off = lrow * 128 + ((lc ^ (lrow & 7)) << 4);
#pragma unroll
    for (int kt = 0; kt < 2; ++kt)
#pragma unroll
      for (int i = 0; i < 4; ++i) *(u32x4*)(sB + kt * 16384 + st_off + i * 4096) = *(const u32x4*)(wt + (size_t)(lrow + 32 * i) * 128 + kt * 64 + 8 * lc);
  }
  {
    const int c8 = tid & 15, rg = tid >> 4;
    const int r0 = 8 * rg;
    const int w = 2 << g;
    const int tb = (m0 & 4095) + r0;
    const bf16_t* up = proj + (size_t)(m0 - (m0 & 4095)) * 1536 + g * 128 + 8 * c8;
    u32x4 v[23];
#pragma unroll
    for (int j = 0; j < 23; ++j) {
      const int t = tb - 15 + j;
      v[j] = (u32x4){0u, 0u, 0u, 0u};
      if (t >= 0 && j >= 16 - w) v[j] = *(const u32x4*)(up + (size_t)t * 1536);
    }
    float md[16];
#pragma unroll
    for (int d = 0; d < 16; ++d) md[d] = (d >= 16 - w) ? 1.f : 0.f;
#pragma unroll
    for (int i = 0; i < 8; ++i) {
      float s[8];
#pragma unroll
      for (int e = 0; e < 8; ++e) s[e] = 0.f;
#pragma unroll
      for (int d = 0; d < 16; ++d) {
        const u32x4 x = v[i + d]; const float m = md[d];
        s[0] += m * bflo(x.x); s[1] += m * bfhi(x.x); s[2] += m * bflo(x.y); s[3] += m * bfhi(x.y);
        s[4] += m * bflo(x.z); s[5] += m * bfhi(x.z); s[6] += m * bflo(x.w); s[7] += m * bfhi(x.w);
      }
      const int t = tb + i; const int cnt = (t + 1 < w) ? (t + 1) : w;
      const float inv = 1.f / (float)cnt;
      const u32x4 xc = v[15 + i];
      const float y0 = s[0] * inv - bflo(xc.x), y1 = s[1] * inv - bfhi(xc.x), y2 = s[2] * inv - bflo(xc.y), y3 = s[3] * inv - bfhi(xc.y);
      const float y4 = s[4] * inv - bflo(xc.z), y5 = s[5] * inv - bfhi(xc.z), y6 = s[6] * inv - bflo(xc.w), y7 = s[7] * inv - bfhi(xc.w);
      const int lr = r0 + i;
      u32x4 o = {pk2(y0, y1), pk2(y2, y3), pk2(y4, y5), pk2(y6, y7)};
      *(u32x4*)(sA + (c8 >> 3) * 16384 + lr * 128 + (((c8 & 7) ^ (lr & 7)) << 4)) = o;
    }
  }
  __syncthreads();
  f32x4 acc[4][4]; zero_acc(acc);
  const int a_rd = (64 * wr + fr) * 128, b_rd = (64 * wc + fr) * 128;
  const int sw0 = (fq ^ (fr & 7)) << 4, sw1 = ((4 + fq) ^ (fr & 7)) << 4;
  mma_stage(acc, sA, sB, a_rd, b_rd, sw0, sw1);
  mma_stage(acc, sA + 16384, sB + 16384, a_rd, b_rd, sw0, sw1);
  const float* psc = p.in[5] + g * 128;
  bf16_t* cat = (bf16_t*)(p.ws + OFF_CAT);
#pragma unroll
  for (int m = 0; m < 4; ++m) {
    const int row = m0 + 64 * wr + 16 * m + fr;
#pragma unroll
    for (int n = 0; n < 4; ++n) {
      const int cl = 64 * wc + 16 * n + 4 * fq;
      const f32x4 s4 = *(const f32x4*)(psc + cl);
      const f32x4 v = acc[m][n] * s4;
      u32x2 o = {pk2(v.x, v.y), pk2(v.z, v.w)};
      *(u32x2*)(cat + (size_t)row * 1024 + g * 128 + cl) = o;
    }
  }
}


template <int I> struct SolveRow {
  static DI void run(float (&sol)[64], const float* A_v) {
    float s = sol[I];
#pragma unroll
    for (int g8 = 0; g8 < (I + 31) / 32; ++g8) {
      f32x4 a[8];
#pragma unroll
      for (int q = 0; q < 8; ++q) if (32 * g8 + 4 * q < I) a[q] = *(const f32x4*)(A_v + I * 68 + 32 * g8 + 4 * q);
#pragma unroll
      for (int q = 0; q < 8; ++q) {
        const int j = 32 * g8 + 4 * q;
        if (j + 0 < I) s -= a[q].x * sol[j + 0];
        if (j + 1 < I) s -= a[q].y * sol[j + 1];
        if (j + 2 < I) s -= a[q].z * sol[j + 2];
        if (j + 3 < I) s -= a[q].w * sol[j + 3];
      }
      __builtin_amdgcn_sched_barrier(0);
    }
    sol[I] = s;
    SolveRow<I + 1>::run(sol, A_v);
  }
};
template <> struct SolveRow<64> { static DI void run(float (&)[64], const float*) {} };

constexpr int GD_RAW = 0, GD_Q = 18224, GD_K = GD_Q + 17408, GD_V = GD_K + 17408, GD_GC = GD_V + 17408, GD_BETA = GD_GC + 256, GD_CW = GD_BETA + 256;
DI void gdn_chunk_item(const P& p, int qi, int item, unsigned char* smem, int tid) {
  const int lane = tid & 63, w = tid >> 6, r = lane & 31, hh = lane >> 5;
  const int h = item & 7, n = (item >> 3) & 63, bq = item >> 9;
  const int b = 2 * qi + bq;
  const int chunk = (b * 8 + h) * 64 + n;
  const bf16_t* qkv = (const bf16_t*)(p.ws + OFF_QKV) + (size_t)(bq * 4096) * 3072;
  const float* gb = (const float*)(p.ws + OFF_GB);
  const float* cw = p.in[9];
  float* gc_s = (float*)(smem + GD_GC); float* beta_s = (float*)(smem + GD_BETA);
  __syncthreads();
  u32x4 rawr[5]; float cwr[2];
#define GD_LOADP(PP) do { \
    _Pragma("unroll") for (int i = 0; i < 5; ++i) { const int idx = tid + 256 * i; const int rr_ = idx >> 4, c_ = idx & 15; const int t_ = 64 * n - 3 + rr_; \
      rawr[i] = (u32x4){0u, 0u, 0u, 0u}; if (idx < 1072 && t_ >= 0) rawr[i] = *(const u32x4*)(qkv + (size_t)t_ * 3072 + (PP) * 1024 + h * 128 + 8 * c_); } \
    _Pragma("unroll") for (int i = 0; i < 2; ++i) { const int idx = tid + 256 * i; cwr[i] = cw[(size_t)(idx >> 7) * 3072 + (PP) * 1024 + h * 128 + (idx & 127)]; } \
  } while (0)
  GD_LOADP(0);
  if (w == 0) {
    const int tok = b * 4096 + 64 * n + lane;
    float g = gb[(size_t)tok * 16 + 8 + h]; const float be = gb[(size_t)tok * 16 + h];
#pragma unroll
    for (int off = 1; off < 64; off <<= 1) { const float t = __shfl_up(g, off); if (lane >= off) g += t; }
    gc_s[lane] = g; beta_s[lane] = be;
  }
#pragma unroll 1
  for (int pp = 0; pp < 3; ++pp) {
#pragma unroll
    for (int i = 0; i < 5; ++i) { const int idx = tid + 256 * i; if (idx < 1072) *(u32x4*)(smem + GD_RAW + (idx >> 4) * 272 + 16 * (idx & 15)) = rawr[i]; }
#pragma unroll
    for (int i = 0; i < 2; ++i) ((float*)(smem + GD_CW))[tid + 256 * i] = cwr[i];
    __syncthreads();
    if (pp < 2) GD_LOADP(pp + 1);
    {
      const int row = tid >> 2, qtr = tid & 3; const int ch0 = 32 * qtr;
      float y[32];
#pragma unroll
      for (int sub = 0; sub < 4; ++sub) {
        float a[8];
#pragma unroll
        for (int e = 0; e < 8; ++e) a[e] = 0.f;
#pragma unroll
        for (int tap = 0; tap < 4; ++tap) {
          const u32x4 xv = *(const u32x4*)(smem + GD_RAW + (row + tap) * 272 + (ch0 + 8 * sub) * 2);
          const float* wp = (const float*)(smem + GD_CW) + tap * 128 + ch0 + 8 * sub;
          const f32x4 w0 = *(const f32x4*)wp, w1 = *(const f32x4*)(wp + 4);
          a[0] += w0.x * bflo(xv.x); a[1] += w0.y * bfhi(xv.x); a[2] += w0.z * bflo(xv.y); a[3] += w0.w * bfhi(xv.y);
          a[4] += w1.x * bflo(xv.z); a[5] += w1.y * bfhi(xv.z); a[6] += w1.z * bflo(xv.w); a[7] += w1.w * bfhi(xv.w);
        }
#pragma unroll
        for (int e = 0; e < 8; ++e) y[8 * sub + e] = siluf_(a[e]);
        __builtin_amdgcn_sched_barrier(0);
      }
      if (pp < 2) {
        float s = 0.f;
#pragma unroll
        for (int e = 0; e < 32; ++e) s += y[e] * y[e];
        s += __shfl_xor(s, 1); s += __shfl_xor(s, 2);
        const float inv = rsqrtf(s + EPSF) * (pp == 0 ? 0.08838834764831845f : 1.f);
#pragma unroll
        for (int e = 0; e < 32; ++e) y[e] *= inv;
      }
      unsigned char* dst = smem + (pp == 0 ? GD_Q : pp == 1 ? GD_K : GD_V) + row * 272 + ch0 * 2;
#pragma unroll
      for (int sub = 0; sub < 4; ++sub) {
        u32x4 o = {pk2(y[8 * sub], y[8 * sub + 1]), pk2(y[8 * sub + 2], y[8 * sub + 3]), pk2(y[8 * sub + 4], y[8 * sub + 5]), pk2(y[8 * sub + 6], y[8 * sub + 7])};
        *(u32x4*)(dst + 16 * sub) = o;
      }
    }
    __syncthreads();
  }
  float* A_s = (float*)(smem + GD_RAW);
  bf16_t* qkb = (bf16_t*)(p.ws + OFF_QK) + (size_t)chunk * 4096;
  {
    const int ti = w >> 1, tj = w & 1;
    const int j = 32 * tj + r;
    if (ti == 0 && tj == 1) {
#pragma unroll
      for (int reg = 0; reg < 16; ++reg) qkb[(32 * ti + crow(reg, hh)) * 64 + j] = 0;
    } else {
      f32x16 kk, qk;
#pragma unroll
      for (int i = 0; i < 16; ++i) { kk[i] = 0.f; qk[i] = 0.f; }
#pragma unroll
      for (int s = 0; s < 8; ++s) {
        const bf16x8 bfrag = *(const bf16x8*)(smem + GD_K + (32 * tj + r) * 272 + (16 * s + 8 * hh) * 2);
        const bf16x8 akf = *(const bf16x8*)(smem + GD_K + (32 * ti + r) * 272 + (16 * s + 8 * hh) * 2);
        const bf16x8 aqf = *(const bf16x8*)(smem + GD_Q + (32 * ti + r) * 272 + (16 * s + 8 * hh) * 2);
        kk = mfma32(akf, bfrag, kk); qk = mfma32(aqf, bfrag, qk);
      }
      const float gcj = gc_s[j];
#pragma unroll
      for (int reg = 0; reg < 16; ++reg) {
        const int i = 32 * ti + crow(reg, hh);
        const float dec = (i >= j) ? __expf(gc_s[i] - gcj) : 0.f;
        A_s[i * 68 + j] = (i > j) ? beta_s[i] * kk[reg] * dec : 0.f;
        qkb[i * 64 + j] = f2bf((i >= j) ? qk[reg] * dec : 0.f);
      }
    }
  }
  __syncthreads();
  {
    const int col = tid; const bool isw = col >= 128; const int d = col & 127;
    int vz; asm volatile("v_mov_b32 %0, 0" : "=v"(vz));
    const float* A_v = A_s + vz; const float* gc_v = gc_s + vz; const float* beta_v = beta_s + vz;
    const unsigned char* src = smem + (isw ? GD_K : GD_V) + d * 2;
    float sol[64];
#pragma unroll
    for (int i = 0; i < 64; ++i) {
      float v = bf2f(*(const bf16_t*)(src + i * 272)) * beta_v[i];
      if (isw) v *= __expf(gc_v[i]);
      sol[i] = v;
    }
    SolveRow<1>::run(sol, A_v);
    __syncthreads();
    if (!isw) {
      bf16_t* ut = (bf16_t*)(p.ws + OFF_UT) + (size_t)chunk * 8192 + d * 64;
#pragma unroll
      for (int c8 = 0; c8 < 8; ++c8) {
        u32x4 o = {pk2(sol[8 * c8], sol[8 * c8 + 1]), pk2(sol[8 * c8 + 2], sol[8 * c8 + 3]), pk2(sol[8 * c8 + 4], sol[8 * c8 + 5]), pk2(sol[8 * c8 + 6], sol[8 * c8 + 7])};
        *(u32x4*)(ut + 8 * c8) = o;
      }
      unsigned char* qp = smem + GD_Q + d * 2;
#pragma unroll
      for (int i = 0; i < 64; ++i) { const float v = bf2f(*(const bf16_t*)(qp + i * 272)) * __expf(gc_v[i]); *(bf16_t*)(qp + i * 272) = f2bf(v); }
    } else {
      unsigned char* wp = smem + GD_V + d * 2;
#pragma unroll
      for (int i = 0; i < 64; ++i) *(bf16_t*)(wp + i * 272) = f2bf(-sol[i]);
      bf16_t* kd = (bf16_t*)(p.ws + OFF_KD) + (size_t)chunk * 8192 + d * 64;
      const float gl = gc_v[63];
#pragma unroll
      for (int c8 = 0; c8 < 8; ++c8) {
        float kv[8];
#pragma unroll
        for (int e = 0; e < 8; ++e) kv[e] = bf2f(*(const bf16_t*)(smem + GD_K + (8 * c8 + e) * 272 + d * 2)) * __expf(gl - gc_v[8 * c8 + e]);
        u32x4 o = {pk2(kv[0], kv[1]), pk2(kv[2], kv[3]), pk2(kv[4], kv[5]), pk2(kv[6], kv[7])};
        *(u32x4*)(kd + 8 * c8) = o;
      }
    }
    if (tid == 0) ((float*)(p.ws + OFF_GL))[chunk] = __expf(gc_s[63]);
    __syncthreads();
    {
      bf16_t* wn = (bf16_t*)(p.ws + OFF_WN) + (size_t)chunk * 8192;
      bf16_t* qd = (bf16_t*)(p.ws + OFF_QD) + (size_t)chunk * 8192;
#pragma unroll 1
      for (int i = 0; i < 4; ++i) {
        const int idx = tid + 256 * i; const int lo = (idx >> 4) * 272 + (idx & 15) * 16;
        *(u32x4*)(wn + (size_t)idx * 8) = *(const u32x4*)(smem + GD_V + lo);
        *(u32x4*)(qd + (size_t)idx * 8) = *(const u32x4*)(smem + GD_Q + lo);
      }
    }
  }
}

constexpr int SC_W = 0, SC_QD = 17408, SC_QK = 34816, SC_KD = 34816 + 9216, SC_U = 34816 + 9216 + 18432;
DI bf16x8 pack44(const f32x4& a, const f32x4& b) { u32x4 v = {pk2(a.x, a.y), pk2(a.z, a.w), pk2(b.x, b.y), pk2(b.z, b.w)}; return __builtin_bit_cast(bf16x8, v); }
DI void scan_item(const P& p, int item, unsigned char* smem, int tid) {
  const int lane = tid & 63, w = tid >> 6, fr = lane & 15, fq = lane >> 4;
  const int bh = item >> 1, hf = item & 1;
  const bf16_t* WN = (const bf16_t*)(p.ws + OFF_WN); const bf16_t* QD = (const bf16_t*)(p.ws + OFF_QD);
  const bf16_t* KD = (const bf16_t*)(p.ws + OFF_KD); const bf16_t* QK = (const bf16_t*)(p.ws + OFF_QK);
  bf16_t* UT = (bf16_t*)(p.ws + OFF_UT) + hf * 4096; const float* GL = (const float*)(p.ws + OFF_GL);
  f32x4 S[8];
#pragma unroll
  for (int dt = 0; dt < 8; ++dt) S[dt] = (f32x4){0.f, 0.f, 0.f, 0.f};
  u32x4 st[16];
  const int chunk0 = bh * 64;
#define SC_LOAD(CH) do { \
    const size_t cb = (size_t)(CH) * 8192; \
    _Pragma("unroll") for (int i = 0; i < 4; ++i) { st[i] = *(const u32x4*)(WN + cb + (size_t)(tid + 256 * i) * 8); st[4 + i] = *(const u32x4*)(QD + cb + (size_t)(tid + 256 * i) * 8); st[10 + i] = *(const u32x4*)(KD + cb + (size_t)(tid + 256 * i) * 8); } \
    _Pragma("unroll") for (int i = 0; i < 2; ++i) { st[8 + i] = *(const u32x4*)(QK + (size_t)(CH) * 4096 + (size_t)(tid + 256 * i) * 8); st[14 + i] = *(const u32x4*)(UT + cb + (size_t)(tid + 256 * i) * 8); } \
  } while (0)
#define SC_STORE() do { \
    _Pragma("unroll") for (int i = 0; i < 4; ++i) { const int idx = tid + 256 * i; const int o16 = (idx >> 4) * 272 + (idx & 15) * 16; *(u32x4*)(smem + SC_W + o16) = st[i]; *(u32x4*)(smem + SC_QD + o16) = st[4 + i]; \
      const int o8 = (idx >> 3) * 144 + (idx & 7) * 16; *(u32x4*)(smem + SC_KD + o8) = st[10 + i]; } \
    _Pragma("unroll") for (int i = 0; i < 2; ++i) { const int idx = tid + 256 * i; const int o8 = (idx >> 3) * 144 + (idx & 7) * 16; *(u32x4*)(smem + SC_QK + o8) = st[8 + i]; *(u32x4*)(smem + SC_U + o8) = st[14 + i]; } \
  } while (0)
  SC_LOAD(chunk0);
  __syncthreads();
  for (int n = 0; n < 64; ++n) {
    const int chunk = chunk0 + n;
    SC_STORE();
    __syncthreads();
    if (n + 1 < 64) SC_LOAD(chunk + 1);
    f32x4 vn[4];
#pragma unroll
    for (int ct = 0; ct < 4; ++ct) { const u32x2 u = *(const u32x2*)(smem + SC_U + (16 * w + fr) * 144 + (16 * ct + 4 * fq) * 2); vn[ct] = (f32x4){bflo(u.x), bfhi(u.x), bflo(u.y), bfhi(u.y)}; }
    const float gl = GL[chunk];
    bf16x8 Sp[4];
#pragma unroll
    for (int kk = 0; kk < 4; ++kk) Sp[kk] = pack44(S[2 * kk], S[2 * kk + 1]);
#pragma unroll
    for (int ct = 0; ct < 4; ++ct)
#pragma unroll
      for (int kk = 0; kk < 4; ++kk) {
        const unsigned char* ap = smem + SC_W + (16 * ct + fr) * 272 + (32 * kk + 4 * fq) * 2;
        vn[ct] = mfma16(mk8(*(const u32x2*)ap, *(const u32x2*)(ap + 32)), Sp[kk], vn[ct]);
      }
    bf16x8 vp[2];
    vp[0] = pack44(vn[0], vn[1]); vp[1] = pack44(vn[2], vn[3]);
#pragma unroll
    for (int ct = 0; ct < 4; ++ct) {
      f32x4 o = {0.f, 0.f, 0.f, 0.f};
#pragma unroll
      for (int kk = 0; kk < 4; ++kk) {
        const unsigned char* ap = smem + SC_QD + (16 * ct + fr) * 272 + (32 * kk + 4 * fq) * 2;
        o = mfma16(mk8(*(const u32x2*)ap, *(const u32x2*)(ap + 32)), Sp[kk], o);
      }
#pragma unroll
      for (int kc = 0; kc < 2; ++kc) {
        const unsigned char* ap = smem + SC_QK + (16 * ct + fr) * 144 + (32 * kc + 4 * fq) * 2;
        o = mfma16(mk8(*(const u32x2*)ap, *(const u32x2*)(ap + 32)), vp[kc], o);
      }
      bf16_t* op = UT + (size_t)chunk * 8192 + (size_t)(16 * ct + 4 * fq) * 64 + 16 * w + fr;
      op[0] = f2bf(o.x); op[64] = f2bf(o.y); op[128] = f2bf(o.z); op[192] = f2bf(o.w);
    }
#pragma unroll
    for (int dt = 0; dt < 8; ++dt) {
      S[dt] = S[dt] * gl;
#pragma unroll
      for (int kc = 0; kc < 2; ++kc) {
        const unsigned char* ap = smem + SC_KD + (16 * dt + fr) * 144 + (32 * kc + 4 * fq) * 2;
        S[dt] = mfma16(mk8(*(const u32x2*)ap, *(const u32x2*)(ap + 32)), vp[kc], S[dt]);
      }
    }
    __syncthreads();
  }
}

DI void phase_final(const P& p, int tid) {
  const int lane = tid & 63, wid = tid >> 6;
  float* x = p.out; const float* g = p.in[21];
  for (int row = blockIdx.x * 4 + wid; row < NTOK; row += gridDim.x * 4) {
    f32x4 v[4]; float s = 0.f;
#pragma unroll
    for (int i = 0; i < 4; ++i) { v[i] = *(const f32x4*)(x + (size_t)row * 1024 + 256 * i + 4 * lane); s += v[i].x * v[i].x + v[i].y * v[i].y + v[i].z * v[i].z + v[i].w * v[i].w; }
#pragma unroll
    for (int off = 32; off > 0; off >>= 1) s += __shfl_xor(s, off);
    const float rs = rsqrtf(s * (1.f / 1024.f) + EPSF);
#pragma unroll
    for (int i = 0; i < 4; ++i) { const f32x4 gg = *(const f32x4*)(g + 256 * i + 4 * lane); *(f32x4*)(x + (size_t)row * 1024 + 256 * i + 4 * lane) = v[i] * rs * gg; }
  }
}


#define XB_TMO      128
#define XB_XCNT(j)  (256  + 64 * (j))
#define XB_XSUB(j)  (1280 + 64 * (j))
#define XB_XGEN(j)  (2304 + 64 * (j))
#define XB_TOP      3328
#define XB_TOPGEN   3392
#define XCD_BAR_WORDS 3456
#define XB_SPIN_CAP (1u << 18)
#define LAS __attribute__((address_space(3)))
DI unsigned xb_ld(unsigned* p)              { return __hip_atomic_load(p, __ATOMIC_RELAXED, __HIP_MEMORY_SCOPE_AGENT); }
DI unsigned xb_add(unsigned* p, unsigned v) { return __hip_atomic_fetch_add(p, v, __ATOMIC_RELAXED, __HIP_MEMORY_SCOPE_AGENT); }
DI unsigned xb_xcc_id() { return (unsigned)__builtin_amdgcn_s_getreg((3 << 11) | 20) & 0xFu; }
#define XB_SPIN(cond, bar) do { unsigned _sp = 0; while (cond) { __builtin_amdgcn_s_sleep(1); \
    if ((++_sp & 255u) == 0u) { if (xb_ld(&(bar)[XB_TMO])) break; if (_sp > XB_SPIN_CAP) { atomicAdd(&(bar)[XB_TMO], 1u); break; } } } } while (0)
struct XcdBarrier { unsigned* bar; unsigned x; volatile LAS unsigned* st; };
DI XcdBarrier xcd_barrier_post(unsigned* bar, volatile LAS unsigned* st) {
  XcdBarrier b; b.bar = bar; b.x = xb_xcc_id(); b.st = st;
  if (threadIdx.x == 0) (void)xb_add(&bar[XB_XCNT(b.x)], 1u);
  return b;
}
DI void xcd_barrier_complete(unsigned* bar, unsigned x, unsigned& nloc, unsigned& nx) {
  const unsigned G = gridDim.x * gridDim.y * gridDim.z;
  unsigned sum, cnt, mine, sp = 0u;
  for (;;) {
    sum = 0u; cnt = 0u; mine = 0u;
#pragma unroll
    for (unsigned j = 0; j < 16; ++j) { const unsigned c = xb_ld(&bar[XB_XCNT(j)]); sum += c; cnt += (c > 0u) ? 1u : 0u; mine = (j == x) ? c : mine; }
    if (sum == G) break;
    __builtin_amdgcn_s_sleep(1);
    if ((++sp & 255u) == 0u) { if (xb_ld(&bar[XB_TMO])) break; if (sp > XB_SPIN_CAP) { atomicAdd(&bar[XB_TMO], 1u); break; } }
  }
  nloc = mine > 0u ? mine : 1u; nx = cnt > 0u ? cnt : 1u;
}
DI void xcd_barrier(const XcdBarrier& b) {
  asm volatile("s_waitcnt vmcnt(0)" ::: "memory");
  __syncthreads();
  if (threadIdx.x == 0) {
    unsigned* bar = b.bar;
    unsigned bx = b.x;
    asm volatile("" : "+s"(bar), "+s"(bx));
    __builtin_amdgcn_s_waitcnt(0);
    unsigned nloc = b.st[0], nx = b.st[1];
    if (nloc == 0u) { xcd_barrier_complete(bar, bx, nloc, nx); b.st[0] = nloc; b.st[1] = nx; }
    const unsigned old = xb_add(&bar[XB_XSUB(bx)], 1u);
    const unsigned gen = old / nloc;
    if (old + 1u == (gen + 1u) * nloc) {
      __builtin_amdgcn_fence(__ATOMIC_RELEASE, "agent");
      asm volatile("s_waitcnt vmcnt(0)" ::: "memory");
      const unsigned og = xb_add(&bar[XB_TOP], 1u);
      const unsigned tg = og / nx;
      if (og + 1u == (tg + 1u) * nx) xb_add(&bar[XB_TOPGEN], 1u);
      else XB_SPIN(xb_ld(&bar[XB_TOPGEN]) == tg, bar);
      __builtin_amdgcn_fence(__ATOMIC_ACQUIRE, "agent");
      xb_add(&bar[XB_XGEN(bx)], 1u);
      asm volatile("s_waitcnt vmcnt(0)" ::: "memory");
    } else {
      XB_SPIN(xb_ld(&bar[XB_XGEN(bx)]) == gen, bar);
      __builtin_amdgcn_fence(__ATOMIC_ACQUIRE, "agent");
      asm volatile("s_waitcnt vmcnt(0)" ::: "memory");
    }
  }
  __syncthreads();
}

constexpr int N_PHASES = 24;
typedef const __attribute__((address_space(4))) P* KP;
DI P loadP(KP kp) {
  P p;
#pragma unroll
  for (int i = 0; i < 22; ++i) p.in[i] = kp->in[i];
  p.out = kp->out; p.ws = kp->ws;
  return p;
}
#define SSP(k) ((float*)(p.ws + OFF_SS) + (k) * NTOK)
#define PH_BEGIN { KP kp = (KP)__builtin_amdgcn_kernarg_segment_ptr(); asm volatile("" : "+s"(kp)); \
    unsigned zz_; asm volatile("v_mov_b32 %0, 0" : "=v"(zz_)); \
    int tid = wbase + (int)__builtin_amdgcn_mbcnt_hi(~0u, __builtin_amdgcn_mbcnt_lo(~0u, zz_)); asm volatile("" : "+v"(tid)); \
    const P p = loadP(kp);
#define PH_END } xcd_barrier(xb);

__global__ void __launch_bounds__(256, 2) mega(P p_arg, int ph_lo, int ph_hi) {
  extern __shared__ __attribute__((aligned(16))) unsigned char smem[];
  __shared__ uint4 xb_words;
  cg::grid_group grid = cg::this_grid();
  if (threadIdx.x == 0) xb_words = make_uint4(0u, 0u, 0u, 0u);
  __syncthreads();
  const int wbase = __builtin_amdgcn_readfirstlane((int)(threadIdx.x & ~63u));
  XcdBarrier xb = xcd_barrier_post((unsigned*)(p_arg.ws + OFF_BAR), (volatile LAS unsigned*)&xb_words);
  if (ph_hi < 0) grid.sync();

  PH_BEGIN phase_prologue(p, smem, tid); PH_END
#if REP_PHASE == 0
  PH_BEGIN phase_prologue(p, smem, tid); PH_END
#endif
#pragma unroll 1
  for (int layer = 0; layer < 2; ++layer) {
    if (layer == 0) {
      PH_BEGIN phase_in_e(p, smem, tid); PH_END
      PH_BEGIN for (int i = blockIdx.x; i < 2048 + 1024; i += gridDim.x) { if (i < 2048) attn_item(p, i, smem, tid); else pool_item(p, i - 2048, smem, tid); } PH_END
#if REP_PHASE == 2
      PH_BEGIN for (int i = blockIdx.x; i < 2048 + 1024; i += gridDim.x) { if (i < 2048) attn_item(p, i, smem, tid); else pool_item(p, i - 2048, smem, tid); } PH_END
#endif
    } else {
#pragma unroll 1
      for (int qi = 0; qi < 4; ++qi) {
        PH_BEGIN
          phase_in_o(p, qi, smem, tid);
          {
            const int G = (int)gridDim.x; const int idle0 = (832 % G == 0 || G >= 832) ? (G >= 832 ? 832 : G) : 832 % G;
            const int g0 = 736 * qi, g1 = 736 * qi + 736;
            if (idle0 < G) { if ((int)blockIdx.x >= idle0) convert_list(p, (float*)smem, tid, 1, g0, g1, (int)blockIdx.x - idle0, G - idle0); }
            else convert_list(p, (float*)smem, tid, 1, g0, g1, (int)blockIdx.x, G);
          }
        PH_END
        PH_BEGIN for (int i = blockIdx.x; i < 1024; i += gridDim.x) gdn_chunk_item(p, qi, i, smem, tid); PH_END
#if REP_PHASE == 9
        if (qi == 0) { PH_BEGIN for (int i = blockIdx.x; i < 1024; i += gridDim.x) gdn_chunk_item(p, qi, i, smem, tid); PH_END }
#endif
      }
      PH_BEGIN for (int i = blockIdx.x; i < 128; i += gridDim.x) scan_item(p, i, smem, tid); PH_END
      PH_BEGIN phase_z_gate(p, smem, tid); PH_END
    }
    PH_BEGIN
      phase_resid(p, (const bf16_t*)(p.ws + (layer ? OFF_OB : OFF_CAT)), 1024, (const bf16_t*)(p.ws + (layer ? OFF_WT_OUTO : OFF_WT_OUTE)), layer ? p.out : p.in[0], SSP(1 + 3 * layer), smem, tid);
    PH_END
    PH_BEGIN phase_ffn_up(p, layer, SSP(1 + 3 * layer), smem, tid); PH_END
#if REP_PHASE == 4
    if (layer == 0) { PH_BEGIN phase_ffn_up(p, layer, SSP(1 + 3 * layer), smem, tid); PH_END }
#endif
    PH_BEGIN phase_resid(p, (const bf16_t*)(p.ws + OFF_ACT), 2816, (const bf16_t*)(p.ws + OFF_WT_DOWN) + (size_t)layer * 1024 * 2816, p.out, SSP(2 + 3 * layer), smem, tid); PH_END
    PH_BEGIN phase_ple_gate(p, layer, SSP(2 + 3 * layer), smem, tid); PH_END
#if REP_PHASE == 6
    if (layer == 0) { PH_BEGIN phase_ple_gate(p, layer, SSP(2 + 3 * layer), smem, tid); PH_END }
#endif
    PH_BEGIN phase_ple_add(p, layer, SSP(3 + 3 * layer), smem, tid); PH_END
  }
#if DUMMY_MODE >= 0
  PH_BEGIN phase_dummy(p, DUMMY_MODE, smem, tid); PH_END
#endif
  PH_BEGIN phase_final(p, tid); }
}

extern "C" void kernel_launch(void* const* d_in, const int* in_sizes, int n_in, void* d_out, int out_size, void* d_ws, size_t ws_size, hipStream_t stream) {
  static int grid_blocks = 0;
  if (!grid_blocks) {
    int dev = 0, cus = 0, per_cu = 0;
    hipGetDevice(&dev);
    hipDeviceGetAttribute(&cus, hipDeviceAttributeMultiprocessorCount, dev);
    hipFuncSetAttribute((const void*)mega, hipFuncAttributeMaxDynamicSharedMemorySize, SMEM_BYTES);
    hipOccupancyMaxActiveBlocksPerMultiprocessor(&per_cu, mega, 256, SMEM_BYTES);
    if (per_cu > 2) per_cu = 2;
    if (per_cu < 1) per_cu = 1;
    grid_blocks = cus * per_cu;
  }
  P p{};
  for (int i = 0; i < 22; ++i) p.in[i] = (const float*)d_in[i];
  p.out = (float*)d_out;
  p.ws = (unsigned char*)d_ws;
  hipMemsetAsync(p.ws + OFF_BAR, 0, XCD_BAR_WORDS * 4, stream);
#if MULTI_LAUNCH
  for (int ph = 0; ph < N_PHASES; ++ph) {
    int lo = ph, hi = ph + 1;
    void* args[] = {&p, &lo, &hi};
    hipError_t e = hipLaunchCooperativeKernel((const void*)mega, dim3(grid_blocks), dim3(256), args, SMEM_BYTES, stream);
    if (e != hipSuccess) fprintf(stderr, "launch failed: %s\n", hipGetErrorString(e));
  }
#else
  int lo = 0, hi = N_PHASES;
  void* args[] = {&p, &lo, &hi};
  hipError_t e = hipLaunchCooperativeKernel((const void*)mega, dim3(grid_blocks), dim3(256), args, SMEM_BYTES, stream);
  if (e != hipSuccess) fprintf(stderr, "launch failed: %s (grid %d)\n", hipGetErrorString(e), grid_blocks);
#endif
}
```

```cpp
#include <hip/hip_runtime.h>
#include <hip/hip_cooperative_groups.h>
#include <stdint.h>
#include <cstdio>
namespace cg = cooperative_groups;

#ifndef REP_PHASE
#define REP_PHASE -1
#endif
#ifndef MULTI_LAUNCH
#define MULTI_LAUNCH 0
#endif

#define DI __device__ __forceinline__
typedef unsigned short bf16_t;
typedef short bf16x8 __attribute__((ext_vector_type(8)));
typedef float f32x4 __attribute__((ext_vector_type(4)));
typedef float f32x2 __attribute__((ext_vector_type(2)));
typedef float f32x16 __attribute__((ext_vector_type(16)));
typedef unsigned u32x4 __attribute__((ext_vector_type(4)));
typedef unsigned u32x2 __attribute__((ext_vector_type(2)));
typedef __bf16 hbf2 __attribute__((ext_vector_type(2)));

DI unsigned pk2(float lo, float hi) { f32x2 v = {lo, hi}; hbf2 r = __builtin_convertvector(v, hbf2); return __builtin_bit_cast(unsigned, r); }
DI bf16_t f2bf(float x) { return (bf16_t)(pk2(x, 0.f) & 0xffffu); }
DI float bf2f(bf16_t v) { return __uint_as_float(((unsigned)v) << 16); }
DI float bflo(unsigned u) { return __uint_as_float(u << 16); }
DI float bfhi(unsigned u) { return __uint_as_float(u & 0xffff0000u); }
DI f32x4 mfma16(bf16x8 a, bf16x8 b, f32x4 c) { return __builtin_amdgcn_mfma_f32_16x16x32_bf16(a, b, c, 0, 0, 0); }
DI f32x16 mfma32(bf16x8 a, bf16x8 b, f32x16 c) { return __builtin_amdgcn_mfma_f32_32x32x16_bf16(a, b, c, 0, 0, 0); }
DI int crow(int reg, int hh) { return (reg & 3) + 8 * (reg >> 2) + 4 * hh; }
DI float fexp2(float x) { return __builtin_amdgcn_exp2f(x); }
DI float flog2(float x) { return __builtin_amdgcn_logf(x); }
DI float frcp(float x) { return __builtin_amdgcn_rcpf(x); }
DI float fexp(float x) { return __builtin_amdgcn_exp2f(x * 1.4426950408889634f); }
DI float sigmoidf_(float x) { return frcp(1.f + fexp(-x)); }
DI float siluf_(float x) { return x * frcp(1.f + fexp(-x)); }
DI bf16x8 mk8(u32x2 lo, u32x2 hi) { u32x4 v = {lo.x, lo.y, hi.x, hi.y}; return __builtin_bit_cast(bf16x8, v); }
DI bf16x8 pack_step(const f32x16& x, int s) {
  u32x4 v;
  v.x = pk2(x[8 * s + 0], x[8 * s + 1]); v.y = pk2(x[8 * s + 2], x[8 * s + 3]);
  v.z = pk2(x[8 * s + 4], x[8 * s + 5]); v.w = pk2(x[8 * s + 6], x[8 * s + 7]);
  return __builtin_bit_cast(bf16x8, v);
}

constexpr int SEQ = 4096, DM = 1024, NTOK = 32768;
constexpr int SMEM_BYTES = 73728;
constexpr float EPSF = 1e-6f;

constexpr size_t OFF_WT_INE = 0;
constexpr size_t OFF_WT_OUTE = OFF_WT_INE + 2048ull * 1024 * 2;
constexpr size_t OFF_WT_INO = OFF_WT_OUTE + 1024ull * 1024 * 2;
constexpr size_t OFF_WT_Z = OFF_WT_INO + 3328ull * 1024 * 2;
constexpr size_t OFF_WT_OUTO = OFF_WT_Z + 1024ull * 1024 * 2;
constexpr size_t OFF_WT_UP = OFF_WT_OUTO + 1024ull * 1024 * 2;
constexpr size_t OFF_WT_DOWN = OFF_WT_UP + 2ull * 5632 * 1024 * 2;
constexpr size_t OFF_WT_PLEG = OFF_WT_DOWN + 2ull * 1024 * 2816 * 2;
constexpr size_t OFF_WT_PLE = OFF_WT_PLEG + 2ull * 1024 * 1024 * 2;
constexpr size_t OFF_WT_POOL = OFF_WT_PLE + 2ull * 1024 * 256 * 2;
constexpr size_t OFF_XB = OFF_WT_POOL + 4ull * 128 * 128 * 2;
constexpr size_t OFF_PB = OFF_XB + 32768ull * 1024 * 2;
constexpr size_t OFF_SS = OFF_PB + 2ull * 32768 * 256 * 2;
constexpr size_t OFF_GB = OFF_SS + 7ull * 32768 * 4;
constexpr size_t OFF_GL = OFF_GB + 32768ull * 16 * 4;
constexpr size_t OFF_BAR = OFF_GL + 4096 * 4;
constexpr size_t OFF_R1 = OFF_BAR + 16384;
constexpr size_t OFF_PROJ0 = OFF_R1;
constexpr size_t OFF_VT = OFF_PROJ0 + 32768ull * 1536 * 2;
constexpr size_t OFF_CAT = OFF_VT + 32768ull * 512 * 2;
constexpr size_t OFF_ACT = OFF_R1;
constexpr size_t OFF_UT = OFF_R1;
constexpr size_t OFF_WN = OFF_UT + 67108864ull;
constexpr size_t OFF_QD = OFF_WN + 67108864ull;
constexpr size_t OFF_KD = OFF_QD + 67108864ull;
constexpr size_t OFF_QK = OFF_KD + 67108864ull;
constexpr size_t OFF_QKV = OFF_QK + 33554432ull;
constexpr size_t OFF_GATE = OFF_R1;
constexpr size_t OFF_OB = OFF_WN;

struct P {
  const float* in[22];
  float* out;
  unsigned char* ws;
};

DI void mma_stage(f32x4 (&acc)[4][4], const unsigned char* cA, const unsigned char* cB, int a_rd, int b_rd, int sw0, int sw1) {
#pragma unroll
  for (int ks = 0; ks < 2; ++ks) {
    const int sw = ks ? sw1 : sw0;
    bf16x8 af[4], bfr[4];
#pragma unroll
    for (int m = 0; m < 4; ++m) af[m] = *(const bf16x8*)(cA + a_rd + m * 2048 + sw);
#pragma unroll
    for (int n = 0; n < 4; ++n) bfr[n] = *(const bf16x8*)(cB + b_rd + n * 2048 + sw);
#pragma unroll
    for (int m = 0; m < 4; ++m)
#pragma unroll
      for (int n = 0; n < 4; ++n) acc[m][n] = mfma16(bfr[n], af[m], acc[m][n]);
  }
}
DI void zero_acc(f32x4 (&acc)[4][4]) {
#pragma unroll
  for (int m = 0; m < 4; ++m)
#pragma unroll
    for (int n = 0; n < 4; ++n) acc[m][n] = (f32x4){0.f, 0.f, 0.f, 0.f};
}

constexpr int G_STAGE = 24576, G_AB = 8192;
DI void glds16(const bf16_t* g, unsigned char* l) { __builtin_amdgcn_global_load_lds((const unsigned*)g, (unsigned*)l, 16, 0, 0); }
DI void zero_acc8(f32x4 (&acc)[4][8]) {
#pragma unroll
  for (int m = 0; m < 4; ++m)
#pragma unroll
    for (int n = 0; n < 8; ++n) acc[m][n] = (f32x4){0.f, 0.f, 0.f, 0.f};
}
DI void gemm_core(f32x4 (&acc)[4][8], const bf16_t* pa0, const bf16_t* pa1, const bf16_t* pb0, long ldb64, int nk, unsigned char* smem, int tid) {
  const int lane = tid & 63, wid = tid >> 6, wr = wid >> 1, wc = wid & 1, fr = lane & 15, fq = lane >> 4;
  const int lrow = tid >> 2, lc = tid & 3;
  const int csrc = 8 * (lc ^ ((-(lrow >> 2)) & 3));
  pa0 += csrc; pa1 += csrc; pb0 += csrc;
  unsigned char* dA = smem + tid * 16; unsigned char* dB = smem + G_AB + tid * 16;
  asm volatile("s_waitcnt vmcnt(0)" ::: "memory");
  __builtin_amdgcn_s_barrier();
#define G_ISSUE(KT, ST) do { const int ko_ = (KT) * 32; unsigned char* a_ = dA + (ST) * G_STAGE; unsigned char* b_ = dB + (ST) * G_STAGE; \
    glds16(pa0 + ko_, a_); glds16(pa1 + ko_, a_ + 4096); \
    glds16(pb0 + ko_, b_); glds16(pb0 + ldb64 + ko_, b_ + 4096); glds16(pb0 + 2 * ldb64 + ko_, b_ + 8192); glds16(pb0 + 3 * ldb64 + ko_, b_ + 12288); } while (0)
  G_ISSUE(0, 0);
  G_ISSUE(1, 1);
  const int swz = (fq ^ ((-(fr >> 2)) & 3)) << 4;
  const int a_rd = (64 * wr + fr) * 64 + swz, b_rd = G_AB + (128 * wc + fr) * 64 + swz;
  int st = 0;
#pragma unroll 1
  for (int kt = 0; kt < nk; ++kt) {
    if (kt + 1 < nk) asm volatile("s_waitcnt vmcnt(6)" ::: "memory"); else asm volatile("s_waitcnt vmcnt(0)" ::: "memory");
    __builtin_amdgcn_s_barrier();
    const unsigned char* cs = smem + st * G_STAGE;
    bf16x8 af[4], bfr[8];
#pragma unroll
    for (int m = 0; m < 4; ++m) af[m] = *(const bf16x8*)(cs + a_rd + m * 1024);
#pragma unroll
    for (int n = 0; n < 8; ++n) bfr[n] = *(const bf16x8*)(cs + b_rd + n * 1024);
    const bool more = (kt + 2 < nk);
    const int s2 = (st >= 1) ? st - 1 : 2;
    const int ko2 = (kt + 2) * 32;
    unsigned char* a2 = dA + s2 * G_STAGE; unsigned char* b2 = dB + s2 * G_STAGE;
    if (more) { glds16(pa0 + ko2, a2); glds16(pa1 + ko2, a2 + 4096); }
    __builtin_amdgcn_s_setprio(1);
#pragma unroll
    for (int n = 0; n < 8; ++n) acc[0][n] = mfma16(bfr[n], af[0], acc[0][n]);
    __builtin_amdgcn_sched_barrier(0);
    if (more) { glds16(pb0 + ko2, b2); glds16(pb0 + ldb64 + ko2, b2 + 4096); }
#pragma unroll
    for (int n = 0; n < 8; ++n) acc[1][n] = mfma16(bfr[n], af[1], acc[1][n]);
    __builtin_amdgcn_sched_barrier(0);
    if (more) { glds16(pb0 + 2 * ldb64 + ko2, b2 + 8192); glds16(pb0 + 3 * ldb64 + ko2, b2 + 12288); }
#pragma unroll
    for (int n = 0; n < 8; ++n) acc[2][n] = mfma16(bfr[n], af[2], acc[2][n]);
#pragma unroll
    for (int n = 0; n < 8; ++n) acc[3][n] = mfma16(bfr[n], af[3], acc[3][n]);
    __builtin_amdgcn_s_setprio(0);
    st = (st == 2) ? 0 : st + 1;
  }
  __syncthreads();
}

DI int permrow(int r) { const int s = r & 31; return (r & ~31) | (((s >> 2) & 3) << 3) | ((s >> 4) << 2) | (s & 3); }
DI void tile_decode(int i, int MT, int NT, int& mt, int& nt) {
  const int g = i / (64 * NT); const int il = i - g * 64 * NT; int gm = MT - 64 * g; gm = gm < 64 ? gm : 64;
  nt = il / gm; mt = 64 * g + (il - nt * gm);
}

DI void transpose_convert(const float* __restrict__ W, int ldw, int K, int mode, int coloff, const float* __restrict__ gain,
                          bf16_t* __restrict__ dst, int kt, int ntile, float* tile, int tid) {
  const int n0 = ntile * 64;
  const int tx = tid & 63, ty = tid >> 6;
  const int n = n0 + tx;
  int src; bool valid = true;
  if (mode == 0) { src = coloff + n; }
  else if (mode == 1) { const int j = n >> 8, nl = n & 255, wc = nl >> 7, hp = (nl >> 6) & 1, nt4 = (nl & 63) >> 4, fr = nl & 15; const int ch = 128 * j + 64 * wc + 32 * hp + 16 * (nt4 & 1) + fr; src = (nt4 < 2) ? ch : 2816 + ch; }
  else { if (n < 3072) src = n; else if (n < 3088) src = 4096 + (n - 3072); else { src = 0; valid = false; } }
  __syncthreads();
#pragma unroll
  for (int i = 0; i < 16; ++i) {
    const int kl = ty + 4 * i, k = 64 * kt + kl;
    float v = 0.f;
    if (valid) { v = W[(size_t)k * ldw + src]; if (gain) v *= gain[k]; }
    tile[kl * 65 + tx] = v;
  }
  __syncthreads();
  const int nl = tid >> 2, kc = tid & 3;
#pragma unroll
  for (int cc = 0; cc < 2; ++cc) {
    const int kch = kc * 2 + cc;
    float v[8];
#pragma unroll
    for (int i = 0; i < 8; ++i) v[i] = tile[(8 * kch + i) * 65 + nl];
    u32x4 o = {pk2(v[0], v[1]), pk2(v[2], v[3]), pk2(v[4], v[5]), pk2(v[6], v[7])};
    *(u32x4*)(dst + (size_t)(n0 + nl) * K + 64 * kt + 8 * kch) = o;
  }
}

DI void convert_list(const P& p, float* tile, int tid, int list, int g0, int g1, int blk, int nblk) {
  for (int g = g0 + blk; g < g1; g += nblk) {
    int task, base;
    if (list == 0) {
      if (g < 512) { task = 0; base = 0; } else if (g < 768) { task = 1; base = 512; } else if (g < 1600) { task = 2; base = 768; }
      else if (g < 3008) { task = 5; base = 1600; } else if (g < 3712) { task = 7; base = 3008; } else if (g < 3968) { task = 9; base = 3712; }
      else if (g < 4032) { task = 11; base = 3968; } else { task = 13 + ((g - 4032) >> 2); base = 4032 + 4 * (task - 13); }
    } else {
      if (g < 256) { task = 3; base = 0; } else if (g < 512) { task = 4; base = 256; } else if (g < 1920) { task = 6; base = 512; }
      else if (g < 2624) { task = 8; base = 1920; } else if (g < 2880) { task = 10; base = 2624; } else { task = 12; base = 2880; }
    }
    const float* W; int ldw, K, mode = 0, coloff = 0; const float* gain = nullptr; size_t doff;
    switch (task) {
      case 0: W = p.in[3]; ldw = 2048; K = 1024; gain = p.in[2]; doff = OFF_WT_INE; break;
      case 1: W = p.in[6]; ldw = 1024; K = 1024; doff = OFF_WT_OUTE; break;
      case 2: W = p.in[8]; ldw = 4112; K = 1024; mode = 2; gain = p.in[7]; doff = OFF_WT_INO; break;
      case 3: W = p.in[8]; ldw = 4112; K = 1024; coloff = 3072; gain = p.in[7]; doff = OFF_WT_Z; break;
      case 4: W = p.in[13]; ldw = 1024; K = 1024; doff = OFF_WT_OUTO; break;
      case 5: W = p.in[15]; ldw = 5632; K = 1024; mode = 1; gain = p.in[14]; doff = OFF_WT_UP; break;
      case 6: W = p.in[15] + 1024ull * 5632; ldw = 5632; K = 1024; mode = 1; gain = p.in[14] + 1024; doff = OFF_WT_UP + 5632ull * 1024 * 2; break;
      case 7: W = p.in[17]; ldw = 1024; K = 2816; doff = OFF_WT_DOWN; break;
      case 8: W = p.in[17] + 2816ull * 1024; ldw = 1024; K = 2816; doff = OFF_WT_DOWN + 1024ull * 2816 * 2; break;
      case 9: W = p.in[19]; ldw = 1024; K = 1024; gain = p.in[18]; doff = OFF_WT_PLEG; break;
      case 10: W = p.in[19] + 1024ull * 1024; ldw = 1024; K = 1024; gain = p.in[18] + 1024; doff = OFF_WT_PLEG + 1024ull * 1024 * 2; break;
      case 11: W = p.in[20]; ldw = 1024; K = 256; doff = OFF_WT_PLE; break;
      case 12: W = p.in[20] + 256ull * 1024; ldw = 1024; K = 256; doff = OFF_WT_PLE + 1024ull * 256 * 2; break;
      default: W = p.in[4] + (size_t)(task - 13) * 128 * 128; ldw = 128; K = 128; doff = OFF_WT_POOL + (size_t)(task - 13) * 128 * 128 * 2; break;
    }
    const int nkt = K / 64; const int t = g - base;
    transpose_convert(W, ldw, K, mode, coloff, gain, (bf16_t*)(p.ws + doff), t % nkt, t / nkt, tile, tid);
  }
}

DI void phase_prologue(const P& p, unsigned char* smem, int tid) {
  float* tile = (float*)smem;
  bf16_t* wsb = (bf16_t*)p.ws;
  convert_list(p, tile, tid, 0, 0, 4048, (int)blockIdx.x, (int)gridDim.x);
  {
    const float* x = p.in[0]; bf16_t* xb = (bf16_t*)(p.ws + OFF_XB); float* ss = (float*)(p.ws + OFF_SS);
    const int lane = tid & 63, wid = tid >> 6;
    for (int row = blockIdx.x * 4 + wid; row < NTOK; row += gridDim.x * 4) {
      float s = 0.f;
#pragma unroll
      for (int i = 0; i < 4; ++i) {
        const f32x4 v = *(const f32x4*)(x + (size_t)row * 1024 + 256 * i + 4 * lane);
        s += v.x * v.x + v.y * v.y + v.z * v.z + v.w * v.w;
        u32x2 o = {pk2(v.x, v.y), pk2(v.z, v.w)};
        *(u32x2*)(xb + (size_t)row * 1024 + 256 * i + 4 * lane) = o;
      }
#pragma unroll
      for (int off = 32; off > 0; off >>= 1) s += __shfl_xor(s, off);
      if (lane == 0) ss[row] = s;
    }
    for (int i = blockIdx.x * 256 + tid; i < 6 * NTOK; i += gridDim.x * 256) ss[NTOK + i] = 0.f;
    const float* pp = p.in[1]; bf16_t* pb = (bf16_t*)(p.ws + OFF_PB);
    const size_t n4 = 2ull * 32768 * 256 / 4;
    for (size_t i = (size_t)blockIdx.x * 256 + tid; i < n4; i += (size_t)gridDim.x * 256) {
      const f32x4 v = *(const f32x4*)(pp + 4 * i);
      u32x2 o = {pk2(v.x, v.y), pk2(v.z, v.w)};
      *(u32x2*)(pb + 4 * i) = o;
    }
  }
}

#define GEMM_IDS const int lrow = tid >> 2;
#define EPI_IDS int tid_e = tid; asm volatile("" : "+v"(tid_e)); const int lane = tid_e & 63, wid = tid_e >> 6, wr = wid >> 1, wc = wid & 1, fr = lane & 15, fq = lane >> 4; (void)lane; (void)wr; (void)wc; (void)fr; (void)fq;

DI void phase_in_e(const P& p, unsigned char* smem, int tid) {
  GEMM_IDS
  const bf16_t* xb = (const bf16_t*)(p.ws + OFF_XB); const bf16_t* wt = (const bf16_t*)(p.ws + OFF_WT_INE);
  const float* ss = (const float*)(p.ws + OFF_SS);
  bf16_t* proj = (bf16_t*)(p.ws + OFF_PROJ0); bf16_t* vT = (bf16_t*)(p.ws + OFF_VT);
  for (int i = blockIdx.x; i < 256 * 8; i += gridDim.x) {
    int mt, nt; tile_decode(i, 256, 8, mt, nt);
    const int m0 = mt * 128, n0 = nt * 256;
    const bf16_t* pa = xb + (size_t)(m0 + lrow) * 1024;
    f32x4 acc[4][8]; zero_acc8(acc);
    gemm_core(acc, pa, pa + 64 * 1024, wt + (size_t)(n0 + permrow(lrow)) * 1024, 64 * 1024, 32, smem, tid);
    EPI_IDS
    const float qs = (n0 >= 512 && n0 < 1024) ? 0.18033688011112042f : 1.f;
#pragma unroll
    for (int m = 0; m < 4; ++m) {
      const int row = m0 + 64 * wr + 16 * m + fr;
      const float rs = rsqrtf(ss[row] * (1.f / 1024.f) + EPSF) * qs;
#pragma unroll
      for (int q = 0; q < 4; ++q) {
        const int col = n0 + 128 * wc + 32 * q + 8 * fq;
        const f32x4 v0 = acc[m][2 * q] * rs, v1 = acc[m][2 * q + 1] * rs;
        if (n0 < 1536) {
          u32x4 o = {pk2(v0.x, v0.y), pk2(v0.z, v0.w), pk2(v1.x, v1.y), pk2(v1.z, v1.w)};
          *(u32x4*)(proj + (size_t)row * 1536 + col) = o;
        } else {
          const int cc = col - 1536; const int bh = (row >> 12) * 8 + (cc >> 6), d = cc & 63, t = row & 4095;
          bf16_t* vp = vT + ((size_t)bh * 64 + d) * 4096 + t;
          vp[0] = f2bf(v0.x); vp[4096] = f2bf(v0.y); vp[8192] = f2bf(v0.z); vp[12288] = f2bf(v0.w);
          vp[16384] = f2bf(v1.x); vp[20480] = f2bf(v1.y); vp[24576] = f2bf(v1.z); vp[28672] = f2bf(v1.w);
        }
      }
    }
  }
}

DI void phase_resid(const P& p, const bf16_t* A, int K, const bf16_t* wt, const float* xold, float* ssn, unsigned char* smem, int tid) {
  GEMM_IDS
  bf16_t* xb = (bf16_t*)(p.ws + OFF_XB); float* xnew = p.out;
  for (int i = blockIdx.x; i < 256 * 4; i += gridDim.x) {
    int mt, nt; tile_decode(i, 256, 4, mt, nt);
    const int m0 = mt * 128, n0 = nt * 256;
    const bf16_t* pa = A + (size_t)(m0 + lrow) * K;
    f32x4 acc[4][8]; zero_acc8(acc);
    gemm_core(acc, pa, pa + 64 * (size_t)K, wt + (size_t)(n0 + permrow(lrow)) * K, 64 * (long)K, K / 32, smem, tid);
    EPI_IDS
#pragma unroll
    for (int m = 0; m < 4; ++m) {
      const int row = m0 + 64 * wr + 16 * m + fr;
      float s = 0.f;
#pragma unroll
      for (int q = 0; q < 4; ++q) {
        const int col = n0 + 128 * wc + 32 * q + 8 * fq;
        const f32x4 v0 = *(const f32x4*)(xold + (size_t)row * 1024 + col) + acc[m][2 * q];
        const f32x4 v1 = *(const f32x4*)(xold + (size_t)row * 1024 + col + 4) + acc[m][2 * q + 1];
        *(f32x4*)(xnew + (size_t)row * 1024 + col) = v0;
        *(f32x4*)(xnew + (size_t)row * 1024 + col + 4) = v1;
        u32x4 o = {pk2(v0.x, v0.y), pk2(v0.z, v0.w), pk2(v1.x, v1.y), pk2(v1.z, v1.w)};
        *(u32x4*)(xb + (size_t)row * 1024 + col) = o;
        s += v0.x * v0.x + v0.y * v0.y + v0.z * v0.z + v0.w * v0.w + v1.x * v1.x + v1.y * v1.y + v1.z * v1.z + v1.w * v1.w;
      }
      s += __shfl_xor(s, 16); s += __shfl_xor(s, 32);
      if (fq == 0) atomicAdd(ssn + row, s);
      __builtin_amdgcn_sched_barrier(0);
    }
  }
}

DI void phase_ffn_up(const P& p, int layer, const float* ssc, unsigned char* smem, int tid) {
  GEMM_IDS
  const bf16_t* xb = (const bf16_t*)(p.ws + OFF_XB); const bf16_t* wt = (const bf16_t*)(p.ws + OFF_WT_UP) + (size_t)layer * 5632 * 1024;
  bf16_t* act = (bf16_t*)(p.ws + OFF_ACT);
  const float* cw = p.in[16] + (size_t)layer * 3 * 5632;
  float* Cs = (float*)smem;
  for (int i = blockIdx.x; i < 264 * 22; i += gridDim.x) {
    int mt, nt; tile_decode(i, 264, 22, mt, nt);
    const int b = mt / 33, mi = mt - b * 33;
    const int t0 = 126 * mi - 2;
    const bf16_t* pa[2];
#pragma unroll
    for (int j = 0; j < 2; ++j) { int t = t0 + lrow + 64 * j; t = t < 0 ? 0 : (t > 4095 ? 4095 : t); pa[j] = xb + (size_t)(b * 4096 + t) * 1024; }
    f32x4 acc[4][8]; zero_acc8(acc);
    gemm_core(acc, pa[0], pa[1], wt + (size_t)(nt * 256 + lrow) * 1024, 64 * 1024, 32, smem, tid);
    EPI_IDS
    float rsv[4];
#pragma unroll
    for (int m = 0; m < 4; ++m) {
      int t = t0 + 64 * wr + 16 * m + fr; const bool neg = t < 0; t = t < 0 ? 0 : (t > 4095 ? 4095 : t);
      rsv[m] = neg ? 0.f : rsqrtf(ssc[b * 4096 + t] * (1.f / 1024.f) + EPSF);
    }
#pragma unroll
    for (int hp = 0; hp < 2; ++hp) {
      if (hp) __syncthreads();
#pragma unroll
      for (int m = 0; m < 4; ++m) {
        const int lr = 64 * wr + 16 * m + fr;
#pragma unroll
        for (int n = 0; n < 4; ++n) *(f32x4*)(Cs + lr * 132 + 64 * wc + 16 * n + 4 * fq) = acc[m][4 * hp + n] * rsv[m];
      }
      __syncthreads();
      const int cl = tid & 63, rg = tid >> 6;
      const int gcol = 64 * (cl >> 5) + 16 * ((cl & 31) >> 4) + (cl & 15), vcol = gcol + 32;
      const int ch = nt * 128 + 64 * (cl >> 5) + 32 * hp + (cl & 31);
      const float wg0 = cw[ch], wg1 = cw[5632 + ch], wg2 = cw[2 * 5632 + ch];
      const float wv0 = cw[2816 + ch], wv1 = cw[5632 + 2816 + ch], wv2 = cw[2 * 5632 + 2816 + ch];
      const int lr0 = 2 + 32 * rg;
      float g2 = Cs[(lr0 - 2) * 132 + gcol], g1 = Cs[(lr0 - 1) * 132 + gcol];
      float v2 = Cs[(lr0 - 2) * 132 + vcol], v1 = Cs[(lr0 - 1) * 132 + vcol];
      for (int r = 0; r < 32; ++r) {
        const int lr = lr0 + r; const int t = t0 + lr;
        if (lr >= 128 || t > 4095) break;
        const float g0 = Cs[lr * 132 + gcol], v0 = Cs[lr * 132 + vcol];
        const float yg = wg0 * g2 + wg1 * g1 + wg2 * g0;
        const float yv = wv0 * v2 + wv1 * v1 + wv2 * v0;
        act[(size_t)(b * 4096 + t) * 2816 + ch] = f2bf(siluf_(yg) * yv);
        g2 = g1; g1 = g0; v2 = v1; v1 = v0;
      }
    }
  }
}

DI void phase_ple_gate(const P& p, int layer, const float* ssc, unsigned char* smem, int tid) {
  GEMM_IDS
  const bf16_t* xb = (const bf16_t*)(p.ws + OFF_XB);
  const bf16_t* wg = (const bf16_t*)(p.ws + OFF_WT_PLEG) + (size_t)layer * 1024 * 1024;
  bf16_t* gate = (bf16_t*)(p.ws + OFF_GATE);
  for (int i = blockIdx.x; i < 256 * 4; i += gridDim.x) {
    int mt, nt; tile_decode(i, 256, 4, mt, nt);
    const int m0 = mt * 128, n0 = nt * 256;
    const bf16_t* pa = xb + (size_t)(m0 + lrow) * 1024;
    f32x4 acc[4][8]; zero_acc8(acc);
    gemm_core(acc, pa, pa + 64 * 1024, wg + (size_t)(n0 + permrow(lrow)) * 1024, 64 * 1024, 32, smem, tid);
    EPI_IDS
#pragma unroll
    for (int m = 0; m < 4; ++m) {
      const int row = m0 + 64 * wr + 16 * m + fr;
      const float rs = rsqrtf(ssc[row] * (1.f / 1024.f) + EPSF);
#pragma unroll
      for (int q = 0; q < 4; ++q) {
        const int col = n0 + 128 * wc + 32 * q + 8 * fq;
        const f32x4 v0 = acc[m][2 * q] * rs, v1 = acc[m][2 * q + 1] * rs;
        u32x4 o = {pk2(sigmoidf_(v0.x), sigmoidf_(v0.y)), pk2(sigmoidf_(v0.z), sigmoidf_(v0.w)), pk2(sigmoidf_(v1.x), sigmoidf_(v1.y)), pk2(sigmoidf_(v1.z), sigmoidf_(v1.w))};
        *(u32x4*)(gate + (size_t)row * 1024 + col) = o;
      }
    }
  }
}

DI void phase_ple_add(const P& p, int layer, float* ssn, unsigned char* smem, int tid) {
  GEMM_IDS
  bf16_t* xb = (bf16_t*)(p.ws + OFF_XB);
  const bf16_t* wp = (const bf16_t*)(p.ws + OFF_WT_PLE) + (size_t)layer * 1024 * 256;
  const bf16_t* pb = (const bf16_t*)(p.ws + OFF_PB) + (size_t)layer * 32768 * 256;
  const bf16_t* gate = (const bf16_t*)(p.ws + OFF_GATE);
  float* x = p.out;
  for (int i = blockIdx.x; i < 256 * 4; i += gridDim.x) {
    int mt, nt; tile_decode(i, 256, 4, mt, nt);
    const int m0 = mt * 128, n0 = nt * 256;
    const bf16_t* pa = pb + (size_t)(m0 + lrow) * 256;
    f32x4 acc[4][8]; zero_acc8(acc);
    gemm_core(acc, pa, pa + 64 * 256, wp + (size_t)(n0 + permrow(lrow)) * 256, 64 * 256, 8, smem, tid);
    EPI_IDS
#pragma unroll
    for (int m = 0; m < 4; ++m) {
      const int row = m0 + 64 * wr + 16 * m + fr;
      float s = 0.f;
#pragma unroll
      for (int q = 0; q < 4; ++q) {
        const int col = n0 + 128 * wc + 32 * q + 8 * fq;
        const u32x4 gp = *(const u32x4*)(gate + (size_t)row * 1024 + col);
        const f32x4 g0 = {bflo(gp.x), bfhi(gp.x), bflo(gp.y), bfhi(gp.y)}, g1 = {bflo(gp.z), bfhi(gp.z), bflo(gp.w), bfhi(gp.w)};
        const f32x4 v0 = *(const f32x4*)(x + (size_t)row * 1024 + col) + acc[m][2 * q] * g0;
        const f32x4 v1 = *(const f32x4*)(x + (size_t)row * 1024 + col + 4) + acc[m][2 * q + 1] * g1;
        *(f32x4*)(x + (size_t)row * 1024 + col) = v0;
        *(f32x4*)(x + (size_t)row * 1024 + col + 4) = v1;
        if (layer == 0) {
          u32x4 o = {pk2(v0.x, v0.y), pk2(v0.z, v0.w), pk2(v1.x, v1.y), pk2(v1.z, v1.w)};
          *(u32x4*)(xb + (size_t)row * 1024 + col) = o;
        }
        s += v0.x * v0.x + v0.y * v0.y + v0.z * v0.z + v0.w * v0.w + v1.x * v1.x + v1.y * v1.y + v1.z * v1.z + v1.w * v1.w;
      }
      s += __shfl_xor(s, 16); s += __shfl_xor(s, 32);
      if (fq == 0 && layer == 0) atomicAdd(ssn + row, s);
      __builtin_amdgcn_sched_barrier(0);
    }
  }
}

DI void phase_in_o(const P& p, int qi, unsigned char* smem, int tid) {
  GEMM_IDS
  const bf16_t* xb = (const bf16_t*)(p.ws + OFF_XB); const bf16_t* wt = (const bf16_t*)(p.ws + OFF_WT_INO);
  const float* ssc = (const float*)(p.ws + OFF_SS) + 3 * NTOK;
  bf16_t* qkv = (bf16_t*)(p.ws + OFF_QKV); float* gb = (float*)(p.ws + OFF_GB);
  const float* a_log = p.in[10]; const float* dt_bias = p.in[11];
  for (int i = blockIdx.x; i < 64 * 13; i += gridDim.x) {
    int mt, nt; tile_decode(i, 64, 13, mt, nt);
    const int mq0 = mt * 128, m0 = qi * 8192 + mq0, n0 = nt * 256;
    const bf16_t* pa = xb + (size_t)(m0 + lrow) * 1024;
    f32x4 acc[4][8]; zero_acc8(acc);
    gemm_core(acc, pa, pa + 64 * 1024, wt + (size_t)(n0 + permrow(lrow)) * 1024, 64 * 1024, 32, smem, tid);
    EPI_IDS
#pragma unroll
    for (int m = 0; m < 4; ++m) {
      const int rl = 64 * wr + 16 * m + fr;
      const float rs = rsqrtf(ssc[m0 + rl] * (1.f / 1024.f) + EPSF);
      if (nt < 12) {
#pragma unroll
        for (int q = 0; q < 4; ++q) {
          const int col = n0 + 128 * wc + 32 * q + 8 * fq;
          const f32x4 v0 = acc[m][2 * q] * rs, v1 = acc[m][2 * q + 1] * rs;
          u32x4 o = {pk2(v0.x, v0.y), pk2(v0.z, v0.w), pk2(v1.x, v1.y), pk2(v1.z, v1.w)};
          *(u32x4*)(qkv + (size_t)(mq0 + rl) * 3072 + col) = o;
        }
      } else if (wc == 0 && fq < 2) {
        const f32x4 v0 = acc[m][0] * rs, v1 = acc[m][1] * rs;
        float o[8];
#pragma unroll
        for (int j = 0; j < 8; ++j) {
          const float vv = j < 4 ? v0[j] : v1[j - 4];
          if (fq == 0) o[j] = sigmoidf_(vv);
          else {
            const float xx = vv + dt_bias[j];
            const float sp = fmaxf(xx, 0.f) + log1pf(__expf(-fabsf(xx)));
            o[j] = -__expf(a_log[j]) * sp;
          }
        }
        float* gp = gb + (size_t)(m0 + rl) * 16 + 8 * fq;
        *(f32x4*)gp = (f32x4){o[0], o[1], o[2], o[3]}; *(f32x4*)(gp + 4) = (f32x4){o[4], o[5], o[6], o[7]};
      }
    }
  }
}

DI void phase_z_gate(const P& p, unsigned char* smem, int tid) {
  GEMM_IDS
  const bf16_t* xb = (const bf16_t*)(p.ws + OFF_XB); const bf16_t* wt = (const bf16_t*)(p.ws + OFF_WT_Z);
  const float* ssc = (const float*)(p.ws + OFF_SS) + 3 * NTOK;
  const bf16_t* ob_in = (const bf16_t*)(p.ws + OFF_UT);
  bf16_t* ob = (bf16_t*)(p.ws + OFF_OB);
  const float* nw = p.in[12];
  for (int i = blockIdx.x; i < 256 * 4; i += gridDim.x) {
    int mt, nt; tile_decode(i, 256, 4, mt, nt);
    const int m0 = mt * 128, n0 = nt * 256;
    const bf16_t* pa = xb + (size_t)(m0 + lrow) * 1024;
    f32x4 acc[4][8]; zero_acc8(acc);
    gemm_core(acc, pa, pa + 64 * 1024, wt + (size_t)(n0 + permrow(lrow)) * 1024, 64 * 1024, 32, smem, tid);
    EPI_IDS
    const int hd = 2 * nt + wc;
#pragma unroll
    for (int m = 0; m < 4; ++m) {
      const int row = m0 + 64 * wr + 16 * m + fr;
      const int chunk = ((row >> 12) * 8 + hd) * 64 + ((row & 4095) >> 6);
      const bf16_t* op = ob_in + (size_t)chunk * 8192 + (row & 63) * 64 + 8 * fq;
      u32x4 ov[4];
      float s = 0.f;
#pragma unroll
      for (int q = 0; q < 4; ++q) {
        ov[q] = *(const u32x4*)(op + (q >> 1) * 4096 + 32 * (q & 1));
        const float a0 = bflo(ov[q].x), a1 = bfhi(ov[q].x), a2 = bflo(ov[q].y), a3 = bfhi(ov[q].y), a4 = bflo(ov[q].z), a5 = bfhi(ov[q].z), a6 = bflo(ov[q].w), a7 = bfhi(ov[q].w);
        s += a0 * a0 + a1 * a1 + a2 * a2 + a3 * a3 + a4 * a4 + a5 * a5 + a6 * a6 + a7 * a7;
      }
      s += __shfl_xor(s, 16); s += __shfl_xor(s, 32);
      const float on = rsqrtf(s * (1.f / 128.f) + EPSF);
      const float rs = rsqrtf(ssc[row] * (1.f / 1024.f) + EPSF);
#pragma unroll
      for (int q = 0; q < 4; ++q) {
        const int cl = 32 * q + 8 * fq;
        const f32x4 z0 = acc[m][2 * q] * rs, z1 = acc[m][2 * q + 1] * rs;
        const f32x4 w0 = *(const f32x4*)(nw + cl), w1 = *(const f32x4*)(nw + cl + 4);
        const f32x4 o0 = {bflo(ov[q].x), bfhi(ov[q].x), bflo(ov[q].y), bfhi(ov[q].y)}, o1 = {bflo(ov[q].z), bfhi(ov[q].z), bflo(ov[q].w), bfhi(ov[q].w)};
        float r[8];
#pragma unroll
        for (int j = 0; j < 4; ++j) { r[j] = o0[j] * on * w0[j] * siluf_(z0[j]); r[4 + j] = o1[j] * on * w1[j] * siluf_(z1[j]); }
        u32x4 o = {pk2(r[0], r[1]), pk2(r[2], r[3]), pk2(r[4], r[5]), pk2(r[6], r[7])};
        *(u32x4*)(ob + (size_t)row * 1024 + n0 + 128 * wc + cl) = o;
      }
      __builtin_amdgcn_sched_barrier(0);
    }
  }
}

#ifndef DUMMY_MODE
#define DUMMY_MODE -1
#endif
DI void phase_dummy(const P& p, int mode, unsigned char* smem, int tid) {
  GEMM_IDS
  const bf16_t* xb = (const bf16_t*)(p.ws + OFF_XB);
  const bf16_t* wg = (const bf16_t*)(p.ws + OFF_WT_PLEG);
  for (int i = blockIdx.x; i < 256 * 4; i += gridDim.x) {
    int mt, nt; tile_decode(i, 256, 4, mt, nt);
    if (mode == 1) { mt = 0; nt = 0; }
    if (mode == 2) { mt = blockIdx.x & 255; nt = 0; }
    const int m0 = mt * 128, n0 = nt * 256;
    const bf16_t* pa = xb + (size_t)(m0 + lrow) * 1024;
    f32x4 acc[4][8]; zero_acc8(acc);
    gemm_core(acc, pa, pa + 64 * 1024, wg + (size_t)(n0 + lrow) * 1024, 64 * 1024, 32, smem, tid);
    EPI_IDS
    float s = 0.f;
#pragma unroll
    for (int m = 0; m < 4; ++m)
#pragma unroll
      for (int n = 0; n < 8; ++n) s += acc[m][n].x + acc[m][n].y + acc[m][n].z + acc[m][n].w;
    if (s == 123456.789f) ((float*)(p.ws + OFF_GL))[0] = s;
  }
}

DI void attn_item(const P& p, int item, unsigned char* smem, int tid) {
  const int lane = tid & 63, w = tid >> 6, r = lane & 31, hh = lane >> 5;
  const int bh = item & 63, jj = item >> 6;
  int qb; { const int a = jj & 7, grp = jj >> 3; qb = grp == 0 ? 31 - a : grp == 1 ? 16 + a : grp == 2 ? 15 - a : a; }
  const int b = bh >> 3, h = bh & 7;
  const int q0 = qb * 128, qw = q0 + 32 * w;
  const bf16_t* proj = (const bf16_t*)(p.ws + OFF_PROJ0);
  const bf16_t* vT = (const bf16_t*)(p.ws + OFF_VT) + (size_t)bh * 64 * 4096;
  bf16x8 qf[4];
  {
    const bf16_t* qp = proj + (size_t)(b * 4096 + qw + r) * 1536 + 512 + h * 64 + 8 * hh;
#pragma unroll
    for (int s = 0; s < 4; ++s) qf[s] = *(const bf16x8*)(qp + 16 * s);
  }
  f32x16 oacc[2];
#pragma unroll
  for (int i = 0; i < 16; ++i) { oacc[0][i] = 0.f; oacc[1][i] = 0.f; }
  float carry = 0.f;
  const int ntile = q0 / 64 + 2;
  const int lrow = tid >> 3, lc = tid & 7;
  const bf16_t* kbase = proj + (size_t)(b * 4096 + lrow) * 1536 + 1024 + h * 64 + 8 * lc;
  const bf16_t* vbase = vT + (size_t)lrow * 4096 + 8 * lc;
  unsigned char* sK = smem;
  unsigned char* sV = smem + 16384;
  const int kst = lrow * 128 + ((lc ^ (lrow & 7)) << 4);
  const int vst = lrow * 136 + lc * 16;
  u32x4 rk[2], rv[2];
  int kt = ntile - 1;
#pragma unroll
  for (int i = 0; i < 2; ++i) { rk[i] = *(const u32x4*)(kbase + (size_t)(kt * 64 + 32 * i) * 1536); rv[i] = *(const u32x4*)(vbase + (size_t)(32 * i) * 4096 + kt * 64); }
  __syncthreads();
#pragma unroll
  for (int i = 0; i < 2; ++i) {
    *(u32x4*)(sK + kst + i * 4096) = rk[i];
    *(u32x2*)(sV + vst + i * 4352) = (u32x2){rv[i].x, rv[i].y}; *(u32x2*)(sV + vst + i * 4352 + 8) = (u32x2){rv[i].z, rv[i].w};
  }
  __syncthreads();
  int cur = 0;
  for (; kt >= 0; --kt) {
    if (kt > 0) {
#pragma unroll
      for (int i = 0; i < 2; ++i) { rk[i] = *(const u32x4*)(kbase + (size_t)((kt - 1) * 64 + 32 * i) * 1536); rv[i] = *(const u32x4*)(vbase + (size_t)(32 * i) * 4096 + (kt - 1) * 64); }
    }
    const unsigned char* cK = sK + cur * 8192; const unsigned char* cV = sV + cur * 8704;
    const int s0 = kt * 64;
#pragma unroll
    for (int sub = 1; sub >= 0; --sub) {
      const int ks = s0 + 32 * sub;
      if (ks <= qw) {
        f32x16 sc;
#pragma unroll
        for (int i = 0; i < 16; ++i) sc[i] = 0.f;
#pragma unroll
        for (int s = 0; s < 4; ++s) {
          const bf16x8 kf = *(const bf16x8*)(cK + (32 * sub + r) * 128 + (((2 * s + hh) ^ (r & 7)) << 4));
          sc = mfma32(kf, qf[s], sc);
        }
        float sp[16], ls[16];
#pragma unroll
        for (int i = 0; i < 16; ++i) {
          const float z = sc[i];
          sp[i] = flog2(1.f + fexp2(z));
          ls[i] = z - sp[i];
        }
        if (ks == qw) {
#pragma unroll
          for (int i = 0; i < 16; ++i) { const bool valid = crow(i, hh) < r; sp[i] = valid ? sp[i] : 0.f; ls[i] = valid ? ls[i] : -1e30f; }
        }
        float G[4], Pp[4], Tt[4];
#pragma unroll
        for (int g = 0; g < 4; ++g) { G[g] = (sp[4 * g] + sp[4 * g + 1]) + (sp[4 * g + 2] + sp[4 * g + 3]); Pp[g] = __shfl_xor(G[g], 32); Tt[g] = G[g] + Pp[g]; }
        float after = carry;
        f32x16 av;
#pragma unroll
        for (int g = 3; g >= 0; --g) {
          float base = after + (hh == 0 ? Pp[g] : 0.f);
          float k3 = base, k2 = k3 + sp[4 * g + 3], k1 = k2 + sp[4 * g + 2], k0 = k1 + sp[4 * g + 1];
          av[4 * g + 3] = fexp2(ls[4 * g + 3] - k3); av[4 * g + 2] = fexp2(ls[4 * g + 2] - k2);
          av[4 * g + 1] = fexp2(ls[4 * g + 1] - k1); av[4 * g + 0] = fexp2(ls[4 * g + 0] - k0);
          after += Tt[g];
        }
        carry = after;
#pragma unroll
        for (int s = 0; s < 2; ++s) {
          const bf16x8 ap = pack_step(av, s);
#pragma unroll
          for (int dt = 0; dt < 2; ++dt) {
            const unsigned char* vp = cV + (32 * dt + r) * 136 + (32 * sub + 16 * s + 4 * hh) * 2;
            const bf16x8 vf = mk8(*(const u32x2*)vp, *(const u32x2*)(vp + 16));
            oacc[dt] = mfma32(vf, ap, oacc[dt]);
          }
        }
      }
    }
    if (kt > 0) {
      unsigned char* nK = sK + (cur ^ 1) * 8192; unsigned char* nV = sV + (cur ^ 1) * 8704;
#pragma unroll
      for (int i = 0; i < 2; ++i) {
        *(u32x4*)(nK + kst + i * 4096) = rk[i];
        *(u32x2*)(nV + vst + i * 4352) = (u32x2){rv[i].x, rv[i].y}; *(u32x2*)(nV + vst + i * 4352 + 8) = (u32x2){rv[i].z, rv[i].w};
      }
    }
    int* flg = (int*)(smem + 34816) + 4 * cur;
    { const bool wdone = (__ballot(carry < 160.f) == 0ull); if (lane == 0) flg[w] = wdone ? 1 : 0; }
    __syncthreads();
    if (flg[0] + flg[1] + flg[2] + flg[3] == 4) break;
    cur ^= 1;
  }
  bf16_t* cat = (bf16_t*)(p.ws + OFF_CAT) + (size_t)(b * 4096 + qw + r) * 1024 + 512 + h * 64;
#pragma unroll
  for (int dt = 0; dt < 2; ++dt)
#pragma unroll
    for (int g = 0; g < 4; ++g) {
      u32x2 o = {pk2(oacc[dt][4 * g], oacc[dt][4 * g + 1]), pk2(oacc[dt][4 * g + 2], oacc[dt][4 * g + 3])};
      *(u32x2*)(cat + 32 * dt + 8 * g + 4 * hh) = o;
    }
}

DI void pool_item(const P& p, int item, unsigned char* smem, int tid) {
  const int lane = tid & 63, wid = tid >> 6, wr = wid >> 1, wc = wid & 1, fr = lane & 15, fq = lane >> 4; const int lrow = tid >> 3, lc = tid & 7; (void)lane;
  const int g = item & 3, mt = item >> 2;
  const int m0 = mt * 128;
  const bf16_t* proj = (const bf16_t*)(p.ws + OFF_PROJ0);
  const bf16_t* wt = (const bf16_t*)(p.ws + OFF_WT_POOL) + (size_t)g * 128 * 128;
  unsigned char* sA = smem; unsigned char* sB = smem + 32768;
  __syncthreads();
  {
    const int st_off = lrow * 128 + ((lc ^ (lrow & 7)) << 4);
#pragma unroll
    for (int kt = 0; kt < 2; ++kt)
#pragma unroll
      for (int i = 0; i < 4; ++i) *(u32x4*)(sB + kt * 16384 + st_off + i * 4096) = *(const u32x4*)(wt + (size_t)(lrow + 32 * i) * 128 + kt * 64 + 8 * lc);
  }
  {
    const int c8 = tid & 15, rg = tid >> 4;
    const int r0 = 8 * rg;
    const int w = 2 << g;
    const int tb = (m0 & 4095) + r0;
    const bf16_t* up = proj + (size_t)(m0 - (m0 & 4095)) * 1536 + g * 128 + 8 * c8;
    u32x4 v[23];
#pragma unroll
    for (int j = 0; j < 23; ++j) {
      const int t = tb - 15 + j;
      v[j] = (u32x4){0u, 0u, 0u, 0u};
      if (t >= 0 && j >= 16 - w) v[j] = *(const u32x4*)(up + (size_t)t * 1536);
    }
    float md[16];
#pragma unroll
    for (int d = 0; d < 16; ++d) md[d] = (d >= 16 - w) ? 1.f : 0.f;
#pragma unroll
    for (int i = 0; i < 8; ++i) {
      float s[8];
#pragma unroll
      for (int e = 0; e < 8; ++e) s[e] = 0.f;
#pragma unroll
      for (int d = 0; d < 16; ++d) {
        const u32x4 x = v[i + d]; const float m = md[d];
        s[0] += m * bflo(x.x); s[1] += m * bfhi(x.x); s[2] += m * bflo(x.y); s[3] += m * bfhi(x.y);
        s[4] += m * bflo(x.z); s[5] += m * bfhi(x.z); s[6] += m * bflo(x.w); s[7] += m * bfhi(x.w);
      }
      const int t = tb + i; const int cnt = (t + 1 < w) ? (t + 1) : w;
      const float inv = 1.f / (float)cnt;
      const u32x4 xc = v[15 + i];
      const float y0 = s[0] * inv - bflo(xc.x), y1 = s[1] * inv - bfhi(xc.x), y2 = s[2] * inv - bflo(xc.y), y3 = s[3] * inv - bfhi(xc.y);
      const float y4 = s[4] * inv - bflo(xc.z), y5 = s[5] * inv - bfhi(xc.z), y6 = s[6] * inv - bflo(xc.w), y7 = s[7] * inv - bfhi(xc.w);
      const int lr = r0 + i;
      u32x4 o = {pk2(y0, y1), pk2(y2, y3), pk2(y4, y5), pk2(y6, y7)};
      *(u32x4*)(sA + (c8 >> 3) * 16384 + lr * 128 + (((c8 & 7) ^ (lr & 7)) << 4)) = o;
    }
  }
  __syncthreads();
  f32x4 acc[4][4]; zero_acc(acc);
  const int a_rd = (64 * wr + fr) * 128, b_rd = (64 * wc + fr) * 128;
  const int sw0 = (fq ^ (fr & 7)) << 4, sw1 = ((4 + fq) ^ (fr & 7)) << 4;
  mma_stage(acc, sA, sB, a_rd, b_rd, sw0, sw1);
  mma_stage(acc, sA + 16384, sB + 16384, a_rd, b_rd, sw0, sw1);
  const float* psc = p.in[5] + g * 128;
  bf16_t* cat = (bf16_t*)(p.ws + OFF_CAT);
#pragma unroll
  for (int m = 0; m < 4; ++m) {
    const int row = m0 + 64 * wr + 16 * m + fr;
#pragma unroll
    for (int n = 0; n < 4; ++n) {
      const int cl = 64 * wc + 16 * n + 4 * fq;
      const f32x4 s4 = *(const f32x4*)(psc + cl);
      const f32x4 v = acc[m][n] * s4;
      u32x2 o = {pk2(v.x, v.y), pk2(v.z, v.w)};
      *(u32x2*)(cat + (size_t)row * 1024 + g * 128 + cl) = o;
    }
  }
}


template <int I> struct SolveRow {
  static DI void run(float (&sol)[64], const float* A_v) {
    float s = sol[I];
#pragma unroll
    for (int g8 = 0; g8 < (I + 31) / 32; ++g8) {
      f32x4 a[8];
#pragma unroll
      for (int q = 0; q < 8; ++q) if (32 * g8 + 4 * q < I) a[q] = *(const f32x4*)(A_v + I * 68 + 32 * g8 + 4 * q);
#pragma unroll
      for (int q = 0; q < 8; ++q) {
        const int j = 32 * g8 + 4 * q;
        if (j + 0 < I) s -= a[q].x * sol[j + 0];
        if (j + 1 < I) s -= a[q].y * sol[j + 1];
        if (j + 2 < I) s -= a[q].z * sol[j + 2];
        if (j + 3 < I) s -= a[q].w * sol[j + 3];
      }
      __builtin_amdgcn_sched_barrier(0);
    }
    sol[I] = s;
    SolveRow<I + 1>::run(sol, A_v);
  }
};
template <> struct SolveRow<64> { static DI void run(float (&)[64], const float*) {} };

constexpr int GD_RAW = 0, GD_Q = 18224, GD_K = GD_Q + 17408, GD_V = GD_K + 17408, GD_GC = GD_V + 17408, GD_BETA = GD_GC + 256, GD_CW = GD_BETA + 256;
DI void gdn_chunk_item(const P& p, int qi, int item, unsigned char* smem, int tid) {
  const int lane = tid & 63, w = tid >> 6, r = lane & 31, hh = lane >> 5;
  const int h = item & 7, n = (item >> 3) & 63, bq = item >> 9;
  const int b = 2 * qi + bq;
  const int chunk = (b * 8 + h) * 64 + n;
  const bf16_t* qkv = (const bf16_t*)(p.ws + OFF_QKV) + (size_t)(bq * 4096) * 3072;
  const float* gb = (const float*)(p.ws + OFF_GB);
  const float* cw = p.in[9];
  float* gc_s = (float*)(smem + GD_GC); float* beta_s = (float*)(smem + GD_BETA);
  __syncthreads();
  u32x4 rawr[5]; float cwr[2];
#define GD_LOADP(PP) do { \
    _Pragma("unroll") for (int i = 0; i < 5; ++i) { const int idx = tid + 256 * i; const int rr_ = idx >> 4, c_ = idx & 15; const int t_ = 64 * n - 3 + rr_; \
      rawr[i] = (u32x4){0u, 0u, 0u, 0u}; if (idx < 1072 && t_ >= 0) rawr[i] = *(const u32x4*)(qkv + (size_t)t_ * 3072 + (PP) * 1024 + h * 128 + 8 * c_); } \
    _Pragma("unroll") for (int i = 0; i < 2; ++i) { const int idx = tid + 256 * i; cwr[i] = cw[(size_t)(idx >> 7) * 3072 + (PP) * 1024 + h * 128 + (idx & 127)]; } \
  } while (0)
  GD_LOADP(0);
  if (w == 0) {
    const int tok = b * 4096 + 64 * n + lane;
    float g = gb[(size_t)tok * 16 + 8 + h]; const float be = gb[(size_t)tok * 16 + h];
#pragma unroll
    for (int off = 1; off < 64; off <<= 1) { const float t = __shfl_up(g, off); if (lane >= off) g += t; }
    gc_s[lane] = g; beta_s[lane] = be;
  }
#pragma unroll 1
  for (int pp = 0; pp < 3; ++pp) {
#pragma unroll
    for (int i = 0; i < 5; ++i) { const int idx = tid + 256 * i; if (idx < 1072) *(u32x4*)(smem + GD_RAW + (idx >> 4) * 272 + 16 * (idx & 15)) = rawr[i]; }
#pragma unroll
    for (int i = 0; i < 2; ++i) ((float*)(smem + GD_CW))[tid + 256 * i] = cwr[i];
    __syncthreads();
    if (pp < 2) GD_LOADP(pp + 1);
    {
      const int row = tid >> 2, qtr = tid & 3; const int ch0 = 32 * qtr;
      float y[32];
#pragma unroll
      for (int sub = 0; sub < 4; ++sub) {
        float a[8];
#pragma unroll
        for (int e = 0; e < 8; ++e) a[e] = 0.f;
#pragma unroll
        for (int tap = 0; tap < 4; ++tap) {
          const u32x4 xv = *(const u32x4*)(smem + GD_RAW + (row + tap) * 272 + (ch0 + 8 * sub) * 2);
          const float* wp = (const float*)(smem + GD_CW) + tap * 128 + ch0 + 8 * sub;
          const f32x4 w0 = *(const f32x4*)wp, w1 = *(const f32x4*)(wp + 4);
          a[0] += w0.x * bflo(xv.x); a[1] += w0.y * bfhi(xv.x); a[2] += w0.z * bflo(xv.y); a[3] += w0.w * bfhi(xv.y);
          a[4] += w1.x * bflo(xv.z); a[5] += w1.y * bfhi(xv.z); a[6] += w1.z * bflo(xv.w); a[7] += w1.w * bfhi(xv.w);
        }
#pragma unroll
        for (int e = 0; e < 8; ++e) y[8 * sub + e] = siluf_(a[e]);
        __builtin_amdgcn_sched_barrier(0);
      }
      if (pp < 2) {
        float s = 0.f;
#pragma unroll
        for (int e = 0; e < 32; ++e) s += y[e] * y[e];
        s += __shfl_xor(s, 1); s += __shfl_xor(s, 2);
        const float inv = rsqrtf(s + EPSF) * (pp == 0 ? 0.08838834764831845f : 1.f);
#pragma unroll
        for (int e = 0; e < 32; ++e) y[e] *= inv;
      }
      unsigned char* dst = smem + (pp == 0 ? GD_Q : pp == 1 ? GD_K : GD_V) + row * 272 + ch0 * 2;
#pragma unroll
      for (int sub = 0; sub < 4; ++sub) {
        u32x4 o = {pk2(y[8 * sub], y[8 * sub + 1]), pk2(y[8 * sub + 2], y[8 * sub + 3]), pk2(y[8 * sub + 4], y[8 * sub + 5]), pk2(y[8 * sub + 6], y[8 * sub + 7])};
        *(u32x4*)(dst + 16 * sub) = o;
      }
    }
    __syncthreads();
  }
  float* A_s = (float*)(smem + GD_RAW);
  bf16_t* qkb = (bf16_t*)(p.ws + OFF_QK) + (size_t)chunk * 4096;
  {
    const int ti = w >> 1, tj = w & 1;
    const int j = 32 * tj + r;
    if (ti == 0 && tj == 1) {
#pragma unroll
      for (int reg = 0; reg < 16; ++reg) qkb[(32 * ti + crow(reg, hh)) * 64 + j] = 0;
    } else {
      f32x16 kk, qk;
#pragma unroll
      for (int i = 0; i < 16; ++i) { kk[i] = 0.f; qk[i] = 0.f; }
#pragma unroll
      for (int s = 0; s < 8; ++s) {
        const bf16x8 bfrag = *(const bf16x8*)(smem + GD_K + (32 * tj + r) * 272 + (16 * s + 8 * hh) * 2);
        const bf16x8 akf = *(const bf16x8*)(smem + GD_K + (32 * ti + r) * 272 + (16 * s + 8 * hh) * 2);
        const bf16x8 aqf = *(const bf16x8*)(smem + GD_Q + (32 * ti + r) * 272 + (16 * s + 8 * hh) * 2);
        kk = mfma32(akf, bfrag, kk); qk = mfma32(aqf, bfrag, qk);
      }
      const float gcj = gc_s[j];
#pragma unroll
      for (int reg = 0; reg < 16; ++reg) {
        const int i = 32 * ti + crow(reg, hh);
        const float dec = (i >= j) ? __expf(gc_s[i] - gcj) : 0.f;
        A_s[i * 68 + j] = (i > j) ? beta_s[i] * kk[reg] * dec : 0.f;
        qkb[i * 64 + j] = f2bf((i >= j) ? qk[reg] * dec : 0.f);
      }
    }
  }
  __syncthreads();
  {
    const int col = tid; const bool isw = col >= 128; const int d = col & 127;
    int vz; asm volatile("v_mov_b32 %0, 0" : "=v"(vz));
    const float* A_v = A_s + vz; const float* gc_v = gc_s + vz; const float* beta_v = beta_s + vz;
    const unsigned char* src = smem + (isw ? GD_K : GD_V) + d * 2;
    float sol[64];
#pragma unroll
    for (int i = 0; i < 64; ++i) {
      float v = bf2f(*(const bf16_t*)(src + i * 272)) * beta_v[i];
      if (isw) v *= __expf(gc_v[i]);
      sol[i] = v;
    }
    SolveRow<1>::run(sol, A_v);
    __syncthreads();
    if (!isw) {
      bf16_t* ut = (bf16_t*)(p.ws + OFF_UT) + (size_t)chunk * 8192 + d * 64;
#pragma unroll
      for (int c8 = 0; c8 < 8; ++c8) {
        u32x4 o = {pk2(sol[8 * c8], sol[8 * c8 + 1]), pk2(sol[8 * c8 + 2], sol[8 * c8 + 3]), pk2(sol[8 * c8 + 4], sol[8 * c8 + 5]), pk2(sol[8 * c8 + 6], sol[8 * c8 + 7])};
        *(u32x4*)(ut + 8 * c8) = o;
      }
      unsigned char* qp = smem + GD_Q + d * 2;
#pragma unroll
      for (int i = 0; i < 64; ++i) { const float v = bf2f(*(const bf16_t*)(qp + i * 272)) * __expf(gc_v[i]); *(bf16_t*)(qp + i * 272) = f2bf(v); }
    } else {
      unsigned char* wp = smem + GD_V + d * 2;
#pragma unroll
      for (int i = 0; i < 64; ++i) *(bf16_t*)(wp + i * 272) = f2bf(-sol[i]);
      bf16_t* kd = (bf16_t*)(p.ws + OFF_KD) + (size_t)chunk * 8192 + d * 64;
      const float gl = gc_v[63];
#pragma unroll
      for (int c8 = 0; c8 < 8; ++c8) {
        float kv[8];
#pragma unroll
        for (int e = 0; e < 8; ++e) kv[e] = bf2f(*(const bf16_t*)(smem + GD_K + (8 * c8 + e) * 272 + d * 2)) * __expf(gl - gc_v[8 * c8 + e]);
        u32x4 o = {pk2(kv[0], kv[1]), pk2(kv[2], kv[3]), pk2(kv[4], kv[5]), pk2(kv[6], kv[7])};
        *(u32x4*)(kd + 8 * c8) = o;
      }
    }
    if (tid == 0) ((float*)(p.ws + OFF_GL))[chunk] = __expf(gc_s[63]);
    __syncthreads();
    {
      bf16_t* wn = (bf16_t*)(p.ws + OFF_WN) + (size_t)chunk * 8192;
      bf16_t* qd = (bf16_t*)(p.ws + OFF_QD) + (size_t)chunk * 8192;
#pragma unroll 1
      for (int i = 0; i < 4; ++i) {
        const int idx = tid + 256 * i; const int lo = (idx >> 4) * 272 + (idx & 15) * 16;
        *(u32x4*)(wn + (size_t)idx * 8) = *(const u32x4*)(smem + GD_V + lo);
        *(u32x4*)(qd + (size_t)idx * 8) = *(const u32x4*)(smem + GD_Q + lo);
      }
    }
  }
}

constexpr int SC_W = 0, SC_QD = 17408, SC_QK = 34816, SC_KD = 34816 + 9216, SC_U = 34816 + 9216 + 18432;
DI bf16x8 pack44(const f32x4& a, const f32x4& b) { u32x4 v = {pk2(a.x, a.y), pk2(a.z, a.w), pk2(b.x, b.y), pk2(b.z, b.w)}; return __builtin_bit_cast(bf16x8, v); }
DI void scan_item(const P& p, int item, unsigned char* smem, int tid) {
  const int lane = tid & 63, w = tid >> 6, fr = lane & 15, fq = lane >> 4;
  const int bh = item >> 1, hf = item & 1;
  const bf16_t* WN = (const bf16_t*)(p.ws + OFF_WN); const bf16_t* QD = (const bf16_t*)(p.ws + OFF_QD);
  const bf16_t* KD = (const bf16_t*)(p.ws + OFF_KD); const bf16_t* QK = (const bf16_t*)(p.ws + OFF_QK);
  bf16_t* UT = (bf16_t*)(p.ws + OFF_UT) + hf * 4096; const float* GL = (const float*)(p.ws + OFF_GL);
  f32x4 S[8];
#pragma unroll
  for (int dt = 0; dt < 8; ++dt) S[dt] = (f32x4){0.f, 0.f, 0.f, 0.f};
  u32x4 st[16];
  const int chunk0 = bh * 64;
#define SC_LOAD(CH) do { \
    const size_t cb = (size_t)(CH) * 8192; \
    _Pragma("unroll") for (int i = 0; i < 4; ++i) { st[i] = *(const u32x4*)(WN + cb + (size_t)(tid + 256 * i) * 8); st[4 + i] = *(const u32x4*)(QD + cb + (size_t)(tid + 256 * i) * 8); st[10 + i] = *(const u32x4*)(KD + cb + (size_t)(tid + 256 * i) * 8); } \
    _Pragma("unroll") for (int i = 0; i < 2; ++i) { st[8 + i] = *(const u32x4*)(QK + (size_t)(CH) * 4096 + (size_t)(tid + 256 * i) * 8); st[14 + i] = *(const u32x4*)(UT + cb + (size_t)(tid + 256 * i) * 8); } \
  } while (0)
#define SC_STORE() do { \
    _Pragma("unroll") for (int i = 0; i < 4; ++i) { const int idx = tid + 256 * i; const int o16 = (idx >> 4) * 272 + (idx & 15) * 16; *(u32x4*)(smem + SC_W + o16) = st[i]; *(u32x4*)(smem + SC_QD + o16) = st[4 + i]; \
      const int o8 = (idx >> 3) * 144 + (idx & 7) * 16; *(u32x4*)(smem + SC_KD + o8) = st[10 + i]; } \
    _Pragma("unroll") for (int i = 0; i < 2; ++i) { const int idx = tid + 256 * i; const int o8 = (idx >> 3) * 144 + (idx & 7) * 16; *(u32x4*)(smem + SC_QK + o8) = st[8 + i]; *(u32x4*)(smem + SC_U + o8) = st[14 + i]; } \
  } while (0)
  SC_LOAD(chunk0);
  __syncthreads();
  for (int n = 0; n < 64; ++n) {
    const int chunk = chunk0 + n;
    SC_STORE();
    __syncthreads();
    if (n + 1 < 64) SC_LOAD(chunk + 1);
    f32x4 vn[4];
#pragma unroll
    for (int ct = 0; ct < 4; ++ct) { const u32x2 u = *(const u32x2*)(smem + SC_U + (16 * w + fr) * 144 + (16 * ct + 4 * fq) * 2); vn[ct] = (f32x4){bflo(u.x), bfhi(u.x), bflo(u.y), bfhi(u.y)}; }
    const float gl = GL[chunk];
    bf16x8 Sp[4];
#pragma unroll
    for (int kk = 0; kk < 4; ++kk) Sp[kk] = pack44(S[2 * kk], S[2 * kk + 1]);
#pragma unroll
    for (int ct = 0; ct < 4; ++ct)
#pragma unroll
      for (int kk = 0; kk < 4; ++kk) {
        const unsigned char* ap = smem + SC_W + (16 * ct + fr) * 272 + (32 * kk + 4 * fq) * 2;
        vn[ct] = mfma16(mk8(*(const u32x2*)ap, *(const u32x2*)(ap + 32)), Sp[kk], vn[ct]);
      }
    bf16x8 vp[2];
    vp[0] = pack44(vn[0], vn[1]); vp[1] = pack44(vn[2], vn[3]);
#pragma unroll
    for (int ct = 0; ct < 4; ++ct) {
      f32x4 o = {0.f, 0.f, 0.f, 0.f};
#pragma unroll
      for (int kk = 0; kk < 4; ++kk) {
        const unsigned char* ap = smem + SC_QD + (16 * ct + fr) * 272 + (32 * kk + 4 * fq) * 2;
        o = mfma16(mk8(*(const u32x2*)ap, *(const u32x2*)(ap + 32)), Sp[kk], o);
      }
#pragma unroll
      for (int kc = 0; kc < 2; ++kc) {
        const unsigned char* ap = smem + SC_QK + (16 * ct + fr) * 144 + (32 * kc + 4 * fq) * 2;
        o = mfma16(mk8(*(const u32x2*)ap, *(const u32x2*)(ap + 32)), vp[kc], o);
      }
      bf16_t* op = UT + (size_t)chunk * 8192 + (size_t)(16 * ct + 4 * fq) * 64 + 16 * w + fr;
      op[0] = f2bf(o.x); op[64] = f2bf(o.y); op[128] = f2bf(o.z); op[192] = f2bf(o.w);
    }
#pragma unroll
    for (int dt = 0; dt < 8; ++dt) {
      S[dt] = S[dt] * gl;
#pragma unroll
      for (int kc = 0; kc < 2; ++kc) {
        const unsigned char* ap = smem + SC_KD + (16 * dt + fr) * 144 + (32 * kc + 4 * fq) * 2;
        S[dt] = mfma16(mk8(*(const u32x2*)ap, *(const u32x2*)(ap + 32)), vp[kc], S[dt]);
      }
    }
    __syncthreads();
  }
}

DI void phase_final(const P& p, int tid) {
  const int lane = tid & 63, wid = tid >> 6;
  float* x = p.out; const float* g = p.in[21];
  for (int row = blockIdx.x * 4 + wid; row < NTOK; row += gridDim.x * 4) {
    f32x4 v[4]; float s = 0.f;
#pragma unroll
    for (int i = 0; i < 4; ++i) { v[i] = *(const f32x4*)(x + (size_t)row * 1024 + 256 * i + 4 * lane); s += v[i].x * v[i].x + v[i].y * v[i].y + v[i].z * v[i].z + v[i].w * v[i].w; }
#pragma unroll
    for (int off = 32; off > 0; off >>= 1) s += __shfl_xor(s, off);
    const float rs = rsqrtf(s * (1.f / 1024.f) + EPSF);
#pragma unroll
    for (int i = 0; i < 4; ++i) { const f32x4 gg = *(const f32x4*)(g + 256 * i + 4 * lane); *(f32x4*)(x + (size_t)row * 1024 + 256 * i + 4 * lane) = v[i] * rs * gg; }
  }
}


#define XB_TMO      128
#define XB_XCNT(j)  (256  + 64 * (j))
#define XB_XSUB(j)  (1280 + 64 * (j))
#define XB_XGEN(j)  (2304 + 64 * (j))
#define XB_TOP      3328
#define XB_TOPGEN   3392
#define XCD_BAR_WORDS 3456
#define XB_SPIN_CAP (1u << 18)
#define LAS __attribute__((address_space(3)))
DI unsigned xb_ld(unsigned* p)              { return __hip_atomic_load(p, __ATOMIC_RELAXED, __HIP_MEMORY_SCOPE_AGENT); }
DI unsigned xb_add(unsigned* p, unsigned v) { return __hip_atomic_fetch_add(p, v, __ATOMIC_RELAXED, __HIP_MEMORY_SCOPE_AGENT); }
DI unsigned xb_xcc_id() { return (unsigned)__builtin_amdgcn_s_getreg((3 << 11) | 20) & 0xFu; }
#define XB_SPIN(cond, bar) do { unsigned _sp = 0; while (cond) { __builtin_amdgcn_s_sleep(1); \
    if ((++_sp & 255u) == 0u) { if (xb_ld(&(bar)[XB_TMO])) break; if (_sp > XB_SPIN_CAP) { atomicAdd(&(bar)[XB_TMO], 1u); break; } } } } while (0)
struct XcdBarrier { unsigned* bar; unsigned x; volatile LAS unsigned* st; };
DI XcdBarrier xcd_barrier_post(unsigned* bar, volatile LAS unsigned* st) {
  XcdBarrier b; b.bar = bar; b.x = xb_xcc_id(); b.st = st;
  if (threadIdx.x == 0) (void)xb_add(&bar[XB_XCNT(b.x)], 1u);
  return b;
}
DI void xcd_barrier_complete(unsigned* bar, unsigned x, unsigned& nloc, unsigned& nx) {
  const unsigned G = gridDim.x * gridDim.y * gridDim.z;
  unsigned sum, cnt, mine, sp = 0u;
  for (;;) {
    sum = 0u; cnt = 0u; mine = 0u;
#pragma unroll
    for (unsigned j = 0; j < 16; ++j) { const unsigned c = xb_ld(&bar[XB_XCNT(j)]); sum += c; cnt += (c > 0u) ? 1u : 0u; mine = (j == x) ? c : mine; }
    if (sum == G) break;
    __builtin_amdgcn_s_sleep(1);
    if ((++sp & 255u) == 0u) { if (xb_ld(&bar[XB_TMO])) break; if (sp > XB_SPIN_CAP) { atomicAdd(&bar[XB_TMO], 1u); break; } }
  }
  nloc = mine > 0u ? mine : 1u; nx = cnt > 0u ? cnt : 1u;
}
DI void xcd_barrier(const XcdBarrier& b) {
  asm volatile("s_waitcnt vmcnt(0)" ::: "memory");
  __syncthreads();
  if (threadIdx.x == 0) {
    unsigned* bar = b.bar;
    unsigned bx = b.x;
    asm volatile("" : "+s"(bar), "+s"(bx));
    __builtin_amdgcn_s_waitcnt(0);
    unsigned nloc = b.st[0], nx = b.st[1];
    if (nloc == 0u) { xcd_barrier_complete(bar, bx, nloc, nx); b.st[0] = nloc; b.st[1] = nx; }
    const unsigned old = xb_add(&bar[XB_XSUB(bx)], 1u);
    const unsigned gen = old / nloc;
    if (old + 1u == (gen + 1u) * nloc) {
      __builtin_amdgcn_fence(__ATOMIC_RELEASE, "agent");
      asm volatile("s_waitcnt vmcnt(0)" ::: "memory");
      const unsigned og = xb_add(&bar[XB_TOP], 1u);
      const unsigned tg = og / nx;
      if (og + 1u == (tg + 1u) * nx) xb_add(&bar[XB_TOPGEN], 1u);
      else XB_SPIN(xb_ld(&bar[XB_TOPGEN]) == tg, bar);
      __builtin_amdgcn_fence(__ATOMIC_ACQUIRE, "agent");
      xb_add(&bar[XB_XGEN(bx)], 1u);
      asm volatile("s_waitcnt vmcnt(0)" ::: "memory");
    } else {
      XB_SPIN(xb_ld(&bar[XB_XGEN(bx)]) == gen, bar);
      __builtin_amdgcn_fence(__ATOMIC_ACQUIRE, "agent");
      asm volatile("s_waitcnt vmcnt(0)" ::: "memory");
    }
  }
  __syncthreads();
}

constexpr int N_PHASES = 24;
typedef const __attribute__((address_space(4))) P* KP;
DI P loadP(KP kp) {
  P p;
#pragma unroll
  for (int i = 0; i < 22; ++i) p.in[i] = kp->in[i];
  p.out = kp->out; p.ws = kp->ws;
  return p;
}
#define SSP(k) ((float*)(p.ws + OFF_SS) + (k) * NTOK)
#define PH_BEGIN { KP kp = (KP)__builtin_amdgcn_kernarg_segment_ptr(); asm volatile("" : "+s"(kp)); \
    unsigned zz_; asm volatile("v_mov_b32 %0, 0" : "=v"(zz_)); \
    int tid = wbase + (int)__builtin_amdgcn_mbcnt_hi(~0u, __builtin_amdgcn_mbcnt_lo(~0u, zz_)); asm volatile("" : "+v"(tid)); \
    const P p = loadP(kp);
#define PH_END } xcd_barrier(xb);

__global__ void __launch_bounds__(256, 2) mega(P p_arg, int ph_lo, int ph_hi) {
  extern __shared__ __attribute__((aligned(16))) unsigned char smem[];
  __shared__ uint4 xb_words;
  cg::grid_group grid = cg::this_grid();
  if (threadIdx.x == 0) xb_words = make_uint4(0u, 0u, 0u, 0u);
  __syncthreads();
  const int wbase = __builtin_amdgcn_readfirstlane((int)(threadIdx.x & ~63u));
  XcdBarrier xb = xcd_barrier_post((unsigned*)(p_arg.ws + OFF_BAR), (volatile LAS unsigned*)&xb_words);
  if (ph_hi < 0) grid.sync();

  PH_BEGIN phase_prologue(p, smem, tid); PH_END
#if REP_PHASE == 0
  PH_BEGIN phase_prologue(p, smem, tid); PH_END
#endif
#pragma unroll 1
  for (int layer = 0; layer < 2; ++layer) {
    if (layer == 0) {
      PH_BEGIN phase_in_e(p, smem, tid); PH_END
      PH_BEGIN for (int i = blockIdx.x; i < 2048 + 1024; i += gridDim.x) { if (i < 2048) attn_item(p, i, smem, tid); else pool_item(p, i - 2048, smem, tid); } PH_END
#if REP_PHASE == 2
      PH_BEGIN for (int i = blockIdx.x; i < 2048 + 1024; i += gridDim.x) { if (i < 2048) attn_item(p, i, smem, tid); else pool_item(p, i - 2048, smem, tid); } PH_END
#endif
    } else {
#pragma unroll 1
      for (int qi = 0; qi < 4; ++qi) {
        PH_BEGIN
          phase_in_o(p, qi, smem, tid);
          {
            const int G = (int)gridDim.x; const int idle0 = (832 % G == 0 || G >= 832) ? (G >= 832 ? 832 : G) : 832 % G;
            const int g0 = 736 * qi, g1 = 736 * qi + 736;
            if (idle0 < G) { if ((int)blockIdx.x >= idle0) convert_list(p, (float*)smem, tid, 1, g0, g1, (int)blockIdx.x - idle0, G - idle0); }
            else convert_list(p, (float*)smem, tid, 1, g0, g1, (int)blockIdx.x, G);
          }
        PH_END
        PH_BEGIN for (int i = blockIdx.x; i < 1024; i += gridDim.x) gdn_chunk_item(p, qi, i, smem, tid); PH_END
#if REP_PHASE == 9
        if (qi == 0) { PH_BEGIN for (int i = blockIdx.x; i < 1024; i += gridDim.x) gdn_chunk_item(p, qi, i, smem, tid); PH_END }
#endif
      }
      PH_BEGIN for (int i = blockIdx.x; i < 128; i += gridDim.x) scan_item(p, i, smem, tid); PH_END
      PH_BEGIN phase_z_gate(p, smem, tid); PH_END
    }
    PH_BEGIN
      phase_resid(p, (const bf16_t*)(p.ws + (layer ? OFF_OB : OFF_CAT)), 1024, (const bf16_t*)(p.ws + (layer ? OFF_WT_OUTO : OFF_WT_OUTE)), layer ? p.out : p.in[0], SSP(1 + 3 * layer), smem, tid);
    PH_END
    PH_BEGIN phase_ffn_up(p, layer, SSP(1 + 3 * layer), smem, tid); PH_END
#if REP_PHASE == 4
    if (layer == 0) { PH_BEGIN phase_ffn_up(p, layer, SSP(1 + 3 * layer), smem, tid); PH_END }
#endif
    PH_BEGIN phase_resid(p, (const bf16_t*)(p.ws + OFF_ACT), 2816, (const bf16_t*)(p.ws + OFF_WT_DOWN) + (size_t)layer * 1024 * 2816, p.out, SSP(2 + 3 * layer), smem, tid); PH_END
    PH_BEGIN phase_ple_gate(p, layer, SSP(2 + 3 * layer), smem, tid); PH_END
#if REP_PHASE == 6
    if (layer == 0) { PH_BEGIN phase_ple_gate(p, layer, SSP(2 + 3 * layer), smem, tid); PH_END }
#endif
    PH_BEGIN phase_ple_add(p, layer, SSP(3 + 3 * layer), smem, tid); PH_END
  }
#if DUMMY_MODE >= 0
  PH_BEGIN phase_dummy(p, DUMMY_MODE, smem, tid); PH_END
#endif
  PH_BEGIN phase_final(p, tid); }
}

extern "C" void kernel_launch(void* const* d_in, const int* in_sizes, int n_in, void* d_out, int out_size, void* d_ws, size_t ws_size, hipStream_t stream) {
  static int grid_blocks = 0;
  if (!grid_blocks) {
    int dev = 0, cus = 0, per_cu = 0;
    hipGetDevice(&dev);
    hipDeviceGetAttribute(&cus, hipDeviceAttributeMultiprocessorCount, dev);
    hipFuncSetAttribute((const void*)mega, hipFuncAttributeMaxDynamicSharedMemorySize, SMEM_BYTES);
    hipOccupancyMaxActiveBlocksPerMultiprocessor(&per_cu, mega, 256, SMEM_BYTES);
    if (per_cu > 2) per_cu = 2;
    if (per_cu < 1) per_cu = 1;
    grid_blocks = cus * per_cu;
  }
  P p{};
  for (int i = 0; i < 22; ++i) p.in[i] = (const float*)d_in[i];
  p.out = (float*)d_out;
  p.ws = (unsigned char*)d_ws;
  hipMemsetAsync(p.ws + OFF_BAR, 0, XCD_BAR_WORDS * 4, stream);
#if MULTI_LAUNCH
  for (int ph = 0; ph < N_PHASES; ++ph) {
    int lo = ph, hi = ph + 1;
    void* args[] = {&p, &lo, &hi};
    hipError_t e = hipLaunchCooperativeKernel((const void*)mega, dim3(grid_blocks), dim3(256), args, SMEM_BYTES, stream);
    if (e != hipSuccess) fprintf(stderr, "launch failed: %s\n", hipGetErrorString(e));
  }
#else
  int lo = 0, hi = N_PHASES;
  void* args[] = {&p, &lo, &hi};
  hipError_t e = hipLaunchCooperativeKernel((const void*)mega, dim3(grid_blocks), dim3(256), args, SMEM_BYTES, stream);
  if (e != hipSuccess) fprintf(stderr, "launch failed: %s (grid %d)\n", hipGetErrorString(e), grid_blocks);
#endif
}
```

```cpp
#include <hip/hip_runtime.h>
#include <hip/hip_cooperative_groups.h>
#include <stdint.h>
#include <cstdio>
namespace cg = cooperative_groups;

#ifndef REP_PHASE
#define REP_PHASE -1
#endif
#ifndef MULTI_LAUNCH
#define MULTI_LAUNCH 0
#endif

#define DI __device__ __forceinline__
typedef unsigned short bf16_t;
typedef short bf16x8 __attribute__((ext_vector_type(8)));
typedef float f32x4 __attribute__((ext_vector_type(4)));
typedef float f32x2 __attribute__((ext_vector_type(2)));
typedef float f32x16 __attribute__((ext_vector_type(16)));
typedef unsigned u32x4 __attribute__((ext_vector_type(4)));
typedef unsigned u32x2 __attribute__((ext_vector_type(2)));
typedef __bf16 hbf2 __attribute__((ext_vector_type(2)));

DI unsigned pk2(float lo, float hi) { f32x2 v = {lo, hi}; hbf2 r = __builtin_convertvector(v, hbf2); return __builtin_bit_cast(unsigned, r); }
DI bf16_t f2bf(float x) { return (bf16_t)(pk2(x, 0.f) & 0xffffu); }
DI float bf2f(bf16_t v) { return __uint_as_float(((unsigned)v) << 16); }
DI float bflo(unsigned u) { return __uint_as_float(u << 16); }
DI float bfhi(unsigned u) { return __uint_as_float(u & 0xffff0000u); }
DI f32x4 mfma16(bf16x8 a, bf16x8 b, f32x4 c) { return __builtin_amdgcn_mfma_f32_16x16x32_bf16(a, b, c, 0, 0, 0); }
DI f32x16 mfma32(bf16x8 a, bf16x8 b, f32x16 c) { return __builtin_amdgcn_mfma_f32_32x32x16_bf16(a, b, c, 0, 0, 0); }
DI int crow(int reg, int hh) { return (reg & 3) + 8 * (reg >> 2) + 4 * hh; }
DI float fexp2(float x) { return __builtin_amdgcn_exp2f(x); }
DI float flog2(float x) { return __builtin_amdgcn_logf(x); }
DI float frcp(float x) { return __builtin_amdgcn_rcpf(x); }
DI float fexp(float x) { return __builtin_amdgcn_exp2f(x * 1.4426950408889634f); }
DI float sigmoidf_(float x) { return frcp(1.f + fexp(-x)); }
DI float siluf_(float x) { return x * frcp(1.f + fexp(-x)); }
DI bf16x8 mk8(u32x2 lo, u32x2 hi) { u32x4 v = {lo.x, lo.y, hi.x, hi.y}; return __builtin_bit_cast(bf16x8, v); }
DI bf16x8 pack_step(const f32x16& x, int s) {
  u32x4 v;
  v.x = pk2(x[8 * s + 0], x[8 * s + 1]); v.y = pk2(x[8 * s + 2], x[8 * s + 3]);
  v.z = pk2(x[8 * s + 4], x[8 * s + 5]); v.w = pk2(x[8 * s + 6], x[8 * s + 7]);
  return __builtin_bit_cast(bf16x8, v);
}

constexpr int SEQ = 4096, DM = 1024, NTOK = 32768;
constexpr int SMEM_BYTES = 73728;
constexpr float EPSF = 1e-6f;

constexpr size_t OFF_WT_INE = 0;
constexpr size_t OFF_WT_OUTE = OFF_WT_INE + 2048ull * 1024 * 2;
constexpr size_t OFF_WT_INO = OFF_WT_OUTE + 1024ull * 1024 * 2;
constexpr size_t OFF_WT_Z = OFF_WT_INO + 3328ull * 1024 * 2;
constexpr size_t OFF_WT_OUTO = OFF_WT_Z + 1024ull * 1024 * 2;
constexpr size_t OFF_WT_UP = OFF_WT_OUTO + 1024ull * 1024 * 2;
constexpr size_t OFF_WT_DOWN = OFF_WT_UP + 2ull * 5632 * 1024 * 2;
constexpr size_t OFF_WT_PLEG = OFF_WT_DOWN + 2ull * 1024 * 2816 * 2;
constexpr size_t OFF_WT_PLE = OFF_WT_PLEG + 2ull * 1024 * 1024 * 2;
constexpr size_t OFF_WT_POOL = OFF_WT_PLE + 2ull * 1024 * 256 * 2;
constexpr size_t OFF_XB = OFF_WT_POOL + 4ull * 128 * 128 * 2;
constexpr size_t OFF_PB = OFF_XB + 32768ull * 1024 * 2;
constexpr size_t OFF_SS = OFF_PB + 2ull * 32768 * 256 * 2;
constexpr size_t OFF_GB = OFF_SS + 7ull * 32768 * 4;
constexpr size_t OFF_GL = OFF_GB + 32768ull * 16 * 4;
constexpr size_t OFF_BAR = OFF_GL + 4096 * 4;
constexpr size_t OFF_R1 = OFF_BAR + 16384;
constexpr size_t OFF_PROJ0 = OFF_R1;
constexpr size_t OFF_VT = OFF_PROJ0 + 32768ull * 1536 * 2;
constexpr size_t OFF_CAT = OFF_VT + 32768ull * 512 * 2;
constexpr size_t OFF_ACT = OFF_R1;
constexpr size_t OFF_UT = OFF_R1;
constexpr size_t OFF_WN = OFF_UT + 67108864ull;
constexpr size_t OFF_QD = OFF_WN + 67108864ull;
constexpr size_t OFF_KD = OFF_QD + 67108864ull;
constexpr size_t OFF_QK = OFF_KD + 67108864ull;
constexpr size_t OFF_QKV = OFF_QK + 33554432ull;
constexpr size_t OFF_GATE = OFF_R1;
constexpr size_t OFF_OB = OFF_WN;

struct P {
  const float* in[22];
  float* out;
  unsigned char* ws;
};

DI void mma_stage(f32x4 (&acc)[4][4], const unsigned char* cA, const unsigned char* cB, int a_rd, int b_rd, int sw0, int sw1) {
#pragma unroll
  for (int ks = 0; ks < 2; ++ks) {
    const int sw = ks ? sw1 : sw0;
    bf16x8 af[4], bfr[4];
#pragma unroll
    for (int m = 0; m < 4; ++m) af[m] = *(const bf16x8*)(cA + a_rd + m * 2048 + sw);
#pragma unroll
    for (int n = 0; n < 4; ++n) bfr[n] = *(const bf16x8*)(cB + b_rd + n * 2048 + sw);
#pragma unroll
    for (int m = 0; m < 4; ++m)
#pragma unroll
      for (int n = 0; n < 4; ++n) acc[m][n] = mfma16(bfr[n], af[m], acc[m][n]);
  }
}
DI void zero_acc(f32x4 (&acc)[4][4]) {
#pragma unroll
  for (int m = 0; m < 4; ++m)
#pragma unroll
    for (int n = 0; n < 4; ++n) acc[m][n] = (f32x4){0.f, 0.f, 0.f, 0.f};
}

constexpr int G_STAGE = 24576, G_AB = 8192;
DI void glds16(const bf16_t* g, unsigned char* l) { __builtin_amdgcn_global_load_lds((const unsigned*)g, (unsigned*)l, 16, 0, 0); }
DI void zero_acc8(f32x4 (&acc)[4][8]) {
#pragma unroll
  for (int m = 0; m < 4; ++m)
#pragma unroll
    for (int n = 0; n < 8; ++n) acc[m][n] = (f32x4){0.f, 0.f, 0.f, 0.f};
}
DI void gemm_core(f32x4 (&acc)[4][8], const bf16_t* pa0, const bf16_t* pa1, const bf16_t* pb0, long ldb64, int nk, unsigned char* smem, int tid) {
  const int lane = tid & 63, wid = tid >> 6, wr = wid >> 1, wc = wid & 1, fr = lane & 15, fq = lane >> 4;
  const int lrow = tid >> 2, lc = tid & 3;
  const int csrc = 8 * (lc ^ ((-(lrow >> 2)) & 3));
  pa0 += csrc; pa1 += csrc; pb0 += csrc;
  unsigned char* dA = smem + tid * 16; unsigned char* dB = smem + G_AB + tid * 16;
  asm volatile("s_waitcnt vmcnt(0)" ::: "memory");
  __builtin_amdgcn_s_barrier();
#define G_ISSUE(KT, ST) do { const int ko_ = (KT) * 32; unsigned char* a_ = dA + (ST) * G_STAGE; unsigned char* b_ = dB + (ST) * G_STAGE; \
    glds16(pa0 + ko_, a_); glds16(pa1 + ko_, a_ + 4096); \
    glds16(pb0 + ko_, b_); glds16(pb0 + ldb64 + ko_, b_ + 4096); glds16(pb0 + 2 * ldb64 + ko_, b_ + 8192); glds16(pb0 + 3 * ldb64 + ko_, b_ + 12288); } while (0)
  G_ISSUE(0, 0);
  G_ISSUE(1, 1);
  const int swz = (fq ^ ((-(fr >> 2)) & 3)) << 4;
  const int a_rd = (64 * wr + fr) * 64 + swz, b_rd = G_AB + (128 * wc + fr) * 64 + swz;
  int st = 0;
#pragma unroll 1
  for (int kt = 0; kt < nk; ++kt) {
    if (kt + 1 < nk) asm volatile("s_waitcnt vmcnt(6)" ::: "memory"); else asm volatile("s_waitcnt vmcnt(0)" ::: "memory");
    __builtin_amdgcn_s_barrier();
    const unsigned char* cs = smem + st * G_STAGE;
    bf16x8 af[4], bfr[8];
#pragma unroll
    for (int m = 0; m < 4; ++m) af[m] = *(const bf16x8*)(cs + a_rd + m * 1024);
#pragma unroll
    for (int n = 0; n < 8; ++n) bfr[n] = *(const bf16x8*)(cs + b_rd + n * 1024);
    const bool more = (kt + 2 < nk);
    const int s2 = (st >= 1) ? st - 1 : 2;
    const int ko2 = (kt + 2) * 32;
    unsigned char* a2 = dA + s2 * G_STAGE; unsigned char* b2 = dB + s2 * G_STAGE;
    if (more) { glds16(pa0 + ko2, a2); glds16(pa1 + ko2, a2 + 4096); }
    __builtin_amdgcn_s_setprio(1);
#pragma unroll
    for (int n = 0; n < 8; ++n) acc[0][n] = mfma16(bfr[n], af[0], acc[0][n]);
    __builtin_amdgcn_sched_barrier(0);
    if (more) { glds16(pb0 + ko2, b2); glds16(pb0 + ldb64 + ko2, b2 + 4096); }
#pragma unroll
    for (int n = 0; n < 8; ++n) acc[1][n] = mfma16(bfr[n], af[1], acc[1][n]);
    __builtin_amdgcn_sched_barrier(0);
    if (more) { glds16(pb0 + 2 * ldb64 + ko2, b2 + 8192); glds16(pb0 + 3 * ldb64 + ko2, b2 + 12288); }
#pragma unroll
    for (int n = 0; n < 8; ++n) acc[2][n] = mfma16(bfr[n], af[2], acc[2][n]);
#pragma unroll
    for (int n = 0; n < 8; ++n) acc[3][n] = mfma16(bfr[n], af[3], acc[3][n]);
    __builtin_amdgcn_s_setprio(0);
    st = (st == 2) ? 0 : st + 1;
  }
  __syncthreads();
}

DI int permrow(int r) { const int s = r & 31; return (r & ~31) | (((s >> 2) & 3) << 3) | ((s >> 4) << 2) | (s & 3); }
DI void tile_decode(int i, int MT, int NT, int& mt, int& nt) {
  const int g = i / (64 * NT); const int il = i - g * 64 * NT; int gm = MT - 64 * g; gm = gm < 64 ? gm : 64;
  nt = il / gm; mt = 64 * g + (il - nt * gm);
}

DI void transpose_convert(const float* __restrict__ W, int ldw, int K, int mode, int coloff, const float* __restrict__ gain,
                          bf16_t* __restrict__ dst, int kt, int ntile, float* tile, int tid) {
  const int n0 = ntile * 64;
  const int tx = tid & 63, ty = tid >> 6;
  const int n = n0 + tx;
  int src; bool valid = true;
  if (mode == 0) { src = coloff + n; }
  else if (mode == 1) { const int j = n >> 8, nl = n & 255, wc = nl >> 7, hp = (nl >> 6) & 1, nt4 = (nl & 63) >> 4, fr = nl & 15; const int ch = 128 * j + 64 * wc + 32 * hp + 16 * (nt4 & 1) + fr; src = (nt4 < 2) ? ch : 2816 + ch; }
  else { if (n < 3072) src = n; else if (n < 3088) src = 4096 + (n - 3072); else { src = 0; valid = false; } }
  __syncthreads();
#pragma unroll
  for (int i = 0; i < 16; ++i) {
    const int kl = ty + 4 * i, k = 64 * kt + kl;
    float v = 0.f;
    if (valid) { v = W[(size_t)k * ldw + src]; if (gain) v *= gain[k]; }
    tile[kl * 65 + tx] = v;
  }
  __syncthreads();
  const int nl = tid >> 2, kc = tid & 3;
#pragma unroll
  for (int cc = 0; cc < 2; ++cc) {
    const int kch = kc * 2 + cc;
    float v[8];
#pragma unroll
    for (int i = 0; i < 8; ++i) v[i] = tile[(8 * kch + i) * 65 + nl];
    u32x4 o = {pk2(v[0], v[1]), pk2(v[2], v[3]), pk2(v[4], v[5]), pk2(v[6], v[7])};
    *(u32x4*)(dst + (size_t)(n0 + nl) * K + 64 * kt + 8 * kch) = o;
  }
}

DI void convert_list(const P& p, float* tile, int tid, int list, int g0, int g1, int blk, int nblk) {
  for (int g = g0 + blk; g < g1; g += nblk) {
    int task, base;
    if (list == 0) {
      if (g < 512) { task = 0; base = 0; } else if (g < 768) { task = 1; base = 512; } else if (g < 1600) { task = 2; base = 768; }
      else if (g < 3008) { task = 5; base = 1600; } else if (g < 3712) { task = 7; base = 3008; } else if (g < 3968) { task = 9; base = 3712; }
      else if (g < 4032) { task = 11; base = 3968; } else { task = 13 + ((g - 4032) >> 2); base = 4032 + 4 * (task - 13); }
    } else {
      if (g < 256) { task = 3; base = 0; } else if (g < 512) { task = 4; base = 256; } else if (g < 1920) { task = 6; base = 512; }
      else if (g < 2624) { task = 8; base = 1920; } else if (g < 2880) { task = 10; base = 2624; } else { task = 12; base = 2880; }
    }
    const float* W; int ldw, K, mode = 0, coloff = 0; const float* gain = nullptr; size_t doff;
    switch (task) {
      case 0: W = p.in[3]; ldw = 2048; K = 1024; gain = p.in[2]; doff = OFF_WT_INE; break;
      case 1: W = p.in[6]; ldw = 1024; K = 1024; doff = OFF_WT_OUTE; break;
      case 2: W = p.in[8]; ldw = 4112; K = 1024; mode = 2; gain = p.in[7]; doff = OFF_WT_INO; break;
      case 3: W = p.in[8]; ldw = 4112; K = 1024; coloff = 3072; gain = p.in[7]; doff = OFF_WT_Z; break;
      case 4: W = p.in[13]; ldw = 1024; K = 1024; doff = OFF_WT_OUTO; break;
      case 5: W = p.in[15]; ldw = 5632; K = 1024; mode = 1; gain = p.in[14]; doff = OFF_WT_UP; break;
      case 6: W = p.in[15] + 1024ull * 5632; ldw = 5632; K = 1024; mode = 1; gain = p.in[14] + 1024; doff = OFF_WT_UP + 5632ull * 1024 * 2; break;
      case 7: W = p.in[17]; ldw = 1024; K = 2816; doff = OFF_WT_DOWN; break;
      case 8: W = p.in[17] + 2816ull * 1024; ldw = 1024; K = 2816; doff = OFF_WT_DOWN + 1024ull * 2816 * 2; break;
      case 9: W = p.in[19]; ldw = 1024; K = 1024; gain = p.in[18]; doff = OFF_WT_PLEG; break;
      case 10: W = p.in[19] + 1024ull * 1024; ldw = 1024; K = 1024; gain = p.in[18] + 1024; doff = OFF_WT_PLEG + 1024ull * 1024 * 2; break;
      case 11: W = p.in[20]; ldw = 1024; K = 256; doff = OFF_WT_PLE; break;
      case 12: W = p.in[20] + 256ull * 1024; ldw = 1024; K = 256; doff = OFF_WT_PLE + 1024ull * 256 * 2; break;
      default: W = p.in[4] + (size_t)(task - 13) * 128 * 128; ldw = 128; K = 128; doff = OFF_WT_POOL + (size_t)(task - 13) * 128 * 128 * 2; break;
    }
    const int nkt = K / 64; const int t = g - base;
    transpose_convert(W, ldw, K, mode, coloff, gain, (bf16_t*)(p.ws + doff), t % nkt, t / nkt, tile, tid);
  }
}

DI void phase_prologue(const P& p, unsigned char* smem, int tid) {
  float* tile = (float*)smem;
  bf16_t* wsb = (bf16_t*)p.ws;
  convert_list(p, tile, tid, 0, 0, 4048, (int)blockIdx.x, (int)gridDim.x);
  {
    const float* x = p.in[0]; bf16_t* xb = (bf16_t*)(p.ws + OFF_XB); float* ss = (float*)(p.ws + OFF_SS);
    const int lane = tid & 63, wid = tid >> 6;
    for (int row = blockIdx.x * 4 + wid; row < NTOK; row += gridDim.x * 4) {
      float s = 0.f;
#pragma unroll
      for (int i = 0; i < 4; ++i) {
        const f32x4 v = *(const f32x4*)(x + (size_t)row * 1024 + 256 * i + 4 * lane);
        s += v.x * v.x + v.y * v.y + v.z * v.z + v.w * v.w;
        u32x2 o = {pk2(v.x, v.y), pk2(v.z, v.w)};
        *(u32x2*)(xb + (size_t)row * 1024 + 256 * i + 4 * lane) = o;
      }
#pragma unroll
      for (int off = 32; off > 0; off >>= 1) s += __shfl_xor(s, off);
      if (lane == 0) ss[row] = s;
    }
    for (int i = blockIdx.x * 256 + tid; i < 6 * NTOK; i += gridDim.x * 256) ss[NTOK + i] = 0.f;
    const float* pp = p.in[1]; bf16_t* pb = (bf16_t*)(p.ws + OFF_PB);
    const size_t n4 = 2ull * 32768 * 256 / 4;
    for (size_t i = (size_t)blockIdx.x * 256 + tid; i < n4; i += (size_t)gridDim.x * 256) {
      const f32x4 v = *(const f32x4*)(pp + 4 * i);
      u32x2 o = {pk2(v.x, v.y), pk2(v.z, v.w)};
      *(u32x2*)(pb + 4 * i) = o;
    }
  }
}

#define GEMM_IDS const int lrow = tid >> 2;
#define EPI_IDS int tid_e = tid; asm volatile("" : "+v"(tid_e)); const int lane = tid_e & 63, wid = tid_e >> 6, wr = wid >> 1, wc = wid & 1, fr = lane & 15, fq = lane >> 4; (void)lane; (void)wr; (void)wc; (void)fr; (void)fq;

DI void phase_in_e(const P& p, unsigned char* smem, int tid) {
  GEMM_IDS
  const bf16_t* xb = (const bf16_t*)(p.ws + OFF_XB); const bf16_t* wt = (const bf16_t*)(p.ws + OFF_WT_INE);
  const float* ss = (const float*)(p.ws + OFF_SS);
  bf16_t* proj = (bf16_t*)(p.ws + OFF_PROJ0); bf16_t* vT = (bf16_t*)(p.ws + OFF_VT);
  for (int i = blockIdx.x; i < 256 * 8; i += gridDim.x) {
    int mt, nt; tile_decode(i, 256, 8, mt, nt);
    const int m0 = mt * 128, n0 = nt * 256;
    const bf16_t* pa = xb + (size_t)(m0 + lrow) * 1024;
    f32x4 acc[4][8]; zero_acc8(acc);
    gemm_core(acc, pa, pa + 64 * 1024, wt + (size_t)(n0 + permrow(lrow)) * 1024, 64 * 1024, 32, smem, tid);
    EPI_IDS
    const float qs = (n0 >= 512 && n0 < 1024) ? 0.18033688011112042f : 1.f;
#pragma unroll
    for (int m = 0; m < 4; ++m) {
      const int row = m0 + 64 * wr + 16 * m + fr;
      const float rs = rsqrtf(ss[row] * (1.f / 1024.f) + EPSF) * qs;
#pragma unroll
      for (int q = 0; q < 4; ++q) {
        const int col = n0 + 128 * wc + 32 * q + 8 * fq;
        const f32x4 v0 = acc[m][2 * q] * rs, v1 = acc[m][2 * q + 1] * rs;
        if (n0 < 1536) {
          u32x4 o = {pk2(v0.x, v0.y), pk2(v0.z, v0.w), pk2(v1.x, v1.y), pk2(v1.z, v1.w)};
          *(u32x4*)(proj + (size_t)row * 1536 + col) = o;
        } else {
          const int cc = col - 1536; const int bh = (row >> 12) * 8 + (cc >> 6), d = cc & 63, t = row & 4095;
          bf16_t* vp = vT + ((size_t)bh * 64 + d) * 4096 + t;
          vp[0] = f2bf(v0.x); vp[4096] = f2bf(v0.y); vp[8192] = f2bf(v0.z); vp[12288] = f2bf(v0.w);
          vp[16384] = f2bf(v1.x); vp[20480] = f2bf(v1.y); vp[24576] = f2bf(v1.z); vp[28672] = f2bf(v1.w);
        }
      }
    }
  }
}

DI void phase_resid(const P& p, const bf16_t* A, int K, const bf16_t* wt, const float* xold, float* ssn, unsigned char* smem, int tid) {
  GEMM_IDS
  bf16_t* xb = (bf16_t*)(p.ws + OFF_XB); float* xnew = p.out;
  for (int i = blockIdx.x; i < 256 * 4; i += gridDim.x) {
    int mt, nt; tile_decode(i, 256, 4, mt, nt);
    const int m0 = mt * 128, n0 = nt * 256;
    const bf16_t* pa = A + (size_t)(m0 + lrow) * K;
    f32x4 acc[4][8]; zero_acc8(acc);
    gemm_core(acc, pa, pa + 64 * (size_t)K, wt + (size_t)(n0 + permrow(lrow)) * K, 64 * (long)K, K / 32, smem, tid);
    EPI_IDS
    f32x4 xo[2][8];
    {
      const float* xr = xold + (size_t)(m0 + 64 * wr + fr) * 1024 + n0 + 128 * wc + 8 * fq;
#pragma unroll
      for (int q = 0; q < 4; ++q) { xo[0][2 * q] = *(const f32x4*)(xr + 32 * q); xo[0][2 * q + 1] = *(const f32x4*)(xr + 32 * q + 4); }
    }
#pragma unroll
    for (int m = 0; m < 4; ++m) {
      const int row = m0 + 64 * wr + 16 * m + fr;
      if (m < 3) {
        const float* xr = xold + (size_t)(row + 16) * 1024 + n0 + 128 * wc + 8 * fq;
#pragma unroll
        for (int q = 0; q < 4; ++q) { xo[(m + 1) & 1][2 * q] = *(const f32x4*)(xr + 32 * q); xo[(m + 1) & 1][2 * q + 1] = *(const f32x4*)(xr + 32 * q + 4); }
      }
      float s = 0.f;
#pragma unroll
      for (int q = 0; q < 4; ++q) {
        const int col = n0 + 128 * wc + 32 * q + 8 * fq;
        const f32x4 v0 = xo[m & 1][2 * q] + acc[m][2 * q];
        const f32x4 v1 = xo[m & 1][2 * q + 1] + acc[m][2 * q + 1];
        *(f32x4*)(xnew + (size_t)row * 1024 + col) = v0;
        *(f32x4*)(xnew + (size_t)row * 1024 + col + 4) = v1;
        u32x4 o = {pk2(v0.x, v0.y), pk2(v0.z, v0.w), pk2(v1.x, v1.y), pk2(v1.z, v1.w)};
        *(u32x4*)(xb + (size_t)row * 1024 + col) = o;
        s += v0.x * v0.x + v0.y * v0.y + v0.z * v0.z + v0.w * v0.w + v1.x * v1.x + v1.y * v1.y + v1.z * v1.z + v1.w * v1.w;
      }
      s += __shfl_xor(s, 16); s += __shfl_xor(s, 32);
      if (fq == 0) atomicAdd(ssn + row, s);
      __builtin_amdgcn_sched_barrier(0);
    }
  }
}

DI void phase_ffn_up(const P& p, int layer, const float* ssc, unsigned char* smem, int tid) {
  GEMM_IDS
  const bf16_t* xb = (const bf16_t*)(p.ws + OFF_XB); const bf16_t* wt = (const bf16_t*)(p.ws + OFF_WT_UP) + (size_t)layer * 5632 * 1024;
  bf16_t* act = (bf16_t*)(p.ws + OFF_ACT);
  const float* cw = p.in[16] + (size_t)layer * 3 * 5632;
  float* Cs = (float*)smem;
  for (int i = blockIdx.x; i < 264 * 22; i += gridDim.x) {
    int mt, nt; tile_decode(i, 264, 22, mt, nt);
    const int b = mt / 33, mi = mt - b * 33;
    const int t0 = 126 * mi - 2;
    const bf16_t* pa[2];
#pragma unroll
    for (int j = 0; j < 2; ++j) { int t = t0 + lrow + 64 * j; t = t < 0 ? 0 : (t > 4095 ? 4095 : t); pa[j] = xb + (size_t)(b * 4096 + t) * 1024; }
    f32x4 acc[4][8]; zero_acc8(acc);
    gemm_core(acc, pa[0], pa[1], wt + (size_t)(nt * 256 + lrow) * 1024, 64 * 1024, 32, smem, tid);
    EPI_IDS
    float rsv[4];
#pragma unroll
    for (int m = 0; m < 4; ++m) {
      int t = t0 + 64 * wr + 16 * m + fr; const bool neg = t < 0; t = t < 0 ? 0 : (t > 4095 ? 4095 : t);
      rsv[m] = neg ? 0.f : rsqrtf(ssc[b * 4096 + t] * (1.f / 1024.f) + EPSF);
    }
#pragma unroll
    for (int hp = 0; hp < 2; ++hp) {
      if (hp) __syncthreads();
#pragma unroll
      for (int m = 0; m < 4; ++m) {
        const int lr = 64 * wr + 16 * m + fr;
#pragma unroll
        for (int n = 0; n < 4; ++n) *(f32x4*)(Cs + lr * 132 + 64 * wc + 16 * n + 4 * fq) = acc[m][4 * hp + n] * rsv[m];
      }
      __syncthreads();
      const int cl = tid & 63, rg = tid >> 6;
      const int gcol = 64 * (cl >> 5) + 16 * ((cl & 31) >> 4) + (cl & 15), vcol = gcol + 32;
      const int ch = nt * 128 + 64 * (cl >> 5) + 32 * hp + (cl & 31);
      const float wg0 = cw[ch], wg1 = cw[5632 + ch], wg2 = cw[2 * 5632 + ch];
      const float wv0 = cw[2816 + ch], wv1 = cw[5632 + 2816 + ch], wv2 = cw[2 * 5632 + 2816 + ch];
      const int lr0 = 2 + 32 * rg;
      float g2 = Cs[(lr0 - 2) * 132 + gcol], g1 = Cs[(lr0 - 1) * 132 + gcol];
      float v2 = Cs[(lr0 - 2) * 132 + vcol], v1 = Cs[(lr0 - 1) * 132 + vcol];
      for (int r = 0; r < 32; ++r) {
        const int lr = lr0 + r; const int t = t0 + lr;
        if (lr >= 128 || t > 4095) break;
        const float g0 = Cs[lr * 132 + gcol], v0 = Cs[lr * 132 + vcol];
        const float yg = wg0 * g2 + wg1 * g1 + wg2 * g0;
        const float yv = wv0 * v2 + wv1 * v1 + wv2 * v0;
        act[(size_t)(b * 4096 + t) * 2816 + ch] = f2bf(siluf_(yg) * yv);
        g2 = g1; g1 = g0; v2 = v1; v1 = v0;
      }
    }
  }
}

DI void phase_ple_gate(const P& p, int layer, const float* ssc, unsigned char* smem, int tid) {
  GEMM_IDS
  const bf16_t* xb = (const bf16_t*)(p.ws + OFF_XB);
  const bf16_t* wg = (const bf16_t*)(p.ws + OFF_WT_PLEG) + (size_t)layer * 1024 * 1024;
  bf16_t* gate = (bf16_t*)(p.ws + OFF_GATE);
  for (int i = blockIdx.x; i < 256 * 4; i += gridDim.x) {
    int mt, nt; tile_decode(i, 256, 4, mt, nt);
    const int m0 = mt * 128, n0 = nt * 256;
    const bf16_t* pa = xb + (size_t)(m0 + lrow) * 1024;
    f32x4 acc[4][8]; zero_acc8(acc);
    gemm_core(acc, pa, pa + 64 * 1024, wg + (size_t)(n0 + permrow(lrow)) * 1024, 64 * 1024, 32, smem, tid);
    EPI_IDS
#pragma unroll
    for (int m = 0; m < 4; ++m) {
      const int row = m0 + 64 * wr + 16 * m + fr;
      const float rs = rsqrtf(ssc[row] * (1.f / 1024.f) + EPSF);
#pragma unroll
      for (int q = 0; q < 4; ++q) {
        const int col = n0 + 128 * wc + 32 * q + 8 * fq;
        const f32x4 v0 = acc[m][2 * q] * rs, v1 = acc[m][2 * q + 1] * rs;
        u32x4 o = {pk2(sigmoidf_(v0.x), sigmoidf_(v0.y)), pk2(sigmoidf_(v0.z), sigmoidf_(v0.w)), pk2(sigmoidf_(v1.x), sigmoidf_(v1.y)), pk2(sigmoidf_(v1.z), sigmoidf_(v1.w))};
        *(u32x4*)(gate + (size_t)row * 1024 + col) = o;
      }
    }
  }
}

DI void phase_ple_add(const P& p, int layer, float* ssn, unsigned char* smem, int tid) {
  GEMM_IDS
  bf16_t* xb = (bf16_t*)(p.ws + OFF_XB);
  const bf16_t* wp = (const bf16_t*)(p.ws + OFF_WT_PLE) + (size_t)layer * 1024 * 256;
  const bf16_t* pb = (const bf16_t*)(p.ws + OFF_PB) + (size_t)layer * 32768 * 256;
  const bf16_t* gate = (const bf16_t*)(p.ws + OFF_GATE);
  float* x = p.out;
  for (int i = blockIdx.x; i < 256 * 4; i += gridDim.x) {
    int mt, nt; tile_decode(i, 256, 4, mt, nt);
    const int m0 = mt * 128, n0 = nt * 256;
    const bf16_t* pa = pb + (size_t)(m0 + lrow) * 256;
    f32x4 acc[4][8]; zero_acc8(acc);
    gemm_core(acc, pa, pa + 64 * 256, wp + (size_t)(n0 + permrow(lrow)) * 256, 64 * 256, 8, smem, tid);
    EPI_IDS
#pragma unroll
    for (int m = 0; m < 4; ++m) {
      const int row = m0 + 64 * wr + 16 * m + fr;
      float s = 0.f;
#pragma unroll
      for (int q = 0; q < 4; ++q) {
        const int col = n0 + 128 * wc + 32 * q + 8 * fq;
        const u32x4 gp = *(const u32x4*)(gate + (size_t)row * 1024 + col);
        const f32x4 g0 = {bflo(gp.x), bfhi(gp.x), bflo(gp.y), bfhi(gp.y)}, g1 = {bflo(gp.z), bfhi(gp.z), bflo(gp.w), bfhi(gp.w)};
        const f32x4 v0 = *(const f32x4*)(x + (size_t)row * 1024 + col) + acc[m][2 * q] * g0;
        const f32x4 v1 = *(const f32x4*)(x + (size_t)row * 1024 + col + 4) + acc[m][2 * q + 1] * g1;
        *(f32x4*)(x + (size_t)row * 1024 + col) = v0;
        *(f32x4*)(x + (size_t)row * 1024 + col + 4) = v1;
        if (layer == 0) {
          u32x4 o = {pk2(v0.x, v0.y), pk2(v0.z, v0.w), pk2(v1.x, v1.y), pk2(v1.z, v1.w)};
          *(u32x4*)(xb + (size_t)row * 1024 + col) = o;
        }
        s += v0.x * v0.x + v0.y * v0.y + v0.z * v0.z + v0.w * v0.w + v1.x * v1.x + v1.y * v1.y + v1.z * v1.z + v1.w * v1.w;
      }
      s += __shfl_xor(s, 16); s += __shfl_xor(s, 32);
      if (fq == 0 && layer == 0) atomicAdd(ssn + row, s);
      __builtin_amdgcn_sched_barrier(0);
    }
  }
}

DI void phase_in_o(const P& p, int qi, unsigned char* smem, int tid) {
  GEMM_IDS
  const bf16_t* xb = (const bf16_t*)(p.ws + OFF_XB); const bf16_t* wt = (const bf16_t*)(p.ws + OFF_WT_INO);
  const float* ssc = (const float*)(p.ws + OFF_SS) + 3 * NTOK;
  bf16_t* qkv = (bf16_t*)(p.ws + OFF_QKV); float* gb = (float*)(p.ws + OFF_GB);
  const float* a_log = p.in[10]; const float* dt_bias = p.in[11];
  for (int i = blockIdx.x; i < 64 * 13; i += gridDim.x) {
    int mt, nt; tile_decode(i, 64, 13, mt, nt);
    const int mq0 = mt * 128, m0 = qi * 8192 + mq0, n0 = nt * 256;
    const bf16_t* pa = xb + (size_t)(m0 + lrow) * 1024;
    f32x4 acc[4][8]; zero_acc8(acc);
    gemm_core(acc, pa, pa + 64 * 1024, wt + (size_t)(n0 + permrow(lrow)) * 1024, 64 * 1024, 32, smem, tid);
    EPI_IDS
#pragma unroll
    for (int m = 0; m < 4; ++m) {
      const int rl = 64 * wr + 16 * m + fr;
      const float rs = rsqrtf(ssc[m0 + rl] * (1.f / 1024.f) + EPSF);
      if (nt < 12) {
#pragma unroll
        for (int q = 0; q < 4; ++q) {
          const int col = n0 + 128 * wc + 32 * q + 8 * fq;
          const f32x4 v0 = acc[m][2 * q] * rs, v1 = acc[m][2 * q + 1] * rs;
          u32x4 o = {pk2(v0.x, v0.y), pk2(v0.z, v0.w), pk2(v1.x, v1.y), pk2(v1.z, v1.w)};
          *(u32x4*)(qkv + (size_t)(mq0 + rl) * 3072 + col) = o;
        }
      } else if (wc == 0 && fq < 2) {
        const f32x4 v0 = acc[m][0] * rs, v1 = acc[m][1] * rs;
        float o[8];
#pragma unroll
        for (int j = 0; j < 8; ++j) {
          const float vv = j < 4 ? v0[j] : v1[j - 4];
          if (fq == 0) o[j] = sigmoidf_(vv);
          else {
            const float xx = vv + dt_bias[j];
            const float sp = fmaxf(xx, 0.f) + log1pf(__expf(-fabsf(xx)));
            o[j] = -__expf(a_log[j]) * sp;
          }
        }
        float* gp = gb + (size_t)(m0 + rl) * 16 + 8 * fq;
        *(f32x4*)gp = (f32x4){o[0], o[1], o[2], o[3]}; *(f32x4*)(gp + 4) = (f32x4){o[4], o[5], o[6], o[7]};
      }
    }
  }
}

DI void phase_z_gate(const P& p, unsigned char* smem, int tid) {
  GEMM_IDS
  const bf16_t* xb = (const bf16_t*)(p.ws + OFF_XB); const bf16_t* wt = (const bf16_t*)(p.ws + OFF_WT_Z);
  const float* ssc = (const float*)(p.ws + OFF_SS) + 3 * NTOK;
  const bf16_t* ob_in = (const bf16_t*)(p.ws + OFF_UT);
  bf16_t* ob = (bf16_t*)(p.ws + OFF_OB);
  const float* nw = p.in[12];
  for (int i = blockIdx.x; i < 256 * 4; i += gridDim.x) {
    int mt, nt; tile_decode(i, 256, 4, mt, nt);
    const int m0 = mt * 128, n0 = nt * 256;
    const bf16_t* pa = xb + (size_t)(m0 + lrow) * 1024;
    f32x4 acc[4][8]; zero_acc8(acc);
    gemm_core(acc, pa, pa + 64 * 1024, wt + (size_t)(n0 + permrow(lrow)) * 1024, 64 * 1024, 32, smem, tid);
    EPI_IDS
    const int hd = 2 * nt + wc;
#pragma unroll
    for (int m = 0; m < 4; ++m) {
      const int row = m0 + 64 * wr + 16 * m + fr;
      const int chunk = ((row >> 12) * 8 + hd) * 64 + ((row & 4095) >> 6);
      const bf16_t* op = ob_in + (size_t)chunk * 8192 + (row & 63) * 64 + 8 * fq;
      u32x4 ov[4];
      float s = 0.f;
#pragma unroll
      for (int q = 0; q < 4; ++q) {
        ov[q] = *(const u32x4*)(op + (q >> 1) * 4096 + 32 * (q & 1));
        const float a0 = bflo(ov[q].x), a1 = bfhi(ov[q].x), a2 = bflo(ov[q].y), a3 = bfhi(ov[q].y), a4 = bflo(ov[q].z), a5 = bfhi(ov[q].z), a6 = bflo(ov[q].w), a7 = bfhi(ov[q].w);
        s += a0 * a0 + a1 * a1 + a2 * a2 + a3 * a3 + a4 * a4 + a5 * a5 + a6 * a6 + a7 * a7;
      }
      s += __shfl_xor(s, 16); s += __shfl_xor(s, 32);
      const float on = rsqrtf(s * (1.f / 128.f) + EPSF);
      const float rs = rsqrtf(ssc[row] * (1.f / 1024.f) + EPSF);
#pragma unroll
      for (int q = 0; q < 4; ++q) {
        const int cl = 32 * q + 8 * fq;
        const f32x4 z0 = acc[m][2 * q] * rs, z1 = acc[m][2 * q + 1] * rs;
        const f32x4 w0 = *(const f32x4*)(nw + cl), w1 = *(const f32x4*)(nw + cl + 4);
        const f32x4 o0 = {bflo(ov[q].x), bfhi(ov[q].x), bflo(ov[q].y), bfhi(ov[q].y)}, o1 = {bflo(ov[q].z), bfhi(ov[q].z), bflo(ov[q].w), bfhi(ov[q].w)};
        float r[8];
#pragma unroll
        for (int j = 0; j < 4; ++j) { r[j] = o0[j] * on * w0[j] * siluf_(z0[j]); r[4 + j] = o1[j] * on * w1[j] * siluf_(z1[j]); }
        u32x4 o = {pk2(r[0], r[1]), pk2(r[2], r[3]), pk2(r[4], r[5]), pk2(r[6], r[7])};
        *(u32x4*)(ob + (size_t)row * 1024 + n0 + 128 * wc + cl) = o;
      }
      __builtin_amdgcn_sched_barrier(0);
    }
  }
}

#ifndef DUMMY_MODE
#define DUMMY_MODE -1
#endif
DI void phase_dummy(const P& p, int mode, unsigned char* smem, int tid) {
  GEMM_IDS
  const bf16_t* xb = (const bf16_t*)(p.ws + OFF_XB);
  const bf16_t* wg = (const bf16_t*)(p.ws + OFF_WT_PLEG);
  for (int i = blockIdx.x; i < 256 * 4; i += gridDim.x) {
    int mt, nt; tile_decode(i, 256, 4, mt, nt);
    if (mode == 1) { mt = 0; nt = 0; }
    if (mode == 2) { mt = blockIdx.x & 255; nt = 0; }
    const int m0 = mt * 128, n0 = nt * 256;
    const bf16_t* pa = xb + (size_t)(m0 + lrow) * 1024;
    f32x4 acc[4][8]; zero_acc8(acc);
    gemm_core(acc, pa, pa + 64 * 1024, wg + (size_t)(n0 + lrow) * 1024, 64 * 1024, 32, smem, tid);
    EPI_IDS
    float s = 0.f;
#pragma unroll
    for (int m = 0; m < 4; ++m)
#pragma unroll
      for (int n = 0; n < 8; ++n) s += acc[m][n].x + acc[m][n].y + acc[m][n].z + acc[m][n].w;
    if (s == 123456.789f) ((float*)(p.ws + OFF_GL))[0] = s;
  }
}

DI void attn_item(const P& p, int item, unsigned char* smem, int tid) {
  const int lane = tid & 63, w = tid >> 6, r = lane & 31, hh = lane >> 5;
  const int bh = item & 63, jj = item >> 6;
  int qb; { const int a = jj & 7, grp = jj >> 3; qb = grp == 0 ? 31 - a : grp == 1 ? 16 + a : grp == 2 ? 15 - a : a; }
  const int b = bh >> 3, h = bh & 7;
  const int q0 = qb * 128, qw = q0 + 32 * w;
  const bf16_t* proj = (const bf16_t*)(p.ws + OFF_PROJ0);
  const bf16_t* vT = (const bf16_t*)(p.ws + OFF_VT) + (size_t)bh * 64 * 4096;
  bf16x8 qf[4];
  {
    const bf16_t* qp = proj + (size_t)(b * 4096 + qw + r) * 1536 + 512 + h * 64 + 8 * hh;
#pragma unroll
    for (int s = 0; s < 4; ++s) qf[s] = *(const bf16x8*)(qp + 16 * s);
  }
  f32x16 oacc[2];
#pragma unroll
  for (int i = 0; i < 16; ++i) { oacc[0][i] = 0.f; oacc[1][i] = 0.f; }
  float carry = 0.f;
  const int ntile = q0 / 64 + 2;
  const int lrow = tid >> 3, lc = tid & 7;
  const bf16_t* kbase = proj + (size_t)(b * 4096 + lrow) * 1536 + 1024 + h * 64 + 8 * lc;
  const bf16_t* vbase = vT + (size_t)lrow * 4096 + 8 * lc;
  unsigned char* sK = smem;
  unsigned char* sV = smem + 16384;
  const int kst = lrow * 128 + ((lc ^ (lrow & 7)) << 4);
  const int vst = lrow * 136 + lc * 16;
  u32x4 rk[2], rv[2];
  int kt = ntile - 1;
#pragma unroll
  for (int i = 0; i < 2; ++i) { rk[i] = *(const u32x4*)(kbase + (size_t)(kt * 64 + 32 * i) * 1536); rv[i] = *(const u32x4*)(vbase + (size_t)(32 * i) * 4096 + kt * 64); }
  __syncthreads();
#pragma unroll
  for (int i = 0; i < 2; ++i) {
    *(u32x4*)(sK + kst + i * 4096) = rk[i];
    *(u32x2*)(sV + vst + i * 4352) = (u32x2){rv[i].x, rv[i].y}; *(u32x2*)(sV + vst + i * 4352 + 8) = (u32x2){rv[i].z, rv[i].w};
  }
  __syncthreads();
  int cur = 0;
  for (; kt >= 0; --kt) {
    if (kt > 0) {
#pragma unroll
      for (int i = 0; i < 2; ++i) { rk[i] = *(const u32x4*)(kbase + (size_t)((kt - 1) * 64 + 32 * i) * 1536); rv[i] = *(const u32x4*)(vbase + (size_t)(32 * i) * 4096 + (kt - 1) * 64); }
    }
    const unsigned char* cK = sK + cur * 8192; const unsigned char* cV = sV + cur * 8704;
    const int s0 = kt * 64;
#pragma unroll
    for (int sub = 1; sub >= 0; --sub) {
      const int ks = s0 + 32 * sub;
      if (ks <= qw) {
        f32x16 sc;
#pragma unroll
        for (int i = 0; i < 16; ++i) sc[i] = 0.f;
#pragma unroll
        for (int s = 0; s < 4; ++s) {
          const bf16x8 kf = *(const bf16x8*)(cK + (32 * sub + r) * 128 + (((2 * s + hh) ^ (r & 7)) << 4));
          sc = mfma32(kf, qf[s], sc);
        }
        float sp[16], ls[16];
#pragma unroll
        for (int i = 0; i < 16; ++i) {
          const float z = sc[i];
          sp[i] = flog2(1.f + fexp2(z));
          ls[i] = z - sp[i];
        }
        if (ks == qw) {
#pragma unroll
          for (int i = 0; i < 16; ++i) { const bool valid = crow(i, hh) < r; sp[i] = valid ? sp[i] : 0.f; ls[i] = valid ? ls[i] : -1e30f; }
        }
        float G[4], Pp[4], Tt[4];
#pragma unroll
        for (int g = 0; g < 4; ++g) { G[g] = (sp[4 * g] + sp[4 * g + 1]) + (sp[4 * g + 2] + sp[4 * g + 3]); Pp[g] = __shfl_xor(G[g], 32); Tt[g] = G[g] + Pp[g]; }
        float after = carry;
        f32x16 av;
#pragma unroll
        for (int g = 3; g >= 0; --g) {
          float base = after + (hh == 0 ? Pp[g] : 0.f);
          float k3 = base, k2 = k3 + sp[4 * g + 3], k1 = k2 + sp[4 * g + 2], k0 = k1 + sp[4 * g + 1];
          av[4 * g + 3] = fexp2(ls[4 * g + 3] - k3); av[4 * g + 2] = fexp2(ls[4 * g + 2] - k2);
          av[4 * g + 1] = fexp2(ls[4 * g + 1] - k1); av[4 * g + 0] = fexp2(ls[4 * g + 0] - k0);
          after += Tt[g];
        }
        carry = after;
#pragma unroll
        for (int s = 0; s < 2; ++s) {
          const bf16x8 ap = pack_step(av, s);
#pragma unroll
          for (int dt = 0; dt < 2; ++dt) {
            const unsigned char* vp = cV + (32 * dt + r) * 136 + (32 * sub + 16 * s + 4 * hh) * 2;
            const bf16x8 vf = mk8(*(const u32x2*)vp, *(const u32x2*)(vp + 16));
            oacc[dt] = mfma32(vf, ap, oacc[dt]);
          }
        }
      }
    }
    if (kt > 0) {
      unsigned char* nK = sK + (cur ^ 1) * 8192; unsigned char* nV = sV + (cur ^ 1) * 8704;
#pragma unroll
      for (int i = 0; i < 2; ++i) {
        *(u32x4*)(nK + kst + i * 4096) = rk[i];
        *(u32x2*)(nV + vst + i * 4352) = (u32x2){rv[i].x, rv[i].y}; *(u32x2*)(nV + vst + i * 4352 + 8) = (u32x2){rv[i].z, rv[i].w};
      }
    }
    int* flg = (int*)(smem + 34816) + 4 * cur;
    { const bool wdone = (__ballot(carry < 160.f) == 0ull); if (lane == 0) flg[w] = wdone ? 1 : 0; }
    __syncthreads();
    if (flg[0] + flg[1] + flg[2] + flg[3] == 4) break;
    cur ^= 1;
  }
  bf16_t* cat = (bf16_t*)(p.ws + OFF_CAT) + (size_t)(b * 4096 + qw + r) * 1024 + 512 + h * 64;
#pragma unroll
  for (int dt = 0; dt < 2; ++dt)
#pragma unroll
    for (int g = 0; g < 4; ++g) {
      u32x2 o = {pk2(oacc[dt][4 * g], oacc[dt][4 * g + 1]), pk2(oacc[dt][4 * g + 2], oacc[dt][4 * g + 3])};
      *(u32x2*)(cat + 32 * dt + 8 * g + 4 * hh) = o;
    }
}

DI void pool_item(const P& p, int item, unsigned char* smem, int tid) {
  const int lane = tid & 63, wid = tid >> 6, wr = wid >> 1, wc = wid & 1, fr = lane & 15, fq = lane >> 4; const int lrow = tid >> 3, lc = tid & 7; (void)lane;
  const int g = item & 3, mt = item >> 2;
  const int m0 = mt * 128;
  const bf16_t* proj = (const bf16_t*)(p.ws + OFF_PROJ0);
  const bf16_t* wt = (const bf16_t*)(p.ws + OFF_WT_POOL) + (size_t)g * 128 * 128;
  unsigned char* sA = smem; unsigned char* sB = smem + 32768;
  __syncthreads();
  {
    const int st_off = lrow * 128 + ((lc ^ (lrow & 7)) << 4);
#pragma unroll
    for (int kt = 0; kt < 2; ++kt)
#pragma unroll
      for (int i = 0; i < 4; ++i) *(u32x4*)(sB + kt * 16384 + st_off + i * 4096) = *(const u32x4*)(wt + (size_t)(lrow + 32 * i) * 128 + kt * 64 + 8 * lc);
  }
  {
    const int c8 = tid & 15, rg = tid >> 4;
    const int r0 = 8 * rg;
    const int w = 2 << g;
    const int tb = (m0 & 4095) + r0;
    const bf16_t* up = proj + (size_t)(m0 - (m0 & 4095)) * 1536 + g * 128 + 8 * c8;
    u32x4 v[23];
#pragma unroll
    for (int j = 0; j < 23; ++j) {
      const int t = tb - 15 + j;
      v[j] = (u32x4){0u, 0u, 0u, 0u};
      if (t >= 0 && j >= 16 - w) v[j] = *(const u32x4*)(up + (size_t)t * 1536);
    }
    float md[16];
#pragma unroll
    for (int d = 0; d < 16; ++d) md[d] = (d >= 16 - w) ? 1.f : 0.f;
#pragma unroll
    for (int i = 0; i < 8; ++i) {
      float s[8];
#pragma unroll
      for (int e = 0; e < 8; ++e) s[e] = 0.f;
#pragma unroll
      for (int d = 0; d < 16; ++d) {
        const u32x4 x = v[i + d]; const float m = md[d];
        s[0] += m * bflo(x.x); s[1] += m * bfhi(x.x); s[2] += m * bflo(x.y); s[3] += m * bfhi(x.y);
        s[4] += m * bflo(x.z); s[5] += m * bfhi(x.z); s[6] += m * bflo(x.w); s[7] += m * bfhi(x.w);
      }
      const int t = tb + i; const int cnt = (t + 1 < w) ? (t + 1) : w;
      const float inv = 1.f / (float)cnt;
      const u32x4 xc = v[15 + i];
      const float y0 = s[0] * inv - bflo(xc.x), y1 = s[1] * inv - bfhi(xc.x), y2 = s[2] * inv - bflo(xc.y), y3 = s[3] * inv - bfhi(xc.y);
      const float y4 = s[4] * inv - bflo(xc.z), y5 = s[5] * inv - bfhi(xc.z), y6 = s[6] * inv - bflo(xc.w), y7 = s[7] * inv - bfhi(xc.w);
      const int lr = r0 + i;
      u32x4 o = {pk2(y0, y1), pk2(y2, y3), pk2(y4, y5), pk2(y6, y7)};
      *(u32x4*)(sA + (c8 >> 3) * 16384 + lr * 128 + (((c8 & 7) ^ (lr & 7)) << 4)) = o;
    }
  }
  __syncthreads();
  f32x4 acc[4][4]; zero_acc(acc);
  const int a_rd = (64 * wr + fr) * 128, b_rd = (64 * wc + fr) * 128;
  const int sw0 = (fq ^ (fr & 7)) << 4, sw1 = ((4 + fq) ^ (fr & 7)) << 4;
  mma_stage(acc, sA, sB, a_rd, b_rd, sw0, sw1);
  mma_stage(acc, sA + 16384, sB + 16384, a_rd, b_rd, sw0, sw1);
  const float* psc = p.in[5] + g * 128;
  bf16_t* cat = (bf16_t*)(p.ws + OFF_CAT);
#pragma unroll
  for (int m = 0; m < 4; ++m) {
    const int row = m0 + 64 * wr + 16 * m + fr;
#pragma unroll
    for (int n = 0; n < 4; ++n) {
      const int cl = 64 * wc + 16 * n + 4 * fq;
      const f32x4 s4 = *(const f32x4*)(psc + cl);
      const f32x4 v = acc[m][n] * s4;
      u32x2 o = {pk2(v.x, v.y), pk2(v.z, v.w)};
      *(u32x2*)(cat + (size_t)row * 1024 + g * 128 + cl) = o;
    }
  }
}


template <int I> struct SolveRow {
  static DI void run(float (&sol)[64], const float* A_v) {
    float s = sol[I];
#pragma unroll
    for (int g8 = 0; g8 < (I + 31) / 32; ++g8) {
      f32x4 a[8];
#pragma unroll
      for (int q = 0; q < 8; ++q) if (32 * g8 + 4 * q < I) a[q] = *(const f32x4*)(A_v + I * 68 + 32 * g8 + 4 * q);
#pragma unroll
      for (int q = 0; q < 8; ++q) {
        const int j = 32 * g8 + 4 * q;
        if (j + 0 < I) s -= a[q].x * sol[j + 0];
        if (j + 1 < I) s -= a[q].y * sol[j + 1];
        if (j + 2 < I) s -= a[q].z * sol[j + 2];
        if (j + 3 < I) s -= a[q].w * sol[j + 3];
      }
      __builtin_amdgcn_sched_barrier(0);
    }
    sol[I] = s;
    SolveRow<I + 1>::run(sol, A_v);
  }
};
template <> struct SolveRow<64> { static DI void run(float (&)[64], const float*) {} };

constexpr int GD_RAW = 0, GD_Q = 18224, GD_K = GD_Q + 17408, GD_V = GD_K + 17408, GD_GC = GD_V + 17408, GD_BETA = GD_GC + 256, GD_CW = GD_BETA + 256;
DI void gdn_chunk_item(const P& p, int qi, int item, unsigned char* smem, int tid) {
  const int lane = tid & 63, w = tid >> 6, r = lane & 31, hh = lane >> 5;
  const int h = item & 7, n = (item >> 3) & 63, bq = item >> 9;
  const int b = 2 * qi + bq;
  const int chunk = (b * 8 + h) * 64 + n;
  const bf16_t* qkv = (const bf16_t*)(p.ws + OFF_QKV) + (size_t)(bq * 4096) * 3072;
  const float* gb = (const float*)(p.ws + OFF_GB);
  const float* cw = p.in[9];
  float* gc_s = (float*)(smem + GD_GC); float* beta_s = (float*)(smem + GD_BETA);
  __syncthreads();
  u32x4 rawr[5]; float cwr[2];
#define GD_LOADP(PP) do { \
    _Pragma("unroll") for (int i = 0; i < 5; ++i) { const int idx = tid + 256 * i; const int rr_ = idx >> 4, c_ = idx & 15; const int t_ = 64 * n - 3 + rr_; \
      rawr[i] = (u32x4){0u, 0u, 0u, 0u}; if (idx < 1072 && t_ >= 0) rawr[i] = *(const u32x4*)(qkv + (size_t)t_ * 3072 + (PP) * 1024 + h * 128 + 8 * c_); } \
    _Pragma("unroll") for (int i = 0; i < 2; ++i) { const int idx = tid + 256 * i; cwr[i] = cw[(size_t)(idx >> 7) * 3072 + (PP) * 1024 + h * 128 + (idx & 127)]; } \
  } while (0)
  GD_LOADP(0);
  if (w == 0) {
    const int tok = b * 4096 + 64 * n + lane;
    float g = gb[(size_t)tok * 16 + 8 + h]; const float be = gb[(size_t)tok * 16 + h];
#pragma unroll
    for (int off = 1; off < 64; off <<= 1) { const float t = __shfl_up(g, off); if (lane >= off) g += t; }
    gc_s[lane] = g; beta_s[lane] = be;
  }
#pragma unroll 1
  for (int pp = 0; pp < 3; ++pp) {
#pragma unroll
    for (int i = 0; i < 5; ++i) { const int idx = tid + 256 * i; if (idx < 1072) *(u32x4*)(smem + GD_RAW + (idx >> 4) * 272 + 16 * (idx & 15)) = rawr[i]; }
#pragma unroll
    for (int i = 0; i < 2; ++i) ((float*)(smem + GD_CW))[tid + 256 * i] = cwr[i];
    __syncthreads();
    if (pp < 2) GD_LOADP(pp + 1);
    {
      const int row = tid >> 2, qtr = tid & 3; const int ch0 = 32 * qtr;
      float y[32];
#pragma unroll
      for (int sub = 0; sub < 4; ++sub) {
        float a[8];
#pragma unroll
        for (int e = 0; e < 8; ++e) a[e] = 0.f;
#pragma unroll
        for (int tap = 0; tap < 4; ++tap) {
          const u32x4 xv = *(const u32x4*)(smem + GD_RAW + (row + tap) * 272 + (ch0 + 8 * sub) * 2);
          const float* wp = (const float*)(smem + GD_CW) + tap * 128 + ch0 + 8 * sub;
          const f32x4 w0 = *(const f32x4*)wp, w1 = *(const f32x4*)(wp + 4);
          a[0] += w0.x * bflo(xv.x); a[1] += w0.y * bfhi(xv.x); a[2] += w0.z * bflo(xv.y); a[3] += w0.w * bfhi(xv.y);
          a[4] += w1.x * bflo(xv.z); a[5] += w1.y * bfhi(xv.z); a[6] += w1.z * bflo(xv.w); a[7] += w1.w * bfhi(xv.w);
        }
#pragma unroll
        for (int e = 0; e < 8; ++e) y[8 * sub + e] = siluf_(a[e]);
        __builtin_amdgcn_sched_barrier(0);
      }
      if (pp < 2) {
        float s = 0.f;
#pragma unroll
        for (int e = 0; e < 32; ++e) s += y[e] * y[e];
        s += __shfl_xor(s, 1); s += __shfl_xor(s, 2);
        const float inv = rsqrtf(s + EPSF) * (pp == 0 ? 0.08838834764831845f : 1.f);
#pragma unroll
        for (int e = 0; e < 32; ++e) y[e] *= inv;
      }
      unsigned char* dst = smem + (pp == 0 ? GD_Q : pp == 1 ? GD_K : GD_V) + row * 272 + ch0 * 2;
#pragma unroll
      for (int sub = 0; sub < 4; ++sub) {
        u32x4 o = {pk2(y[8 * sub], y[8 * sub + 1]), pk2(y[8 * sub + 2], y[8 * sub + 3]), pk2(y[8 * sub + 4], y[8 * sub + 5]), pk2(y[8 * sub + 6], y[8 * sub + 7])};
        *(u32x4*)(dst + 16 * sub) = o;
      }
    }
    __syncthreads();
  }
  float* A_s = (float*)(smem + GD_RAW);
  bf16_t* qkb = (bf16_t*)(p.ws + OFF_QK) + (size_t)chunk * 4096;
  {
    const int ti = w >> 1, tj = w & 1;
    const int j = 32 * tj + r;
    if (ti == 0 && tj == 1) {
#pragma unroll
      for (int reg = 0; reg < 16; ++reg) qkb[(32 * ti + crow(reg, hh)) * 64 + j] = 0;
    } else {
      f32x16 kk, qk;
#pragma unroll
      for (int i = 0; i < 16; ++i) { kk[i] = 0.f; qk[i] = 0.f; }
#pragma unroll
      for (int s = 0; s < 8; ++s) {
        const bf16x8 bfrag = *(const bf16x8*)(smem + GD_K + (32 * tj + r) * 272 + (16 * s + 8 * hh) * 2);
        const bf16x8 akf = *(const bf16x8*)(smem + GD_K + (32 * ti + r) * 272 + (16 * s + 8 * hh) * 2);
        const bf16x8 aqf = *(const bf16x8*)(smem + GD_Q + (32 * ti + r) * 272 + (16 * s + 8 * hh) * 2);
        kk = mfma32(akf, bfrag, kk); qk = mfma32(aqf, bfrag, qk);
      }
      const float gcj = gc_s[j];
#pragma unroll
      for (int reg = 0; reg < 16; ++reg) {
        const int i = 32 * ti + crow(reg, hh);
        const float dec = (i >= j) ? __expf(gc_s[i] - gcj) : 0.f;
        A_s[i * 68 + j] = (i > j) ? beta_s[i] * kk[reg] * dec : 0.f;
        qkb[i * 64 + j] = f2bf((i >= j) ? qk[reg] * dec : 0.f);
      }
    }
  }
  __syncthreads();
  {
    const int col = tid; const bool isw = col >= 128; const int d = col & 127;
    int vz; asm volatile("v_mov_b32 %0, 0" : "=v"(vz));
    const float* A_v = A_s + vz; const float* gc_v = gc_s + vz; const float* beta_v = beta_s + vz;
    const unsigned char* src = smem + (isw ? GD_K : GD_V) + d * 2;
    float sol[64];
#pragma unroll
    for (int i = 0; i < 64; ++i) {
      float v = bf2f(*(const bf16_t*)(src + i * 272)) * beta_v[i];
      if (isw) v *= __expf(gc_v[i]);
      sol[i] = v;
    }
    SolveRow<1>::run(sol, A_v);
    __syncthreads();
    if (!isw) {
      bf16_t* ut = (bf16_t*)(p.ws + OFF_UT) + (size_t)chunk * 8192 + d * 64;
#pragma unroll
      for (int c8 = 0; c8 < 8; ++c8) {
        u32x4 o = {pk2(sol[8 * c8], sol[8 * c8 + 1]), pk2(sol[8 * c8 + 2], sol[8 * c8 + 3]), pk2(sol[8 * c8 + 4], sol[8 * c8 + 5]), pk2(sol[8 * c8 + 6], sol[8 * c8 + 7])};
        *(u32x4*)(ut + 8 * c8) = o;
      }
      unsigned char* qp = smem + GD_Q + d * 2;
#pragma unroll
      for (int i = 0; i < 64; ++i) { const float v = bf2f(*(const bf16_t*)(qp + i * 272)) * __expf(gc_v[i]); *(bf16_t*)(qp + i * 272) = f2bf(v); }
    } else {
      unsigned char* wp = smem + GD_V + d * 2;
#pragma unroll
      for (int i = 0; i < 64; ++i) *(bf16_t*)(wp + i * 272) = f2bf(-sol[i]);
      bf16_t* kd = (bf16_t*)(p.ws + OFF_KD) + (size_t)chunk * 8192 + d * 64;
      const float gl = gc_v[63];
#pragma unroll
      for (int c8 = 0; c8 < 8; ++c8) {
        float kv[8];
#pragma unroll
        for (int e = 0; e < 8; ++e) kv[e] = bf2f(*(const bf16_t*)(smem + GD_K + (8 * c8 + e) * 272 + d * 2)) * __expf(gl - gc_v[8 * c8 + e]);
        u32x4 o = {pk2(kv[0], kv[1]), pk2(kv[2], kv[3]), pk2(kv[4], kv[5]), pk2(kv[6], kv[7])};
        *(u32x4*)(kd + 8 * c8) = o;
      }
    }
    if (tid == 0) ((float*)(p.ws + OFF_GL))[chunk] = __expf(gc_s[63]);
    __syncthreads();
    {
      bf16_t* wn = (bf16_t*)(p.ws + OFF_WN) + (size_t)chunk * 8192;
      bf16_t* qd = (bf16_t*)(p.ws + OFF_QD) + (size_t)chunk * 8192;
#pragma unroll 1
      for (int i = 0; i < 4; ++i) {
        const int idx = tid + 256 * i; const int lo = (idx >> 4) * 272 + (idx & 15) * 16;
        *(u32x4*)(wn + (size_t)idx * 8) = *(const u32x4*)(smem + GD_V + lo);
        *(u32x4*)(qd + (size_t)idx * 8) = *(const u32x4*)(smem + GD_Q + lo);
      }
    }
  }
}

constexpr int SC_W = 0, SC_QD = 17408, SC_QK = 34816, SC_KD = 34816 + 9216, SC_U = 34816 + 9216 + 18432;
DI bf16x8 pack44(const f32x4& a, const f32x4& b) { u32x4 v = {pk2(a.x, a.y), pk2(a.z, a.w), pk2(b.x, b.y), pk2(b.z, b.w)}; return __builtin_bit_cast(bf16x8, v); }
DI void scan_item(const P& p, int item, unsigned char* smem, int tid) {
  const int lane = tid & 63, w = tid >> 6, fr = lane & 15, fq = lane >> 4;
  const int bh = item >> 1, hf = item & 1;
  const bf16_t* WN = (const bf16_t*)(p.ws + OFF_WN); const bf16_t* QD = (const bf16_t*)(p.ws + OFF_QD);
  const bf16_t* KD = (const bf16_t*)(p.ws + OFF_KD); const bf16_t* QK = (const bf16_t*)(p.ws + OFF_QK);
  bf16_t* UT = (bf16_t*)(p.ws + OFF_UT) + hf * 4096; const float* GL = (const float*)(p.ws + OFF_GL);
  f32x4 S[8];
#pragma unroll
  for (int dt = 0; dt < 8; ++dt) S[dt] = (f32x4){0.f, 0.f, 0.f, 0.f};
  u32x4 st[16];
  const int chunk0 = bh * 64;
#define SC_LOAD(CH) do { \
    const size_t cb = (size_t)(CH) * 8192; \
    _Pragma("unroll") for (int i = 0; i < 4; ++i) { st[i] = *(const u32x4*)(WN + cb + (size_t)(tid + 256 * i) * 8); st[4 + i] = *(const u32x4*)(QD + cb + (size_t)(tid + 256 * i) * 8); st[10 + i] = *(const u32x4*)(KD + cb + (size_t)(tid + 256 * i) * 8); } \
    _Pragma("unroll") for (int i = 0; i < 2; ++i) { st[8 + i] = *(const u32x4*)(QK + (size_t)(CH) * 4096 + (size_t)(tid + 256 * i) * 8); st[14 + i] = *(const u32x4*)(UT + cb + (size_t)(tid + 256 * i) * 8); } \
  } while (0)
#define SC_STORE() do { \
    _Pragma("unroll") for (int i = 0; i < 4; ++i) { const int idx = tid + 256 * i; const int o16 = (idx >> 4) * 272 + (idx & 15) * 16; *(u32x4*)(smem + SC_W + o16) = st[i]; *(u32x4*)(smem + SC_QD + o16) = st[4 + i]; \
      const int o8 = (idx >> 3) * 144 + (idx & 7) * 16; *(u32x4*)(smem + SC_KD + o8) = st[10 + i]; } \
    _Pragma("unroll") for (int i = 0; i < 2; ++i) { const int idx = tid + 256 * i; const int o8 = (idx >> 3) * 144 + (idx & 7) * 16; *(u32x4*)(smem + SC_QK + o8) = st[8 + i]; *(u32x4*)(smem + SC_U + o8) = st[14 + i]; } \
  } while (0)
  SC_LOAD(chunk0);
  __syncthreads();
  for (int n = 0; n < 64; ++n) {
    const int chunk = chunk0 + n;
    SC_STORE();
    __syncthreads();
    if (n + 1 < 64) SC_LOAD(chunk + 1);
    f32x4 vn[4];
#pragma unroll
    for (int ct = 0; ct < 4; ++ct) { const u32x2 u = *(const u32x2*)(smem + SC_U + (16 * w + fr) * 144 + (16 * ct + 4 * fq) * 2); vn[ct] = (f32x4){bflo(u.x), bfhi(u.x), bflo(u.y), bfhi(u.y)}; }
    const float gl = GL[chunk];
    bf16x8 Sp[4];
#pragma unroll
    for (int kk = 0; kk < 4; ++kk) Sp[kk] = pack44(S[2 * kk], S[2 * kk + 1]);
#pragma unroll
    for (int ct = 0; ct < 4; ++ct)
#pragma unroll
      for (int kk = 0; kk < 4; ++kk) {
        const unsigned char* ap = smem + SC_W + (16 * ct + fr) * 272 + (32 * kk + 4 * fq) * 2;
        vn[ct] = mfma16(mk8(*(const u32x2*)ap, *(const u32x2*)(ap + 32)), Sp[kk], vn[ct]);
      }
    bf16x8 vp[2];
    vp[0] = pack44(vn[0], vn[1]); vp[1] = pack44(vn[2], vn[3]);
#pragma unroll
    for (int ct = 0; ct < 4; ++ct) {
      f32x4 o = {0.f, 0.f, 0.f, 0.f};
#pragma unroll
      for (int kk = 0; kk < 4; ++kk) {
        const unsigned char* ap = smem + SC_QD + (16 * ct + fr) * 272 + (32 * kk + 4 * fq) * 2;
        o = mfma16(mk8(*(const u32x2*)ap, *(const u32x2*)(ap + 32)), Sp[kk], o);
      }
#pragma unroll
      for (int kc = 0; kc < 2; ++kc) {
        const unsigned char* ap = smem + SC_QK + (16 * ct + fr) * 144 + (32 * kc + 4 * fq) * 2;
        o = mfma16(mk8(*(const u32x2*)ap, *(const u32x2*)(ap + 32)), vp[kc], o);
      }
      bf16_t* op = UT + (size_t)chunk * 8192 + (size_t)(16 * ct + 4 * fq) * 64 + 16 * w + fr;
      op[0] = f2bf(o.x); op[64] = f2bf(o.y); op[128] = f2bf(o.z); op[192] = f2bf(o.w);
    }
#pragma unroll
    for (int dt = 0; dt < 8; ++dt) {
      S[dt] = S[dt] * gl;
#pragma unroll
      for (int kc = 0; kc < 2; ++kc) {
        const unsigned char* ap = smem + SC_KD + (16 * dt + fr) * 144 + (32 * kc + 4 * fq) * 2;
        S[dt] = mfma16(mk8(*(const u32x2*)ap, *(const u32x2*)(ap + 32)), vp[kc], S[dt]);
      }
    }
    __syncthreads();
  }
}

DI void phase_final(const P& p, int tid) {
  const int lane = tid & 63, wid = tid >> 6;
  float* x = p.out; const float* g = p.in[21];
  for (int row = blockIdx.x * 4 + wid; row < NTOK; row += gridDim.x * 4) {
    f32x4 v[4]; float s = 0.f;
#pragma unroll
    for (int i = 0; i < 4; ++i) { v[i] = *(const f32x4*)(x + (size_t)row * 1024 + 256 * i + 4 * lane); s += v[i].x * v[i].x + v[i].y * v[i].y + v[i].z * v[i].z + v[i].w * v[i].w; }
#pragma unroll
    for (int off = 32; off > 0; off >>= 1) s += __shfl_xor(s, off);
    const float rs = rsqrtf(s * (1.f / 1024.f) + EPSF);
#pragma unroll
    for (int i = 0; i < 4; ++i) { const f32x4 gg = *(const f32x4*)(g + 256 * i + 4 * lane); *(f32x4*)(x + (size_t)row * 1024 + 256 * i + 4 * lane) = v[i] * rs * gg; }
  }
}


#define XB_TMO      128
#define XB_XCNT(j)  (256  + 64 * (j))
#define XB_XSUB(j)  (1280 + 64 * (j))
#define XB_XGEN(j)  (2304 + 64 * (j))
#define XB_TOP      3328
#define XB_TOPGEN   3392
#define XCD_BAR_WORDS 3456
#define XB_SPIN_CAP (1u << 18)
#define LAS __attribute__((address_space(3)))
DI unsigned xb_ld(unsigned* p)              { return __hip_atomic_load(p, __ATOMIC_RELAXED, __HIP_MEMORY_SCOPE_AGENT); }
DI unsigned xb_add(unsigned* p, unsigned v) { return __hip_atomic_fetch_add(p, v, __ATOMIC_RELAXED, __HIP_MEMORY_SCOPE_AGENT); }
DI unsigned xb_xcc_id() { return (unsigned)__builtin_amdgcn_s_getreg((3 << 11) | 20) & 0xFu; }
#define XB_SPIN(cond, bar) do { unsigned _sp = 0; while (cond) { __builtin_amdgcn_s_sleep(1); \
    if ((++_sp & 255u) == 0u) { if (xb_ld(&(bar)[XB_TMO])) break; if (_sp > XB_SPIN_CAP) { atomicAdd(&(bar)[XB_TMO], 1u); break; } } } } while (0)
struct XcdBarrier { unsigned* bar; unsigned x; volatile LAS unsigned* st; };
DI XcdBarrier xcd_barrier_post(unsigned* bar, volatile LAS unsigned* st) {
  XcdBarrier b; b.bar = bar; b.x = xb_xcc_id(); b.st = st;
  if (threadIdx.x == 0) (void)xb_add(&bar[XB_XCNT(b.x)], 1u);
  return b;
}
DI void xcd_barrier_complete(unsigned* bar, unsigned x, unsigned& nloc, unsigned& nx) {
  const unsigned G = gridDim.x * gridDim.y * gridDim.z;
  unsigned sum, cnt, mine, sp = 0u;
  for (;;) {
    sum = 0u; cnt = 0u; mine = 0u;
#pragma unroll
    for (unsigned j = 0; j < 16; ++j) { const unsigned c = xb_ld(&bar[XB_XCNT(j)]); sum += c; cnt += (c > 0u) ? 1u : 0u; mine = (j == x) ? c : mine; }
    if (sum == G) break;
    __builtin_amdgcn_s_sleep(1);
    if ((++sp & 255u) == 0u) { if (xb_ld(&bar[XB_TMO])) break; if (sp > XB_SPIN_CAP) { atomicAdd(&bar[XB_TMO], 1u); break; } }
  }
  nloc = mine > 0u ? mine : 1u; nx = cnt > 0u ? cnt : 1u;
}
DI void xcd_barrier(const XcdBarrier& b) {
  asm volatile("s_waitcnt vmcnt(0)" ::: "memory");
  __syncthreads();
  if (threadIdx.x == 0) {
    unsigned* bar = b.bar;
    unsigned bx = b.x;
    asm volatile("" : "+s"(bar), "+s"(bx));
    __builtin_amdgcn_s_waitcnt(0);
    unsigned nloc = b.st[0], nx = b.st[1];
    if (nloc == 0u) { xcd_barrier_complete(bar, bx, nloc, nx); b.st[0] = nloc; b.st[1] = nx; }
    const unsigned old = xb_add(&bar[XB_XSUB(bx)], 1u);
    const unsigned gen = old / nloc;
    if (old + 1u == (gen + 1u) * nloc) {
      __builtin_amdgcn_fence(__ATOMIC_RELEASE, "agent");
      asm volatile("s_waitcnt vmcnt(0)" ::: "memory");
      const unsigned og = xb_add(&bar[XB_TOP], 1u);
      const unsigned tg = og / nx;
      if (og + 1u == (tg + 1u) * nx) xb_add(&bar[XB_TOPGEN], 1u);
      else XB_SPIN(xb_ld(&bar[XB_TOPGEN]) == tg, bar);
      __builtin_amdgcn_fence(__ATOMIC_ACQUIRE, "agent");
      xb_add(&bar[XB_XGEN(bx)], 1u);
      asm volatile("s_waitcnt vmcnt(0)" ::: "memory");
    } else {
      XB_SPIN(xb_ld(&bar[XB_XGEN(bx)]) == gen, bar);
      __builtin_amdgcn_fence(__ATOMIC_ACQUIRE, "agent");
      asm volatile("s_waitcnt vmcnt(0)" ::: "memory");
    }
  }
  __syncthreads();
}

constexpr int N_PHASES = 24;
typedef const __attribute__((address_space(4))) P* KP;
DI P loadP(KP kp) {
  P p;
#pragma unroll
  for (int i = 0; i < 22; ++i) p.in[i] = kp->in[i];
  p.out = kp->out; p.ws = kp->ws;
  return p;
}
#define SSP(k) ((float*)(p.ws + OFF_SS) + (k) * NTOK)
#define PH_BEGIN { KP kp = (KP)__builtin_amdgcn_kernarg_segment_ptr(); asm volatile("" : "+s"(kp)); \
    unsigned zz_; asm volatile("v_mov_b32 %0, 0" : "=v"(zz_)); \
    int tid = wbase + (int)__builtin_amdgcn_mbcnt_hi(~0u, __builtin_amdgcn_mbcnt_lo(~0u, zz_)); asm volatile("" : "+v"(tid)); \
    const P p = loadP(kp);
#define PH_END } xcd_barrier(xb);

__global__ void __launch_bounds__(256, 2) mega(P p_arg, int ph_lo, int ph_hi) {
  extern __shared__ __attribute__((aligned(16))) unsigned char smem[];
  __shared__ uint4 xb_words;
  cg::grid_group grid = cg::this_grid();
  if (threadIdx.x == 0) xb_words = make_uint4(0u, 0u, 0u, 0u);
  __syncthreads();
  const int wbase = __builtin_amdgcn_readfirstlane((int)(threadIdx.x & ~63u));
  XcdBarrier xb = xcd_barrier_post((unsigned*)(p_arg.ws + OFF_BAR), (volatile LAS unsigned*)&xb_words);
  if (ph_hi < 0) grid.sync();

  PH_BEGIN phase_prologue(p, smem, tid); PH_END
#if REP_PHASE == 0
  PH_BEGIN phase_prologue(p, smem, tid); PH_END
#endif
#pragma unroll 1
  for (int layer = 0; layer < 2; ++layer) {
    if (layer == 0) {
      PH_BEGIN phase_in_e(p, smem, tid); PH_END
      PH_BEGIN for (int i = blockIdx.x; i < 2048 + 1024; i += gridDim.x) { if (i < 2048) attn_item(p, i, smem, tid); else pool_item(p, i - 2048, smem, tid); } PH_END
#if REP_PHASE == 2
      PH_BEGIN for (int i = blockIdx.x; i < 2048 + 1024; i += gridDim.x) { if (i < 2048) attn_item(p, i, smem, tid); else pool_item(p, i - 2048, smem, tid); } PH_END
#endif
    } else {
#pragma unroll 1
      for (int qi = 0; qi < 4; ++qi) {
        PH_BEGIN
          phase_in_o(p, qi, smem, tid);
          {
            const int G = (int)gridDim.x; const int idle0 = (832 % G == 0 || G >= 832) ? (G >= 832 ? 832 : G) : 832 % G;
            const int g0 = 736 * qi, g1 = 736 * qi + 736;
            if (idle0 < G) { if ((int)blockIdx.x >= idle0) convert_list(p, (float*)smem, tid, 1, g0, g1, (int)blockIdx.x - idle0, G - idle0); }
            else convert_list(p, (float*)smem, tid, 1, g0, g1, (int)blockIdx.x, G);
          }
        PH_END
        PH_BEGIN for (int i = blockIdx.x; i < 1024; i += gridDim.x) gdn_chunk_item(p, qi, i, smem, tid); PH_END
#if REP_PHASE == 9
        if (qi == 0) { PH_BEGIN for (int i = blockIdx.x; i < 1024; i += gridDim.x) gdn_chunk_item(p, qi, i, smem, tid); PH_END }
#endif
      }
      PH_BEGIN for (int i = blockIdx.x; i < 128; i += gridDim.x) scan_item(p, i, smem, tid); PH_END
      PH_BEGIN phase_z_gate(p, smem, tid); PH_END
    }
    PH_BEGIN
      phase_resid(p, (const bf16_t*)(p.ws + (layer ? OFF_OB : OFF_CAT)), 1024, (const bf16_t*)(p.ws + (layer ? OFF_WT_OUTO : OFF_WT_OUTE)), layer ? p.out : p.in[0], SSP(1 + 3 * layer), smem, tid);
    PH_END
    PH_BEGIN phase_ffn_up(p, layer, SSP(1 + 3 * layer), smem, tid); PH_END
#if REP_PHASE == 4
    if (layer == 0) { PH_BEGIN phase_ffn_up(p, layer, SSP(1 + 3 * layer), smem, tid); PH_END }
#endif
    PH_BEGIN phase_resid(p, (const bf16_t*)(p.ws + OFF_ACT), 2816, (const bf16_t*)(p.ws + OFF_WT_DOWN) + (size_t)layer * 1024 * 2816, p.out, SSP(2 + 3 * layer), smem, tid); PH_END
    PH_BEGIN phase_ple_gate(p, layer, SSP(2 + 3 * layer), smem, tid); PH_END
#if REP_PHASE == 6
    if (layer == 0) { PH_BEGIN phase_ple_gate(p, layer, SSP(2 + 3 * layer), smem, tid); PH_END }
#endif
    PH_BEGIN phase_ple_add(p, layer, SSP(3 + 3 * layer), smem, tid); PH_END
  }
#if DUMMY_MODE >= 0
  PH_BEGIN phase_dummy(p, DUMMY_MODE, smem, tid); PH_END
#endif
  PH_BEGIN phase_final(p, tid); }
}

extern "C" void kernel_launch(void* const* d_in, const int* in_sizes, int n_in, void* d_out, int out_size, void* d_ws, size_t ws_size, hipStream_t stream) {
  static int grid_blocks = 0;
  if (!grid_blocks) {
    int dev = 0, cus = 0, per_cu = 0;
    hipGetDevice(&dev);
    hipDeviceGetAttribute(&cus, hipDeviceAttributeMultiprocessorCount, dev);
    hipFuncSetAttribute((const void*)mega, hipFuncAttributeMaxDynamicSharedMemorySize, SMEM_BYTES);
    hipOccupancyMaxActiveBlocksPerMultiprocessor(&per_cu, mega, 256, SMEM_BYTES);
    if (per_cu > 2) per_cu = 2;
    if (per_cu < 1) per_cu = 1;
    grid_blocks = cus * per_cu;
  }
  P p{};
  for (int i = 0; i < 22; ++i) p.in[i] = (const float*)d_in[i];
  p.out = (float*)d_out;
  p.ws = (unsigned char*)d_ws;
  hipMemsetAsync(p.ws + OFF_BAR, 0, XCD_BAR_WORDS * 4, stream);
#if MULTI_LAUNCH
  for (int ph = 0; ph < N_PHASES; ++ph) {
    int lo = ph, hi = ph + 1;
    void* args[] = {&p, &lo, &hi};
    hipError_t e = hipLaunchCooperativeKernel((const void*)mega, dim3(grid_blocks), dim3(256), args, SMEM_BYTES, stream);
    if (e != hipSuccess) fprintf(stderr, "launch failed: %s\n", hipGetErrorString(e));
  }
#else
  int lo = 0, hi = N_PHASES;
  void* args[] = {&p, &lo, &hi};
  hipError_t e = hipLaunchCooperativeKernel((const void*)mega, dim3(grid_blocks), dim3(256), args, SMEM_BYTES, stream);
  if (e != hipSuccess) fprintf(stderr, "launch failed: %s (grid %d)\n", hipGetErrorString(e), grid_blocks);
#endif
}
```
